# Optimizing an MI355X kernel written in HIP

```python
import math
import jax, jax.numpy as jnp
from jax import lax
import numpy as np

D_MODEL = 1024
BATCH = 16
SEQ = 4096
DEPTH = 4

CHUNK = 64
Q_BLOCK = 128
HEAD_DIM = 64
N_BRANCH = 4
D_BRANCH = D_MODEL // 4
D_CONV = D_BRANCH
CONV_WIDTH = 31
D_POOL = D_BRANCH
POOL_WINDOWS = (2, 4, 8, 16)
POOL_GROUP = D_POOL // len(POOL_WINDOWS)
SB_HEADS = D_BRANCH // HEAD_DIM
RET_HEADS = D_BRANCH // HEAD_DIM
XA_HEADS = 4
D_XA = XA_HEADS * HEAD_DIM
N_MEM = 256
D_FF = 2816
N_EXPERTS = 8
TOP_K = 2
ROPE_THETA = 10000.0
EPS = 1e-6
IN_SPLITS = (2 * D_CONV, 2 * D_CONV + D_POOL, 2 * D_CONV + D_POOL + 3 * D_BRANCH)
D_IN = 2 * D_CONV + D_POOL + 3 * D_BRANCH + 4 * D_BRANCH

kernel_name = 'hybrid_conv_pool_stickbreak_retention_moe_trunk'


def _rms_norm(x, g):
    xf = x.astype(jnp.float32)
    y = xf * lax.rsqrt(jnp.mean(xf * xf, axis=-1, keepdims=True) + EPS)
    return (y * g.astype(jnp.float32)).astype(x.dtype)


def _layer_norm(x, g, b):
    xf = x.astype(jnp.float32)
    xc = xf - jnp.mean(xf, axis=-1, keepdims=True)
    y = xc * lax.rsqrt(jnp.mean(xc * xc, axis=-1, keepdims=True) + EPS)
    return (y * g.astype(jnp.float32) + b.astype(jnp.float32)).astype(x.dtype)


def _head_norm(x):
    xc = x - jnp.mean(x, axis=-1, keepdims=True)
    return xc * lax.rsqrt(jnp.mean(xc * xc, axis=-1, keepdims=True) + EPS)


def _rotary(x, positions):
    half = x.shape[-1] // 2
    inv_freq = ROPE_THETA ** (-jnp.arange(half, dtype=jnp.float32) / half)
    ang = positions.astype(jnp.float32)[:, :, None, None] * inv_freq
    cos, sin = jnp.cos(ang), jnp.sin(ang)
    x1, x2 = x[..., :half], x[..., half:]
    return jnp.concatenate([x1 * cos - x2 * sin, x1 * sin + x2 * cos], axis=-1)


def _swiglu(h, w_gu, w_down):
    g, u = jnp.split(h @ w_gu, 2, axis=-1)
    return (jax.nn.silu(g) * u) @ w_down


def _conformer_conv(u, conv_w, conv_b, ln_g, ln_b):
    a, g = jnp.split(u, 2, axis=-1)
    v = a * jax.nn.sigmoid(g)
    v = lax.conv_general_dilated(
        v, conv_w.astype(v.dtype)[:, None, :], window_strides=(1,),
        padding=[(CONV_WIDTH - 1, 0)], dimension_numbers=('NWC', 'WIO', 'NWC'),
        feature_group_count=D_CONV) + conv_b
    return jax.nn.silu(_layer_norm(v, ln_g, ln_b))


def _multiscale_pool(u, pool_w, pool_scale):
    B, S, _ = u.shape
    uf = u.astype(jnp.float32)
    cs = jnp.pad(jnp.cumsum(uf, axis=1), ((0, 0), (1, 0), (0, 0)))
    t = jnp.arange(S, dtype=jnp.float32)[None, :, None]
    diffs = []
    for gi, w in enumerate(POOL_WINDOWS):
        sl = slice(gi * POOL_GROUP, (gi + 1) * POOL_GROUP)
        c = cs[:, :, sl]
        lower = jnp.pad(c, ((0, 0), (w - 1, 0), (0, 0)))[:, :S]
        mean = (c[:, 1:] - lower) / jnp.minimum(t + 1.0, float(w))
        diffs.append(mean - uf[:, :, sl])
    d = jnp.stack(diffs, axis=2).astype(u.dtype)
    y = jnp.einsum('bsgc,gcd->bsgd', d, pool_w).reshape(B, S, D_POOL)
    return y * pool_scale


def _stick_breaking(q, k, v):
    B, S, H, Dh = q.shape
    scale = Dh ** -0.5
    outs = []
    for qs in range(0, S, Q_BLOCK):
        qe = qs + Q_BLOCK
        z = jnp.einsum('bqhd,bkhd->bhqk', q[:, qs:qe], k[:, :qe]).astype(jnp.float32) * scale
        t_idx = qs + jnp.arange(Q_BLOCK)[:, None]
        s_idx = jnp.arange(qe)[None, :]
        mask = s_idx < t_idx
        log_1m = jnp.where(mask, jax.nn.log_sigmoid(-z), 0.0)
        tail = lax.cumsum(log_1m, axis=log_1m.ndim - 1, reverse=True) - log_1m
        a = jnp.where(mask, jnp.exp(jax.nn.log_sigmoid(z) + tail), 0.0)
        outs.append(jnp.einsum('bhqk,bkhd->bqhd', a.astype(v.dtype), v[:, :qe]))
    return jnp.concatenate(outs, axis=1)


def _retention(q, k, v, g, positions, gammas):
    B, S, _ = q.shape
    nc = S // CHUNK
    hs = (B, S, RET_HEADS, HEAD_DIM)
    cs = (B, nc, CHUNK, RET_HEADS, HEAD_DIM)
    q = _rotary(q.astype(jnp.float32).reshape(hs), positions).reshape(cs)
    k = (_rotary(k.astype(jnp.float32).reshape(hs), positions) * HEAD_DIM ** -0.5).reshape(cs)
    v = v.astype(jnp.float32).reshape(cs)
    log_g = jnp.log(gammas)
    idx = jnp.arange(CHUNK, dtype=jnp.float32)
    rel = idx[:, None] - idx[None, :]
    decay = jnp.where(rel >= 0, jnp.exp(jnp.maximum(rel, 0.0) * log_g[:, None, None]), 0.0)
    inner = jnp.einsum('bcnhd,bcmhd->bchnm', q, k) * decay
    inner = jnp.einsum('bchnm,bcmhd->bcnhd', inner, v)
    zeta = jnp.exp((CHUNK - 1 - idx)[:, None] * log_g)
    xi = jnp.exp((idx + 1.0)[:, None] * log_g)
    g_chunk = jnp.exp(CHUNK * log_g)
    kv = jnp.einsum('bcmhd,bcmhe->bchde', k * zeta[:, :, None], v)

    def step(state, inp):
        q_c, kv_c = inp
        cross = jnp.einsum('bnhd,bhde->bnhe', q_c, state)
        return state * g_chunk[:, None, None] + kv_c, cross

    state0 = jnp.zeros((B, RET_HEADS, HEAD_DIM, HEAD_DIM), jnp.float32)
    _, cross = lax.scan(step, state0, (jnp.moveaxis(q * xi[:, :, None], 1, 0), jnp.moveaxis(kv, 1, 0)))
    o = (inner + jnp.moveaxis(cross, 0, 1)).reshape(hs)
    o = _head_norm(o).reshape(B, S, D_BRANCH)
    return (jax.nn.silu(g.astype(jnp.float32)) * o).astype(g.dtype)


def _memory_cross_attention(h, m, wq, wkv, gq, gk, wo):
    B, S, _ = h.shape
    M = m.shape[1]
    q = _rms_norm((h @ wq).reshape(B, S, XA_HEADS, HEAD_DIM), gq)
    k, v = jnp.split(m @ wkv, 2, axis=-1)
    k = _rms_norm(k.reshape(B, M, XA_HEADS, HEAD_DIM), gk)
    v = v.reshape(B, M, XA_HEADS, HEAD_DIM)
    s = jnp.einsum('bshd,bmhd->bhsm', q, k).astype(jnp.float32) * HEAD_DIM ** -0.5
    p = jax.nn.softmax(s, axis=-1).astype(v.dtype)
    o = jnp.einsum('bhsm,bmhd->bshd', p, v).reshape(B, S, D_XA)
    return o @ wo


def _moe_swiglu(h, router, w_gu, w_down):
    B, S, D = h.shape
    t = h.reshape(B * S, D)
    logits = (t @ router).astype(jnp.float32)
    top_val, top_idx = lax.top_k(logits, TOP_K)
    w = jax.nn.softmax(top_val, axis=-1)
    combine = jnp.einsum('tk,tke->te', w, jax.nn.one_hot(top_idx, N_EXPERTS, dtype=jnp.float32)).astype(t.dtype)
    y = jnp.zeros_like(t)
    for e in range(N_EXPERTS):
        y = y + combine[:, e:e + 1] * _swiglu(t, w_gu[e], w_down[e])
    return y.reshape(B, S, D)


def setup_inputs(seed: int = 0) -> dict:
    key = jax.random.key(seed)
    ks = jax.random.split(key, 32)
    nd, nm = (DEPTH + 1) // 2, DEPTH // 2

    def nrm(k, shape, scale):
        return jax.random.normal(k, shape, jnp.float32) * scale

    def gain(k, shape):
        return 1.0 + 0.02 * jax.random.normal(k, shape, jnp.float32)

    x = nrm(ks[0], (BATCH, SEQ, D_MODEL), 1.0)
    mem = nrm(ks[1], (BATCH, N_MEM, D_MODEL), 1.0)
    offset = jax.random.randint(ks[2], (BATCH, 1), 0, 8192, dtype=jnp.int32)
    positions = (offset + jnp.arange(SEQ, dtype=jnp.int32)[None, :]).astype(jnp.int32)
    return {
        'x': x,
        'mem': mem,
        'positions': positions,
        'norm_mix_g': gain(ks[3], (DEPTH, D_MODEL)),
        'w_in': nrm(ks[4], (DEPTH, D_MODEL, D_IN), D_MODEL ** -0.5),
        'conv_w': nrm(ks[5], (DEPTH, CONV_WIDTH, D_CONV), CONV_WIDTH ** -0.5),
        'conv_b': nrm(ks[6], (DEPTH, D_CONV), 0.02),
        'conv_ln_g': gain(ks[7], (DEPTH, D_CONV)),
        'conv_ln_b': nrm(ks[8], (DEPTH, D_CONV), 0.02),
        'pool_w': nrm(ks[9], (DEPTH, len(POOL_WINDOWS), POOL_GROUP, POOL_GROUP), POOL_GROUP ** -0.5),
        'pool_scale': gain(ks[10], (DEPTH, D_POOL)),
        'w_gate': nrm(ks[11], (DEPTH, N_BRANCH, D_MODEL, D_MODEL), D_MODEL ** -0.5),
        'w_branch': nrm(ks[12], (DEPTH, N_BRANCH, D_BRANCH, D_MODEL), D_BRANCH ** -0.5),
        'w_out': nrm(ks[13], (DEPTH, D_MODEL, D_MODEL), D_MODEL ** -0.5),
        'norm_xa_g': gain(ks[14], (DEPTH, D_MODEL)),
        'norm_mem_g': gain(ks[15], (DEPTH, D_MODEL)),
        'xa_wq': nrm(ks[16], (DEPTH, D_MODEL, D_XA), D_MODEL ** -0.5),
        'xa_wkv': nrm(ks[17], (DEPTH, D_MODEL, 2 * D_XA), D_MODEL ** -0.5),
        'xa_q_norm_g': gain(ks[18], (DEPTH, HEAD_DIM)),
        'xa_k_norm_g': gain(ks[19], (DEPTH, HEAD_DIM)),
        'xa_wo': nrm(ks[20], (DEPTH, D_XA, D_MODEL), D_XA ** -0.5),
        'norm_ffn_g': gain(ks[21], (DEPTH, D_MODEL)),
        'ffn_w_gu': nrm(ks[22], (nd, D_MODEL, 2 * D_FF), D_MODEL ** -0.5),
        'ffn_w_down': nrm(ks[23], (nd, D_FF, D_MODEL), D_FF ** -0.5),
        'moe_router': nrm(ks[24], (nm, D_MODEL, N_EXPERTS), D_MODEL ** -0.5),
        'moe_w_gu': nrm(ks[25], (nm, N_EXPERTS, D_MODEL, 2 * D_FF), D_MODEL ** -0.5),
        'moe_w_down': nrm(ks[26], (nm, N_EXPERTS, D_FF, D_MODEL), D_FF ** -0.5),
    }


def reference(x, mem, positions, norm_mix_g, w_in, conv_w, conv_b, conv_ln_g, conv_ln_b,
              pool_w, pool_scale, w_gate, w_branch, w_out, norm_xa_g, norm_mem_g,
              xa_wq, xa_wkv, xa_q_norm_g, xa_k_norm_g, xa_wo, norm_ffn_g,
              ffn_w_gu, ffn_w_down, moe_router, moe_w_gu, moe_w_down):
    B, S, _ = x.shape
    gammas = 1.0 - jnp.exp2(-5.0 - jnp.arange(RET_HEADS, dtype=jnp.float32))
    for l in range(DEPTH):
        h = _rms_norm(x, norm_mix_g[l])
        u_conv, u_pool, u_sb, u_ret = jnp.split(h @ w_in[l], IN_SPLITS, axis=-1)
        y_conv = _conformer_conv(u_conv, conv_w[l], conv_b[l], conv_ln_g[l], conv_ln_b[l])
        y_pool = _multiscale_pool(u_pool, pool_w[l], pool_scale[l])
        q_sb, k_sb, v_sb = [t.reshape(B, S, SB_HEADS, HEAD_DIM) for t in jnp.split(u_sb, 3, axis=-1)]
        y_sb = _stick_breaking(q_sb, k_sb, v_sb).reshape(B, S, D_BRANCH)
        q_r, k_r, v_r, g_r = jnp.split(u_ret, 4, axis=-1)
        y_ret = _retention(q_r, k_r, v_r, g_r, positions, gammas)
        branches = (y_conv, y_pool, y_sb, y_ret)
        merged = jax.nn.sigmoid(h @ w_gate[l, 0]) * (branches[0].astype(x.dtype) @ w_branch[l, 0])
        for i in range(1, N_BRANCH):
            merged = merged + jax.nn.sigmoid(h @ w_gate[l, i]) * (branches[i].astype(x.dtype) @ w_branch[l, i])
        x = x + merged @ w_out[l]
        x = x + _memory_cross_attention(_rms_norm(x, norm_xa_g[l]), _rms_norm(mem, norm_mem_g[l]),
                                        xa_wq[l], xa_wkv[l], xa_q_norm_g[l], xa_k_norm_g[l], xa_wo[l])
        h = _rms_norm(x, norm_ffn_g[l])
        if l % 2 == 0:
            x = x + _swiglu(h, ffn_w_gu[l // 2], ffn_w_down[l // 2])
        else:
            x = x + _moe_swiglu(h, moe_router[l // 2], moe_w_gu[l // 2], moe_w_down[l // 2])
    return x
```

```cpp
#include <hip/hip_runtime.h>
#include <cstdio>
#include <cstdint>

#define DI __device__ __forceinline__
#define LAS __attribute__((address_space(3)))
#define GAS __attribute__((address_space(1)))
typedef unsigned short bf16;
typedef short bf16x8 __attribute__((ext_vector_type(8)));
typedef short s16x4 __attribute__((ext_vector_type(4)));
typedef float f32x2 __attribute__((ext_vector_type(2)));
typedef float f32x4 __attribute__((ext_vector_type(4)));
typedef float f32x16 __attribute__((ext_vector_type(16)));
typedef unsigned u32x2 __attribute__((ext_vector_type(2)));
typedef unsigned u32x4 __attribute__((ext_vector_type(4)));
typedef __bf16 bf16x2_t __attribute__((ext_vector_type(2)));
typedef GAS unsigned gu32;
typedef int i32x8 __attribute__((ext_vector_type(8)));
#ifndef FFN_FP8_MASK
#define FFN_FP8_MASK 0xE
#endif
constexpr float W8_SCALE = 64.f, W8_INV = 1.f / 64.f;

constexpr int NB = 16, SEQ = 4096, D = 1024, DEPTH = 4, NG = 2, BG = NB / NG, MG = BG * SEQ, MTOT = NB * SEQ;
constexpr int DIN = 2560, NCAT = DIN + 4096, DFF = 2816, NGU = 2 * DFF, NEXP = 8, NMEM = 256, MMEM = NB * NMEM;
constexpr int MOE_SLOTS = 2 * MG + NEXP * 256;
constexpr float EPS = 1e-6f;
constexpr int NWAVES = 8, NTHR = 512;
constexpr int UC_CA = 0, UC_CG = 256, UC_POOL = 512, UC_SBQ = 768, UC_SBK = 1024, UC_SBV = 1280, UC_RQ = 1536, UC_RK = 1792, UC_RV = 2048, UC_RG = 2304;
constexpr int YC_CONV = 0, YC_POOL = 256, YC_SB = 512, YC_RET = 768;

constexpr size_t MiB = 1u << 20;
constexpr size_t WS_CTL = 0, CTL_ZERO_BYTES = 1 * MiB;
constexpr size_t WS_WCAT = 1 * MiB;
constexpr size_t WS_WB = 53 * MiB;
constexpr size_t WS_WOUT = 61 * MiB;
constexpr size_t WS_WQ = 69 * MiB;
constexpr size_t WS_WKV = 71 * MiB;
constexpr size_t WS_WO = 75 * MiB;
constexpr size_t WS_WGUD = 77 * MiB;
constexpr size_t WS_WDND = 99 * MiB;
constexpr size_t WS_WGUM = 110 * MiB;
constexpr size_t WS_WDNM = 286 * MiB;
constexpr size_t WS_ROT = 374 * MiB;
constexpr size_t WS_MEMH = 390 * MiB;
constexpr size_t WS_KV = 422 * MiB;
constexpr size_t WS_HB = 438 * MiB;
constexpr size_t WS_U = 502 * MiB;
constexpr size_t WS_GATES = 662 * MiB;
constexpr size_t WS_Y = 918 * MiB;
constexpr size_t WS_MERGED = 982 * MiB;
constexpr size_t WS_QB = 1046 * MiB;
constexpr size_t WS_OB = 1062 * MiB;
constexpr size_t WS_ROUTE = 1078 * MiB;
constexpr size_t WS_KVS = 1079 * MiB;
constexpr size_t WS_END = 1087 * MiB;
constexpr size_t WS_ACT = WS_U, WS_HP = WS_Y;
static_assert((size_t)MOE_SLOTS * DFF * 2 <= WS_Y - WS_U, "act overlay");
static_assert((size_t)MOE_SLOTS * D * 2 <= WS_ROUTE - WS_Y, "hp overlay");
constexpr int CW_TMO = 0, CW_CODE = 1;
constexpr int CW_BAR = 4096;
constexpr int CW_QCTR = 8192;
constexpr int CW_KMAX = 10240;
constexpr int CW_MOFF = 10752;
constexpr int CW_WGCNT = 16384;

constexpr int RING_BYTES = 131072;
constexpr int LDSCTL_OFF = RING_BYTES, MISC_OFF = LDSCTL_OFF + 320;
constexpr int LDS_BYTES = 147456;
constexpr int KS = 72, VS = 264;
constexpr int L_KS = 0, L_VT = 36864, L_KT = 70656, L_ST = 104448;

#define SHX(x, m, lane) __builtin_bit_cast(float, __builtin_amdgcn_ds_bpermute((((lane) ^ (m)) << 2), __builtin_bit_cast(int, (float)(x))))
DI float wave_sum(float v, int lane) {
#pragma unroll
    for (int o = 1; o < 64; o <<= 1) v += SHX(v, o, lane);
    return v;
}
DI unsigned cvtpk(float lo, float hi) { f32x2 v = {lo, hi}; bf16x2_t b = __builtin_convertvector(v, bf16x2_t); return __builtin_bit_cast(unsigned, b); }
DI float bflo(unsigned w) { return __uint_as_float(w << 16); }
DI float bfhi(unsigned w) { return __uint_as_float(w & 0xffff0000u); }
DI void unpack8(const u32x4 w, float (&f)[8]) { f[0] = bflo(w.x); f[1] = bfhi(w.x); f[2] = bflo(w.y); f[3] = bfhi(w.y); f[4] = bflo(w.z); f[5] = bfhi(w.z); f[6] = bflo(w.w); f[7] = bfhi(w.w); }
DI u32x4 pack8(const float (&f)[8]) { u32x4 w; w.x = cvtpk(f[0], f[1]); w.y = cvtpk(f[2], f[3]); w.z = cvtpk(f[4], f[5]); w.w = cvtpk(f[6], f[7]); return w; }
DI unsigned cvt4_fp8(float a, float b, float c, float d) { int w = __builtin_amdgcn_cvt_pk_fp8_f32(a, b, 0, false); w = __builtin_amdgcn_cvt_pk_fp8_f32(c, d, w, true); return (unsigned)w; }
DI float fexp2(float x) { return __builtin_amdgcn_exp2f(x); }
DI float frcp(float x) { return __builtin_amdgcn_rcpf(x); }
DI float sigmoid_f(float x) { return frcp(1.f + fexp2(-1.44269504f * x)); }
DI int lane_id() { int l; asm volatile("v_mbcnt_lo_u32_b32 %0, -1, 0\n\tv_mbcnt_hi_u32_b32 %0, -1, %0" : "=v"(l)); return l; }
DI int crow(int reg, int h) { return (reg & 3) + 8 * (reg >> 2) + 4 * h; }
#define MFMA32(a, b, c) __builtin_amdgcn_mfma_f32_32x32x16_bf16((a), (b), (c), 0, 0, 0)

__device__ const float INV_FREQ[32] = {1.0f, 0.7498942017555237f, 0.5623413324356079f, 0.4216965138912201f, 0.3162277638912201f, 0.23713737726211548f, 0.17782793939113617f, 0.1333521455526352f,
    0.10000000149011612f, 0.0749894231557846f, 0.05623413249850273f, 0.04216964915394783f, 0.03162277489900589f, 0.023713737726211548f, 0.017782794311642647f, 0.013335213996469975f,
    0.009999999776482582f, 0.007498942315578461f, 0.005623413249850273f, 0.0042169648222625256f, 0.003162277629598975f, 0.0023713738191872835f, 0.0017782794311642647f, 0.0013335214462131262f,
    0.0010000000474974513f, 0.0007498941849917173f, 0.000562341301701963f, 0.0004216965171508491f, 0.0003162277571391314f, 0.00023713737027719617f, 0.00017782794020604342f, 0.0001333521504420787f};

namespace pg8 {
constexpr int BM = 256, BK = 64, HALF = 128, HTB = HALF * BK * 2, STAGE_BYTES = 8 * HTB, NXCD = 8, WGM = 8;
__host__ __device__ __forceinline__ int lds_byte(int r, int c) { const int st = (r >> 4) * 2 + (c >> 5), rr = r & 15, cc = c & 31, ob = rr * 64 + cc * 2; return st * 1024 + (ob ^ (((ob >> 9) & 1) << 5)); }
__host__ __device__ __forceinline__ void stage_rc(int b, int& R, int& C) { const int st = b / 1024, sb = b % 1024, swz = sb ^ (((sb >> 9) & 1) << 5); R = (st >> 1) * 16 + swz / 64; C = (st & 1) * 32 + (swz % 64) / 2; }
__host__ __device__ __forceinline__ int perm32(int rho) { const int n = rho >> 4, i = rho & 15; return 8 * (i >> 2) + 4 * n + (i & 3); }

struct Unit { int pm, pn, z; const char* a; const char* b; };
DI const char* uni(const char* p) { const unsigned long long v = (unsigned long long)p; const unsigned lo = __builtin_amdgcn_readfirstlane((unsigned)v), hi = __builtin_amdgcn_readfirstlane((unsigned)(v >> 32)); return (const char*)(((unsigned long long)hi << 32) | lo); }

struct TileOrder {
    int nM, nN, nwg, G, c;
    DI void init(int nM_, int nN_, int G_, int c_) { nM = nM_; nN = nN_; nwg = nM * nN; G = G_; c = c_; }
    DI bool tile(int i, int& pm, int& pn) const {
        const long L = (long)i * G + c; if (L >= nwg) return false;
        int wgid = (int)L; { const int q = nwg / NXCD, r = nwg % NXCD, xcd = wgid % NXCD, off = wgid / NXCD; wgid = (xcd < r ? xcd * (q + 1) : r * (q + 1) + (xcd - r) * q) + off; }
        const int nig = WGM * nN, gid = wgid / nig, fm = gid * WGM, gsz = (nM - fm) < WGM ? (nM - fm) : WGM;
        pm = fm + ((wgid % nig) % gsz); pn = (wgid % nig) / gsz; return true;
    }
};

template <class Epi, class Sched, bool F8 = false>
DI void gemm_phase(LAS unsigned char* lds, const int K, const int lda, const Sched& S, const Epi& E, const int wid_in) {
    int wid = wid_in; asm volatile("" : "+s"(wid));
    int lane = lane_id(); asm volatile("" : "+v"(lane));
    const int tid = wid * 64 + lane, wr = wid >> 2, wc = wid & 3, fr = lane & 15, fq = lane >> 4;
    constexpr int ESZ = F8 ? 1 : 2; const int nt = (K * ESZ) / (BK * 2);
    unsigned voffA, voffB;
    { int R, C; stage_rc(tid * 16, R, C); const int Rb = Epi::PERM ? ((R & ~31) + perm32(R & 31)) : R;
      voffA = (unsigned)(R * lda * ESZ + C * 2); voffB = (unsigned)(Rb * K * ESZ + C * 2); }
    const size_t i1voffA = (size_t)64 * lda * ESZ, i1voffB = (size_t)64 * K * ESZ;
    const size_t kstep = (size_t)(BK * 2);
    const size_t hstepA = (size_t)HALF * lda * ESZ, hstepB = (size_t)HALF * K * ESZ;
    const unsigned ldsw = (unsigned)wid * 1024u;
    constexpr int PIECE = F8 ? 16 : 1024;
    const int aoff = lds_byte(wr * 64 + fr, F8 ? fq * 16 : fq * 8), boff = lds_byte(wc * 32 + fr, F8 ? fq * 16 : fq * 8);
#define PG8_SA(b, h) (((b) * 2 + (h)) * HTB)
#define PG8_SB(b, h) ((4 + (b) * 2 + (h)) * HTB)
#define PG8_STAGE(bufoff, gbase, voff) do { _Pragma("unroll") for (int _i = 0; _i < 2; ++_i) { asm volatile("" : "+v"(voff));     \
        __builtin_amdgcn_global_load_lds((const GAS unsigned*)((const GAS char*)(gbase) + (_i ? i1##voff : (size_t)0) + voff), (LAS unsigned*)(lds + (bufoff) + ldsw + _i * 8192), 16, 0, 0); } } while (0)
#define PG8_LD16(off) (*(const LAS u32x4*)(lds + (off)))
#define PG8_LD16B(off) (*(const LAS u32x4*)(ldsB + (off)))
#define PG8_SBR(b, h) (((b) * 2 + (h)) * HTB)
#define PG8_LDA(dst, b, h) do { _Pragma("unroll") for (int m = 0; m < 4; ++m) { if constexpr (F8) dst##8[m] = __builtin_bit_cast(i32x8, __builtin_shufflevector(PG8_LD16(PG8_SA(b, h) + aoff + m * 2048), PG8_LD16(PG8_SA(b, h) + aoff + PIECE + m * 2048), 0, 1, 2, 3, 4, 5, 6, 7)); \
        else { _Pragma("unroll") for (int k = 0; k < 2; ++k) dst[m][k] = *(const LAS bf16x8*)(lds + PG8_SA(b, h) + aoff + k * PIECE + m * 2048); } } } while (0)
#define PG8_LDB(dst, b, h) do { _Pragma("unroll") for (int n = 0; n < 2; ++n) { if constexpr (F8) dst##8[n] = __builtin_bit_cast(i32x8, __builtin_shufflevector(PG8_LD16B(PG8_SBR(b, h) + n * 2048), PG8_LD16B(PG8_SBR(b, h) + PIECE + n * 2048), 0, 1, 2, 3, 4, 5, 6, 7)); \
        else { _Pragma("unroll") for (int k = 0; k < 2; ++k) dst[n][k] = *(const LAS bf16x8*)(ldsB + PG8_SBR(b, h) + k * PIECE + n * 2048); } } } while (0)
#define PG8_MMA(ai, bj, At, Bt) do { __builtin_amdgcn_s_setprio(1); _Pragma("unroll") for (int m = 0; m < 4; ++m) _Pragma("unroll") for (int n = 0; n < 2; ++n) { \
        if constexpr (F8) acc[ai][bj][m][n] = __builtin_amdgcn_mfma_scale_f32_16x16x128_f8f6f4(Bt##8[n], At##8[m], acc[ai][bj][m][n], 0, 0, 0, 0, 0, 0);     \
        else { _Pragma("unroll") for (int k = 0; k < 2; ++k) acc[ai][bj][m][n] = __builtin_amdgcn_mfma_f32_16x16x32_bf16(Bt[n][k], At[m][k], acc[ai][bj][m][n], 0, 0, 0); } } __builtin_amdgcn_s_setprio(0); } while (0)
#define PG8_WAIT_V(n) asm volatile("s_waitcnt vmcnt(" #n ")" ::: "memory")
#define PG8_WAIT_L(n) asm volatile("s_waitcnt lgkmcnt(" #n ")" ::: "memory")
#define PG8_BAR __builtin_amdgcn_s_barrier()
#define PG8_SCHED __builtin_amdgcn_sched_barrier(0)
    const LAS unsigned char* ldsB = lds + 4 * HTB + boff;
    Unit cur, nxt; int ui = 0;
    if (!S.next(0, cur)) return;
    f32x4 acc[2][2][4][2];
#pragma unroll
    for (int a = 0; a < 2; ++a)
#pragma unroll
        for (int b = 0; b < 2; ++b)
#pragma unroll
            for (int m = 0; m < 4; ++m)
#pragma unroll
                for (int n = 0; n < 2; ++n) acc[a][b][m][n] = (f32x4){0.f, 0.f, 0.f, 0.f};
    bf16x8 At[4][2], B0[2][2], B1[2][2]; i32x8 At8[4], B08[2], B18[2];
    const char* cA = cur.a; const char* cB = cur.b;
    PG8_STAGE(PG8_SB(0, 0), cB, voffB); PG8_STAGE(PG8_SB(0, 1), cB + hstepB, voffB); PG8_STAGE(PG8_SA(0, 0), cA, voffA); PG8_STAGE(PG8_SA(0, 1), cA + hstepA, voffA);
    if (wr == 1) PG8_BAR;
    PG8_WAIT_V(2); PG8_BAR;
    PG8_STAGE(PG8_SB(1, 0), cB + kstep, voffB); PG8_STAGE(PG8_SA(1, 0), cA + kstep, voffA); PG8_STAGE(PG8_SB(1, 1), cB + hstepB + kstep, voffB);
    PG8_WAIT_V(6); PG8_BAR;
    for (;;) {
        const bool has_next = S.next(ui + 1, nxt);
        const char* nA = has_next ? nxt.a : cA; const char* nB = has_next ? nxt.b : cB;
#pragma nounroll
        for (int t = 0; t < nt; t += 2) {
            const bool last = (t == nt - 2);
            const char* a1 = cA + (size_t)(t + 1) * kstep;
            const char* a2 = last ? nA : cA + (size_t)(t + 2) * kstep; const char* b2 = last ? nB : cB + (size_t)(t + 2) * kstep;
            asm volatile("" : "+s"(a1), "+s"(a2), "+s"(b2));
            const char* a3 = a2 + kstep; const char* b3 = b2 + kstep;
            PG8_LDB(B0, 0, 0); PG8_LDB(B1, 0, 1); PG8_SCHED; PG8_LDA(At, 0, 0); PG8_STAGE(PG8_SA(1, 1), a1 + hstepA, voffA);
            PG8_WAIT_V(8); PG8_WAIT_L(0); PG8_BAR; PG8_MMA(0, 0, At, B0); PG8_MMA(0, 1, At, B1); PG8_BAR; PG8_SCHED;
            PG8_LDA(At, 0, 1); PG8_STAGE(PG8_SB(0, 0), b2, voffB); PG8_STAGE(PG8_SB(0, 1), b2 + hstepB, voffB); PG8_STAGE(PG8_SA(0, 0), a2, voffA);
            PG8_WAIT_V(8); PG8_WAIT_L(0); PG8_BAR; PG8_MMA(1, 0, At, B0); PG8_MMA(1, 1, At, B1); PG8_BAR; PG8_SCHED;
            PG8_LDB(B0, 1, 0); PG8_LDB(B1, 1, 1); PG8_SCHED; PG8_LDA(At, 1, 0); PG8_STAGE(PG8_SA(0, 1), a2 + hstepA, voffA);
            PG8_WAIT_V(8); PG8_WAIT_L(0); PG8_BAR; PG8_MMA(0, 0, At, B0); PG8_MMA(0, 1, At, B1); PG8_BAR; PG8_SCHED;
            PG8_LDA(At, 1, 1); PG8_STAGE(PG8_SB(1, 0), b3, voffB); PG8_STAGE(PG8_SB(1, 1), b3 + hstepB, voffB); PG8_STAGE(PG8_SA(1, 0), a3, voffA);
            PG8_WAIT_V(8); PG8_WAIT_L(0); PG8_BAR; PG8_MMA(1, 0, At, B0); PG8_MMA(1, 1, At, B1); PG8_BAR; PG8_SCHED;
        }
        if (wr == 0) PG8_BAR;
        { int le = lane_id(); asm volatile("" : "+v"(le));
          E(acc, cur, wr, wc, le & 15, le >> 4); }
        if (!has_next) break;
#pragma unroll
        for (int a = 0; a < 2; ++a)
#pragma unroll
            for (int b = 0; b < 2; ++b)
#pragma unroll
                for (int m = 0; m < 4; ++m)
#pragma unroll
                    for (int n = 0; n < 2; ++n) acc[a][b][m][n] = (f32x4){0.f, 0.f, 0.f, 0.f};
        cur = nxt; cA = nA; cB = nB; ++ui;
        if (wr == 1) PG8_BAR;
    }
    PG8_WAIT_V(0);
    PG8_BAR;
#undef PG8_SA
#undef PG8_SB
#undef PG8_STAGE
#undef PG8_LDA
#undef PG8_LDB
#undef PG8_MMA
#undef PG8_LD16
#undef PG8_LD16B
#undef PG8_SBR
#undef PG8_WAIT_V
#undef PG8_WAIT_L
#undef PG8_BAR
#undef PG8_SCHED
}

struct OrdStd {
    TileOrder to; const char* A; const char* B; size_t atile, btile;
    DI bool next(int i, Unit& u) const { if (!to.tile(i, u.pm, u.pn)) return false; u.z = 0; u.a = A + (size_t)u.pm * atile; u.b = B + (size_t)u.pn * btile; return true; }
};
struct OrdKV {
    TileOrder to; const char* A; const char* B;
    DI bool next(int i, Unit& u) const { if (!to.tile(i, u.pm, u.pn)) return false; const int l = u.pm >> 4; u.z = l; u.a = A + (size_t)u.pm * (256 * 1024 * 2); u.b = B + (size_t)l * (512 * 1024 * 2) + (size_t)u.pn * (256 * 1024 * 2); return true; }
};
struct OrdMerge {
    int G, c, ntiles; const char* A; const char* B;
    DI bool next(int i, Unit& u) const { const int tl = (i >> 2) * G + c; if (tl >= ntiles) return false; u.z = i & 3; u.pm = tl >> 2; u.pn = tl & 3;
        u.a = A + (size_t)u.pm * (256 * 1024 * 2) + (size_t)u.z * 512; u.b = B + (size_t)u.z * (1024 * 256 * 2) + (size_t)u.pn * (256 * 256 * 2); return true; }
};
struct OrdMoe {
    TileOrder to; const char* A; const char* B; size_t atile, btile, bexp; int off[9];
    DI bool next(int i, Unit& u) const { if (!to.tile(i, u.pm, u.pn)) return false; const int r0 = u.pm * 256; int e = 0;
#pragma unroll
        for (int k = 1; k < 8; ++k) e += (r0 >= off[k]) ? 1 : 0;
        u.z = e; u.a = uni(A + (size_t)u.pm * atile); u.b = uni(B + (size_t)e * bexp + (size_t)u.pn * btile); return true; }
};

struct EpiCat {
    static constexpr bool PERM = true;
    bf16* U; bf16* Gt;
    DI void operator()(const f32x4 (&acc)[2][2][4][2], const Unit& u, int wr, int wc, int fr, int fq) const {
        const bool isg = u.pn >= 10; bf16* base = isg ? Gt : U; const int ldc = isg ? 4096 : DIN; const int colt = isg ? (u.pn - 10) * 256 : u.pn * 256;
        const int row0 = u.pm * BM + wr * 64 + fr, col0 = colt + wc * 32 + 8 * fq;
#pragma unroll
        for (int ai = 0; ai < 2; ++ai)
#pragma unroll
            for (int m = 0; m < 4; ++m) { bf16* rowp = base + (size_t)(row0 + ai * HALF + m * 16) * ldc + col0;
#pragma unroll
                for (int bj = 0; bj < 2; ++bj) { f32x4 v0 = acc[ai][bj][m][0], v1 = acc[ai][bj][m][1];
                    if (isg) {
#pragma unroll
                        for (int j = 0; j < 4; ++j) { v0[j] = sigmoid_f(v0[j]); v1[j] = sigmoid_f(v1[j]); } }
                    u32x4 w; w.x = cvtpk(v0[0], v0[1]); w.y = cvtpk(v0[2], v0[3]); w.z = cvtpk(v1[0], v1[1]); w.w = cvtpk(v1[2], v1[3]);
                    *(u32x4*)(rowp + bj * HALF) = w; } }
    }
};
struct EpiBf16 {
    static constexpr bool PERM = true;
    bf16* O; int ldc; float sc;
    DI void operator()(const f32x4 (&acc)[2][2][4][2], const Unit& u, int wr, int wc, int fr, int fq) const {
        const int row0 = u.pm * BM + wr * 64 + fr, col0 = u.pn * BM + wc * 32 + 8 * fq;
#pragma unroll
        for (int ai = 0; ai < 2; ++ai)
#pragma unroll
            for (int m = 0; m < 4; ++m) { bf16* rowp = O + (size_t)(row0 + ai * HALF + m * 16) * ldc + col0;
#pragma unroll
                for (int bj = 0; bj < 2; ++bj) { const f32x4 v0 = acc[ai][bj][m][0] * sc, v1 = acc[ai][bj][m][1] * sc;
                    u32x4 w; w.x = cvtpk(v0[0], v0[1]); w.y = cvtpk(v0[2], v0[3]); w.z = cvtpk(v1[0], v1[1]); w.w = cvtpk(v1[2], v1[3]);
                    *(u32x4*)(rowp + bj * HALF) = w; } }
    }
};
struct EpiMerge {
    static constexpr bool PERM = true;
    const bf16* Gt; bf16* Mg;
    DI void operator()(const f32x4 (&acc)[2][2][4][2], const Unit& u, int wr, int wc, int fr, int fq) const {
        const int row0 = u.pm * BM + wr * 64 + fr, col0 = u.pn * BM + wc * 32 + 8 * fq;
#pragma unroll
        for (int ai = 0; ai < 2; ++ai)
#pragma unroll
            for (int m = 0; m < 4; ++m) { const size_t row = (size_t)(row0 + ai * HALF + m * 16);
#pragma unroll
                for (int bj = 0; bj < 2; ++bj) { const f32x4 v0 = acc[ai][bj][m][0], v1 = acc[ai][bj][m][1];
                    const u32x4 gw = *(const u32x4*)(Gt + row * 4096 + u.z * 1024 + col0 + bj * HALF);
                    bf16* mp = Mg + row * 1024 + col0 + bj * HALF;
                    float g[8]; unpack8(gw, g); float r[8];
                    r[0] = g[0] * v0[0]; r[1] = g[1] * v0[1]; r[2] = g[2] * v0[2]; r[3] = g[3] * v0[3]; r[4] = g[4] * v1[0]; r[5] = g[5] * v1[1]; r[6] = g[6] * v1[2]; r[7] = g[7] * v1[3];
                    if (u.z != 0) { const u32x4 pw = *(const u32x4*)mp; float p[8]; unpack8(pw, p);
#pragma unroll
                        for (int j = 0; j < 8; ++j) r[j] += p[j]; }
                    *(u32x4*)mp = pack8(r); }
                asm volatile("" ::: "memory"); }
    }
};
struct EpiRes {
    static constexpr bool PERM = false;
    const float* base; float* out; float sc;
    DI void operator()(const f32x4 (&acc)[2][2][4][2], const Unit& u, int wr, int wc, int fr, int fq) const {
        const int row0 = u.pm * BM + wr * 64 + fr, col0 = u.pn * BM + wc * 32 + 4 * fq;
#pragma unroll
        for (int ai = 0; ai < 2; ++ai)
#pragma unroll
            for (int m = 0; m < 4; ++m) { const size_t off = (size_t)(row0 + ai * HALF + m * 16) * D + col0;
#pragma unroll
                for (int bj = 0; bj < 2; ++bj)
#pragma unroll
                    for (int n = 0; n < 2; ++n) { const f32x4 bs = *(const f32x4*)(base + off + bj * HALF + n * 16); *(f32x4*)(out + off + bj * HALF + n * 16) = bs + acc[ai][bj][m][n] * sc; }
                asm volatile("" ::: "memory"); }
    }
};
template <bool F8O> struct EpiGU {
    static constexpr bool PERM = true;
    void* O; float sc;
    DI void operator()(const f32x4 (&acc)[2][2][4][2], const Unit& u, int wr, int wc, int fr, int fq) const {
        const int row0 = u.pm * BM + wr * 64 + fr, col0 = u.pn * HALF + wc * 32 + 8 * fq;
#pragma unroll
        for (int ai = 0; ai < 2; ++ai)
#pragma unroll
            for (int m = 0; m < 4; ++m) { const size_t eo = (size_t)(row0 + ai * HALF + m * 16) * DFF + col0;
                float r[8];
#pragma unroll
                for (int n = 0; n < 2; ++n)
#pragma unroll
                    for (int j = 0; j < 4; ++j) { const float g = acc[ai][0][m][n][j] * sc, uu = acc[ai][1][m][n][j] * sc; r[4 * n + j] = g * sigmoid_f(g) * uu; }
                if constexpr (F8O) { u32x2 w; w.x = cvt4_fp8(r[0], r[1], r[2], r[3]); w.y = cvt4_fp8(r[4], r[5], r[6], r[7]); *(u32x2*)((unsigned char*)O + eo) = w; }
                else *(u32x4*)((bf16*)O + eo) = pack8(r); }
    }
};
}

#define XB_TMO      128
#define XB_XCNT(j)  (256  + 64 * (j))
#define XB_XSUB(j)  (1280 + 64 * (j))
#define XB_XGEN(j)  (2304 + 64 * (j))
#define XB_TOP      3328
#define XB_TOPGEN   3392
#define XCD_BAR_WORDS 3456
#define XB_SPIN_CAP (1u << 22)
DI unsigned xb_ld(unsigned* p)              { return __hip_atomic_load(p, __ATOMIC_RELAXED, __HIP_MEMORY_SCOPE_AGENT); }
DI unsigned xb_add(unsigned* p, unsigned v) { return __hip_atomic_fetch_add(p, v, __ATOMIC_RELAXED, __HIP_MEMORY_SCOPE_AGENT); }
DI unsigned xb_xcc_id() { return (unsigned)__builtin_amdgcn_s_getreg((3 << 11) | 20) & 0xFu; }
#define XB_SPIN(cond, bar) do { unsigned _sp = 0; while (cond) { __builtin_amdgcn_s_sleep(1); \
    if ((++_sp & 255u) == 0u) { if (xb_ld(&(bar)[XB_TMO])) break; if (_sp > XB_SPIN_CAP) { atomicAdd(&(bar)[XB_TMO], 1u); break; } } } } while (0)
struct XcdBarrier { unsigned* bar; unsigned x; volatile LAS unsigned* st; };
DI XcdBarrier xcd_barrier_post(unsigned* bar, volatile LAS unsigned* st) {
    XcdBarrier b; b.bar = bar; b.x = xb_xcc_id(); b.st = st;
    if (threadIdx.x == 0) (void)xb_add(&bar[XB_XCNT(b.x)], 1u);
    return b;
}
DI void xcd_barrier_complete(unsigned* bar, unsigned x, unsigned& nloc, unsigned& nx) {
    const unsigned G = gridDim.x * gridDim.y * gridDim.z;
    unsigned sum, cnt, mine, sp = 0u;
    for (;;) {
        sum = 0u; cnt = 0u; mine = 0u;
#pragma unroll
        for (unsigned j = 0; j < 16; ++j) { const unsigned c = xb_ld(&bar[XB_XCNT(j)]); sum += c; cnt += (c > 0u) ? 1u : 0u; mine = (j == x) ? c : mine; }
        if (sum == G) break;
        __builtin_amdgcn_s_sleep(1);
        if ((++sp & 255u) == 0u) { if (xb_ld(&bar[XB_TMO])) break; if (sp > XB_SPIN_CAP) { atomicAdd(&bar[XB_TMO], 1u); break; } }
    }
    nloc = mine > 0u ? mine : 1u; nx = cnt > 0u ? cnt : 1u;
}
__device__ __noinline__ void xcd_barrier_fn(GAS unsigned* gbar, unsigned bx, volatile LAS unsigned* bst, int wave) {
    XcdBarrier b; b.bar = (unsigned*)gbar; b.x = bx; b.st = bst; const bool t0 = (wave == 0) && (lane_id() == 0);
    asm volatile("s_waitcnt vmcnt(0)" ::: "memory");
    __syncthreads();
    if (t0) {
        unsigned* bar = b.bar;
        __builtin_amdgcn_s_waitcnt(0);
        unsigned nloc = b.st[0], nx = b.st[1];
        if (nloc == 0u) { xcd_barrier_complete(bar, b.x, nloc, nx); b.st[0] = nloc; b.st[1] = nx; }
        const unsigned old = xb_add(&bar[XB_XSUB(b.x)], 1u);
        const unsigned gen = old / nloc;
        if (old + 1u == (gen + 1u) * nloc) {
            __builtin_amdgcn_fence(__ATOMIC_RELEASE, "agent");
            asm volatile("s_waitcnt vmcnt(0)" ::: "memory");
            const unsigned og = xb_add(&bar[XB_TOP], 1u);
            const unsigned tg = og / nx;
            if (og + 1u == (tg + 1u) * nx) xb_add(&bar[XB_TOPGEN], 1u);
            else XB_SPIN(xb_ld(&bar[XB_TOPGEN]) == tg, bar);
            __builtin_amdgcn_fence(__ATOMIC_ACQUIRE, "agent");
            xb_add(&bar[XB_XGEN(b.x)], 1u);
            asm volatile("s_waitcnt vmcnt(0)" ::: "memory");
        } else {
            XB_SPIN(xb_ld(&bar[XB_XGEN(b.x)]) == gen, bar);
            __builtin_amdgcn_fence(__ATOMIC_ACQUIRE, "agent");
            asm volatile("s_waitcnt vmcnt(0)" ::: "memory");
        }
    }
    __syncthreads();
}

DI void tr_item(const float* W, int ldw, int k0, int n0, bf16* WT, int ldwt, int drow0, LAS float* scr, int lane) {
#pragma unroll 8
    for (int i = 0; i < 32; ++i) { const int kk = 2 * i + (lane >> 5); scr[kk * 33 + (lane & 31)] = W[(size_t)(k0 + kk) * ldw + n0 + (lane & 31)]; }
    asm volatile("s_waitcnt lgkmcnt(0)" ::: "memory");
    const int c = lane & 7;
#pragma unroll
    for (int j = 0; j < 4; ++j) { const int n = (lane >> 3) + 8 * j; const LAS float* s = scr + (8 * c) * 33 + n;
        u32x4 o; o.x = cvtpk(s[0 * 33], s[1 * 33]); o.y = cvtpk(s[2 * 33], s[3 * 33]); o.z = cvtpk(s[4 * 33], s[5 * 33]); o.w = cvtpk(s[6 * 33], s[7 * 33]);
        *(u32x4*)(WT + (size_t)(drow0 + n) * ldwt + k0 + 8 * c) = o; }
    asm volatile("s_waitcnt lgkmcnt(0)" ::: "memory");
}
DI void tr_item8(const float* W, int ldw, int k0, int n0, unsigned char* WT, int ldwt, int drow0, LAS float* scr, int lane) {
#pragma unroll 8
    for (int i = 0; i < 32; ++i) { const int kk = 2 * i + (lane >> 5); scr[kk * 33 + (lane & 31)] = W[(size_t)(k0 + kk) * ldw + n0 + (lane & 31)] * W8_SCALE; }
    asm volatile("s_waitcnt lgkmcnt(0)" ::: "memory");
    const int c = lane & 7;
#pragma unroll
    for (int j = 0; j < 4; ++j) { const int n = (lane >> 3) + 8 * j; const LAS float* s = scr + (8 * c) * 33 + n;
        u32x2 o; o.x = cvt4_fp8(s[0 * 33], s[1 * 33], s[2 * 33], s[3 * 33]); o.y = cvt4_fp8(s[4 * 33], s[5 * 33], s[6 * 33], s[7 * 33]);
        *(u32x2*)(WT + (size_t)(drow0 + n) * ldwt + k0 + 8 * c) = o; }
    asm volatile("s_waitcnt lgkmcnt(0)" ::: "memory");
}
DI int gu_row(int n) { return n < DFF ? (n >> 7) * 256 + (n & 127) : ((n - DFF) >> 7) * 256 + 128 + ((n - DFF) & 127); }
template <bool F8 = false>
DI void tr_matrix(const float* W, int K, int N, void* WT, int row_off, int gu, LAS float* scr, int gw, int NGW, int lane) {
    const int nblk = N >> 5, nit = (K >> 6) * nblk;
    for (int it = gw; it < nit; it += NGW) { const int kb = it / nblk, nb = it - kb * nblk, n0 = nb * 32;
        if constexpr (F8) tr_item8(W, N, kb * 64, n0, (unsigned char*)WT, K, gu ? gu_row(n0) : row_off + n0, scr, lane);
        else tr_item(W, N, kb * 64, n0, (bf16*)WT, K, gu ? gu_row(n0) : row_off + n0, scr, lane); }
}
DI void rms_row_bf16(const float* xrow, const float* gain, bf16* orow, int lane) {
    const f32x4* xr = (const f32x4*)xrow + lane; const f32x4* gr = (const f32x4*)gain + lane;
    f32x4 v[4]; float s = 0.f;
#pragma unroll
    for (int j = 0; j < 4; ++j) { v[j] = xr[64 * j]; s += (v[j].x * v[j].x + v[j].y * v[j].y) + (v[j].z * v[j].z + v[j].w * v[j].w); }
    const float rstd = 1.f / sqrtf(wave_sum(s, lane) * (1.f / D) + EPS);
    u32x2* o8 = (u32x2*)orow + lane;
#pragma unroll
    for (int j = 0; j < 4; ++j) { const f32x4 g = gr[64 * j]; u32x2 w; w.x = cvtpk(v[j].x * rstd * g.x, v[j].y * rstd * g.y); w.y = cvtpk(v[j].z * rstd * g.z, v[j].w * rstd * g.w); o8[64 * j] = w; }
}

DI void rms_row_fp8(const float* xrow, const float* gain, unsigned char* orow, int lane) {
    const f32x4* xr = (const f32x4*)xrow + lane; const f32x4* gr = (const f32x4*)gain + lane;
    f32x4 v[4]; float s = 0.f;
#pragma unroll
    for (int j = 0; j < 4; ++j) { v[j] = xr[64 * j]; s += (v[j].x * v[j].x + v[j].y * v[j].y) + (v[j].z * v[j].z + v[j].w * v[j].w); }
    const float rstd = 1.f / sqrtf(wave_sum(s, lane) * (1.f / D) + EPS);
    unsigned* o4 = (unsigned*)orow + lane;
#pragma unroll
    for (int j = 0; j < 4; ++j) { const f32x4 g = gr[64 * j]; o4[64 * j] = cvt4_fp8(v[j].x * rstd * g.x, v[j].y * rstd * g.y, v[j].z * rstd * g.z, v[j].w * rstd * g.w); }
}

struct KVStage { u32x4 k[4], v[4]; };
DI void kv_load(KVStage& st, const bf16* Kp, int kpitch, const bf16* Vp, int vpitch, int tid) {
#pragma unroll
    for (int i = 0; i < 4; ++i) { const int id = tid + 512 * i, row = id >> 3, c8 = id & 7;
        st.k[i] = *(const u32x4*)(Kp + (size_t)row * kpitch + 8 * c8); st.v[i] = *(const u32x4*)(Vp + (size_t)row * vpitch + 8 * c8); }
}
DI void kv_write(const KVStage& st, LAS bf16* Ksm, LAS bf16* Vtm, int tid) {
#pragma unroll
    for (int i = 0; i < 4; ++i) { const int id = tid + 512 * i, row = id >> 3, c8 = id & 7;
        *(LAS u32x4*)(Ksm + row * KS + 8 * c8) = st.k[i];
        const unsigned w0 = st.v[i].x, w1 = st.v[i].y, w2 = st.v[i].z, w3 = st.v[i].w;
        LAS bf16* vp = Vtm + (8 * c8) * VS + row;
        vp[0 * VS] = (bf16)(w0 & 0xffffu); vp[1 * VS] = (bf16)(w0 >> 16); vp[2 * VS] = (bf16)(w1 & 0xffffu); vp[3 * VS] = (bf16)(w1 >> 16);
        vp[4 * VS] = (bf16)(w2 & 0xffffu); vp[5 * VS] = (bf16)(w2 >> 16); vp[6 * VS] = (bf16)(w3 & 0xffffu); vp[7 * VS] = (bf16)(w3 >> 16); }
}
DI void qk_subtile(const LAS bf16* Ksm, int ktl, const bf16x8 (&qf)[4], int r, int h, f32x16& z0, f32x16& z1) {
#pragma unroll
    for (int i = 0; i < 16; ++i) { z0[i] = 0.f; z1[i] = 0.f; }
#pragma unroll
    for (int s = 0; s < 4; ++s) {
        const bf16x8 k0 = *(const LAS bf16x8*)(Ksm + (64 * ktl + r) * KS + 16 * s + 8 * h);
        const bf16x8 k1 = *(const LAS bf16x8*)(Ksm + (64 * ktl + 32 + r) * KS + 16 * s + 8 * h);
        z0 = MFMA32(k0, qf[s], z0); z1 = MFMA32(k1, qf[s], z1); }
}
template <int ST> DI bf16x8 pack_step(const f32x16& x) {
    u32x4 p; p.x = cvtpk(x[8 * ST + 0], x[8 * ST + 1]); p.y = cvtpk(x[8 * ST + 2], x[8 * ST + 3]); p.z = cvtpk(x[8 * ST + 4], x[8 * ST + 5]); p.w = cvtpk(x[8 * ST + 6], x[8 * ST + 7]);
    return __builtin_bit_cast(bf16x8, p);
}
DI void pv_subtile(const LAS bf16* Vtm, int ktl, const f32x16& p0, const f32x16& p1, int r, int h, f32x16 (&o)[2]) {
    const bf16x8 pf[4] = {pack_step<0>(p0), pack_step<1>(p0), pack_step<0>(p1), pack_step<1>(p1)};
#pragma unroll
    for (int ts = 0; ts < 4; ++ts) {
#pragma unroll
        for (int dt = 0; dt < 2; ++dt) {
            const LAS bf16* vp = Vtm + (32 * dt + r) * VS + 64 * ktl + 16 * ts + 4 * h;
            const s16x4 lo = *(const LAS s16x4*)vp, hi = *(const LAS s16x4*)(vp + 8);
            const bf16x8 vf = __builtin_shufflevector(lo, hi, 0, 1, 2, 3, 4, 5, 6, 7);
            o[dt] = MFMA32(vf, pf[ts], o[dt]); } }
}
template <int T, int GI> DI void sb_group(f32x16& z, float& c, int h, bool need_mask, int krel, int lane) {
    float s[4], m[4];
#pragma unroll
    for (int i = 0; i < 4; ++i) { const float e = fexp2(fminf(-z[4 * GI + i], 126.f)); s[i] = frcp(1.f + e); m[i] = e * s[i];
        if (need_mask) { const bool ok = (krel + 32 * T + 8 * GI + 4 * h + i) < 0; s[i] = ok ? s[i] : 0.f; m[i] = ok ? m[i] : 1.f; } }
    const float w2 = m[3], w1 = m[3] * m[2], w0 = w1 * m[1], Gm = w0 * m[0];
    const float Gp = SHX(Gm, 32, lane);
    const float mc = h ? c : c * Gp;
    z[4 * GI + 3] = s[3] * mc; z[4 * GI + 2] = s[2] * w2 * mc; z[4 * GI + 1] = s[1] * w1 * mc; z[4 * GI + 0] = s[0] * w0 * mc;
    c *= Gm * Gp;
}
DI void sb_transform(f32x16& z0, f32x16& z1, float& c, int h, bool need_mask, int krel, int lane) {
    sb_group<1, 3>(z1, c, h, need_mask, krel, lane); sb_group<1, 2>(z1, c, h, need_mask, krel, lane); sb_group<1, 1>(z1, c, h, need_mask, krel, lane); sb_group<1, 0>(z1, c, h, need_mask, krel, lane);
    sb_group<0, 3>(z0, c, h, need_mask, krel, lane); sb_group<0, 2>(z0, c, h, need_mask, krel, lane); sb_group<0, 1>(z0, c, h, need_mask, krel, lane); sb_group<0, 0>(z0, c, h, need_mask, krel, lane);
}
DI void store_ot(const f32x16 (&o)[2], bf16* orow, int h, float sc) {
#pragma unroll
    for (int dt = 0; dt < 2; ++dt)
#pragma unroll
        for (int g = 0; g < 4; ++g) { u32x2 w; w.x = cvtpk(o[dt][4 * g] * sc, o[dt][4 * g + 1] * sc); w.y = cvtpk(o[dt][4 * g + 2] * sc, o[dt][4 * g + 3] * sc);
            *(u32x2*)(orow + 32 * dt + 8 * g + 4 * h) = w; }
}

DI void sb_unit(const bf16* U, bf16* Y, int bl, int hd, int qb, LAS unsigned char* lds, int tid, int wave, int lane) {
    LAS bf16* Ksm = (LAS bf16*)(lds + L_KS); LAS bf16* Vtm = (LAS bf16*)(lds + L_VT);
    const int r = lane & 31, h = lane >> 5;
    const size_t tok0 = (size_t)bl * SEQ; const int tq = qb * 256 + 32 * wave + r;
    bf16x8 qf[4];
    { const bf16* qrow = U + (tok0 + tq) * DIN + UC_SBQ + 64 * hd;
#pragma unroll
      for (int s = 0; s < 4; ++s) { const u32x4 w = *(const u32x4*)(qrow + 16 * s + 8 * h); float f[8]; unpack8(w, f);
#pragma unroll
          for (int j = 0; j < 8; ++j) f[j] *= (0.125f * 1.44269504f);
          qf[s] = __builtin_bit_cast(bf16x8, pack8(f)); } }
    f32x16 o[2];
#pragma unroll
    for (int i = 0; i < 16; ++i) { o[0][i] = 0.f; o[1][i] = 0.f; }
    float c = 1.f;
    const bf16* Kb = U + tok0 * DIN + UC_SBK + 64 * hd; const bf16* Vb = U + tok0 * DIN + UC_SBV + 64 * hd;
    KVStage st; kv_load(st, Kb + (size_t)(256 * qb) * DIN, DIN, Vb + (size_t)(256 * qb) * DIN, DIN, tid);
    for (int kb = qb; kb >= 0; --kb) {
        { volatile LAS unsigned* fl = (volatile LAS unsigned*)(lds + MISC_OFF) + 2;
          if (lane == 0 && __builtin_amdgcn_ballot_w64(c != 0.f) != 0ull) fl[kb & 1] = 1u;
          __syncthreads();
          const unsigned live = fl[kb & 1];
          if (tid == 0) fl[(kb + 1) & 1] = 0u;
          if (live == 0u) break; }
        kv_write(st, Ksm, Vtm, tid);
        __syncthreads();
        if (kb > 0) kv_load(st, Kb + (size_t)(256 * (kb - 1)) * DIN, DIN, Vb + (size_t)(256 * (kb - 1)) * DIN, DIN, tid);
        const bool diag = (kb == qb);
        const int khi = diag ? ((32 * wave + 31) >> 6) : 3;
        for (int ktl = khi; ktl >= 0; --ktl) {
            if (__builtin_amdgcn_ballot_w64(c != 0.f) == 0ull) break;
            f32x16 z0, z1; qk_subtile(Ksm, ktl, qf, r, h, z0, z1);
            const bool need_mask = diag && (64 * ktl + 63 >= 32 * wave);
            sb_transform(z0, z1, c, h, need_mask, 256 * kb + 64 * ktl - tq, lane);
            pv_subtile(Vtm, ktl, z0, z1, r, h, o);
        }
    }
    store_ot(o, Y + (tok0 + tq) * D + YC_SB + 64 * hd, h, 1.f);
}

DI void xa_unit(const bf16* QB, const bf16* kvl, const float* gq, float kmax, bf16* OB, int bl, int bglob, int hd, int qblk, LAS unsigned char* lds, int tid, int wave, int lane) {
    LAS bf16* Ksm = (LAS bf16*)(lds + L_KS); LAS bf16* Vtm = (LAS bf16*)(lds + L_VT);
    const int r = lane & 31, h = lane >> 5;
    const size_t row = (size_t)bl * SEQ + qblk * 256 + 32 * wave + r;
    __syncthreads();
    { KVStage st; const bf16* Kp = kvl + (size_t)bglob * NMEM * 512 + 64 * hd; kv_load(st, Kp, 512, Kp + 256, 512, tid); kv_write(st, Ksm, Vtm, tid); }
    float qv[4][8]; float ss = 0.f;
    { const bf16* qrow = QB + row * 256 + 64 * hd;
#pragma unroll
      for (int s = 0; s < 4; ++s) { const u32x4 w = *(const u32x4*)(qrow + 16 * s + 8 * h); unpack8(w, qv[s]);
#pragma unroll
          for (int j = 0; j < 8; ++j) ss += qv[s][j] * qv[s][j]; } }
    ss += SHX(ss, 32, lane);
    const float rq = 1.f / sqrtf(ss * (1.f / 64.f) + EPS) * (0.125f * 1.44269504f);
    bf16x8 qf[4]; float qn2 = 0.f;
#pragma unroll
    for (int s = 0; s < 4; ++s) {
#pragma unroll
        for (int j = 0; j < 8; ++j) { qv[s][j] *= rq * gq[16 * s + 8 * h + j]; qn2 += qv[s][j] * qv[s][j]; }
        qf[s] = __builtin_bit_cast(bf16x8, pack8(qv[s])); }
    qn2 += SHX(qn2, 32, lane);
    const float bnd = sqrtf(qn2) * kmax * 1.02f + 0.5f;
    f32x16 o[2];
#pragma unroll
    for (int i = 0; i < 16; ++i) { o[0][i] = 0.f; o[1][i] = 0.f; }
    float l = 0.f;
    __syncthreads();
    for (int ktl = 0; ktl < 4; ++ktl) {
        f32x16 z0, z1; qk_subtile(Ksm, ktl, qf, r, h, z0, z1);
#pragma unroll
        for (int i = 0; i < 16; ++i) { z0[i] = fexp2(z0[i] - bnd); z1[i] = fexp2(z1[i] - bnd); l += z0[i] + z1[i]; }
        pv_subtile(Vtm, ktl, z0, z1, r, h, o);
    }
    l += SHX(l, 32, lane);
    store_ot(o, OB + row * 256 + 64 * hd, h, 1.f / l);
}

template <bool ROWM, bool TRANS>
DI void ret_stage(const bf16* U, const f32x2* rot, size_t trow0, int gtok, int hd, float lg, LAS bf16* Ksm, LAS bf16* Ktm, LAS bf16* Vtm, int tid) {
    const int m = tid >> 1, hf = tid & 1; const size_t trow = trow0 + m;
    const bf16* kp = U + trow * DIN + UC_RK + 64 * hd + 16 * hf; const f32x2* rp = rot + (size_t)(gtok + m) * 32 + 16 * hf;
    const float sk = fexp2(-(float)m * lg) * 0.125f;
    float x1[16], x2[16];
    { const u32x4 a0 = *(const u32x4*)kp, a1 = *(const u32x4*)(kp + 8), b0 = *(const u32x4*)(kp + 32), b1 = *(const u32x4*)(kp + 40);
      float t[8]; unpack8(a0, t);
#pragma unroll
      for (int j = 0; j < 8; ++j) x1[j] = t[j];
      unpack8(a1, t);
#pragma unroll
      for (int j = 0; j < 8; ++j) x1[8 + j] = t[j];
      unpack8(b0, t);
#pragma unroll
      for (int j = 0; j < 8; ++j) x2[j] = t[j];
      unpack8(b1, t);
#pragma unroll
      for (int j = 0; j < 8; ++j) x2[8 + j] = t[j]; }
    float o1[16], o2[16];
#pragma unroll
    for (int j = 0; j < 16; ++j) { const f32x2 cs = rp[j]; o1[j] = (x1[j] * cs.x - x2[j] * cs.y) * sk; o2[j] = (x1[j] * cs.y + x2[j] * cs.x) * sk; }
    if (ROWM) { LAS bf16* kr = Ksm + m * KS + 16 * hf; float t[8];
#pragma unroll
        for (int j = 0; j < 8; ++j) t[j] = o1[j];
        *(LAS u32x4*)kr = pack8(t);
#pragma unroll
        for (int j = 0; j < 8; ++j) t[j] = o1[8 + j];
        *(LAS u32x4*)(kr + 8) = pack8(t);
#pragma unroll
        for (int j = 0; j < 8; ++j) t[j] = o2[j];
        *(LAS u32x4*)(kr + 32) = pack8(t);
#pragma unroll
        for (int j = 0; j < 8; ++j) t[j] = o2[8 + j];
        *(LAS u32x4*)(kr + 40) = pack8(t); }
    if (TRANS) {
#pragma unroll
        for (int j = 0; j < 16; ++j) { Ktm[(16 * hf + j) * VS + m] = (bf16)(cvtpk(o1[j], 0.f) & 0xffffu); Ktm[(32 + 16 * hf + j) * VS + m] = (bf16)(cvtpk(o2[j], 0.f) & 0xffffu); } }
    const bf16* vp = U + trow * DIN + UC_RV + 64 * hd + 32 * hf;
#pragma unroll
    for (int q = 0; q < 4; ++q) { const u32x4 w = *(const u32x4*)(vp + 8 * q); LAS bf16* d = Vtm + (32 * hf + 8 * q) * VS + m;
        d[0 * VS] = (bf16)(w.x & 0xffffu); d[1 * VS] = (bf16)(w.x >> 16); d[2 * VS] = (bf16)(w.y & 0xffffu); d[3 * VS] = (bf16)(w.y >> 16);
        d[4 * VS] = (bf16)(w.z & 0xffffu); d[5 * VS] = (bf16)(w.z >> 16); d[6 * VS] = (bf16)(w.w & 0xffffu); d[7 * VS] = (bf16)(w.w >> 16); }
}
DI float ret_lg(int hd) { const float gam = 1.f - fexp2(-5.f - (float)hd); return __log2f(gam); }
DI void retkv_unit(const bf16* U, float* KVS, const f32x2* rot, int bl, int gtok0, int hd, int ch, LAS unsigned char* lds, int tid, int wave, int lane) {
    LAS bf16* Vtm = (LAS bf16*)(lds + L_VT); LAS bf16* Ktm = (LAS bf16*)(lds + L_KT);
    const int r = lane & 31, h = lane >> 5; const float lg = ret_lg(hd);
    __syncthreads();
    ret_stage<false, true>(U, rot, (size_t)bl * SEQ + ch * 256, gtok0 + ch * 256, hd, lg, nullptr, Ktm, Vtm, tid);
    __syncthreads();
    if (wave < 4) { const int dti = wave >> 1, eti = wave & 1;
        f32x16 kv;
#pragma unroll
        for (int i = 0; i < 16; ++i) kv[i] = 0.f;
#pragma unroll 4
        for (int s = 0; s < 16; ++s) { const bf16x8 af = *(const LAS bf16x8*)(Ktm + (32 * dti + r) * VS + 16 * s + 8 * h); const bf16x8 bfr = *(const LAS bf16x8*)(Vtm + (32 * eti + r) * VS + 16 * s + 8 * h);
            kv = MFMA32(af, bfr, kv); }
        float* dst = KVS + (size_t)((bl * 4 + hd) * 16 + ch) * 4096 + 32 * eti + r;
#pragma unroll
        for (int i = 0; i < 16; ++i) dst[(32 * dti + crow(i, h)) * 64] = kv[i]; }
}
DI void reto_unit(const bf16* U, bf16* Y, const float* KVS, const f32x2* rot, int bl, int gtok0, int hd, int ch, LAS unsigned char* lds, int tid, int wave, int lane) {
    LAS bf16* Ksm = (LAS bf16*)(lds + L_KS); LAS bf16* Vtm = (LAS bf16*)(lds + L_VT); LAS bf16* Stm = (LAS bf16*)(lds + L_ST);
    const int r = lane & 31, h = lane >> 5; const float lg = ret_lg(hd);
    const size_t tok0 = (size_t)bl * SEQ; const int n0 = ch * 256;
    __syncthreads();
    { const int d = tid >> 3, e0 = 8 * (tid & 7); float acc[8];
#pragma unroll
      for (int j = 0; j < 8; ++j) acc[j] = 0.f;
      const float* src = KVS + (size_t)((bl * 4 + hd) * 16) * 4096 + d * 64 + e0;
      for (int cp = 0; cp < ch; ++cp) { const float w = fexp2((256.f * (float)(ch - 1 - cp) + 256.f) * lg); const f32x4 a = *(const f32x4*)(src + (size_t)cp * 4096), b = *(const f32x4*)(src + (size_t)cp * 4096 + 4);
          acc[0] += w * a.x; acc[1] += w * a.y; acc[2] += w * a.z; acc[3] += w * a.w; acc[4] += w * b.x; acc[5] += w * b.y; acc[6] += w * b.z; acc[7] += w * b.w; }
#pragma unroll
      for (int j = 0; j < 8; ++j) Stm[(e0 + j) * KS + d] = (bf16)(cvtpk(acc[j], 0.f) & 0xffffu); }
    ret_stage<true, false>(U, rot, tok0 + n0, gtok0 + n0, hd, lg, Ksm, nullptr, Vtm, tid);
    bf16x8 qf[4];
    { const int nl = 32 * wave + r; const size_t trow = tok0 + n0 + nl;
      const bf16* qp = U + trow * DIN + UC_RQ + 64 * hd + 8 * h; const f32x2* rp = rot + (size_t)(gtok0 + n0 + nl) * 32 + 8 * h;
      const float sq = fexp2((float)nl * lg);
      float a[4][8];
#pragma unroll
      for (int s = 0; s < 4; ++s) { const u32x4 w = *(const u32x4*)(qp + 16 * s); unpack8(w, a[s]); }
      float b[4][8];
#pragma unroll
      for (int j = 0; j < 8; ++j) { const f32x2 c0 = rp[j], c1 = rp[16 + j];
          b[0][j] = (a[0][j] * c0.x - a[2][j] * c0.y) * sq; b[2][j] = (a[0][j] * c0.y + a[2][j] * c0.x) * sq;
          b[1][j] = (a[1][j] * c1.x - a[3][j] * c1.y) * sq; b[3][j] = (a[1][j] * c1.y + a[3][j] * c1.x) * sq; }
#pragma unroll
      for (int s = 0; s < 4; ++s) qf[s] = __builtin_bit_cast(bf16x8, pack8(b[s])); }
    __syncthreads();
    f32x16 o[2];
#pragma unroll
    for (int i = 0; i < 16; ++i) { o[0][i] = 0.f; o[1][i] = 0.f; }
    const int khi = (32 * wave + 31) >> 6;
    for (int ktl = 0; ktl <= khi; ++ktl) {
        f32x16 z0, z1; qk_subtile(Ksm, ktl, qf, r, h, z0, z1);
        if (64 * ktl + 63 > 32 * wave) {
            const int krel = 64 * ktl - (32 * wave + r);
#pragma unroll
            for (int i = 0; i < 16; ++i) { const int kk = krel + crow(i, h); z0[i] = (kk <= 0) ? z0[i] : 0.f; z1[i] = (kk + 32 <= 0) ? z1[i] : 0.f; } }
        pv_subtile(Vtm, ktl, z0, z1, r, h, o);
    }
#pragma unroll
    for (int s = 0; s < 4; ++s)
#pragma unroll
        for (int dt = 0; dt < 2; ++dt) { const bf16x8 af = *(const LAS bf16x8*)(Stm + (32 * dt + r) * KS + 16 * s + 8 * h); o[dt] = MFMA32(af, qf[s], o[dt]); }
    { float sm = 0.f;
#pragma unroll
      for (int i = 0; i < 16; ++i) sm += o[0][i] + o[1][i];
      sm += SHX(sm, 32, lane); const float mean = sm * (1.f / 64.f); float vq = 0.f;
#pragma unroll
      for (int i = 0; i < 16; ++i) { const float d0 = o[0][i] - mean, d1 = o[1][i] - mean; vq += d0 * d0 + d1 * d1; }
      vq += SHX(vq, 32, lane); const float rstd = 1.f / sqrtf(vq * (1.f / 64.f) + EPS);
      const size_t trow = tok0 + n0 + 32 * wave + r;
      const bf16* gp = U + trow * DIN + UC_RG + 64 * hd; bf16* yp = Y + trow * D + YC_RET + 64 * hd;
#pragma unroll
      for (int dt = 0; dt < 2; ++dt)
#pragma unroll
          for (int g = 0; g < 4; ++g) { const int e0 = 32 * dt + 8 * g + 4 * h; const u32x2 gw = *(const u32x2*)(gp + e0);
              const float g0 = bflo(gw.x), g1 = bfhi(gw.x), g2 = bflo(gw.y), g3 = bfhi(gw.y);
              u32x2 w; w.x = cvtpk(g0 * sigmoid_f(g0) * (o[dt][4 * g] - mean) * rstd, g1 * sigmoid_f(g1) * (o[dt][4 * g + 1] - mean) * rstd);
              w.y = cvtpk(g2 * sigmoid_f(g2) * (o[dt][4 * g + 2] - mean) * rstd, g3 * sigmoid_f(g3) * (o[dt][4 * g + 3] - mean) * rstd);
              *(u32x2*)(yp + e0) = w; } }
}

DI void conv_unit(const bf16* U, bf16* Y, const float* cw, const float* cb, const float* lng, const float* lnb, int bl, int tile, LAS unsigned char* lds, int tid, int wave, int lane) {
    LAS float* vs = (LAS float*)lds;
    const int t0 = tile * 64; const size_t tok0 = (size_t)bl * SEQ;
    __syncthreads();
    for (int id = tid; id < 94 * 32; id += NTHR) { const int rr = id >> 5, c8 = id & 31, t = t0 - 30 + rr; float v[8];
        if (t >= 0) { const bf16* p = U + (tok0 + t) * DIN + 8 * c8; const u32x4 aw = *(const u32x4*)(p + UC_CA), gw = *(const u32x4*)(p + UC_CG); float a[8], g[8]; unpack8(aw, a); unpack8(gw, g);
#pragma unroll
            for (int j = 0; j < 8; ++j) v[j] = a[j] * sigmoid_f(g[j]); }
        else {
#pragma unroll
            for (int j = 0; j < 8; ++j) v[j] = 0.f; }
        LAS f32x4* d = (LAS f32x4*)(vs + rr * 256 + 8 * c8); d[0] = (f32x4){v[0], v[1], v[2], v[3]}; d[1] = (f32x4){v[4], v[5], v[6], v[7]}; }
    __syncthreads();
    const int c = tid & 255, half = tid >> 8;
    float acc[32];
    { const float bias = cb[c];
#pragma unroll
      for (int i = 0; i < 32; ++i) acc[i] = bias; }
    for (int j = 0; j < 31; ++j) { const float w = cw[j * 256 + c]; const LAS float* vp = vs + (32 * half + j) * 256 + c;
#pragma unroll
        for (int i = 0; i < 32; ++i) acc[i] += w * vp[i * 256]; }
    __syncthreads();
#pragma unroll
    for (int i = 0; i < 32; ++i) vs[(32 * half + i) * 256 + c] = acc[i];
    __syncthreads();
    const f32x4 g4 = *(const f32x4*)(lng + 4 * lane), b4 = *(const f32x4*)(lnb + 4 * lane);
    for (int i = 0; i < 8; ++i) { const int tt = 8 * wave + i; const f32x4 v = *(const LAS f32x4*)(vs + tt * 256 + 4 * lane);
        const float mean = wave_sum((v.x + v.y) + (v.z + v.w), lane) * (1.f / 256.f);
        const f32x4 dv = v - mean; const float var = wave_sum((dv.x * dv.x + dv.y * dv.y) + (dv.z * dv.z + dv.w * dv.w), lane) * (1.f / 256.f);
        const float rstd = 1.f / sqrtf(var + EPS); const f32x4 xn = dv * rstd * g4 + b4;
        u32x2 w; w.x = cvtpk(xn.x * sigmoid_f(xn.x), xn.y * sigmoid_f(xn.y)); w.y = cvtpk(xn.z * sigmoid_f(xn.z), xn.w * sigmoid_f(xn.w));
        *(u32x2*)(Y + (tok0 + t0 + tt) * D + YC_CONV + 4 * lane) = w; }
}

DI void pool_unit(const bf16* U, bf16* Y, int bl, int tile, LAS unsigned char* lds, int tid) {
    LAS float* us = (LAS float*)lds;
    const int t0 = tile * 64; const size_t tok0 = (size_t)bl * SEQ;
    __syncthreads();
    for (int id = tid; id < 79 * 32; id += NTHR) { const int rr = id >> 5, c8 = id & 31, t = t0 - 15 + rr; float v[8];
        if (t >= 0) { const u32x4 w = *(const u32x4*)(U + (tok0 + t) * DIN + UC_POOL + 8 * c8); unpack8(w, v); }
        else {
#pragma unroll
            for (int j = 0; j < 8; ++j) v[j] = 0.f; }
        LAS f32x4* d = (LAS f32x4*)(us + rr * 256 + 8 * c8); d[0] = (f32x4){v[0], v[1], v[2], v[3]}; d[1] = (f32x4){v[4], v[5], v[6], v[7]}; }
    __syncthreads();
    const int c = tid & 255, half = tid >> 8; const int w = 2 << (c >> 6);
    for (int i = 0; i < 32; ++i) { const int tl = 32 * half + i, t = t0 + tl; const LAS float* p = us + (15 + tl) * 256 + c;
        float s = 0.f; for (int j = 0; j < w; ++j) s += p[-j * 256];
        const int n = (t + 1 < w) ? (t + 1) : w; const float d = s / (float)n - p[0];
        Y[(tok0 + t) * D + YC_POOL + c] = (bf16)(cvtpk(d, 0.f) & 0xffffu); }
}

struct Args { const void* in[27]; float* out; unsigned char* ws; };
static_assert(sizeof(Args) == 29 * 8, "Args has no padding");
typedef const __attribute__((address_space(4))) Args* KArgs;
DI KArgs KA() { KArgs p = (KArgs)__builtin_amdgcn_kernarg_segment_ptr(); asm volatile("" : "+s"(p)); return p; }
#define KIN(T, k) ((const T*)KA()->in[k])
#define PH DI
#define PHN __device__ __noinline__
enum { I_X = 0, I_MEM, I_POS, I_NMIXG, I_WIN, I_CONVW, I_CONVB, I_CLNG, I_CLNB, I_POOLW, I_POOLS, I_WGATE, I_WBR, I_WOUT, I_NXAG, I_NMEMG, I_WQ, I_WKV, I_QG, I_KG, I_WO, I_NFFNG, I_FGU, I_FDN, I_ROUTER, I_MGU, I_MDN };

constexpr unsigned F8MASK = FFN_FP8_MASK;
constexpr bool DENSE_ANY8 = (F8MASK & 0x5) != 0, DENSE_ANYB = (F8MASK & 0x5) != 0x5, MOE_ANY8 = (F8MASK & 0xA) != 0, MOE_ANYB = (F8MASK & 0xA) != 0xA;
struct Ids { int tid, lane, wave, G, wg, gw, NGW; };
DI Ids ids(int wave) { Ids i; i.lane = lane_id(); asm volatile("" : "+v"(i.lane)); asm volatile("" : "+s"(wave)); i.wave = wave; i.tid = wave * 64 + i.lane; i.G = gridDim.x; i.wg = blockIdx.x; asm volatile("" : "+s"(i.G), "+s"(i.wg)); i.gw = i.wg * NWAVES + i.wave; i.NGW = i.G * NWAVES; return i; }

PHN void ph_w_layer(KArgs ka, int wv, LAS unsigned char* lds, int l) {
    const Ids t = ids(__builtin_amdgcn_readfirstlane(wv));     unsigned char* ws = ka->ws; LAS float* scr = (LAS float*)(lds + t.wave * 16384);
    bf16* wc = (bf16*)(ws + WS_WCAT) + (size_t)l * NCAT * D;
    tr_matrix(((const float*)ka->in[I_WIN]) + (size_t)l * D * DIN, D, DIN, wc, 0, 0, scr, t.gw, t.NGW, t.lane);
    for (int i = 0; i < 4; ++i) tr_matrix(((const float*)ka->in[I_WGATE]) + (size_t)(l * 4 + i) * D * D, D, D, wc, DIN + i * D, 0, scr, t.gw, t.NGW, t.lane);
    for (int i = 0; i < 4; ++i) if (i != 1) tr_matrix(((const float*)ka->in[I_WBR]) + (size_t)(l * 4 + i) * 256 * D, 256, D, (bf16*)(ws + WS_WB) + (size_t)(l * 4 + i) * D * 256, 0, 0, scr, t.gw, t.NGW, t.lane);
    tr_matrix(((const float*)ka->in[I_WOUT]) + (size_t)l * D * D, D, D, (bf16*)(ws + WS_WOUT) + (size_t)l * D * D, 0, 0, scr, t.gw, t.NGW, t.lane);
    tr_matrix(((const float*)ka->in[I_WQ]) + (size_t)l * D * 256, D, 256, (bf16*)(ws + WS_WQ) + (size_t)l * 256 * D, 0, 0, scr, t.gw, t.NGW, t.lane);
    tr_matrix(((const float*)ka->in[I_WKV]) + (size_t)l * D * 512, D, 512, (bf16*)(ws + WS_WKV) + (size_t)l * 512 * D, 0, 0, scr, t.gw, t.NGW, t.lane);
    tr_matrix(((const float*)ka->in[I_WO]) + (size_t)l * 256 * D, 256, D, (bf16*)(ws + WS_WO) + (size_t)l * D * 256, 0, 0, scr, t.gw, t.NGW, t.lane);
}
PHN void ph_w_ffn(KArgs ka, int wv, LAS unsigned char* lds, int s) {
    const Ids t = ids(__builtin_amdgcn_readfirstlane(wv));     unsigned char* ws = ka->ws; LAS float* scr = (LAS float*)(lds + t.wave * 16384);
    if (s < 2) { const bool f8 = (F8MASK >> (2 * s)) & 1u;
        const float* gu = ((const float*)ka->in[I_FGU]) + (size_t)s * D * NGU; const float* dn = ((const float*)ka->in[I_FDN]) + (size_t)s * DFF * D;
        unsigned char* wgu = ws + WS_WGUD + (size_t)s * NGU * D * 2; unsigned char* wdn = ws + WS_WDND + (size_t)s * D * DFF * 2;
        if (f8) { if constexpr (DENSE_ANY8) { tr_matrix<true>(gu, D, NGU, wgu, 0, 1, scr, t.gw, t.NGW, t.lane); tr_matrix<true>(dn, DFF, D, wdn, 0, 0, scr, t.gw, t.NGW, t.lane); } }
        else { if constexpr (DENSE_ANYB) { tr_matrix<false>(gu, D, NGU, wgu, 0, 1, scr, t.gw, t.NGW, t.lane); tr_matrix<false>(dn, DFF, D, wdn, 0, 0, scr, t.gw, t.NGW, t.lane); } }
    } else { const int k = s - 2; const bool f8 = (F8MASK >> (2 * (k >> 3) + 1)) & 1u;
        const float* gu = ((const float*)ka->in[I_MGU]) + (size_t)k * D * NGU; const float* dn = ((const float*)ka->in[I_MDN]) + (size_t)k * DFF * D;
        unsigned char* wgu = ws + WS_WGUM + (size_t)k * NGU * D * 2; unsigned char* wdn = ws + WS_WDNM + (size_t)k * D * DFF * 2;
        if (f8) { if constexpr (MOE_ANY8) { tr_matrix<true>(gu, D, NGU, wgu, 0, 1, scr, t.gw, t.NGW, t.lane); tr_matrix<true>(dn, DFF, D, wdn, 0, 0, scr, t.gw, t.NGW, t.lane); } }
        else { if constexpr (MOE_ANYB) { tr_matrix<false>(gu, D, NGU, wgu, 0, 1, scr, t.gw, t.NGW, t.lane); tr_matrix<false>(dn, DFF, D, wdn, 0, 0, scr, t.gw, t.NGW, t.lane); } }
    }
}
PHN void ph_misc0(KArgs ka, int wv) {
    const Ids t = ids(__builtin_amdgcn_readfirstlane(wv));     unsigned char* ws = ka->ws;
    { const float* pool_w = ((const float*)ka->in[I_POOLW]); const float* pool_scale = ((const float*)ka->in[I_POOLS]); const float* w_branch = ((const float*)ka->in[I_WBR]); bf16* WB = (bf16*)(ws + WS_WB);
      for (int idx = t.wg * NTHR + t.tid; idx < DEPTH * 1024 * 256; idx += t.G * NTHR) {
          const int l = idx >> 18, n = (idx >> 8) & 1023, gc = idx & 255, g = gc >> 6;
          const float* pw = pool_w + ((size_t)(l * 4) * 64 + gc) * 64; const float* ps = pool_scale + l * 256 + 64 * g; const float* wb = w_branch + ((size_t)(l * 4 + 1) * 256 + 64 * g) * D + n;
          float s = 0.f;
          for (int d = 0; d < 64; ++d) s += pw[d] * ps[d] * wb[(size_t)d * D];
          WB[(size_t)(l * 4 + 1) * D * 256 + (size_t)n * 256 + gc] = (bf16)(cvtpk(s, 0.f) & 0xffffu); } }
    { const float* mem = ((const float*)ka->in[I_MEM]); const float* gm = ((const float*)ka->in[I_NMEMG]); bf16* MEMH = (bf16*)(ws + WS_MEMH);
      for (int it = t.gw; it < DEPTH * MMEM; it += t.NGW) { const int l = it / MMEM, rw = it - l * MMEM; rms_row_bf16(mem + (size_t)rw * D, gm + l * D, MEMH + (size_t)it * D, t.lane); } }
    { const int* positions = ((const int*)ka->in[I_POS]); f32x2* ROT = (f32x2*)(ws + WS_ROT);
      for (int idx = t.wg * NTHR + t.tid; idx < MTOT * 32; idx += t.G * NTHR) { const int tok = idx >> 5, i = idx & 31;
          const float ang = (float)positions[tok] * INV_FREQ[i]; double rev = (double)ang * 0.15915494309189535; rev -= floor(rev); const float rv = (float)rev;
          ROT[idx] = (f32x2){__builtin_amdgcn_cosf(rv), __builtin_amdgcn_sinf(rv)}; } }
}
PH void ph_kv(int wv, LAS unsigned char* lds) {
    const Ids t = ids(wv); unsigned char* ws = KA()->ws;
    pg8::OrdKV S; S.to.init(DEPTH * (MMEM / 256), 2, t.G, t.wg); S.A = (const char*)(ws + WS_MEMH); S.B = (const char*)(ws + WS_WKV);
    pg8::EpiBf16 E{(bf16*)(ws + WS_KV), 512, 1.f};
    pg8::gemm_phase<pg8::EpiBf16, pg8::OrdKV>(lds, D, D, S, E, t.wave);
}
PHN void ph_knorm(KArgs ka, int wv) {
    const Ids t = ids(__builtin_amdgcn_readfirstlane(wv));     unsigned char* ws = ka->ws; unsigned* ctl = (unsigned*)(ws + WS_CTL); bf16* KV = (bf16*)(ws + WS_KV); const float* xa_kg = ((const float*)ka->in[I_KG]);
    for (int it = t.gw; it < DEPTH * MMEM; it += t.NGW) { const int l = it / MMEM, rw = it - l * MMEM, b = rw >> 8; const int lane = t.lane;
        if (lane < 32) { bf16* kp = KV + (size_t)it * 512 + 8 * lane; const u32x4 w = *(const u32x4*)kp; float f[8]; unpack8(w, f); float ss = 0.f;
#pragma unroll
            for (int j = 0; j < 8; ++j) ss += f[j] * f[j];
            ss += SHX(ss, 1, lane); ss += SHX(ss, 2, lane); ss += SHX(ss, 4, lane);
            const float rs = 1.f / sqrtf(ss * (1.f / 64.f) + EPS); const float* gk = xa_kg + l * 64 + 8 * (lane & 7); float n2 = 0.f;
#pragma unroll
            for (int j = 0; j < 8; ++j) { f[j] *= rs * gk[j]; n2 += f[j] * f[j]; }
            *(u32x4*)kp = pack8(f);
            n2 += SHX(n2, 1, lane); n2 += SHX(n2, 2, lane); n2 += SHX(n2, 4, lane);
            if ((lane & 7) == 0) atomicMax(ctl + CW_KMAX + (l * NB + b) * 4 + (lane >> 3), __float_as_uint(n2 * 1.02f)); } }
}
PHN void ph_norm(KArgs ka, int wv, int g, int l, int which) {
    const Ids t = ids(__builtin_amdgcn_readfirstlane(wv));     unsigned char* ws = ka->ws; const size_t grow = (size_t)g * MG;
    const float* src = (which == 0 && l == 0) ? (((const float*)ka->in[I_X]) + grow * D) : (ka->out + grow * D);
    const float* gain = (which == 0 ? ((const float*)ka->in[I_NMIXG]) : which == 1 ? ((const float*)ka->in[I_NXAG]) : ((const float*)ka->in[I_NFFNG])) + l * D;
    bf16* HB = (bf16*)(ws + WS_HB);
    if (which == 3) { unsigned char* H8 = ws + WS_HB; for (int m = t.gw; m < MG; m += t.NGW) rms_row_fp8(src + (size_t)m * D, gain, H8 + (size_t)m * D, t.lane); }
    else for (int m = t.gw; m < MG; m += t.NGW) rms_row_bf16(src + (size_t)m * D, gain, HB + (size_t)m * D, t.lane);
}
PH void ph_gemm1(int wv, LAS unsigned char* lds, int l) {
    const Ids t = ids(wv); unsigned char* ws = KA()->ws;
    pg8::OrdStd S; S.to.init(MG / 256, NCAT / 256, t.G, t.wg); S.A = (const char*)(ws + WS_HB); S.B = (const char*)((bf16*)(ws + WS_WCAT) + (size_t)l * NCAT * D); S.atile = 256 * D * 2; S.btile = 256 * D * 2;
    pg8::EpiCat E{(bf16*)(ws + WS_U), (bf16*)(ws + WS_GATES)};
    pg8::gemm_phase<pg8::EpiCat, pg8::OrdStd>(lds, D, D, S, E, t.wave);
}
constexpr int NSB = BG * 4 * 16, NRC = BG * 4 * 16, NCONV = BG * 64, NPOOL = BG * 64;
PH void ph_mix(int wv, LAS unsigned char* lds, int g, int l, int part, int rep = 0) {
    const Ids t = ids(wv); unsigned char* ws = KA()->ws; unsigned* ctl = (unsigned*)(ws + WS_CTL);
    volatile LAS unsigned* MISC = (volatile LAS unsigned*)(lds + MISC_OFF);
    unsigned* qctr = ctl + CW_QCTR + 64 * ((g * 4 + l) * 2 + part + 16 * rep);
    const bf16* UB = (const bf16*)(ws + WS_U); bf16* YB = (bf16*)(ws + WS_Y); float* KVS = (float*)(ws + WS_KVS); const f32x2* ROT = (const f32x2*)(ws + WS_ROT);
    const int NUQ = part == 0 ? (NSB + NRC + NPOOL) : (NRC + NCONV);
    for (;;) {
        __syncthreads();
        if (t.tid == 0) { MISC[0] = __hip_atomic_fetch_add(qctr, 1u, __ATOMIC_RELAXED, __HIP_MEMORY_SCOPE_AGENT); MISC[2] = 0u; MISC[3] = 0u; }
        __syncthreads();
        const int j = (int)MISC[0];
        if (j >= NUQ) break;
        if (part == 0) {
            if (j < NSB) sb_unit(UB, YB, (j >> 2) & 7, j & 3, 15 - (j >> 5), lds, t.tid, t.wave, t.lane);
            else if (j < NSB + NRC) { const int k = j - NSB, bl = k >> 6; retkv_unit(UB, KVS, ROT, bl, (g * BG + bl) * SEQ, (k >> 4) & 3, k & 15, lds, t.tid, t.wave, t.lane); }
            else { const int k = j - (NSB + NRC); pool_unit(UB, YB, k >> 6, k & 63, lds, t.tid); }
        } else {
            if (j < NRC) { const int bl = j >> 6; reto_unit(UB, YB, KVS, ROT, bl, (g * BG + bl) * SEQ, (j >> 4) & 3, j & 15, lds, t.tid, t.wave, t.lane); }
            else { const int k = j - NRC;
                conv_unit(UB, YB, KIN(float, I_CONVW) + (size_t)l * 31 * 256, KIN(float, I_CONVB) + l * 256, KIN(float, I_CLNG) + l * 256, KIN(float, I_CLNB) + l * 256, k >> 6, k & 63, lds, t.tid, t.wave, t.lane); }
        }
    }
}
PH void ph_merge(int wv, LAS unsigned char* lds, int l) {
    const Ids t = ids(wv); unsigned char* ws = KA()->ws;
    pg8::OrdMerge S; S.G = t.G; S.c = t.wg; S.ntiles = (MG / 256) * 4; S.A = (const char*)(ws + WS_Y); S.B = (const char*)((bf16*)(ws + WS_WB) + (size_t)l * 4 * D * 256);
    pg8::EpiMerge E{(const bf16*)(ws + WS_GATES), (bf16*)(ws + WS_MERGED)};
    pg8::gemm_phase<pg8::EpiMerge, pg8::OrdMerge>(lds, 256, D, S, E, t.wave);
}
PH void ph_res(int wv, LAS unsigned char* lds, int g, int l, int which) {
    const Ids t = ids(wv); unsigned char* ws = KA()->ws; const size_t grow = (size_t)g * MG; float* xo = KA()->out + grow * D;
    const float* xi = (which == 0 && l == 0) ? (KIN(float, I_X) + grow * D) : xo;
    int K; const char* A; const char* B;
    if (which == 0) { K = D; A = (const char*)(ws + WS_MERGED); B = (const char*)((bf16*)(ws + WS_WOUT) + (size_t)l * D * D); }
    else { K = 256; A = (const char*)(ws + WS_OB); B = (const char*)((bf16*)(ws + WS_WO) + (size_t)l * D * 256); }
    pg8::OrdStd S; S.to.init(MG / 256, 4, t.G, t.wg); S.A = A; S.B = B; S.atile = (size_t)256 * K * 2; S.btile = (size_t)256 * K * 2;
    pg8::EpiRes E{xi, xo, 1.f};
    pg8::gemm_phase<pg8::EpiRes, pg8::OrdStd>(lds, K, K, S, E, t.wave);
}
template <bool F8> PH void ph_down(int wv, LAS unsigned char* lds, int g, int l) {
    constexpr int FE = F8 ? 1 : 2;
    const Ids t = ids(wv); unsigned char* ws = KA()->ws; float* xo = KA()->out + (size_t)g * MG * D;
    pg8::OrdStd S; S.to.init(MG / 256, 4, t.G, t.wg); S.A = (const char*)(ws + WS_ACT); S.B = (const char*)(ws + WS_WDND + (size_t)(l >> 1) * D * DFF * 2); S.atile = (size_t)256 * DFF * FE; S.btile = (size_t)256 * DFF * FE;
    pg8::EpiRes E{xo, xo, F8 ? W8_INV : 1.f};
    pg8::gemm_phase<pg8::EpiRes, pg8::OrdStd, F8>(lds, DFF, DFF, S, E, t.wave);
}
PH void ph_q(int wv, LAS unsigned char* lds, int l) {
    const Ids t = ids(wv); unsigned char* ws = KA()->ws;
    pg8::OrdStd S; S.to.init(MG / 256, 1, t.G, t.wg); S.A = (const char*)(ws + WS_HB); S.B = (const char*)((bf16*)(ws + WS_WQ) + (size_t)l * 256 * D); S.atile = 256 * D * 2; S.btile = 256 * D * 2;
    pg8::EpiBf16 E{(bf16*)(ws + WS_QB), 256, 1.f};
    pg8::gemm_phase<pg8::EpiBf16, pg8::OrdStd>(lds, D, D, S, E, t.wave);
}
PH void ph_xa(int wv, LAS unsigned char* lds, int g, int l) {
    const Ids t = ids(wv); unsigned char* ws = KA()->ws; const unsigned* ctl = (const unsigned*)(ws + WS_CTL);
    for (int j = t.wg; j < BG * 4 * 16; j += t.G) { const int bl = j >> 6, hd = (j >> 4) & 3, qblk = j & 15, bglob = g * BG + bl;
        const float kmax = sqrtf(__uint_as_float(ctl[CW_KMAX + (l * NB + bglob) * 4 + hd]));
        xa_unit((const bf16*)(ws + WS_QB), (const bf16*)(ws + WS_KV) + (size_t)l * MMEM * 512, KIN(float, I_QG) + l * 64, kmax, (bf16*)(ws + WS_OB), bl, bglob, hd, qblk, lds, t.tid, t.wave, t.lane); }
}
template <bool F8> PH void ph_gu(int wv, LAS unsigned char* lds, int l) {
    constexpr int FE = F8 ? 1 : 2;
    const Ids t = ids(wv); unsigned char* ws = KA()->ws;
    pg8::OrdStd S; S.to.init(MG / 256, NGU / 256, t.G, t.wg); S.A = (const char*)(ws + WS_HB); S.B = (const char*)(ws + WS_WGUD + (size_t)(l >> 1) * NGU * D * 2); S.atile = 256 * D * FE; S.btile = 256 * D * FE;
    pg8::EpiGU<F8> E{(void*)(ws + WS_ACT), F8 ? W8_INV : 1.f};
    pg8::gemm_phase<pg8::EpiGU<F8>, pg8::OrdStd, F8>(lds, D, D, S, E, t.wave);
}
struct MoeCtx { int rpw, r_lo, r_hi; };
DI MoeCtx moe_ctx(const Ids& t) { MoeCtx c; c.rpw = (MG + t.G - 1) / t.G; c.r_lo = t.wg * c.rpw; c.r_hi = (c.r_lo + c.rpw < MG) ? (c.r_lo + c.rpw) : MG; return c; }
template <bool F8> PH void ph_route(int wv, LAS unsigned char* lds, int g, int l) {
    constexpr int FE = F8 ? 1 : 2;
    const Ids t = ids(wv); unsigned char* ws = KA()->ws; unsigned* ctl = (unsigned*)(ws + WS_CTL); const int l2 = l >> 1, inst = g * 2 + l2;
    unsigned* wgcnt = ctl + CW_WGCNT + inst * 8192; const MoeCtx mc = moe_ctx(t);
    volatile LAS unsigned* LC = (volatile LAS unsigned*)(lds + MISC_OFF) + 16;
    const float* xo = KA()->out + (size_t)g * MG * D; bf16* HB = (bf16*)(ws + WS_HB);
    int* R_E = (int*)(ws + WS_ROUTE); float* R_W1 = (float*)(R_E + MG); float* R_W2 = R_W1 + MG;
    if (t.tid < 16) LC[t.tid] = 0u;
    __syncthreads();
    const float* rt = KIN(float, I_ROUTER) + (size_t)l2 * D * NEXP; const float* gn = KIN(float, I_NFFNG) + l * D; const int lane = t.lane;
    for (int m = mc.r_lo + t.wave; m < mc.r_hi; m += NWAVES) {
        const f32x4* xr = (const f32x4*)(xo + (size_t)m * D) + lane; const f32x4* gr = (const f32x4*)gn + lane;
        f32x4 v[4]; float s = 0.f;
#pragma unroll
        for (int j = 0; j < 4; ++j) { v[j] = xr[64 * j]; s += (v[j].x * v[j].x + v[j].y * v[j].y) + (v[j].z * v[j].z + v[j].w * v[j].w); }
        const float rstd = 1.f / sqrtf(wave_sum(s, lane) * (1.f / D) + EPS);
        float lg[8];
#pragma unroll
        for (int e = 0; e < 8; ++e) lg[e] = 0.f;
        u32x2* o8 = (u32x2*)(HB + (size_t)m * D) + lane; unsigned* o4 = (unsigned*)((unsigned char*)HB + (size_t)m * D) + lane;
#pragma unroll
        for (int j = 0; j < 4; ++j) { const f32x4 gg = gr[64 * j]; const f32x4 hn = v[j] * rstd * gg;
            if (F8) o4[64 * j] = cvt4_fp8(hn.x, hn.y, hn.z, hn.w);
            else { u32x2 w; w.x = cvtpk(hn.x, hn.y); w.y = cvtpk(hn.z, hn.w); o8[64 * j] = w; }
            const f32x4* rp = (const f32x4*)(rt + (size_t)(4 * lane + 256 * j) * NEXP);
#pragma unroll
            for (int q = 0; q < 4; ++q) { const f32x4 r0 = rp[2 * q], r1 = rp[2 * q + 1]; const float hv = hn[q];
                lg[0] += hv * r0.x; lg[1] += hv * r0.y; lg[2] += hv * r0.z; lg[3] += hv * r0.w; lg[4] += hv * r1.x; lg[5] += hv * r1.y; lg[6] += hv * r1.z; lg[7] += hv * r1.w; } }
#pragma unroll
        for (int e = 0; e < 8; ++e) lg[e] = wave_sum(lg[e], lane);
        float v1 = lg[0]; int i1 = 0;
#pragma unroll
        for (int e = 1; e < 8; ++e) if (lg[e] > v1) { v1 = lg[e]; i1 = e; }
        float v2 = -3.0e38f; int i2 = -1;
#pragma unroll
        for (int e = 0; e < 8; ++e) if (e != i1 && (i2 < 0 || lg[e] > v2)) { v2 = lg[e]; i2 = e; }
        const float w1 = 1.f / (1.f + __expf(v2 - v1));
        if (lane == 0) { R_E[m] = i1 | (i2 << 8); R_W1[m] = w1; R_W2[m] = 1.f - w1;
            __hip_atomic_fetch_add((LAS unsigned*)&LC[i1], 1u, __ATOMIC_RELAXED, __HIP_MEMORY_SCOPE_WORKGROUP); __hip_atomic_fetch_add((LAS unsigned*)&LC[i2], 1u, __ATOMIC_RELAXED, __HIP_MEMORY_SCOPE_WORKGROUP); }
    }
    __syncthreads();
    if (t.tid < 8) wgcnt[t.wg * 8 + t.tid] = LC[t.tid];
}
template <bool F8> PHN void ph_gather(KArgs ka, int wv, LAS unsigned char* lds, int g, int l) {
    constexpr int FE = F8 ? 1 : 2;
    const Ids t = ids(__builtin_amdgcn_readfirstlane(wv));     unsigned char* ws = ka->ws; unsigned* ctl = (unsigned*)(ws + WS_CTL); const int l2 = l >> 1, inst = g * 2 + l2;
    unsigned* wgcnt = ctl + CW_WGCNT + inst * 8192; unsigned* moff = ctl + CW_MOFF + 64 * inst; const MoeCtx mc = moe_ctx(t);
    volatile LAS unsigned* LC = (volatile LAS unsigned*)(lds + MISC_OFF) + 16;
    const bf16* HB = (const bf16*)(ws + WS_HB); bf16* HP = (bf16*)(ws + WS_HP);
    const int* R_E = (const int*)(ws + WS_ROUTE); int* R_S1 = (int*)(ws + WS_ROUTE) + 3 * MG; int* R_S2 = R_S1 + MG;
    if (t.tid < 16) LC[t.tid] = 0u;
    __syncthreads();
    for (int idx = t.tid; idx < t.G * 8; idx += NTHR) { const unsigned v = wgcnt[idx]; const int e = idx & 7;
        __hip_atomic_fetch_add((LAS unsigned*)&LC[8 + e], v, __ATOMIC_RELAXED, __HIP_MEMORY_SCOPE_WORKGROUP);
        if ((idx >> 3) < t.wg) __hip_atomic_fetch_add((LAS unsigned*)&LC[e], v, __ATOMIC_RELAXED, __HIP_MEMORY_SCOPE_WORKGROUP); }
    __syncthreads();
    if (t.tid == 0) { unsigned o = 0;
        for (int e = 0; e < 8; ++e) { const unsigned tot = LC[8 + e]; if (t.wg == 0) moff[e] = o; LC[e] = LC[e] + o; o += (tot + 255u) & ~255u; }
        if (t.wg == 0) moff[8] = o; }
    __syncthreads();
    const int lane = t.lane;
    for (int m = mc.r_lo + t.wave; m < mc.r_hi; m += NWAVES) {
        int s1 = 0, s2 = 0;
        if (lane == 0) { const int ee = R_E[m];
            s1 = (int)__hip_atomic_fetch_add((LAS unsigned*)&LC[ee & 255], 1u, __ATOMIC_RELAXED, __HIP_MEMORY_SCOPE_WORKGROUP);
            s2 = (int)__hip_atomic_fetch_add((LAS unsigned*)&LC[ee >> 8], 1u, __ATOMIC_RELAXED, __HIP_MEMORY_SCOPE_WORKGROUP);
            R_S1[m] = s1; R_S2[m] = s2; }
        s1 = __builtin_amdgcn_readfirstlane(s1); s2 = __builtin_amdgcn_readfirstlane(s2);
        if (F8) { const u32x4 a = *((const u32x4*)((const unsigned char*)HB + (size_t)m * D) + lane);
            *((u32x4*)((unsigned char*)HP + (size_t)s1 * D) + lane) = a; *((u32x4*)((unsigned char*)HP + (size_t)s2 * D) + lane) = a; }
        else { const u32x4* src = (const u32x4*)(HB + (size_t)m * D) + lane; const u32x4 a = src[0], b = src[64];
            u32x4* d1 = (u32x4*)(HP + (size_t)s1 * D) + lane; u32x4* d2 = (u32x4*)(HP + (size_t)s2 * D) + lane;
            d1[0] = a; d1[64] = b; d2[0] = a; d2[64] = b; } }
}
template <bool F8> PH void ph_moe_gu(int wv, LAS unsigned char* lds, int g, int l) {
    constexpr int FE = F8 ? 1 : 2;
    const Ids t = ids(wv); unsigned char* ws = KA()->ws; const unsigned* ctl = (const unsigned*)(ws + WS_CTL); const int l2 = l >> 1, inst = g * 2 + l2; const unsigned* moff = ctl + CW_MOFF + 64 * inst;
    pg8::OrdMoe S;
#pragma unroll
    for (int e = 0; e < 9; ++e) S.off[e] = __builtin_amdgcn_readfirstlane((int)moff[e]);
    S.to.init(S.off[8] >> 8, NGU / 256, t.G, t.wg); S.A = (const char*)(ws + WS_HP); S.B = (const char*)(ws + WS_WGUM + (size_t)l2 * NEXP * NGU * D * 2); S.atile = 256 * D * FE; S.btile = 256 * D * FE; S.bexp = (size_t)NGU * D * 2;
    pg8::EpiGU<F8> E{(void*)(ws + WS_ACT), F8 ? W8_INV : 1.f};
    pg8::gemm_phase<pg8::EpiGU<F8>, pg8::OrdMoe, F8>(lds, D, D, S, E, t.wave);
}
template <bool F8> PH void ph_moe_dn(int wv, LAS unsigned char* lds, int g, int l) {
    constexpr int FE = F8 ? 1 : 2;
    const Ids t = ids(wv); unsigned char* ws = KA()->ws; const unsigned* ctl = (const unsigned*)(ws + WS_CTL); const int l2 = l >> 1, inst = g * 2 + l2; const unsigned* moff = ctl + CW_MOFF + 64 * inst;
    pg8::OrdMoe S;
#pragma unroll
    for (int e = 0; e < 9; ++e) S.off[e] = __builtin_amdgcn_readfirstlane((int)moff[e]);
    S.to.init(S.off[8] >> 8, 4, t.G, t.wg); S.A = (const char*)(ws + WS_ACT); S.B = (const char*)(ws + WS_WDNM + (size_t)l2 * NEXP * D * DFF * 2); S.atile = (size_t)256 * DFF * FE; S.btile = (size_t)256 * DFF * FE; S.bexp = (size_t)D * DFF * 2;
    pg8::EpiBf16 E{(bf16*)(ws + WS_HP), D, F8 ? W8_INV : 1.f};
    pg8::gemm_phase<pg8::EpiBf16, pg8::OrdMoe, F8>(lds, DFF, DFF, S, E, t.wave);
}
PHN void ph_combine(KArgs ka, int wv, int g) {
    const Ids t = ids(__builtin_amdgcn_readfirstlane(wv));     unsigned char* ws = ka->ws; float* xo = ka->out + (size_t)g * MG * D; const bf16* HP = (const bf16*)(ws + WS_HP);
    const int* R_E = (const int*)(ws + WS_ROUTE); const float* R_W1 = (const float*)(R_E + MG); const float* R_W2 = R_W1 + MG; const int* R_S1 = (const int*)(R_W2 + MG); const int* R_S2 = R_S1 + MG;
    const int lane = t.lane;
    for (int m = t.gw; m < MG; m += t.NGW) { const int s1 = R_S1[m], s2 = R_S2[m]; const float w1 = R_W1[m], w2 = R_W2[m];
        f32x4* xr = (f32x4*)(xo + (size_t)m * D) + 2 * lane; const u32x4* p1 = (const u32x4*)(HP + (size_t)s1 * D) + lane; const u32x4* p2 = (const u32x4*)(HP + (size_t)s2 * D) + lane;
#pragma unroll
        for (int j = 0; j < 2; ++j) { float a[8], b[8]; unpack8(p1[64 * j], a); unpack8(p2[64 * j], b); f32x4 x0 = xr[128 * j], x1 = xr[128 * j + 1];
            x0.x += w1 * a[0] + w2 * b[0]; x0.y += w1 * a[1] + w2 * b[1]; x0.z += w1 * a[2] + w2 * b[2]; x0.w += w1 * a[3] + w2 * b[3];
            x1.x += w1 * a[4] + w2 * b[4]; x1.y += w1 * a[5] + w2 * b[5]; x1.z += w1 * a[6] + w2 * b[6]; x1.w += w1 * a[7] + w2 * b[7];
            xr[128 * j] = x0; xr[128 * j + 1] = x1; } }
}

__global__ void __launch_bounds__(NTHR, 2) trunk_fwd(Args args) {
    extern __shared__ __attribute__((aligned(16))) unsigned char lds_raw[];
    LAS unsigned char* lds = (LAS unsigned char*)lds_raw;
    volatile LAS unsigned* MISC = (volatile LAS unsigned*)(lds + MISC_OFF);
    const int tid = threadIdx.x; int wave = __builtin_amdgcn_readfirstlane(tid >> 6); asm volatile("" : "+s"(wave));
    unsigned* ctl = (unsigned*)(args.ws + WS_CTL);
    for (int u = tid; u < (LDS_BYTES - LDSCTL_OFF) / 4; u += NTHR) ((LAS unsigned*)(lds + LDSCTL_OFF))[u] = 0u;
    __syncthreads();
    XcdBarrier bar; bar.bar = ctl + CW_BAR; bar.x = xb_xcc_id(); bar.st = MISC + 8;
    if (tid == 0) (void)xb_add(&bar.bar[XB_XCNT(bar.x)], 1u);
#define WV() ({ int _w = wave; asm volatile("" : "+s"(_w)); _w; })
#define GRID_BAR() xcd_barrier_fn((GAS unsigned*)bar.bar, bar.x, bar.st, WV())
    for (int l = 0; l < DEPTH; ++l) ph_w_layer(KA(), WV(), lds, l);
    for (int s = 0; s < 2 + 2 * NEXP; ++s) ph_w_ffn(KA(), WV(), lds, s);
    ph_misc0(KA(), WV());
    GRID_BAR();
    ph_kv(wave, lds);
    GRID_BAR();
    ph_knorm(KA(), WV());
    GRID_BAR();
    for (int g = 0; g < NG; ++g) {
        for (int l = 0; l < DEPTH; ++l) {
            ph_norm(KA(), WV(), g, l, 0); GRID_BAR();
            ph_gemm1(wave, lds, l); GRID_BAR();
            ph_mix(wave, lds, g, l, 0); GRID_BAR();
            ph_mix(wave, lds, g, l, 1); GRID_BAR();
#ifdef DUP_MIX
            ph_mix(wave, lds, g, l, 0, 1); GRID_BAR();
            ph_mix(wave, lds, g, l, 1, 1); GRID_BAR();
#endif
#ifdef DUP_XA
            ph_q(wave, lds, l); GRID_BAR();
#endif
            ph_merge(wave, lds, l); GRID_BAR();
            ph_res(wave, lds, g, l, 0); GRID_BAR();
            ph_norm(KA(), WV(), g, l, 1); GRID_BAR();
            ph_q(wave, lds, l); GRID_BAR();
            ph_xa(wave, lds, g, l); GRID_BAR();
            ph_res(wave, lds, g, l, 1); GRID_BAR();
            const bool f8 = (F8MASK >> l) & 1u;
            if ((l & 1) == 0) {
                ph_norm(KA(), WV(), g, l, f8 ? 3 : 2); GRID_BAR();
                if (f8) { if constexpr (DENSE_ANY8) { ph_gu<true>(wave, lds, l); GRID_BAR(); ph_down<true>(wave, lds, g, l); GRID_BAR(); } }
                else { if constexpr (DENSE_ANYB) { ph_gu<false>(wave, lds, l); GRID_BAR(); ph_down<false>(wave, lds, g, l); GRID_BAR(); } }
            } else {
                if (f8) { if constexpr (MOE_ANY8) { ph_route<true>(wave, lds, g, l); GRID_BAR(); ph_gather<true>(KA(), WV(), lds, g, l); GRID_BAR(); ph_moe_gu<true>(wave, lds, g, l); GRID_BAR(); ph_moe_dn<true>(wave, lds, g, l); GRID_BAR(); } }
                else { if constexpr (MOE_ANYB) { ph_route<false>(wave, lds, g, l); GRID_BAR(); ph_gather<false>(KA(), WV(), lds, g, l); GRID_BAR(); ph_moe_gu<false>(wave, lds, g, l); GRID_BAR(); ph_moe_dn<false>(wave, lds, g, l); GRID_BAR(); } }
                ph_combine(KA(), WV(), g); GRID_BAR();
            }
        }
    }
}

extern "C" void kernel_launch(void* const* d_in, const int* in_sizes, int n_in, void* d_out, int out_size, void* d_ws, size_t ws_size, hipStream_t stream) {
    static int grid = 0;
    if (grid == 0) {
        if (n_in != 27 || in_sizes[0] != MTOT * D || out_size != MTOT * D || ws_size < WS_END) { fprintf(stderr, "kernel_launch: unexpected problem (n_in %d, in0 %d, out %d, ws %zu < %zu)\n", n_in, n_in > 0 ? in_sizes[0] : -1, out_size, ws_size, (size_t)WS_END); grid = -1; return; }
        int dev = 0, cus = 0, per_cu = 0;
        if (hipGetDevice(&dev) != hipSuccess || hipDeviceGetAttribute(&cus, hipDeviceAttributeMultiprocessorCount, dev) != hipSuccess) { grid = -1; return; }
        if (hipFuncSetAttribute((const void*)trunk_fwd, hipFuncAttributeMaxDynamicSharedMemorySize, LDS_BYTES) != hipSuccess) { fprintf(stderr, "kernel_launch: hipFuncSetAttribute failed\n"); grid = -1; return; }
        if (hipOccupancyMaxActiveBlocksPerMultiprocessor(&per_cu, (const void*)trunk_fwd, NTHR, LDS_BYTES) != hipSuccess || per_cu < 1) fprintf(stderr, "kernel_launch: occupancy query reports %d\n", per_cu);
        (void)hipGetLastError();
        grid = cus;
    }
    if (grid < 0) return;
    if (hipMemsetAsync((char*)d_ws + WS_CTL, 0, CTL_ZERO_BYTES, stream) != hipSuccess) return;
    Args a{};
    for (int i = 0; i < 27; ++i) a.in[i] = d_in[i];
    a.out = (float*)d_out; a.ws = (unsigned char*)d_ws;
    hipLaunchKernelGGL(trunk_fwd, dim3(grid), dim3(NTHR), LDS_BYTES, stream, a);
}
```

```cpp
#include <hip/hip_runtime.h>
#include <cstdio>
#include <cstdint>

#define DI __device__ __forceinline__
#define LAS __attribute__((address_space(3)))
#define GAS __attribute__((address_space(1)))
typedef unsigned short bf16;
typedef short bf16x8 __attribute__((ext_vector_type(8)));
typedef short s16x4 __attribute__((ext_vector_type(4)));
typedef float f32x2 __attribute__((ext_vector_type(2)));
typedef float f32x4 __attribute__((ext_vector_type(4)));
typedef float f32x16 __attribute__((ext_vector_type(16)));
typedef unsigned u32x2 __attribute__((ext_vector_type(2)));
typedef unsigned u32x4 __attribute__((ext_vector_type(4)));
typedef __bf16 bf16x2_t __attribute__((ext_vector_type(2)));
typedef GAS unsigned gu32;
typedef int i32x8 __attribute__((ext_vector_type(8)));
#ifndef GATE_FP8
#define GATE_FP8 1
#endif
#ifndef FFN_FP8_MASK
#define FFN_FP8_MASK 0xE
#endif
constexpr float W8_SCALE = 64.f, W8_INV = 1.f / 64.f;

constexpr int NB = 16, SEQ = 4096, D = 1024, DEPTH = 4, NG = 2, BG = NB / NG, MG = BG * SEQ, MTOT = NB * SEQ;
constexpr int DIN = 2560, NCAT = DIN + 4096, DFF = 2816, NGU = 2 * DFF, NEXP = 8, NMEM = 256, MMEM = NB * NMEM;
constexpr int MOE_SLOTS = 2 * MG + NEXP * 256;
constexpr float EPS = 1e-6f;
constexpr int NWAVES = 8, NTHR = 512;
constexpr int UC_CA = 0, UC_CG = 256, UC_POOL = 512, UC_SBQ = 768, UC_SBK = 1024, UC_SBV = 1280, UC_RQ = 1536, UC_RK = 1792, UC_RV = 2048, UC_RG = 2304;
constexpr int YC_CONV = 0, YC_POOL = 256, YC_SB = 512, YC_RET = 768;

constexpr size_t MiB = 1u << 20;
constexpr size_t WS_CTL = 0, CTL_ZERO_BYTES = 1 * MiB;
constexpr size_t WS_WCAT = 1 * MiB;
constexpr size_t WS_WB = 53 * MiB;
constexpr size_t WS_WOUT = 61 * MiB;
constexpr size_t WS_WQ = 69 * MiB;
constexpr size_t WS_WKV = 71 * MiB;
constexpr size_t WS_WO = 75 * MiB;
constexpr size_t WS_WGUD = 77 * MiB;
constexpr size_t WS_WDND = 99 * MiB;
constexpr size_t WS_WGUM = 110 * MiB;
constexpr size_t WS_WDNM = 286 * MiB;
constexpr size_t WS_ROT = 374 * MiB;
constexpr size_t WS_MEMH = 390 * MiB;
constexpr size_t WS_KV = 422 * MiB;
constexpr size_t WS_HB = 438 * MiB;
constexpr size_t WS_U = 502 * MiB;
constexpr size_t WS_GATES = 662 * MiB;
constexpr size_t WS_Y = 918 * MiB;
constexpr size_t WS_MERGED = 982 * MiB;
constexpr size_t WS_QB = 1046 * MiB;
constexpr size_t WS_OB = 1062 * MiB;
constexpr size_t WS_ROUTE = 1078 * MiB;
constexpr size_t WS_KVS = 1079 * MiB;
constexpr size_t WS_SSQ = 1087 * MiB;
constexpr size_t WS_XB8 = 1089 * MiB;
constexpr size_t WS_END = 1121 * MiB;
constexpr size_t WS_ACT = WS_U, WS_HP = WS_Y;
static_assert((size_t)MOE_SLOTS * DFF * 2 <= WS_Y - WS_U, "act overlay");
static_assert((size_t)MOE_SLOTS * D * 2 <= WS_ROUTE - WS_Y, "hp overlay");
constexpr int CW_TMO = 0, CW_CODE = 1;
constexpr int CW_BAR = 4096;
constexpr int CW_QCTR = 8192;
constexpr int CW_KMAX = 10240;
constexpr int CW_MOFF = 10752;
constexpr int CW_WGCNT = 16384;

constexpr int RING_BYTES = 131072;
constexpr int LDSCTL_OFF = RING_BYTES, MISC_OFF = LDSCTL_OFF + 320;
constexpr int LDS_BYTES = 147456;
constexpr int KS = 72, VS = 264;
constexpr int L_KS = 0, L_VT = 36864, L_KT = 70656, L_ST = 104448;

#define SHX(x, m, lane) __builtin_bit_cast(float, __builtin_amdgcn_ds_bpermute((((lane) ^ (m)) << 2), __builtin_bit_cast(int, (float)(x))))
DI float wave_sum(float v, int lane) {
#pragma unroll
    for (int o = 1; o < 64; o <<= 1) v += SHX(v, o, lane);
    return v;
}
DI unsigned cvtpk(float lo, float hi) { f32x2 v = {lo, hi}; bf16x2_t b = __builtin_convertvector(v, bf16x2_t); return __builtin_bit_cast(unsigned, b); }
DI float bflo(unsigned w) { return __uint_as_float(w << 16); }
DI float bfhi(unsigned w) { return __uint_as_float(w & 0xffff0000u); }
DI void unpack8(const u32x4 w, float (&f)[8]) { f[0] = bflo(w.x); f[1] = bfhi(w.x); f[2] = bflo(w.y); f[3] = bfhi(w.y); f[4] = bflo(w.z); f[5] = bfhi(w.z); f[6] = bflo(w.w); f[7] = bfhi(w.w); }
DI u32x4 pack8(const float (&f)[8]) { u32x4 w; w.x = cvtpk(f[0], f[1]); w.y = cvtpk(f[2], f[3]); w.z = cvtpk(f[4], f[5]); w.w = cvtpk(f[6], f[7]); return w; }
DI unsigned cvt4_fp8(float a, float b, float c, float d) { int w = __builtin_amdgcn_cvt_pk_fp8_f32(a, b, 0, false); w = __builtin_amdgcn_cvt_pk_fp8_f32(c, d, w, true); return (unsigned)w; }
DI float fexp2(float x) { return __builtin_amdgcn_exp2f(x); }
DI float frcp(float x) { return __builtin_amdgcn_rcpf(x); }
DI float sigmoid_f(float x) { return frcp(1.f + fexp2(-1.44269504f * x)); }
DI int lane_id() { int l; asm volatile("v_mbcnt_lo_u32_b32 %0, -1, 0\n\tv_mbcnt_hi_u32_b32 %0, -1, %0" : "=v"(l)); return l; }
DI int crow(int reg, int h) { return (reg & 3) + 8 * (reg >> 2) + 4 * h; }
#define MFMA32(a, b, c) __builtin_amdgcn_mfma_f32_32x32x16_bf16((a), (b), (c), 0, 0, 0)

__device__ const float INV_FREQ[32] = {1.0f, 0.7498942017555237f, 0.5623413324356079f, 0.4216965138912201f, 0.3162277638912201f, 0.23713737726211548f, 0.17782793939113617f, 0.1333521455526352f,
    0.10000000149011612f, 0.0749894231557846f, 0.05623413249850273f, 0.04216964915394783f, 0.03162277489900589f, 0.023713737726211548f, 0.017782794311642647f, 0.013335213996469975f,
    0.009999999776482582f, 0.007498942315578461f, 0.005623413249850273f, 0.0042169648222625256f, 0.003162277629598975f, 0.0023713738191872835f, 0.0017782794311642647f, 0.0013335214462131262f,
    0.0010000000474974513f, 0.0007498941849917173f, 0.000562341301701963f, 0.0004216965171508491f, 0.0003162277571391314f, 0.00023713737027719617f, 0.00017782794020604342f, 0.0001333521504420787f};

namespace pg8 {
constexpr int BM = 256, BK = 64, HALF = 128, HTB = HALF * BK * 2, STAGE_BYTES = 8 * HTB, NXCD = 8, WGM = 8;
__host__ __device__ __forceinline__ int lds_byte(int r, int c) { const int st = (r >> 4) * 2 + (c >> 5), rr = r & 15, cc = c & 31, ob = rr * 64 + cc * 2; return st * 1024 + (ob ^ (((ob >> 9) & 1) << 5)); }
__host__ __device__ __forceinline__ void stage_rc(int b, int& R, int& C) { const int st = b / 1024, sb = b % 1024, swz = sb ^ (((sb >> 9) & 1) << 5); R = (st >> 1) * 16 + swz / 64; C = (st & 1) * 32 + (swz % 64) / 2; }
__host__ __device__ __forceinline__ int perm32(int rho) { const int n = rho >> 4, i = rho & 15; return 8 * (i >> 2) + 4 * n + (i & 3); }

struct Unit { int pm, pn, z; const char* a; const char* b; };
DI const char* uni(const char* p) { const unsigned long long v = (unsigned long long)p; const unsigned lo = __builtin_amdgcn_readfirstlane((unsigned)v), hi = __builtin_amdgcn_readfirstlane((unsigned)(v >> 32)); return (const char*)(((unsigned long long)hi << 32) | lo); }

struct TileOrder {
    int nM, nN, nwg, G, c;
    DI void init(int nM_, int nN_, int G_, int c_) { nM = nM_; nN = nN_; nwg = nM * nN; G = G_; c = c_; }
    DI bool tile(int i, int& pm, int& pn) const {
        const long L = (long)i * G + c; if (L >= nwg) return false;
        int wgid = (int)L; { const int q = nwg / NXCD, r = nwg % NXCD, xcd = wgid % NXCD, off = wgid / NXCD; wgid = (xcd < r ? xcd * (q + 1) : r * (q + 1) + (xcd - r) * q) + off; }
        const int nig = WGM * nN, gid = wgid / nig, fm = gid * WGM, gsz = (nM - fm) < WGM ? (nM - fm) : WGM;
        pm = fm + ((wgid % nig) % gsz); pn = (wgid % nig) / gsz; return true;
    }
};

template <class Epi, class Sched, bool F8 = false, bool HN = false>
DI void gemm_phase(LAS unsigned char* lds, const int K, const int lda, const Sched& S, const Epi& E, const int wid_in) {
    int wid = wid_in; asm volatile("" : "+s"(wid));
    int lane = lane_id(); asm volatile("" : "+v"(lane));
    const int tid = wid * 64 + lane, wr = wid >> 2, wc = wid & 3, fr = lane & 15, fq = lane >> 4;
    constexpr int ESZ = F8 ? 1 : 2; const int nt = (K * ESZ) / (BK * 2);
    unsigned voffA, voffB;
    { int R, C; stage_rc(tid * 16, R, C); const int Rb = Epi::PERM ? ((R & ~31) + perm32(R & 31)) : R;
      voffA = (unsigned)(R * lda * ESZ + C * 2); voffB = (unsigned)(Rb * K * ESZ + C * 2); }
    const size_t i1voffA = (size_t)64 * lda * ESZ, i1voffB = (size_t)64 * K * ESZ;
    const size_t kstep = (size_t)(BK * 2);
    const size_t hstepA = (size_t)HALF * lda * ESZ, hstepB = (size_t)HALF * K * ESZ;
    const unsigned ldsw = (unsigned)wid * 1024u;
    constexpr int PIECE = F8 ? 16 : 1024;
    const int aoff = lds_byte(wr * 64 + fr, F8 ? fq * 16 : fq * 8), boff = lds_byte(wc * 32 + fr, F8 ? fq * 16 : fq * 8);
#define PG8_SA(b, h) (((b) * 2 + (h)) * HTB)
#define PG8_SB(b, h) ((4 + (b) * 2 + (h)) * HTB)
#define PG8_STAGE(bufoff, gbase, voff) do { _Pragma("unroll") for (int _i = 0; _i < 2; ++_i) { asm volatile("" : "+v"(voff));     \
        __builtin_amdgcn_global_load_lds((const GAS unsigned*)((const GAS char*)(gbase) + (_i ? i1##voff : (size_t)0) + voff), (LAS unsigned*)(lds + (bufoff) + ldsw + _i * 8192), 16, 0, 0); } } while (0)
#define PG8_LD16(off) (*(const LAS u32x4*)(lds + (off)))
#define PG8_LD16B(off) (*(const LAS u32x4*)(ldsB + (off)))
#define PG8_SBR(b, h) (((b) * 2 + (h)) * HTB)
#define PG8_LDA(dst, b, h) do { _Pragma("unroll") for (int m = 0; m < 4; ++m) { if constexpr (F8) dst##8[m] = __builtin_bit_cast(i32x8, __builtin_shufflevector(PG8_LD16(PG8_SA(b, h) + aoff + m * 2048), PG8_LD16(PG8_SA(b, h) + aoff + PIECE + m * 2048), 0, 1, 2, 3, 4, 5, 6, 7)); \
        else { _Pragma("unroll") for (int k = 0; k < 2; ++k) dst[m][k] = *(const LAS bf16x8*)(lds + PG8_SA(b, h) + aoff + k * PIECE + m * 2048); } } } while (0)
#define PG8_LDB(dst, b, h) do { _Pragma("unroll") for (int n = 0; n < 2; ++n) { if constexpr (F8) dst##8[n] = __builtin_bit_cast(i32x8, __builtin_shufflevector(PG8_LD16B(PG8_SBR(b, h) + n * 2048), PG8_LD16B(PG8_SBR(b, h) + PIECE + n * 2048), 0, 1, 2, 3, 4, 5, 6, 7)); \
        else { _Pragma("unroll") for (int k = 0; k < 2; ++k) dst[n][k] = *(const LAS bf16x8*)(ldsB + PG8_SBR(b, h) + k * PIECE + n * 2048); } } } while (0)
#define PG8_MMA(ai, bj, At, Bt) do { if constexpr (HN && (bj) == 1) break; __builtin_amdgcn_s_setprio(1); _Pragma("unroll") for (int m = 0; m < 4; ++m) _Pragma("unroll") for (int n = 0; n < 2; ++n) { \
        if constexpr (F8) acc[ai][bj][m][n] = __builtin_amdgcn_mfma_scale_f32_16x16x128_f8f6f4(Bt##8[n], At##8[m], acc[ai][bj][m][n], 0, 0, 0, 0, 0, 0);     \
        else { _Pragma("unroll") for (int k = 0; k < 2; ++k) acc[ai][bj][m][n] = __builtin_amdgcn_mfma_f32_16x16x32_bf16(Bt[n][k], At[m][k], acc[ai][bj][m][n], 0, 0, 0); } } __builtin_amdgcn_s_setprio(0); } while (0)
#define PG8_WAIT_V(n) asm volatile("s_waitcnt vmcnt(" #n ")" ::: "memory")
#define PG8_WAIT_L(n) asm volatile("s_waitcnt lgkmcnt(" #n ")" ::: "memory")
#define PG8_BAR __builtin_amdgcn_s_barrier()
#define PG8_SCHED __builtin_amdgcn_sched_barrier(0)
    const LAS unsigned char* ldsB = lds + 4 * HTB + boff;
    Unit cur, nxt; int ui = 0;
    if (!S.next(0, cur)) return;
    f32x4 acc[2][2][4][2];
#pragma unroll
    for (int a = 0; a < 2; ++a)
#pragma unroll
        for (int b = 0; b < 2; ++b)
#pragma unroll
            for (int m = 0; m < 4; ++m)
#pragma unroll
                for (int n = 0; n < 2; ++n) acc[a][b][m][n] = (f32x4){0.f, 0.f, 0.f, 0.f};
    bf16x8 At[4][2], B0[2][2], B1[2][2]; i32x8 At8[4], B08[2], B18[2];
    const char* cA = cur.a; const char* cB = cur.b;
    PG8_STAGE(PG8_SB(0, 0), cB, voffB); PG8_STAGE(PG8_SB(0, 1), cB + hstepB, voffB); PG8_STAGE(PG8_SA(0, 0), cA, voffA); PG8_STAGE(PG8_SA(0, 1), cA + hstepA, voffA);
    if (wr == 1) PG8_BAR;
    PG8_WAIT_V(2); PG8_BAR;
    PG8_STAGE(PG8_SB(1, 0), cB + kstep, voffB); PG8_STAGE(PG8_SA(1, 0), cA + kstep, voffA); PG8_STAGE(PG8_SB(1, 1), cB + hstepB + kstep, voffB);
    PG8_WAIT_V(6); PG8_BAR;
    for (;;) {
        const bool has_next = S.next(ui + 1, nxt);
        const char* nA = has_next ? nxt.a : cA; const char* nB = has_next ? nxt.b : cB;
#pragma nounroll
        for (int t = 0; t < nt; t += 2) {
            const bool last = (t == nt - 2);
            const char* a1 = cA + (size_t)(t + 1) * kstep;
            const char* a2 = last ? nA : cA + (size_t)(t + 2) * kstep; const char* b2 = last ? nB : cB + (size_t)(t + 2) * kstep;
            asm volatile("" : "+s"(a1), "+s"(a2), "+s"(b2));
            const char* a3 = a2 + kstep; const char* b3 = b2 + kstep;
            PG8_LDB(B0, 0, 0); if constexpr (!HN) PG8_LDB(B1, 0, 1); PG8_SCHED; PG8_LDA(At, 0, 0); PG8_STAGE(PG8_SA(1, 1), a1 + hstepA, voffA);
            PG8_WAIT_V(8); PG8_WAIT_L(0); PG8_BAR; PG8_MMA(0, 0, At, B0); PG8_MMA(0, 1, At, B1); PG8_BAR; PG8_SCHED;
            PG8_LDA(At, 0, 1); PG8_STAGE(PG8_SB(0, 0), b2, voffB); PG8_STAGE(PG8_SB(0, 1), b2 + hstepB, voffB); PG8_STAGE(PG8_SA(0, 0), a2, voffA);
            PG8_WAIT_V(8); PG8_WAIT_L(0); PG8_BAR; PG8_MMA(1, 0, At, B0); PG8_MMA(1, 1, At, B1); PG8_BAR; PG8_SCHED;
            PG8_LDB(B0, 1, 0); if constexpr (!HN) PG8_LDB(B1, 1, 1); PG8_SCHED; PG8_LDA(At, 1, 0); PG8_STAGE(PG8_SA(0, 1), a2 + hstepA, voffA);
            PG8_WAIT_V(8); PG8_WAIT_L(0); PG8_BAR; PG8_MMA(0, 0, At, B0); PG8_MMA(0, 1, At, B1); PG8_BAR; PG8_SCHED;
            PG8_LDA(At, 1, 1); PG8_STAGE(PG8_SB(1, 0), b3, voffB); PG8_STAGE(PG8_SB(1, 1), b3 + hstepB, voffB); PG8_STAGE(PG8_SA(1, 0), a3, voffA);
            PG8_WAIT_V(8); PG8_WAIT_L(0); PG8_BAR; PG8_MMA(1, 0, At, B0); PG8_MMA(1, 1, At, B1); PG8_BAR; PG8_SCHED;
        }
        if (wr == 0) PG8_BAR;
        { int le = lane_id(); asm volatile("" : "+v"(le));
          E(acc, cur, wr, wc, le & 15, le >> 4); }
        if (!has_next) break;
#pragma unroll
        for (int a = 0; a < 2; ++a)
#pragma unroll
            for (int b = 0; b < (HN ? 1 : 2); ++b)
#pragma unroll
                for (int m = 0; m < 4; ++m)
#pragma unroll
                    for (int n = 0; n < 2; ++n) acc[a][b][m][n] = (f32x4){0.f, 0.f, 0.f, 0.f};
        cur = nxt; cA = nA; cB = nB; ++ui;
        if (wr == 1) PG8_BAR;
    }
    PG8_WAIT_V(0);
    PG8_BAR;
#undef PG8_SA
#undef PG8_SB
#undef PG8_STAGE
#undef PG8_LDA
#undef PG8_LDB
#undef PG8_MMA
#undef PG8_LD16
#undef PG8_LD16B
#undef PG8_SBR
#undef PG8_WAIT_V
#undef PG8_WAIT_L
#undef PG8_BAR
#undef PG8_SCHED
}

struct OrdStd {
    TileOrder to; const char* A; const char* B; size_t atile, btile;
    DI bool next(int i, Unit& u) const { if (!to.tile(i, u.pm, u.pn)) return false; u.z = 0; u.a = A + (size_t)u.pm * atile; u.b = B + (size_t)u.pn * btile; return true; }
};
struct OrdKV {
    TileOrder to; const char* A; const char* B;
    DI bool next(int i, Unit& u) const { if (!to.tile(i, u.pm, u.pn)) return false; const int l = u.pm >> 4; u.z = l; u.a = A + (size_t)u.pm * (256 * 1024 * 2); u.b = B + (size_t)l * (512 * 1024 * 2) + (size_t)u.pn * (256 * 1024 * 2); return true; }
};
struct OrdMerge {
    int G, c, ntiles; const char* A; const char* B;
    DI bool next(int i, Unit& u) const { const int tl = (i >> 2) * G + c; if (tl >= ntiles) return false; u.z = i & 3; u.pm = tl >> 3; u.pn = tl & 7;
        u.a = A + (size_t)u.pm * (256 * 1024 * 2) + (size_t)u.z * 512; u.b = B + (size_t)u.z * (1024 * 256 * 2) + (size_t)u.pn * (128 * 256 * 2); return true; }
};
struct OrdMoe {
    TileOrder to; const char* A; const char* B; size_t atile, btile, bexp; int off[9];
    DI bool next(int i, Unit& u) const { if (!to.tile(i, u.pm, u.pn)) return false; const int r0 = u.pm * 256; int e = 0;
#pragma unroll
        for (int k = 1; k < 8; ++k) e += (r0 >= off[k]) ? 1 : 0;
        u.z = e; u.a = uni(A + (size_t)u.pm * atile); u.b = uni(B + (size_t)e * bexp + (size_t)u.pn * btile); return true; }
};

DI float row_rstd(const float* ssq, size_t row, int fq, int lane) {
    const f32x4 a = *(const f32x4*)(ssq + row * 16 + 4 * fq); float s = (a.x + a.y) + (a.z + a.w); s += SHX(s, 16, lane); s += SHX(s, 32, lane); return 1.f / sqrtf(s * (1.f / D) + EPS); }
template <bool G8> struct EpiCat {
    static constexpr bool PERM = true;
    bf16* U; bf16* Gt; const float* ssq;
    DI void operator()(const f32x4 (&acc)[2][2][4][2], const Unit& u, int wr, int wc, int fr, int fq) const {
        const bool isg = G8 || u.pn >= 10; bf16* base = isg ? Gt : U; const int ldc = isg ? 4096 : DIN; const int colt = G8 ? u.pn * 256 : (isg ? (u.pn - 10) * 256 : u.pn * 256);
        const int row0 = u.pm * BM + wr * 64 + fr, col0 = colt + wc * 32 + 8 * fq;
#pragma unroll
        for (int ai = 0; ai < 2; ++ai)
#pragma unroll
            for (int m = 0; m < 4; ++m) { const size_t row = (size_t)(row0 + ai * HALF + m * 16); bf16* rowp = base + row * ldc + col0; const float rs = row_rstd(ssq, row, fq, fr + 16 * fq) * (G8 ? W8_INV : 1.f);
#pragma unroll
                for (int bj = 0; bj < 2; ++bj) { f32x4 v0 = acc[ai][bj][m][0] * rs, v1 = acc[ai][bj][m][1] * rs;
                    if (isg) {
#pragma unroll
                        for (int j = 0; j < 4; ++j) { v0[j] = sigmoid_f(v0[j]); v1[j] = sigmoid_f(v1[j]); } }
                    u32x4 w; w.x = cvtpk(v0[0], v0[1]); w.y = cvtpk(v0[2], v0[3]); w.z = cvtpk(v1[0], v1[1]); w.w = cvtpk(v1[2], v1[3]);
                    *(u32x4*)(rowp + bj * HALF) = w; } }
    }
};
template <bool S8> struct EpiBf16 {
    static constexpr bool PERM = true; static constexpr float sc = S8 ? W8_INV : 1.f;
    bf16* O; int ldc; const float* ssq;
    DI void operator()(const f32x4 (&acc)[2][2][4][2], const Unit& u, int wr, int wc, int fr, int fq) const {
        const int row0 = u.pm * BM + wr * 64 + fr, col0 = u.pn * BM + wc * 32 + 8 * fq;
#pragma unroll
        for (int ai = 0; ai < 2; ++ai)
#pragma unroll
            for (int m = 0; m < 4; ++m) { const size_t row = (size_t)(row0 + ai * HALF + m * 16); bf16* rowp = O + row * ldc + col0; const float s2 = ssq ? sc * row_rstd(ssq, row, fq, fr + 16 * fq) : sc;
#pragma unroll
                for (int bj = 0; bj < 2; ++bj) { const f32x4 v0 = acc[ai][bj][m][0] * s2, v1 = acc[ai][bj][m][1] * s2;
                    u32x4 w; w.x = cvtpk(v0[0], v0[1]); w.y = cvtpk(v0[2], v0[3]); w.z = cvtpk(v1[0], v1[1]); w.w = cvtpk(v1[2], v1[3]);
                    *(u32x4*)(rowp + bj * HALF) = w; } }
    }
};
struct EpiMerge {
    static constexpr bool PERM = true;
    const bf16* Gt; bf16* Mg;
    DI void operator()(f32x4 (&acc)[2][2][4][2], const Unit& u, int wr, int wc, int fr, int fq) const {
        const int row0 = u.pm * BM + wr * 64 + fr, col0 = u.pn * HALF + wc * 32 + 8 * fq;
        u32x4 gw[2][4];
#pragma unroll
        for (int ai = 0; ai < 2; ++ai)
#pragma unroll
            for (int m = 0; m < 4; ++m) gw[ai][m] = *(const u32x4*)(Gt + (size_t)(row0 + ai * HALF + m * 16) * 4096 + u.z * 1024 + col0);
#pragma unroll
        for (int ai = 0; ai < 2; ++ai)
#pragma unroll
            for (int m = 0; m < 4; ++m) { float g[8]; unpack8(gw[ai][m], g); const f32x4 v0 = acc[ai][0][m][0], v1 = acc[ai][0][m][1];
                f32x4 t0 = (f32x4){g[0] * v0[0], g[1] * v0[1], g[2] * v0[2], g[3] * v0[3]}, t1 = (f32x4){g[4] * v1[0], g[5] * v1[1], g[6] * v1[2], g[7] * v1[3]};
                if (u.z != 0) { t0 += acc[ai][1][m][0]; t1 += acc[ai][1][m][1]; }
                acc[ai][1][m][0] = t0; acc[ai][1][m][1] = t1;
                if (u.z == 3) { u32x4 w; w.x = cvtpk(t0[0], t0[1]); w.y = cvtpk(t0[2], t0[3]); w.z = cvtpk(t1[0], t1[1]); w.w = cvtpk(t1[2], t1[3]);
                    *(u32x4*)(Mg + (size_t)(row0 + ai * HALF + m * 16) * 1024 + col0) = w; } }
    }
};
template <bool XB, bool S8> struct EpiRes {
    static constexpr bool PERM = true;
    static constexpr float sc = S8 ? W8_INV : 1.f;
    static constexpr int MB = S8 ? 1 : 2;
    const float* base; float* out; int xbm; void* xb; float* ssq; unsigned char* xb8;
    DI void operator()(const f32x4 (&acc)[2][2][4][2], const Unit& u, int wr, int wc, int fr, int fq) const {
        const int row0 = u.pm * BM + wr * 64 + fr, col0 = u.pn * BM + wc * 32 + 8 * fq, lane = fr + 16 * fq;
#pragma unroll
        for (int ai = 0; ai < 2; ++ai)
#pragma unroll
            for (int m0 = 0; m0 < 4; m0 += MB) {
                f32x4 bsv[MB][2][2];
#pragma unroll
                for (int mm = 0; mm < MB; ++mm)
#pragma unroll
                    for (int bj = 0; bj < 2; ++bj) { const size_t off = (size_t)(row0 + ai * HALF + (m0 + mm) * 16) * D + col0 + bj * HALF; bsv[mm][bj][0] = *(const f32x4*)(base + off); bsv[mm][bj][1] = *(const f32x4*)(base + off + 4); }
#pragma unroll
                for (int mm = 0; mm < MB; ++mm) { const int m = m0 + mm; const size_t row = (size_t)(row0 + ai * HALF + m * 16), off = row * D + col0; float s = 0.f;
#pragma unroll
                    for (int bj = 0; bj < 2; ++bj) {
                        const f32x4 v0 = bsv[mm][bj][0] + acc[ai][bj][m][0] * sc, v1 = bsv[mm][bj][1] + acc[ai][bj][m][1] * sc;
                        *(f32x4*)(out + off + bj * HALF) = v0; *(f32x4*)(out + off + bj * HALF + 4) = v1;
                        if constexpr (XB) { s += ((v0.x * v0.x + v0.y * v0.y) + (v0.z * v0.z + v0.w * v0.w)) + ((v1.x * v1.x + v1.y * v1.y) + (v1.z * v1.z + v1.w * v1.w));
                            if (xbm & 1) { u32x4 w; w.x = cvtpk(v0.x, v0.y); w.y = cvtpk(v0.z, v0.w); w.z = cvtpk(v1.x, v1.y); w.w = cvtpk(v1.z, v1.w); *(u32x4*)((bf16*)xb + off + bj * HALF) = w; }
                            if (xbm & 2) { u32x2 w; w.x = cvt4_fp8(v0.x, v0.y, v0.z, v0.w); w.y = cvt4_fp8(v1.x, v1.y, v1.z, v1.w); *(u32x2*)(xb8 + off + bj * HALF) = w; } } }
                    if constexpr (XB) { s += SHX(s, 16, lane); s += SHX(s, 32, lane); if (xbm != 0 && fq == 0) ssq[row * 16 + u.pn * 4 + wc] = s; } }
                asm volatile("" ::: "memory"); }
    }
};
template <bool F8O> struct EpiGU {
    static constexpr bool PERM = true;
    static constexpr float sc = F8O ? W8_INV : 1.f;
    void* O; const float* ssq;
    DI void operator()(const f32x4 (&acc)[2][2][4][2], const Unit& u, int wr, int wc, int fr, int fq) const {
        const int row0 = u.pm * BM + wr * 64 + fr, col0 = u.pn * HALF + wc * 32 + 8 * fq;
#pragma unroll
        for (int ai = 0; ai < 2; ++ai)
#pragma unroll
            for (int m = 0; m < 4; ++m) { const size_t row = (size_t)(row0 + ai * HALF + m * 16), eo = row * DFF + col0; const float s2 = ssq ? sc * row_rstd(ssq, row, fq, fr + 16 * fq) : sc;
                float r[8];
#pragma unroll
                for (int n = 0; n < 2; ++n)
#pragma unroll
                    for (int j = 0; j < 4; ++j) { const float g = acc[ai][0][m][n][j] * s2, uu = acc[ai][1][m][n][j] * s2; r[4 * n + j] = g * sigmoid_f(g) * uu; }
                if constexpr (F8O) { u32x2 w; w.x = cvt4_fp8(r[0], r[1], r[2], r[3]); w.y = cvt4_fp8(r[4], r[5], r[6], r[7]); *(u32x2*)((unsigned char*)O + eo) = w; }
                else *(u32x4*)((bf16*)O + eo) = pack8(r); }
    }
};
}

#define XB_TMO      128
#define XB_XCNT(j)  (256  + 64 * (j))
#define XB_XSUB(j)  (1280 + 64 * (j))
#define XB_XGEN(j)  (2304 + 64 * (j))
#define XB_TOP      3328
#define XB_TOPGEN   3392
#define XCD_BAR_WORDS 3456
#define XB_SPIN_CAP (1u << 22)
DI unsigned xb_ld(unsigned* p)              { return __hip_atomic_load(p, __ATOMIC_RELAXED, __HIP_MEMORY_SCOPE_AGENT); }
DI unsigned xb_add(unsigned* p, unsigned v) { return __hip_atomic_fetch_add(p, v, __ATOMIC_RELAXED, __HIP_MEMORY_SCOPE_AGENT); }
DI unsigned xb_xcc_id() { return (unsigned)__builtin_amdgcn_s_getreg((3 << 11) | 20) & 0xFu; }
#define XB_SPIN(cond, bar) do { unsigned _sp = 0; while (cond) { __builtin_amdgcn_s_sleep(1); \
    if ((++_sp & 255u) == 0u) { if (xb_ld(&(bar)[XB_TMO])) break; if (_sp > XB_SPIN_CAP) { atomicAdd(&(bar)[XB_TMO], 1u); break; } } } } while (0)
struct XcdBarrier { unsigned* bar; unsigned x; volatile LAS unsigned* st; };
DI XcdBarrier xcd_barrier_post(unsigned* bar, volatile LAS unsigned* st) {
    XcdBarrier b; b.bar = bar; b.x = xb_xcc_id(); b.st = st;
    if (threadIdx.x == 0) (void)xb_add(&bar[XB_XCNT(b.x)], 1u);
    return b;
}
DI void xcd_barrier_complete(unsigned* bar, unsigned x, unsigned& nloc, unsigned& nx) {
    const unsigned G = gridDim.x * gridDim.y * gridDim.z;
    unsigned sum, cnt, mine, sp = 0u;
    for (;;) {
        sum = 0u; cnt = 0u; mine = 0u;
#pragma unroll
        for (unsigned j = 0; j < 16; ++j) { const unsigned c = xb_ld(&bar[XB_XCNT(j)]); sum += c; cnt += (c > 0u) ? 1u : 0u; mine = (j == x) ? c : mine; }
        if (sum == G) break;
        __builtin_amdgcn_s_sleep(1);
        if ((++sp & 255u) == 0u) { if (xb_ld(&bar[XB_TMO])) break; if (sp > XB_SPIN_CAP) { atomicAdd(&bar[XB_TMO], 1u); break; } }
    }
    nloc = mine > 0u ? mine : 1u; nx = cnt > 0u ? cnt : 1u;
}
__device__ __noinline__ void xcd_barrier_fn(GAS unsigned* gbar, unsigned bx, volatile LAS unsigned* bst, int wave) {
    XcdBarrier b; b.bar = (unsigned*)gbar; b.x = bx; b.st = bst; const bool t0 = (wave == 0) && (lane_id() == 0);
    asm volatile("s_waitcnt vmcnt(0)" ::: "memory");
    __syncthreads();
    if (t0) {
        unsigned* bar = b.bar;
        __builtin_amdgcn_s_waitcnt(0);
        unsigned nloc = b.st[0], nx = b.st[1];
        if (nloc == 0u) { xcd_barrier_complete(bar, b.x, nloc, nx); b.st[0] = nloc; b.st[1] = nx; }
        const unsigned old = xb_add(&bar[XB_XSUB(b.x)], 1u);
        const unsigned gen = old / nloc;
        if (old + 1u == (gen + 1u) * nloc) {
            __builtin_amdgcn_fence(__ATOMIC_RELEASE, "agent");
            asm volatile("s_waitcnt vmcnt(0)" ::: "memory");
            const unsigned og = xb_add(&bar[XB_TOP], 1u);
            const unsigned tg = og / nx;
            if (og + 1u == (tg + 1u) * nx) xb_add(&bar[XB_TOPGEN], 1u);
            else XB_SPIN(xb_ld(&bar[XB_TOPGEN]) == tg, bar);
            __builtin_amdgcn_fence(__ATOMIC_ACQUIRE, "agent");
            xb_add(&bar[XB_XGEN(b.x)], 1u);
            asm volatile("s_waitcnt vmcnt(0)" ::: "memory");
        } else {
            XB_SPIN(xb_ld(&bar[XB_XGEN(b.x)]) == gen, bar);
            __builtin_amdgcn_fence(__ATOMIC_ACQUIRE, "agent");
            asm volatile("s_waitcnt vmcnt(0)" ::: "memory");
        }
    }
    __syncthreads();
}

template <bool F8>
DI void tr_item_t(const float* W, int ldw, int k0, int n0, void* WT, int ldwt, int drow0, LAS float* scr, int lane, const float* gain) {
    const int c4 = 4 * (lane & 7), r8 = lane >> 3;
#pragma unroll
    for (int i = 0; i < 8; ++i) { const int kk = r8 + 8 * i; const f32x4 v = *(const f32x4*)(W + (size_t)(k0 + kk) * ldw + n0 + c4);
        LAS float* d = scr + kk * 33 + c4; d[0] = v.x; d[1] = v.y; d[2] = v.z; d[3] = v.w; }
    asm volatile("s_waitcnt lgkmcnt(0)" ::: "memory");
    const int c = lane & 7;
    float gs[8];
    if (gain) { const f32x4 g0 = *(const f32x4*)(gain + k0 + 8 * c), g1 = *(const f32x4*)(gain + k0 + 8 * c + 4); gs[0] = g0.x; gs[1] = g0.y; gs[2] = g0.z; gs[3] = g0.w; gs[4] = g1.x; gs[5] = g1.y; gs[6] = g1.z; gs[7] = g1.w; }
    else {
#pragma unroll
        for (int i = 0; i < 8; ++i) gs[i] = 1.f; }
    if (F8) {
#pragma unroll
        for (int i = 0; i < 8; ++i) gs[i] *= W8_SCALE; }
#pragma unroll
    for (int j = 0; j < 4; ++j) { const int n = (lane >> 3) + 8 * j; const LAS float* s = scr + (8 * c) * 33 + n;
        if (F8) { u32x2 o; o.x = cvt4_fp8(s[0 * 33] * gs[0], s[1 * 33] * gs[1], s[2 * 33] * gs[2], s[3 * 33] * gs[3]); o.y = cvt4_fp8(s[4 * 33] * gs[4], s[5 * 33] * gs[5], s[6 * 33] * gs[6], s[7 * 33] * gs[7]);
            *(u32x2*)((unsigned char*)WT + (size_t)(drow0 + n) * ldwt + k0 + 8 * c) = o; }
        else { u32x4 o; o.x = cvtpk(s[0 * 33] * gs[0], s[1 * 33] * gs[1]); o.y = cvtpk(s[2 * 33] * gs[2], s[3 * 33] * gs[3]); o.z = cvtpk(s[4 * 33] * gs[4], s[5 * 33] * gs[5]); o.w = cvtpk(s[6 * 33] * gs[6], s[7 * 33] * gs[7]);
            *(u32x4*)((bf16*)WT + (size_t)(drow0 + n) * ldwt + k0 + 8 * c) = o; } }
    asm volatile("s_waitcnt lgkmcnt(0)" ::: "memory");
}
DI int gu_row(int n) { return n < DFF ? (n >> 7) * 256 + (n & 127) : ((n - DFF) >> 7) * 256 + 128 + ((n - DFF) & 127); }
template <bool F8 = false>
DI void tr_matrix(unsigned& ibase, const float* W, int K, int N, void* WT, int row_off, int gu, LAS float* scr, int gw, int NGW, int lane, const float* gain = nullptr) {
    const int nblk = N >> 5, nit = (K >> 6) * nblk; const int first = (int)(((unsigned)gw + (unsigned)NGW - ibase % (unsigned)NGW) % (unsigned)NGW); ibase += (unsigned)nit;
    for (int it = first; it < nit; it += NGW) { const int kb = it / nblk, nb = it - kb * nblk, n0 = nb * 32;
        tr_item_t<F8>(W, N, kb * 64, n0, WT, K, gu ? gu_row(n0) : row_off + n0, scr, lane, gain); }
}
DI void rms_row_bf16(const float* xrow, const float* gain, bf16* orow, int lane) {
    const f32x4* xr = (const f32x4*)xrow + lane; const f32x4* gr = (const f32x4*)gain + lane;
    f32x4 v[4]; float s = 0.f;
#pragma unroll
    for (int j = 0; j < 4; ++j) { v[j] = xr[64 * j]; s += (v[j].x * v[j].x + v[j].y * v[j].y) + (v[j].z * v[j].z + v[j].w * v[j].w); }
    const float rstd = 1.f / sqrtf(wave_sum(s, lane) * (1.f / D) + EPS);
    u32x2* o8 = (u32x2*)orow + lane;
#pragma unroll
    for (int j = 0; j < 4; ++j) { const f32x4 g = gr[64 * j]; u32x2 w; w.x = cvtpk(v[j].x * rstd * g.x, v[j].y * rstd * g.y); w.y = cvtpk(v[j].z * rstd * g.z, v[j].w * rstd * g.w); o8[64 * j] = w; }
}

DI void rms_row_fp8(const float* xrow, const float* gain, unsigned char* orow, int lane) {
    const f32x4* xr = (const f32x4*)xrow + lane; const f32x4* gr = (const f32x4*)gain + lane;
    f32x4 v[4]; float s = 0.f;
#pragma unroll
    for (int j = 0; j < 4; ++j) { v[j] = xr[64 * j]; s += (v[j].x * v[j].x + v[j].y * v[j].y) + (v[j].z * v[j].z + v[j].w * v[j].w); }
    const float rstd = 1.f / sqrtf(wave_sum(s, lane) * (1.f / D) + EPS);
    unsigned* o4 = (unsigned*)orow + lane;
#pragma unroll
    for (int j = 0; j < 4; ++j) { const f32x4 g = gr[64 * j]; o4[64 * j] = cvt4_fp8(v[j].x * rstd * g.x, v[j].y * rstd * g.y, v[j].z * rstd * g.z, v[j].w * rstd * g.w); }
}

struct KVStage { u32x4 k[4], v[4]; };
DI void kv_load(KVStage& st, const bf16* Kp, int kpitch, const bf16* Vp, int vpitch, int tid) {
#pragma unroll
    for (int i = 0; i < 4; ++i) { const int id = tid + 512 * i, row = id >> 3, c8 = id & 7;
        st.k[i] = *(const u32x4*)(Kp + (size_t)row * kpitch + 8 * c8); st.v[i] = *(const u32x4*)(Vp + (size_t)row * vpitch + 8 * c8); }
}
DI void kv_write(const KVStage& st, LAS bf16* Ksm, LAS bf16* Vtm, int tid) {
#pragma unroll
    for (int i = 0; i < 4; ++i) { const int id = tid + 512 * i, row = id >> 3, c8 = id & 7;
        *(LAS u32x4*)(Ksm + row * KS + 8 * c8) = st.k[i];
        const unsigned w0 = st.v[i].x, w1 = st.v[i].y, w2 = st.v[i].z, w3 = st.v[i].w;
        LAS bf16* vp = Vtm + (8 * c8) * VS + row;
        vp[0 * VS] = (bf16)(w0 & 0xffffu); vp[1 * VS] = (bf16)(w0 >> 16); vp[2 * VS] = (bf16)(w1 & 0xffffu); vp[3 * VS] = (bf16)(w1 >> 16);
        vp[4 * VS] = (bf16)(w2 & 0xffffu); vp[5 * VS] = (bf16)(w2 >> 16); vp[6 * VS] = (bf16)(w3 & 0xffffu); vp[7 * VS] = (bf16)(w3 >> 16); }
}
DI void qk_subtile(const LAS bf16* Ksm, int ktl, const bf16x8 (&qf)[4], int r, int h, f32x16& z0, f32x16& z1) {
#pragma unroll
    for (int i = 0; i < 16; ++i) { z0[i] = 0.f; z1[i] = 0.f; }
#pragma unroll
    for (int s = 0; s < 4; ++s) {
        const bf16x8 k0 = *(const LAS bf16x8*)(Ksm + (64 * ktl + r) * KS + 16 * s + 8 * h);
        const bf16x8 k1 = *(const LAS bf16x8*)(Ksm + (64 * ktl + 32 + r) * KS + 16 * s + 8 * h);
        z0 = MFMA32(k0, qf[s], z0); z1 = MFMA32(k1, qf[s], z1); }
}
template <int ST> DI bf16x8 pack_step(const f32x16& x) {
    u32x4 p; p.x = cvtpk(x[8 * ST + 0], x[8 * ST + 1]); p.y = cvtpk(x[8 * ST + 2], x[8 * ST + 3]); p.z = cvtpk(x[8 * ST + 4], x[8 * ST + 5]); p.w = cvtpk(x[8 * ST + 6], x[8 * ST + 7]);
    return __builtin_bit_cast(bf16x8, p);
}
DI void pv_subtile(const LAS bf16* Vtm, int ktl, const f32x16& p0, const f32x16& p1, int r, int h, f32x16 (&o)[2]) {
    const bf16x8 pf[4] = {pack_step<0>(p0), pack_step<1>(p0), pack_step<0>(p1), pack_step<1>(p1)};
#pragma unroll
    for (int ts = 0; ts < 4; ++ts) {
#pragma unroll
        for (int dt = 0; dt < 2; ++dt) {
            const LAS bf16* vp = Vtm + (32 * dt + r) * VS + 64 * ktl + 16 * ts + 4 * h;
            const s16x4 lo = *(const LAS s16x4*)vp, hi = *(const LAS s16x4*)(vp + 8);
            const bf16x8 vf = __builtin_shufflevector(lo, hi, 0, 1, 2, 3, 4, 5, 6, 7);
            o[dt] = MFMA32(vf, pf[ts], o[dt]); } }
}
template <int T, int GI> DI void sb_group(f32x16& z, float& c, int h, bool need_mask, int krel, int lane) {
    float s[4], m[4];
#pragma unroll
    for (int i = 0; i < 4; ++i) { const float e = fexp2(fminf(-z[4 * GI + i], 126.f)); s[i] = frcp(1.f + e); m[i] = e * s[i];
        if (need_mask) { const bool ok = (krel + 32 * T + 8 * GI + 4 * h + i) < 0; s[i] = ok ? s[i] : 0.f; m[i] = ok ? m[i] : 1.f; } }
    const float w2 = m[3], w1 = m[3] * m[2], w0 = w1 * m[1], Gm = w0 * m[0];
    const float Gp = SHX(Gm, 32, lane);
    const float mc = h ? c : c * Gp;
    z[4 * GI + 3] = s[3] * mc; z[4 * GI + 2] = s[2] * w2 * mc; z[4 * GI + 1] = s[1] * w1 * mc; z[4 * GI + 0] = s[0] * w0 * mc;
    c *= Gm * Gp;
}
DI void sb_transform(f32x16& z0, f32x16& z1, float& c, int h, bool need_mask, int krel, int lane) {
    sb_group<1, 3>(z1, c, h, need_mask, krel, lane); sb_group<1, 2>(z1, c, h, need_mask, krel, lane); sb_group<1, 1>(z1, c, h, need_mask, krel, lane); sb_group<1, 0>(z1, c, h, need_mask, krel, lane);
    sb_group<0, 3>(z0, c, h, need_mask, krel, lane); sb_group<0, 2>(z0, c, h, need_mask, krel, lane); sb_group<0, 1>(z0, c, h, need_mask, krel, lane); sb_group<0, 0>(z0, c, h, need_mask, krel, lane);
}
DI void store_ot(const f32x16 (&o)[2], bf16* orow, int h, float sc) {
#pragma unroll
    for (int dt = 0; dt < 2; ++dt)
#pragma unroll
        for (int g = 0; g < 4; ++g) { u32x2 w; w.x = cvtpk(o[dt][4 * g] * sc, o[dt][4 * g + 1] * sc); w.y = cvtpk(o[dt][4 * g + 2] * sc, o[dt][4 * g + 3] * sc);
            *(u32x2*)(orow + 32 * dt + 8 * g + 4 * h) = w; }
}

DI void sb_unit(const bf16* U, bf16* Y, int bl, int hd, int qb, LAS unsigned char* lds, int tid, int wave, int lane) {
    LAS bf16* Ksm = (LAS bf16*)(lds + L_KS); LAS bf16* Vtm = (LAS bf16*)(lds + L_VT);
    const int r = lane & 31, h = lane >> 5;
    const size_t tok0 = (size_t)bl * SEQ; const int tq = qb * 256 + 32 * wave + r;
    bf16x8 qf[4];
    { const bf16* qrow = U + (tok0 + tq) * DIN + UC_SBQ + 64 * hd;
#pragma unroll
      for (int s = 0; s < 4; ++s) { const u32x4 w = *(const u32x4*)(qrow + 16 * s + 8 * h); float f[8]; unpack8(w, f);
#pragma unroll
          for (int j = 0; j < 8; ++j) f[j] *= (0.125f * 1.44269504f);
          qf[s] = __builtin_bit_cast(bf16x8, pack8(f)); } }
    f32x16 o[2];
#pragma unroll
    for (int i = 0; i < 16; ++i) { o[0][i] = 0.f; o[1][i] = 0.f; }
    float c = 1.f;
    const bf16* Kb = U + tok0 * DIN + UC_SBK + 64 * hd; const bf16* Vb = U + tok0 * DIN + UC_SBV + 64 * hd;
    KVStage st; kv_load(st, Kb + (size_t)(256 * qb) * DIN, DIN, Vb + (size_t)(256 * qb) * DIN, DIN, tid);
    for (int kb = qb; kb >= 0; --kb) {
        { volatile LAS unsigned* fl = (volatile LAS unsigned*)(lds + MISC_OFF) + 2;
          if (lane == 0 && __builtin_amdgcn_ballot_w64(c != 0.f) != 0ull) fl[kb & 1] = 1u;
          __syncthreads();
          const unsigned live = fl[kb & 1];
          if (tid == 0) fl[(kb + 1) & 1] = 0u;
          if (live == 0u) break; }
        kv_write(st, Ksm, Vtm, tid);
        __syncthreads();
        if (kb > 0) kv_load(st, Kb + (size_t)(256 * (kb - 1)) * DIN, DIN, Vb + (size_t)(256 * (kb - 1)) * DIN, DIN, tid);
        const bool diag = (kb == qb);
        const int khi = diag ? ((32 * wave + 31) >> 6) : 3;
        for (int ktl = khi; ktl >= 0; --ktl) {
            if (__builtin_amdgcn_ballot_w64(c != 0.f) == 0ull) break;
            f32x16 z0, z1; qk_subtile(Ksm, ktl, qf, r, h, z0, z1);
            const bool need_mask = diag && (64 * ktl + 63 >= 32 * wave);
            sb_transform(z0, z1, c, h, need_mask, 256 * kb + 64 * ktl - tq, lane);
            pv_subtile(Vtm, ktl, z0, z1, r, h, o);
        }
    }
    store_ot(o, Y + (tok0 + tq) * D + YC_SB + 64 * hd, h, 1.f);
}

DI void xa_unit(const bf16* QB, const bf16* kvl, const float* gq, float kmax, bf16* OB, int bl, int bglob, int hd, int qblk, LAS unsigned char* lds, int tid, int wave, int lane) {
    LAS bf16* Ksm = (LAS bf16*)(lds + L_KS); LAS bf16* Vtm = (LAS bf16*)(lds + L_VT);
    const int r = lane & 31, h = lane >> 5;
    const size_t row = (size_t)bl * SEQ + qblk * 256 + 32 * wave + r;
    __syncthreads();
    { KVStage st; const bf16* Kp = kvl + (size_t)bglob * NMEM * 512 + 64 * hd; kv_load(st, Kp, 512, Kp + 256, 512, tid); kv_write(st, Ksm, Vtm, tid); }
    float qv[4][8]; float ss = 0.f;
    { const bf16* qrow = QB + row * 256 + 64 * hd;
#pragma unroll
      for (int s = 0; s < 4; ++s) { const u32x4 w = *(const u32x4*)(qrow + 16 * s + 8 * h); unpack8(w, qv[s]);
#pragma unroll
          for (int j = 0; j < 8; ++j) ss += qv[s][j] * qv[s][j]; } }
    ss += SHX(ss, 32, lane);
    const float rq = 1.f / sqrtf(ss * (1.f / 64.f) + EPS) * (0.125f * 1.44269504f);
    bf16x8 qf[4]; float qn2 = 0.f;
#pragma unroll
    for (int s = 0; s < 4; ++s) {
#pragma unroll
        for (int j = 0; j < 8; ++j) { qv[s][j] *= rq * gq[16 * s + 8 * h + j]; qn2 += qv[s][j] * qv[s][j]; }
        qf[s] = __builtin_bit_cast(bf16x8, pack8(qv[s])); }
    qn2 += SHX(qn2, 32, lane);
    const float bnd = sqrtf(qn2) * kmax * 1.02f + 0.5f;
    f32x16 o[2];
#pragma unroll
    for (int i = 0; i < 16; ++i) { o[0][i] = 0.f; o[1][i] = 0.f; }
    float l = 0.f;
    __syncthreads();
    for (int ktl = 0; ktl < 4; ++ktl) {
        f32x16 z0, z1; qk_subtile(Ksm, ktl, qf, r, h, z0, z1);
#pragma unroll
        for (int i = 0; i < 16; ++i) { z0[i] = fexp2(z0[i] - bnd); z1[i] = fexp2(z1[i] - bnd); l += z0[i] + z1[i]; }
        pv_subtile(Vtm, ktl, z0, z1, r, h, o);
    }
    l += SHX(l, 32, lane);
    store_ot(o, OB + row * 256 + 64 * hd, h, 1.f / l);
}

template <bool ROWM, bool TRANS>
DI void ret_stage(const bf16* U, const f32x2* rot, size_t trow0, int gtok, int hd, float lg, LAS bf16* Ksm, LAS bf16* Ktm, LAS bf16* Vtm, int tid) {
    const int m = tid >> 1, hf = tid & 1; const size_t trow = trow0 + m;
    const bf16* kp = U + trow * DIN + UC_RK + 64 * hd + 16 * hf; const f32x2* rp = rot + (size_t)(gtok + m) * 32 + 16 * hf;
    const float sk = fexp2(-(float)m * lg) * 0.125f;
    float x1[16], x2[16];
    { const u32x4 a0 = *(const u32x4*)kp, a1 = *(const u32x4*)(kp + 8), b0 = *(const u32x4*)(kp + 32), b1 = *(const u32x4*)(kp + 40);
      float t[8]; unpack8(a0, t);
#pragma unroll
      for (int j = 0; j < 8; ++j) x1[j] = t[j];
      unpack8(a1, t);
#pragma unroll
      for (int j = 0; j < 8; ++j) x1[8 + j] = t[j];
      unpack8(b0, t);
#pragma unroll
      for (int j = 0; j < 8; ++j) x2[j] = t[j];
      unpack8(b1, t);
#pragma unroll
      for (int j = 0; j < 8; ++j) x2[8 + j] = t[j]; }
    float o1[16], o2[16];
#pragma unroll
    for (int j = 0; j < 16; ++j) { const f32x2 cs = rp[j]; o1[j] = (x1[j] * cs.x - x2[j] * cs.y) * sk; o2[j] = (x1[j] * cs.y + x2[j] * cs.x) * sk; }
    if (ROWM) { LAS bf16* kr = Ksm + m * KS + 16 * hf; float t[8];
#pragma unroll
        for (int j = 0; j < 8; ++j) t[j] = o1[j];
        *(LAS u32x4*)kr = pack8(t);
#pragma unroll
        for (int j = 0; j < 8; ++j) t[j] = o1[8 + j];
        *(LAS u32x4*)(kr + 8) = pack8(t);
#pragma unroll
        for (int j = 0; j < 8; ++j) t[j] = o2[j];
        *(LAS u32x4*)(kr + 32) = pack8(t);
#pragma unroll
        for (int j = 0; j < 8; ++j) t[j] = o2[8 + j];
        *(LAS u32x4*)(kr + 40) = pack8(t); }
    if (TRANS) {
#pragma unroll
        for (int j = 0; j < 16; ++j) { Ktm[(16 * hf + j) * VS + m] = (bf16)(cvtpk(o1[j], 0.f) & 0xffffu); Ktm[(32 + 16 * hf + j) * VS + m] = (bf16)(cvtpk(o2[j], 0.f) & 0xffffu); } }
    const bf16* vp = U + trow * DIN + UC_RV + 64 * hd + 32 * hf;
#pragma unroll
    for (int q = 0; q < 4; ++q) { const u32x4 w = *(const u32x4*)(vp + 8 * q); LAS bf16* d = Vtm + (32 * hf + 8 * q) * VS + m;
        d[0 * VS] = (bf16)(w.x & 0xffffu); d[1 * VS] = (bf16)(w.x >> 16); d[2 * VS] = (bf16)(w.y & 0xffffu); d[3 * VS] = (bf16)(w.y >> 16);
        d[4 * VS] = (bf16)(w.z & 0xffffu); d[5 * VS] = (bf16)(w.z >> 16); d[6 * VS] = (bf16)(w.w & 0xffffu); d[7 * VS] = (bf16)(w.w >> 16); }
}
DI float ret_lg(int hd) { const float gam = 1.f - fexp2(-5.f - (float)hd); return __log2f(gam); }
DI void retkv_unit(const bf16* U, float* KVS, const f32x2* rot, int bl, int gtok0, int hd, int ch, LAS unsigned char* lds, int tid, int wave, int lane) {
    LAS bf16* Vtm = (LAS bf16*)(lds + L_VT); LAS bf16* Ktm = (LAS bf16*)(lds + L_KT);
    const int r = lane & 31, h = lane >> 5; const float lg = ret_lg(hd);
    __syncthreads();
    ret_stage<false, true>(U, rot, (size_t)bl * SEQ + ch * 256, gtok0 + ch * 256, hd, lg, nullptr, Ktm, Vtm, tid);
    __syncthreads();
    if (wave < 4) { const int dti = wave >> 1, eti = wave & 1;
        f32x16 kv;
#pragma unroll
        for (int i = 0; i < 16; ++i) kv[i] = 0.f;
#pragma unroll 4
        for (int s = 0; s < 16; ++s) { const bf16x8 af = *(const LAS bf16x8*)(Ktm + (32 * dti + r) * VS + 16 * s + 8 * h); const bf16x8 bfr = *(const LAS bf16x8*)(Vtm + (32 * eti + r) * VS + 16 * s + 8 * h);
            kv = MFMA32(af, bfr, kv); }
        float* dst = KVS + (size_t)((bl * 4 + hd) * 16 + ch) * 4096 + 32 * eti + r;
#pragma unroll
        for (int i = 0; i < 16; ++i) dst[(32 * dti + crow(i, h)) * 64] = kv[i]; }
}
DI void reto_unit(const bf16* U, bf16* Y, const float* KVS, const f32x2* rot, int bl, int gtok0, int hd, int ch, LAS unsigned char* lds, int tid, int wave, int lane) {
    LAS bf16* Ksm = (LAS bf16*)(lds + L_KS); LAS bf16* Vtm = (LAS bf16*)(lds + L_VT); LAS bf16* Stm = (LAS bf16*)(lds + L_ST);
    const int r = lane & 31, h = lane >> 5; const float lg = ret_lg(hd);
    const size_t tok0 = (size_t)bl * SEQ; const int n0 = ch * 256;
    __syncthreads();
    { const int d = tid >> 3, e0 = 8 * (tid & 7); float acc[8];
#pragma unroll
      for (int j = 0; j < 8; ++j) acc[j] = 0.f;
      const float* src = KVS + (size_t)((bl * 4 + hd) * 16) * 4096 + d * 64 + e0;
      for (int cp = 0; cp < ch; ++cp) { const float w = fexp2((256.f * (float)(ch - 1 - cp) + 256.f) * lg); const f32x4 a = *(const f32x4*)(src + (size_t)cp * 4096), b = *(const f32x4*)(src + (size_t)cp * 4096 + 4);
          acc[0] += w * a.x; acc[1] += w * a.y; acc[2] += w * a.z; acc[3] += w * a.w; acc[4] += w * b.x; acc[5] += w * b.y; acc[6] += w * b.z; acc[7] += w * b.w; }
#pragma unroll
      for (int j = 0; j < 8; ++j) Stm[(e0 + j) * KS + d] = (bf16)(cvtpk(acc[j], 0.f) & 0xffffu); }
    ret_stage<true, false>(U, rot, tok0 + n0, gtok0 + n0, hd, lg, Ksm, nullptr, Vtm, tid);
    bf16x8 qf[4];
    { const int nl = 32 * wave + r; const size_t trow = tok0 + n0 + nl;
      const bf16* qp = U + trow * DIN + UC_RQ + 64 * hd + 8 * h; const f32x2* rp = rot + (size_t)(gtok0 + n0 + nl) * 32 + 8 * h;
      const float sq = fexp2((float)nl * lg);
      float a[4][8];
#pragma unroll
      for (int s = 0; s < 4; ++s) { const u32x4 w = *(const u32x4*)(qp + 16 * s); unpack8(w, a[s]); }
      float b[4][8];
#pragma unroll
      for (int j = 0; j < 8; ++j) { const f32x2 c0 = rp[j], c1 = rp[16 + j];
          b[0][j] = (a[0][j] * c0.x - a[2][j] * c0.y) * sq; b[2][j] = (a[0][j] * c0.y + a[2][j] * c0.x) * sq;
          b[1][j] = (a[1][j] * c1.x - a[3][j] * c1.y) * sq; b[3][j] = (a[1][j] * c1.y + a[3][j] * c1.x) * sq; }
#pragma unroll
      for (int s = 0; s < 4; ++s) qf[s] = __builtin_bit_cast(bf16x8, pack8(b[s])); }
    __syncthreads();
    f32x16 o[2];
#pragma unroll
    for (int i = 0; i < 16; ++i) { o[0][i] = 0.f; o[1][i] = 0.f; }
    const int khi = (32 * wave + 31) >> 6;
    for (int ktl = 0; ktl <= khi; ++ktl) {
        f32x16 z0, z1; qk_subtile(Ksm, ktl, qf, r, h, z0, z1);
        if (64 * ktl + 63 > 32 * wave) {
            const int krel = 64 * ktl - (32 * wave + r);
#pragma unroll
            for (int i = 0; i < 16; ++i) { const int kk = krel + crow(i, h); z0[i] = (kk <= 0) ? z0[i] : 0.f; z1[i] = (kk + 32 <= 0) ? z1[i] : 0.f; } }
        pv_subtile(Vtm, ktl, z0, z1, r, h, o);
    }
#pragma unroll
    for (int s = 0; s < 4; ++s)
#pragma unroll
        for (int dt = 0; dt < 2; ++dt) { const bf16x8 af = *(const LAS bf16x8*)(Stm + (32 * dt + r) * KS + 16 * s + 8 * h); o[dt] = MFMA32(af, qf[s], o[dt]); }
    { float sm = 0.f;
#pragma unroll
      for (int i = 0; i < 16; ++i) sm += o[0][i] + o[1][i];
      sm += SHX(sm, 32, lane); const float mean = sm * (1.f / 64.f); float vq = 0.f;
#pragma unroll
      for (int i = 0; i < 16; ++i) { const float d0 = o[0][i] - mean, d1 = o[1][i] - mean; vq += d0 * d0 + d1 * d1; }
      vq += SHX(vq, 32, lane); const float rstd = 1.f / sqrtf(vq * (1.f / 64.f) + EPS);
      const size_t trow = tok0 + n0 + 32 * wave + r;
      const bf16* gp = U + trow * DIN + UC_RG + 64 * hd; bf16* yp = Y + trow * D + YC_RET + 64 * hd;
#pragma unroll
      for (int dt = 0; dt < 2; ++dt)
#pragma unroll
          for (int g = 0; g < 4; ++g) { const int e0 = 32 * dt + 8 * g + 4 * h; const u32x2 gw = *(const u32x2*)(gp + e0);
              const float g0 = bflo(gw.x), g1 = bfhi(gw.x), g2 = bflo(gw.y), g3 = bfhi(gw.y);
              u32x2 w; w.x = cvtpk(g0 * sigmoid_f(g0) * (o[dt][4 * g] - mean) * rstd, g1 * sigmoid_f(g1) * (o[dt][4 * g + 1] - mean) * rstd);
              w.y = cvtpk(g2 * sigmoid_f(g2) * (o[dt][4 * g + 2] - mean) * rstd, g3 * sigmoid_f(g3) * (o[dt][4 * g + 3] - mean) * rstd);
              *(u32x2*)(yp + e0) = w; } }
}

DI void conv_unit(const bf16* U, bf16* Y, const float* cw, const float* cb, const float* lng, const float* lnb, int bl, int tile, LAS unsigned char* lds, int tid, int wave, int lane) {
    LAS float* vs = (LAS float*)lds;
    const int t0 = tile * 64; const size_t tok0 = (size_t)bl * SEQ;
    __syncthreads();
    for (int id = tid; id < 94 * 32; id += NTHR) { const int rr = id >> 5, c8 = id & 31, t = t0 - 30 + rr; float v[8];
        if (t >= 0) { const bf16* p = U + (tok0 + t) * DIN + 8 * c8; const u32x4 aw = *(const u32x4*)(p + UC_CA), gw = *(const u32x4*)(p + UC_CG); float a[8], g[8]; unpack8(aw, a); unpack8(gw, g);
#pragma unroll
            for (int j = 0; j < 8; ++j) v[j] = a[j] * sigmoid_f(g[j]); }
        else {
#pragma unroll
            for (int j = 0; j < 8; ++j) v[j] = 0.f; }
        LAS f32x4* d = (LAS f32x4*)(vs + rr * 256 + 8 * c8); d[0] = (f32x4){v[0], v[1], v[2], v[3]}; d[1] = (f32x4){v[4], v[5], v[6], v[7]}; }
    __syncthreads();
    const int c = tid & 255, half = tid >> 8;
    float acc[32];
    { const float bias = cb[c];
#pragma unroll
      for (int i = 0; i < 32; ++i) acc[i] = bias; }
    for (int j = 0; j < 31; ++j) { const float w = cw[j * 256 + c]; const LAS float* vp = vs + (32 * half + j) * 256 + c;
#pragma unroll
        for (int i = 0; i < 32; ++i) acc[i] += w * vp[i * 256]; }
    __syncthreads();
#pragma unroll
    for (int i = 0; i < 32; ++i) vs[(32 * half + i) * 256 + c] = acc[i];
    __syncthreads();
    const f32x4 g4 = *(const f32x4*)(lng + 4 * lane), b4 = *(const f32x4*)(lnb + 4 * lane);
    for (int i = 0; i < 8; ++i) { const int tt = 8 * wave + i; const f32x4 v = *(const LAS f32x4*)(vs + tt * 256 + 4 * lane);
        const float mean = wave_sum((v.x + v.y) + (v.z + v.w), lane) * (1.f / 256.f);
        const f32x4 dv = v - mean; const float var = wave_sum((dv.x * dv.x + dv.y * dv.y) + (dv.z * dv.z + dv.w * dv.w), lane) * (1.f / 256.f);
        const float rstd = 1.f / sqrtf(var + EPS); const f32x4 xn = dv * rstd * g4 + b4;
        u32x2 w; w.x = cvtpk(xn.x * sigmoid_f(xn.x), xn.y * sigmoid_f(xn.y)); w.y = cvtpk(xn.z * sigmoid_f(xn.z), xn.w * sigmoid_f(xn.w));
        *(u32x2*)(Y + (tok0 + t0 + tt) * D + YC_CONV + 4 * lane) = w; }
}

DI void pool_unit(const bf16* U, bf16* Y, int bl, int tile, LAS unsigned char* lds, int tid) {
    LAS float* us = (LAS float*)lds;
    const int t0 = tile * 64; const size_t tok0 = (size_t)bl * SEQ;
    __syncthreads();
    for (int id = tid; id < 79 * 32; id += NTHR) { const int rr = id >> 5, c8 = id & 31, t = t0 - 15 + rr; float v[8];
        if (t >= 0) { const u32x4 w = *(const u32x4*)(U + (tok0 + t) * DIN + UC_POOL + 8 * c8); unpack8(w, v); }
        else {
#pragma unroll
            for (int j = 0; j < 8; ++j) v[j] = 0.f; }
        LAS f32x4* d = (LAS f32x4*)(us + rr * 256 + 8 * c8); d[0] = (f32x4){v[0], v[1], v[2], v[3]}; d[1] = (f32x4){v[4], v[5], v[6], v[7]}; }
    __syncthreads();
    const int c = tid & 255, half = tid >> 8; const int w = 2 << (c >> 6);
    for (int i = 0; i < 32; ++i) { const int tl = 32 * half + i, t = t0 + tl; const LAS float* p = us + (15 + tl) * 256 + c;
        float s = 0.f; for (int j = 0; j < w; ++j) s += p[-j * 256];
        const int n = (t + 1 < w) ? (t + 1) : w; const float d = s / (float)n - p[0];
        Y[(tok0 + t) * D + YC_POOL + c] = (bf16)(cvtpk(d, 0.f) & 0xffffu); }
}

struct Args { const void* in[27]; float* out; unsigned char* ws; };
static_assert(sizeof(Args) == 29 * 8, "Args has no padding");
typedef const __attribute__((address_space(4))) Args* KArgs;
DI KArgs KA() { KArgs p = (KArgs)__builtin_amdgcn_kernarg_segment_ptr(); asm volatile("" : "+s"(p)); return p; }
#define KIN(T, k) ((const T*)KA()->in[k])
#define PH DI
#define PHN __device__ __noinline__
enum { I_X = 0, I_MEM, I_POS, I_NMIXG, I_WIN, I_CONVW, I_CONVB, I_CLNG, I_CLNB, I_POOLW, I_POOLS, I_WGATE, I_WBR, I_WOUT, I_NXAG, I_NMEMG, I_WQ, I_WKV, I_QG, I_KG, I_WO, I_NFFNG, I_FGU, I_FDN, I_ROUTER, I_MGU, I_MDN };

constexpr unsigned F8MASK = FFN_FP8_MASK;
constexpr bool DENSE_ANY8 = (F8MASK & 0x5) != 0, DENSE_ANYB = (F8MASK & 0x5) != 0x5, MOE_ANY8 = (F8MASK & 0xA) != 0, MOE_ANYB = (F8MASK & 0xA) != 0xA;
struct Ids { int tid, lane, wave, G, wg, gw, NGW; };
DI Ids ids(int wave) { Ids i; i.lane = lane_id(); asm volatile("" : "+v"(i.lane)); asm volatile("" : "+s"(wave)); i.wave = wave; i.tid = wave * 64 + i.lane; i.G = gridDim.x; i.wg = blockIdx.x; asm volatile("" : "+s"(i.G), "+s"(i.wg)); i.gw = i.wg * NWAVES + i.wave; i.NGW = i.G * NWAVES; return i; }

PHN unsigned ph_w_layer(KArgs ka, int wv, LAS unsigned char* lds, int l, unsigned ib) {
    const Ids t = ids(__builtin_amdgcn_readfirstlane(wv));     unsigned char* ws = ka->ws; LAS float* scr = (LAS float*)(lds + t.wave * 16384);
    bf16* wc = (bf16*)(ws + WS_WCAT) + (size_t)l * NCAT * D;
    const float* gmix = ((const float*)ka->in[I_NMIXG]) + l * D;
    tr_matrix(ib, ((const float*)ka->in[I_WIN]) + (size_t)l * D * DIN, D, DIN, wc, 0, 0, scr, t.gw, t.NGW, t.lane, gmix);
    for (int i = 0; i < 4; ++i) { if (GATE_FP8) tr_matrix<true>(ib, ((const float*)ka->in[I_WGATE]) + (size_t)(l * 4 + i) * D * D, D, D, (unsigned char*)(wc + (size_t)DIN * D), i * D, 0, scr, t.gw, t.NGW, t.lane, gmix);
        else tr_matrix(ib, ((const float*)ka->in[I_WGATE]) + (size_t)(l * 4 + i) * D * D, D, D, wc, DIN + i * D, 0, scr, t.gw, t.NGW, t.lane, gmix); }
    for (int i = 0; i < 4; ++i) if (i != 1) tr_matrix(ib, ((const float*)ka->in[I_WBR]) + (size_t)(l * 4 + i) * 256 * D, 256, D, (bf16*)(ws + WS_WB) + (size_t)(l * 4 + i) * D * 256, 0, 0, scr, t.gw, t.NGW, t.lane);
    tr_matrix(ib, ((const float*)ka->in[I_WOUT]) + (size_t)l * D * D, D, D, (bf16*)(ws + WS_WOUT) + (size_t)l * D * D, 0, 0, scr, t.gw, t.NGW, t.lane);
    tr_matrix(ib, ((const float*)ka->in[I_WQ]) + (size_t)l * D * 256, D, 256, (bf16*)(ws + WS_WQ) + (size_t)l * 256 * D, 0, 0, scr, t.gw, t.NGW, t.lane, ((const float*)ka->in[I_NXAG]) + l * D);
    tr_matrix(ib, ((const float*)ka->in[I_WKV]) + (size_t)l * D * 512, D, 512, (bf16*)(ws + WS_WKV) + (size_t)l * 512 * D, 0, 0, scr, t.gw, t.NGW, t.lane);
    tr_matrix(ib, ((const float*)ka->in[I_WO]) + (size_t)l * 256 * D, 256, D, (bf16*)(ws + WS_WO) + (size_t)l * D * 256, 0, 0, scr, t.gw, t.NGW, t.lane);
    return ib;
}
PHN unsigned ph_w_ffn(KArgs ka, int wv, LAS unsigned char* lds, int s, unsigned ib) {
    const Ids t = ids(__builtin_amdgcn_readfirstlane(wv));     unsigned char* ws = ka->ws; LAS float* scr = (LAS float*)(lds + t.wave * 16384);
    if (s < 2) { const bool f8 = (F8MASK >> (2 * s)) & 1u;
        const float* gu = ((const float*)ka->in[I_FGU]) + (size_t)s * D * NGU; const float* dn = ((const float*)ka->in[I_FDN]) + (size_t)s * DFF * D;
        unsigned char* wgu = ws + WS_WGUD + (size_t)s * NGU * D * 2; unsigned char* wdn = ws + WS_WDND + (size_t)s * D * DFF * 2;
        const float* gf = ((const float*)ka->in[I_NFFNG]) + (2 * s) * D;
        if (f8) { if constexpr (DENSE_ANY8) { tr_matrix<true>(ib, gu, D, NGU, wgu, 0, 1, scr, t.gw, t.NGW, t.lane, gf); tr_matrix<true>(ib, dn, DFF, D, wdn, 0, 0, scr, t.gw, t.NGW, t.lane); } }
        else { if constexpr (DENSE_ANYB) { tr_matrix<false>(ib, gu, D, NGU, wgu, 0, 1, scr, t.gw, t.NGW, t.lane, gf); tr_matrix<false>(ib, dn, DFF, D, wdn, 0, 0, scr, t.gw, t.NGW, t.lane); } }
    } else { const int k = s - 2; const bool f8 = (F8MASK >> (2 * (k >> 3) + 1)) & 1u;
        const float* gu = ((const float*)ka->in[I_MGU]) + (size_t)k * D * NGU; const float* dn = ((const float*)ka->in[I_MDN]) + (size_t)k * DFF * D;
        unsigned char* wgu = ws + WS_WGUM + (size_t)k * NGU * D * 2; unsigned char* wdn = ws + WS_WDNM + (size_t)k * D * DFF * 2;
        if (f8) { if constexpr (MOE_ANY8) { tr_matrix<true>(ib, gu, D, NGU, wgu, 0, 1, scr, t.gw, t.NGW, t.lane); tr_matrix<true>(ib, dn, DFF, D, wdn, 0, 0, scr, t.gw, t.NGW, t.lane); } }
        else { if constexpr (MOE_ANYB) { tr_matrix<false>(ib, gu, D, NGU, wgu, 0, 1, scr, t.gw, t.NGW, t.lane); tr_matrix<false>(ib, dn, DFF, D, wdn, 0, 0, scr, t.gw, t.NGW, t.lane); } }
    }
    return ib;
}
PHN void ph_misc0(KArgs ka, int wv) {
    const Ids t = ids(__builtin_amdgcn_readfirstlane(wv));     unsigned char* ws = ka->ws;
    { const float* pool_w = ((const float*)ka->in[I_POOLW]); const float* pool_scale = ((const float*)ka->in[I_POOLS]); const float* w_branch = ((const float*)ka->in[I_WBR]); bf16* WB = (bf16*)(ws + WS_WB);
      for (int idx = t.wg * NTHR + t.tid; idx < DEPTH * 1024 * 256; idx += t.G * NTHR) {
          const int l = idx >> 18, n = (idx >> 8) & 1023, gc = idx & 255, g = gc >> 6;
          const float* pw = pool_w + ((size_t)(l * 4) * 64 + gc) * 64; const float* ps = pool_scale + l * 256 + 64 * g; const float* wb = w_branch + ((size_t)(l * 4 + 1) * 256 + 64 * g) * D + n;
          float s = 0.f;
          for (int d = 0; d < 64; ++d) s += pw[d] * ps[d] * wb[(size_t)d * D];
          WB[(size_t)(l * 4 + 1) * D * 256 + (size_t)n * 256 + gc] = (bf16)(cvtpk(s, 0.f) & 0xffffu); } }
    { const float* mem = ((const float*)ka->in[I_MEM]); const float* gm = ((const float*)ka->in[I_NMEMG]); bf16* MEMH = (bf16*)(ws + WS_MEMH);
      for (int it = t.gw; it < DEPTH * MMEM; it += t.NGW) { const int l = it / MMEM, rw = it - l * MMEM; rms_row_bf16(mem + (size_t)rw * D, gm + l * D, MEMH + (size_t)it * D, t.lane); } }
    { const int* positions = ((const int*)ka->in[I_POS]); f32x2* ROT = (f32x2*)(ws + WS_ROT);
      for (int idx = t.wg * NTHR + t.tid; idx < MTOT * 32; idx += t.G * NTHR) { const int tok = idx >> 5, i = idx & 31;
          const float ang = (float)positions[tok] * INV_FREQ[i]; double rev = (double)ang * 0.15915494309189535; rev -= floor(rev); const float rv = (float)rev;
          ROT[idx] = (f32x2){__builtin_amdgcn_cosf(rv), __builtin_amdgcn_sinf(rv)}; } }
}
PH void ph_kv(int wv, LAS unsigned char* lds) {
    const Ids t = ids(wv); unsigned char* ws = KA()->ws;
    pg8::OrdKV S; S.to.init(DEPTH * (MMEM / 256), 2, t.G, t.wg); S.A = (const char*)(ws + WS_MEMH); S.B = (const char*)(ws + WS_WKV);
    pg8::EpiBf16<false> E{(bf16*)(ws + WS_KV), 512, nullptr};
    pg8::gemm_phase<pg8::EpiBf16<false>, pg8::OrdKV>(lds, D, D, S, E, t.wave);
}
PHN void ph_knorm(KArgs ka, int wv) {
    const Ids t = ids(__builtin_amdgcn_readfirstlane(wv));     unsigned char* ws = ka->ws; unsigned* ctl = (unsigned*)(ws + WS_CTL); bf16* KV = (bf16*)(ws + WS_KV); const float* xa_kg = ((const float*)ka->in[I_KG]);
    for (int it = t.gw; it < DEPTH * MMEM; it += t.NGW) { const int l = it / MMEM, rw = it - l * MMEM, b = rw >> 8; const int lane = t.lane;
        if (lane < 32) { bf16* kp = KV + (size_t)it * 512 + 8 * lane; const u32x4 w = *(const u32x4*)kp; float f[8]; unpack8(w, f); float ss = 0.f;
#pragma unroll
            for (int j = 0; j < 8; ++j) ss += f[j] * f[j];
            ss += SHX(ss, 1, lane); ss += SHX(ss, 2, lane); ss += SHX(ss, 4, lane);
            const float rs = 1.f / sqrtf(ss * (1.f / 64.f) + EPS); const float* gk = xa_kg + l * 64 + 8 * (lane & 7); float n2 = 0.f;
#pragma unroll
            for (int j = 0; j < 8; ++j) { f[j] *= rs * gk[j]; n2 += f[j] * f[j]; }
            *(u32x4*)kp = pack8(f);
            n2 += SHX(n2, 1, lane); n2 += SHX(n2, 2, lane); n2 += SHX(n2, 4, lane);
            if ((lane & 7) == 0) atomicMax(ctl + CW_KMAX + (l * NB + b) * 4 + (lane >> 3), __float_as_uint(n2 * 1.02f)); } }
}
PHN void ph_xprep(KArgs ka, int wv, int g, int from_in) {
    const Ids t = ids(__builtin_amdgcn_readfirstlane(wv));
    unsigned char* ws = ka->ws; const size_t grow = (size_t)g * MG;
    const float* src = from_in ? (((const float*)ka->in[I_X]) + grow * D) : (ka->out + grow * D);
    bf16* XB = (bf16*)(ws + WS_HB); float* ssq = (float*)(ws + WS_SSQ); const int lane = t.lane;
    for (int m = t.gw; m < MG; m += t.NGW) {
        const f32x4* xr = (const f32x4*)(src + (size_t)m * D) + lane; f32x4 v[4]; float s = 0.f;
#pragma unroll
        for (int j = 0; j < 4; ++j) { v[j] = xr[64 * j]; s += (v[j].x * v[j].x + v[j].y * v[j].y) + (v[j].z * v[j].z + v[j].w * v[j].w); }
        s = wave_sum(s, lane);
        u32x2* o8 = (u32x2*)(XB + (size_t)m * D) + lane;
#pragma unroll
        for (int j = 0; j < 4; ++j) { u32x2 w; w.x = cvtpk(v[j].x, v[j].y); w.y = cvtpk(v[j].z, v[j].w); o8[64 * j] = w; }
        if (GATE_FP8) { unsigned* o4 = (unsigned*)(ws + WS_XB8 + (size_t)m * D) + lane;
#pragma unroll
            for (int j = 0; j < 4; ++j) o4[64 * j] = cvt4_fp8(v[j].x, v[j].y, v[j].z, v[j].w); }
        if (lane < 16) ssq[(size_t)m * 16 + lane] = lane == 0 ? s : 0.f; }
}
PH void ph_gemm1(int wv, LAS unsigned char* lds, int l) {
    const Ids t = ids(wv); unsigned char* ws = KA()->ws; bf16* wcat = (bf16*)(ws + WS_WCAT) + (size_t)l * NCAT * D;
    { pg8::OrdStd S; S.to.init(MG / 256, (GATE_FP8 ? DIN : NCAT) / 256, t.G, t.wg); S.A = (const char*)(ws + WS_HB); S.B = (const char*)wcat; S.atile = 256 * D * 2; S.btile = 256 * D * 2;
      pg8::EpiCat<false> E{(bf16*)(ws + WS_U), (bf16*)(ws + WS_GATES), (const float*)(ws + WS_SSQ)};
      pg8::gemm_phase<pg8::EpiCat<false>, pg8::OrdStd>(lds, D, D, S, E, t.wave); }
    if constexpr (GATE_FP8 != 0) {
      pg8::OrdStd S; S.to.init(MG / 256, 4096 / 256, t.G, t.wg); S.A = (const char*)(ws + WS_XB8); S.B = (const char*)(wcat + (size_t)DIN * D); S.atile = 256 * D; S.btile = 256 * D;
      pg8::EpiCat<true> E{(bf16*)(ws + WS_U), (bf16*)(ws + WS_GATES), (const float*)(ws + WS_SSQ)};
      pg8::gemm_phase<pg8::EpiCat<true>, pg8::OrdStd, true>(lds, D, D, S, E, t.wave); }
}
constexpr int NSB = BG * 4 * 16, NRC = BG * 4 * 16, NCONV = BG * 64, NPOOL = BG * 64;
PH void ph_mix(int wv, LAS unsigned char* lds, int g, int l, int part, int rep = 0) {
    const Ids t = ids(wv); unsigned char* ws = KA()->ws; unsigned* ctl = (unsigned*)(ws + WS_CTL);
    volatile LAS unsigned* MISC = (volatile LAS unsigned*)(lds + MISC_OFF);
    unsigned* qctr = ctl + CW_QCTR + 64 * ((g * 4 + l) * 2 + part + 16 * rep);
    const bf16* UB = (const bf16*)(ws + WS_U); bf16* YB = (bf16*)(ws + WS_Y); float* KVS = (float*)(ws + WS_KVS); const f32x2* ROT = (const f32x2*)(ws + WS_ROT);
    const int NUQ = part == 0 ? (NSB + NRC + NPOOL) : (NRC + NCONV);
    for (;;) {
        __syncthreads();
        if (t.tid == 0) { MISC[0] = __hip_atomic_fetch_add(qctr, 1u, __ATOMIC_RELAXED, __HIP_MEMORY_SCOPE_AGENT); MISC[2] = 0u; MISC[3] = 0u; }
        __syncthreads();
        const int j = (int)MISC[0];
        if (j >= NUQ) break;
        if (part == 0) {
            if (j < NSB) sb_unit(UB, YB, (j >> 2) & 7, j & 3, 15 - (j >> 5), lds, t.tid, t.wave, t.lane);
            else if (j < NSB + NRC) { const int k = j - NSB, bl = k >> 6; retkv_unit(UB, KVS, ROT, bl, (g * BG + bl) * SEQ, (k >> 4) & 3, k & 15, lds, t.tid, t.wave, t.lane); }
            else { const int k = j - (NSB + NRC); pool_unit(UB, YB, k >> 6, k & 63, lds, t.tid); }
        } else {
            if (j < NRC) { const int bl = j >> 6; reto_unit(UB, YB, KVS, ROT, bl, (g * BG + bl) * SEQ, (j >> 4) & 3, j & 15, lds, t.tid, t.wave, t.lane); }
            else { const int k = j - NRC;
                conv_unit(UB, YB, KIN(float, I_CONVW) + (size_t)l * 31 * 256, KIN(float, I_CONVB) + l * 256, KIN(float, I_CLNG) + l * 256, KIN(float, I_CLNB) + l * 256, k >> 6, k & 63, lds, t.tid, t.wave, t.lane); }
        }
    }
}
PH void ph_merge(int wv, LAS unsigned char* lds, int l) {
    const Ids t = ids(wv); unsigned char* ws = KA()->ws;
    pg8::OrdMerge S; S.G = t.G; S.c = t.wg; S.ntiles = (MG / 256) * 8; S.A = (const char*)(ws + WS_Y); S.B = (const char*)((bf16*)(ws + WS_WB) + (size_t)l * 4 * D * 256);
    pg8::EpiMerge E{(const bf16*)(ws + WS_GATES), (bf16*)(ws + WS_MERGED)};
    pg8::gemm_phase<pg8::EpiMerge, pg8::OrdMerge, false, true>(lds, 256, D, S, E, t.wave);
}
PH void ph_res(int wv, LAS unsigned char* lds, int g, int l, int which, int xbm) {
    const Ids t = ids(wv); unsigned char* ws = KA()->ws; const size_t grow = (size_t)g * MG; float* xo = KA()->out + grow * D;
    const float* xi = (which == 0 && l == 0) ? (KIN(float, I_X) + grow * D) : xo;
    int K; const char* A; const char* B;
    if (which == 0) { K = D; A = (const char*)(ws + WS_MERGED); B = (const char*)((bf16*)(ws + WS_WOUT) + (size_t)l * D * D); }
    else { K = 256; A = (const char*)(ws + WS_OB); B = (const char*)((bf16*)(ws + WS_WO) + (size_t)l * D * 256); }
    pg8::OrdStd S; S.to.init(MG / 256, 4, t.G, t.wg); S.A = A; S.B = B; S.atile = (size_t)256 * K * 2; S.btile = (size_t)256 * K * 2;
    pg8::EpiRes<true, false> E{xi, xo, xbm, (void*)(ws + WS_HB), (float*)(ws + WS_SSQ), ws + WS_HB};
    pg8::gemm_phase<pg8::EpiRes<true, false>, pg8::OrdStd>(lds, K, K, S, E, t.wave);
}
template <bool F8> PH void ph_down(int wv, LAS unsigned char* lds, int g, int l, int xbm) {
    constexpr int FE = F8 ? 1 : 2;
    const Ids t = ids(wv); unsigned char* ws = KA()->ws; float* xo = KA()->out + (size_t)g * MG * D;
    pg8::OrdStd S; S.to.init(MG / 256, 4, t.G, t.wg); S.A = (const char*)(ws + WS_ACT); S.B = (const char*)(ws + WS_WDND + (size_t)(l >> 1) * D * DFF * 2); S.atile = (size_t)256 * DFF * FE; S.btile = (size_t)256 * DFF * FE;
    pg8::EpiRes<!F8, F8> E{xo, xo, xbm, (void*)(ws + WS_HB), (float*)(ws + WS_SSQ), ws + WS_XB8};
    pg8::gemm_phase<pg8::EpiRes<!F8, F8>, pg8::OrdStd, F8>(lds, DFF, DFF, S, E, t.wave);
}
PH void ph_q(int wv, LAS unsigned char* lds, int l) {
    const Ids t = ids(wv); unsigned char* ws = KA()->ws;
    pg8::OrdStd S; S.to.init(MG / 256, 1, t.G, t.wg); S.A = (const char*)(ws + WS_HB); S.B = (const char*)((bf16*)(ws + WS_WQ) + (size_t)l * 256 * D); S.atile = 256 * D * 2; S.btile = 256 * D * 2;
    pg8::EpiBf16<false> E{(bf16*)(ws + WS_QB), 256, (const float*)(ws + WS_SSQ)};
    pg8::gemm_phase<pg8::EpiBf16<false>, pg8::OrdStd>(lds, D, D, S, E, t.wave);
}
PH void ph_xa(int wv, LAS unsigned char* lds, int g, int l) {
    const Ids t = ids(wv); unsigned char* ws = KA()->ws; const unsigned* ctl = (const unsigned*)(ws + WS_CTL);
    for (int j = t.wg; j < BG * 4 * 16; j += t.G) { const int bl = j >> 6, hd = (j >> 4) & 3, qblk = j & 15, bglob = g * BG + bl;
        const float kmax = sqrtf(__uint_as_float(ctl[CW_KMAX + (l * NB + bglob) * 4 + hd]));
        xa_unit((const bf16*)(ws + WS_QB), (const bf16*)(ws + WS_KV) + (size_t)l * MMEM * 512, KIN(float, I_QG) + l * 64, kmax, (bf16*)(ws + WS_OB), bl, bglob, hd, qblk, lds, t.tid, t.wave, t.lane); }
}
template <bool F8> PH void ph_gu(int wv, LAS unsigned char* lds, int l) {
    constexpr int FE = F8 ? 1 : 2;
    const Ids t = ids(wv); unsigned char* ws = KA()->ws;
    pg8::OrdStd S; S.to.init(MG / 256, NGU / 256, t.G, t.wg); S.A = (const char*)(ws + WS_HB); S.B = (const char*)(ws + WS_WGUD + (size_t)(l >> 1) * NGU * D * 2); S.atile = 256 * D * FE; S.btile = 256 * D * FE;
    pg8::EpiGU<F8> E{(void*)(ws + WS_ACT), (const float*)(ws + WS_SSQ)};
    pg8::gemm_phase<pg8::EpiGU<F8>, pg8::OrdStd, F8>(lds, D, D, S, E, t.wave);
}
struct MoeCtx { int rpw, r_lo, r_hi; };
DI MoeCtx moe_ctx(const Ids& t) { MoeCtx c; c.rpw = (MG + t.G - 1) / t.G; c.r_lo = t.wg * c.rpw; c.r_hi = (c.r_lo + c.rpw < MG) ? (c.r_lo + c.rpw) : MG; return c; }
template <bool F8> PH void ph_route(int wv, LAS unsigned char* lds, int g, int l) {
    constexpr int FE = F8 ? 1 : 2;
    const Ids t = ids(wv); unsigned char* ws = KA()->ws; unsigned* ctl = (unsigned*)(ws + WS_CTL); const int l2 = l >> 1, inst = g * 2 + l2;
    unsigned* wgcnt = ctl + CW_WGCNT + inst * 8192; const MoeCtx mc = moe_ctx(t);
    volatile LAS unsigned* LC = (volatile LAS unsigned*)(lds + MISC_OFF) + 16;
    const float* xo = KA()->out + (size_t)g * MG * D; bf16* HB = (bf16*)(ws + WS_HB);
    int* R_E = (int*)(ws + WS_ROUTE); float* R_W1 = (float*)(R_E + MG); float* R_W2 = R_W1 + MG;
    if (t.tid < 16) LC[t.tid] = 0u;
    __syncthreads();
    const float* rt = KIN(float, I_ROUTER) + (size_t)l2 * D * NEXP; const float* gn = KIN(float, I_NFFNG) + l * D; const int lane = t.lane;
    for (int m = mc.r_lo + t.wave; m < mc.r_hi; m += NWAVES) {
        const f32x4* xr = (const f32x4*)(xo + (size_t)m * D) + lane; const f32x4* gr = (const f32x4*)gn + lane;
        f32x4 v[4]; float s = 0.f;
#pragma unroll
        for (int j = 0; j < 4; ++j) { v[j] = xr[64 * j]; s += (v[j].x * v[j].x + v[j].y * v[j].y) + (v[j].z * v[j].z + v[j].w * v[j].w); }
        const float rstd = 1.f / sqrtf(wave_sum(s, lane) * (1.f / D) + EPS);
        float lg[8];
#pragma unroll
        for (int e = 0; e < 8; ++e) lg[e] = 0.f;
        u32x2* o8 = (u32x2*)(HB + (size_t)m * D) + lane; unsigned* o4 = (unsigned*)((unsigned char*)HB + (size_t)m * D) + lane;
#pragma unroll
        for (int j = 0; j < 4; ++j) { const f32x4 gg = gr[64 * j]; const f32x4 hn = v[j] * rstd * gg;
            if (F8) o4[64 * j] = cvt4_fp8(hn.x, hn.y, hn.z, hn.w);
            else { u32x2 w; w.x = cvtpk(hn.x, hn.y); w.y = cvtpk(hn.z, hn.w); o8[64 * j] = w; }
            const f32x4* rp = (const f32x4*)(rt + (size_t)(4 * lane + 256 * j) * NEXP);
#pragma unroll
            for (int q = 0; q < 4; ++q) { const f32x4 r0 = rp[2 * q], r1 = rp[2 * q + 1]; const float hv = hn[q];
                lg[0] += hv * r0.x; lg[1] += hv * r0.y; lg[2] += hv * r0.z; lg[3] += hv * r0.w; lg[4] += hv * r1.x; lg[5] += hv * r1.y; lg[6] += hv * r1.z; lg[7] += hv * r1.w; } }
#pragma unroll
        for (int e = 0; e < 8; ++e) lg[e] = wave_sum(lg[e], lane);
        float v1 = lg[0]; int i1 = 0;
#pragma unroll
        for (int e = 1; e < 8; ++e) if (lg[e] > v1) { v1 = lg[e]; i1 = e; }
        float v2 = -3.0e38f; int i2 = -1;
#pragma unroll
        for (int e = 0; e < 8; ++e) if (e != i1 && (i2 < 0 || lg[e] > v2)) { v2 = lg[e]; i2 = e; }
        const float w1 = 1.f / (1.f + __expf(v2 - v1));
        if (lane == 0) { R_E[m] = i1 | (i2 << 8); R_W1[m] = w1; R_W2[m] = 1.f - w1;
            __hip_atomic_fetch_add((LAS unsigned*)&LC[i1], 1u, __ATOMIC_RELAXED, __HIP_MEMORY_SCOPE_WORKGROUP); __hip_atomic_fetch_add((LAS unsigned*)&LC[i2], 1u, __ATOMIC_RELAXED, __HIP_MEMORY_SCOPE_WORKGROUP); }
    }
    __syncthreads();
    if (t.tid < 8) wgcnt[t.wg * 8 + t.tid] = LC[t.tid];
}
template <bool F8> PHN void ph_gather(KArgs ka, int wv, LAS unsigned char* lds, int g, int l) {
    constexpr int FE = F8 ? 1 : 2;
    const Ids t = ids(__builtin_amdgcn_readfirstlane(wv));     unsigned char* ws = ka->ws; unsigned* ctl = (unsigned*)(ws + WS_CTL); const int l2 = l >> 1, inst = g * 2 + l2;
    unsigned* wgcnt = ctl + CW_WGCNT + inst * 8192; unsigned* moff = ctl + CW_MOFF + 64 * inst; const MoeCtx mc = moe_ctx(t);
    volatile LAS unsigned* LC = (volatile LAS unsigned*)(lds + MISC_OFF) + 16;
    const bf16* HB = (const bf16*)(ws + WS_HB); bf16* HP = (bf16*)(ws + WS_HP);
    const int* R_E = (const int*)(ws + WS_ROUTE); int* R_S1 = (int*)(ws + WS_ROUTE) + 3 * MG; int* R_S2 = R_S1 + MG;
    if (t.tid < 16) LC[t.tid] = 0u;
    __syncthreads();
    for (int idx = t.tid; idx < t.G * 8; idx += NTHR) { const unsigned v = wgcnt[idx]; const int e = idx & 7;
        __hip_atomic_fetch_add((LAS unsigned*)&LC[8 + e], v, __ATOMIC_RELAXED, __HIP_MEMORY_SCOPE_WORKGROUP);
        if ((idx >> 3) < t.wg) __hip_atomic_fetch_add((LAS unsigned*)&LC[e], v, __ATOMIC_RELAXED, __HIP_MEMORY_SCOPE_WORKGROUP); }
    __syncthreads();
    if (t.tid == 0) { unsigned o = 0;
        for (int e = 0; e < 8; ++e) { const unsigned tot = LC[8 + e]; if (t.wg == 0) moff[e] = o; LC[e] = LC[e] + o; o += (tot + 255u) & ~255u; }
        if (t.wg == 0) moff[8] = o; }
    __syncthreads();
    const int lane = t.lane;
    for (int m = mc.r_lo + t.wave; m < mc.r_hi; m += NWAVES) {
        int s1 = 0, s2 = 0;
        if (lane == 0) { const int ee = R_E[m];
            s1 = (int)__hip_atomic_fetch_add((LAS unsigned*)&LC[ee & 255], 1u, __ATOMIC_RELAXED, __HIP_MEMORY_SCOPE_WORKGROUP);
            s2 = (int)__hip_atomic_fetch_add((LAS unsigned*)&LC[ee >> 8], 1u, __ATOMIC_RELAXED, __HIP_MEMORY_SCOPE_WORKGROUP);
            R_S1[m] = s1; R_S2[m] = s2; }
        s1 = __builtin_amdgcn_readfirstlane(s1); s2 = __builtin_amdgcn_readfirstlane(s2);
        if (F8) { const u32x4 a = *((const u32x4*)((const unsigned char*)HB + (size_t)m * D) + lane);
            *((u32x4*)((unsigned char*)HP + (size_t)s1 * D) + lane) = a; *((u32x4*)((unsigned char*)HP + (size_t)s2 * D) + lane) = a; }
        else { const u32x4* src = (const u32x4*)(HB + (size_t)m * D) + lane; const u32x4 a = src[0], b = src[64];
            u32x4* d1 = (u32x4*)(HP + (size_t)s1 * D) + lane; u32x4* d2 = (u32x4*)(HP + (size_t)s2 * D) + lane;
            d1[0] = a; d1[64] = b; d2[0] = a; d2[64] = b; } }
}
template <bool F8> PH void ph_moe_gu(int wv, LAS unsigned char* lds, int g, int l) {
    constexpr int FE = F8 ? 1 : 2;
    const Ids t = ids(wv); unsigned char* ws = KA()->ws; const unsigned* ctl = (const unsigned*)(ws + WS_CTL); const int l2 = l >> 1, inst = g * 2 + l2; const unsigned* moff = ctl + CW_MOFF + 64 * inst;
    pg8::OrdMoe S;
#pragma unroll
    for (int e = 0; e < 9; ++e) S.off[e] = __builtin_amdgcn_readfirstlane((int)moff[e]);
    S.to.init(S.off[8] >> 8, NGU / 256, t.G, t.wg); S.A = (const char*)(ws + WS_HP); S.B = (const char*)(ws + WS_WGUM + (size_t)l2 * NEXP * NGU * D * 2); S.atile = 256 * D * FE; S.btile = 256 * D * FE; S.bexp = (size_t)NGU * D * 2;
    pg8::EpiGU<F8> E{(void*)(ws + WS_ACT), nullptr};
    pg8::gemm_phase<pg8::EpiGU<F8>, pg8::OrdMoe, F8>(lds, D, D, S, E, t.wave);
}
template <bool F8> PH void ph_moe_dn(int wv, LAS unsigned char* lds, int g, int l) {
    constexpr int FE = F8 ? 1 : 2;
    const Ids t = ids(wv); unsigned char* ws = KA()->ws; const unsigned* ctl = (const unsigned*)(ws + WS_CTL); const int l2 = l >> 1, inst = g * 2 + l2; const unsigned* moff = ctl + CW_MOFF + 64 * inst;
    pg8::OrdMoe S;
#pragma unroll
    for (int e = 0; e < 9; ++e) S.off[e] = __builtin_amdgcn_readfirstlane((int)moff[e]);
    S.to.init(S.off[8] >> 8, 4, t.G, t.wg); S.A = (const char*)(ws + WS_ACT); S.B = (const char*)(ws + WS_WDNM + (size_t)l2 * NEXP * D * DFF * 2); S.atile = (size_t)256 * DFF * FE; S.btile = (size_t)256 * DFF * FE; S.bexp = (size_t)D * DFF * 2;
    pg8::EpiBf16<F8> E{(bf16*)(ws + WS_HP), D, nullptr};
    pg8::gemm_phase<pg8::EpiBf16<F8>, pg8::OrdMoe, F8>(lds, DFF, DFF, S, E, t.wave);
}
PHN void ph_combine(KArgs ka, int wv, int g, int xbm) {
    const Ids t = ids(__builtin_amdgcn_readfirstlane(wv));     unsigned char* ws = ka->ws; float* xo = ka->out + (size_t)g * MG * D; const bf16* HP = (const bf16*)(ws + WS_HP);
    const int* R_E = (const int*)(ws + WS_ROUTE); const float* R_W1 = (const float*)(R_E + MG); const float* R_W2 = R_W1 + MG; const int* R_S1 = (const int*)(R_W2 + MG); const int* R_S2 = R_S1 + MG;
    const int lane = t.lane;
    bf16* XB = (bf16*)(ws + WS_HB); float* ssq = (float*)(ws + WS_SSQ);
    for (int m = t.gw; m < MG; m += t.NGW) { const int s1 = R_S1[m], s2 = R_S2[m]; const float w1 = R_W1[m], w2 = R_W2[m]; float ssum = 0.f;
        f32x4* xr = (f32x4*)(xo + (size_t)m * D) + 2 * lane; const u32x4* p1 = (const u32x4*)(HP + (size_t)s1 * D) + lane; const u32x4* p2 = (const u32x4*)(HP + (size_t)s2 * D) + lane;
#pragma unroll
        for (int j = 0; j < 2; ++j) { float a[8], b[8]; unpack8(p1[64 * j], a); unpack8(p2[64 * j], b); f32x4 x0 = xr[128 * j], x1 = xr[128 * j + 1];
            x0.x += w1 * a[0] + w2 * b[0]; x0.y += w1 * a[1] + w2 * b[1]; x0.z += w1 * a[2] + w2 * b[2]; x0.w += w1 * a[3] + w2 * b[3];
            x1.x += w1 * a[4] + w2 * b[4]; x1.y += w1 * a[5] + w2 * b[5]; x1.z += w1 * a[6] + w2 * b[6]; x1.w += w1 * a[7] + w2 * b[7];
            xr[128 * j] = x0; xr[128 * j + 1] = x1;
            if (xbm) { ssum += (x0.x * x0.x + x0.y * x0.y) + (x0.z * x0.z + x0.w * x0.w) + (x1.x * x1.x + x1.y * x1.y) + (x1.z * x1.z + x1.w * x1.w);
                u32x4 w; w.x = cvtpk(x0.x, x0.y); w.y = cvtpk(x0.z, x0.w); w.z = cvtpk(x1.x, x1.y); w.w = cvtpk(x1.z, x1.w); *((u32x4*)(XB + (size_t)m * D) + lane + 64 * j) = w;
                if (GATE_FP8) { u32x2 w8; w8.x = cvt4_fp8(x0.x, x0.y, x0.z, x0.w); w8.y = cvt4_fp8(x1.x, x1.y, x1.z, x1.w); *((u32x2*)(ws + WS_XB8 + (size_t)m * D) + lane + 64 * j) = w8; } } }
        if (xbm) { ssum = wave_sum(ssum, lane); if (lane < 16) ssq[(size_t)m * 16 + lane] = lane == 0 ? ssum : 0.f; } }
}

__global__ void __launch_bounds__(NTHR, 2) trunk_fwd(Args args) {
    extern __shared__ __attribute__((aligned(16))) unsigned char lds_raw[];
    LAS unsigned char* lds = (LAS unsigned char*)lds_raw;
    volatile LAS unsigned* MISC = (volatile LAS unsigned*)(lds + MISC_OFF);
    const int tid = threadIdx.x; int wave = __builtin_amdgcn_readfirstlane(tid >> 6); asm volatile("" : "+s"(wave));
    unsigned* ctl = (unsigned*)(args.ws + WS_CTL);
    for (int u = tid; u < (LDS_BYTES - LDSCTL_OFF) / 4; u += NTHR) ((LAS unsigned*)(lds + LDSCTL_OFF))[u] = 0u;
    __syncthreads();
    XcdBarrier bar; bar.bar = ctl + CW_BAR; bar.x = xb_xcc_id(); bar.st = MISC + 8;
    if (tid == 0) (void)xb_add(&bar.bar[XB_XCNT(bar.x)], 1u);
#define WV() ({ int _w = wave; asm volatile("" : "+s"(_w)); _w; })
#define GRID_BAR() xcd_barrier_fn((GAS unsigned*)bar.bar, bar.x, bar.st, WV())
    unsigned ib = 0;
    for (int l = 0; l < DEPTH; ++l) ib = ph_w_layer(KA(), WV(), lds, l, ib);
    for (int s = 0; s < 2 + 2 * NEXP; ++s) ib = ph_w_ffn(KA(), WV(), lds, s, ib);
    ph_misc0(KA(), WV());
#ifdef DUP_PRO
    for (int l = 0; l < DEPTH; ++l) ib = ph_w_layer(KA(), WV(), lds, l, ib);
    for (int s = 0; s < 2 + 2 * NEXP; ++s) ib = ph_w_ffn(KA(), WV(), lds, s, ib);
    ph_misc0(KA(), WV());
#endif
    GRID_BAR();
    ph_kv(wave, lds);
    GRID_BAR();
    ph_knorm(KA(), WV());
    GRID_BAR();
    for (int g = 0; g < NG; ++g) {
        for (int l = 0; l < DEPTH; ++l) {
            if (l == 0) { ph_xprep(KA(), WV(), g, 1); GRID_BAR(); }
            ph_gemm1(wave, lds, l); GRID_BAR();
#ifdef DUP_G1
            ph_gemm1(wave, lds, l); GRID_BAR();
#endif
            ph_mix(wave, lds, g, l, 0); GRID_BAR();
            ph_mix(wave, lds, g, l, 1); GRID_BAR();
            ph_merge(wave, lds, l); GRID_BAR();
#ifdef DUP_MERGE
            ph_merge(wave, lds, l); GRID_BAR();
#endif
            ph_res(wave, lds, g, l, 0, 1); GRID_BAR();
            ph_q(wave, lds, l); GRID_BAR();
            ph_xa(wave, lds, g, l); GRID_BAR();
            const bool f8 = (F8MASK >> l) & 1u; const int nxt = (l + 1 < DEPTH) ? 1 : 0;
            if ((l & 1) == 0) {
                ph_res(wave, lds, g, l, 1, f8 ? 2 : 1); GRID_BAR();
                if (f8) { if constexpr (DENSE_ANY8) { ph_gu<true>(wave, lds, l); GRID_BAR(); ph_down<true>(wave, lds, g, l, 0); GRID_BAR(); if (nxt) { ph_xprep(KA(), WV(), g, 0); GRID_BAR(); } } }
                else { if constexpr (DENSE_ANYB) { ph_gu<false>(wave, lds, l); GRID_BAR(); ph_down<false>(wave, lds, g, l, nxt ? (GATE_FP8 ? 3 : 1) : 0); GRID_BAR(); } }
            } else {
                ph_res(wave, lds, g, l, 1, 0); GRID_BAR();
                if (f8) { if constexpr (MOE_ANY8) { ph_route<true>(wave, lds, g, l); GRID_BAR(); ph_gather<true>(KA(), WV(), lds, g, l); GRID_BAR(); ph_moe_gu<true>(wave, lds, g, l); GRID_BAR(); ph_moe_dn<true>(wave, lds, g, l); GRID_BAR(); } }
                else { if constexpr (MOE_ANYB) { ph_route<false>(wave, lds, g, l); GRID_BAR(); ph_gather<false>(KA(), WV(), lds, g, l); GRID_BAR(); ph_moe_gu<false>(wave, lds, g, l); GRID_BAR(); ph_moe_dn<false>(wave, lds, g, l); GRID_BAR(); } }
                ph_combine(KA(), WV(), g, nxt); GRID_BAR();
            }
        }
    }
}

extern "C" void kernel_launch(void* const* d_in, const int* in_sizes, int n_in, void* d_out, int out_size, void* d_ws, size_t ws_size, hipStream_t stream) {
    static int grid = 0;
    if (grid == 0) {
        if (n_in != 27 || in_sizes[0] != MTOT * D || out_size != MTOT * D || ws_size < WS_END) { fprintf(stderr, "kernel_launch: unexpected problem (n_in %d, in0 %d, out %d, ws %zu < %zu)\n", n_in, n_in > 0 ? in_sizes[0] : -1, out_size, ws_size, (size_t)WS_END); grid = -1; return; }
        int dev = 0, cus = 0, per_cu = 0;
        if (hipGetDevice(&dev) != hipSuccess || hipDeviceGetAttribute(&cus, hipDeviceAttributeMultiprocessorCount, dev) != hipSuccess) { grid = -1; return; }
        if (hipFuncSetAttribute((const void*)trunk_fwd, hipFuncAttributeMaxDynamicSharedMemorySize, LDS_BYTES) != hipSuccess) { fprintf(stderr, "kernel_launch: hipFuncSetAttribute failed\n"); grid = -1; return; }
        if (hipOccupancyMaxActiveBlocksPerMultiprocessor(&per_cu, (const void*)trunk_fwd, NTHR, LDS_BYTES) != hipSuccess || per_cu < 1) fprintf(stderr, "kernel_launch: occupancy query reports %d\n", per_cu);
        (void)hipGetLastError();
        grid = cus;
    }
    if (grid < 0) return;
    if (hipMemsetAsync((char*)d_ws + WS_CTL, 0, CTL_ZERO_BYTES, stream) != hipSuccess) return;
    Args a{};
    for (int i = 0; i < 27; ++i) a.in[i] = d_in[i];
    a.out = (float*)d_out; a.ws = (unsigned char*)d_ws;
    hipLaunchKernelGGL(trunk_fwd, dim3(grid), dim3(NTHR), LDS_BYTES, stream, a);
}
```

```cpp
#include <hip/hip_runtime.h>
#include <cstdio>
#include <cstdint>

#define DI __device__ __forceinline__
#define LAS __attribute__((address_space(3)))
#define GAS __attribute__((address_space(1)))
typedef unsigned short bf16;
typedef short bf16x8 __attribute__((ext_vector_type(8)));
typedef short s16x4 __attribute__((ext_vector_type(4)));
typedef float f32x2 __attribute__((ext_vector_type(2)));
typedef float f32x4 __attribute__((ext_vector_type(4)));
typedef float f32x16 __attribute__((ext_vector_type(16)));
typedef unsigned u32x2 __attribute__((ext_vector_type(2)));
typedef unsigned u32x4 __attribute__((ext_vector_type(4)));
typedef __bf16 bf16x2_t __attribute__((ext_vector_type(2)));
typedef GAS unsigned gu32;
typedef int i32x8 __attribute__((ext_vector_type(8)));
#ifndef GATE_FP8
#define GATE_FP8 1
#endif
#ifndef FFN_FP8_MASK
#define FFN_FP8_MASK 0xE
#endif
constexpr float W8_SCALE = 64.f, W8_INV = 1.f / 64.f;

constexpr int NB = 16, SEQ = 4096, D = 1024, DEPTH = 4, NG = 2, BG = NB / NG, MG = BG * SEQ, MTOT = NB * SEQ;
constexpr int DIN = 2560, NCAT = DIN + 4096, DFF = 2816, NGU = 2 * DFF, NEXP = 8, NMEM = 256, MMEM = NB * NMEM;
constexpr int MOE_SLOTS = 2 * MG + NEXP * 256;
constexpr float EPS = 1e-6f;
constexpr int NWAVES = 8, NTHR = 512;
constexpr int UC_CA = 0, UC_CG = 256, UC_POOL = 512, UC_SBQ = 768, UC_SBK = 1024, UC_SBV = 1280, UC_RQ = 1536, UC_RK = 1792, UC_RV = 2048, UC_RG = 2304;
constexpr int YC_CONV = 0, YC_POOL = 256, YC_SB = 512, YC_RET = 768;

constexpr size_t MiB = 1u << 20;
constexpr size_t WS_CTL = 0, CTL_ZERO_BYTES = 1 * MiB;
constexpr size_t WS_WCAT = 1 * MiB;
constexpr size_t WS_WB = 53 * MiB;
constexpr size_t WS_WOUT = 61 * MiB;
constexpr size_t WS_WQ = 69 * MiB;
constexpr size_t WS_WKV = 71 * MiB;
constexpr size_t WS_WO = 75 * MiB;
constexpr size_t WS_WGUD = 77 * MiB;
constexpr size_t WS_WDND = 99 * MiB;
constexpr size_t WS_WGUM = 110 * MiB;
constexpr size_t WS_WDNM = 286 * MiB;
constexpr size_t WS_ROT = 374 * MiB;
constexpr size_t WS_MEMH = 390 * MiB;
constexpr size_t WS_KV = 422 * MiB;
constexpr size_t WS_HB = 438 * MiB;
constexpr size_t WS_U = 502 * MiB;
constexpr size_t WS_GATES = 662 * MiB;
constexpr size_t WS_Y = 918 * MiB;
constexpr size_t WS_MERGED = 982 * MiB;
constexpr size_t WS_QB = 1046 * MiB;
constexpr size_t WS_OB = 1062 * MiB;
constexpr size_t WS_ROUTE = 1078 * MiB;
constexpr size_t WS_KVS = 1079 * MiB;
constexpr size_t WS_SSQ = 1087 * MiB;
constexpr size_t WS_XB8 = 1089 * MiB;
constexpr size_t WS_END = 1121 * MiB;
constexpr size_t WS_ACT = WS_U, WS_HP = WS_Y;
static_assert((size_t)MOE_SLOTS * DFF * 2 <= WS_Y - WS_U, "act overlay");
static_assert((size_t)MOE_SLOTS * D * 2 <= WS_ROUTE - WS_Y, "hp overlay");
constexpr int CW_TMO = 0, CW_CODE = 1;
constexpr int CW_BAR = 4096;
constexpr int CW_QCTR = 8192;
constexpr int CW_KMAX = 10240;
constexpr int CW_MOFF = 10752;
constexpr int CW_WGCNT = 16384;

constexpr int RING_BYTES = 131072;
constexpr int LDSCTL_OFF = RING_BYTES, MISC_OFF = LDSCTL_OFF + 320;
constexpr int LDS_BYTES = 147456;
constexpr int KS = 72, VS = 264;
constexpr int L_KS = 0, L_VT = 36864, L_KT = 70656, L_ST = 104448;

#define SHX(x, m, lane) __builtin_bit_cast(float, __builtin_amdgcn_ds_bpermute((((lane) ^ (m)) << 2), __builtin_bit_cast(int, (float)(x))))
DI float shx32(float x, int lane) { const auto r = __builtin_amdgcn_permlane32_swap(__builtin_bit_cast(unsigned, x), __builtin_bit_cast(unsigned, x), false, false); return __builtin_bit_cast(float, (lane & 32) ? r[0] : r[1]); }
DI float shx16(float x, int lane) { const auto r = __builtin_amdgcn_permlane16_swap(__builtin_bit_cast(unsigned, x), __builtin_bit_cast(unsigned, x), false, false); return __builtin_bit_cast(float, (lane & 16) ? r[0] : r[1]); }
DI float wave_sum(float v, int lane) {
#pragma unroll
    for (int o = 1; o < 64; o <<= 1) v += SHX(v, o, lane);
    return v;
}
DI unsigned cvtpk(float lo, float hi) { f32x2 v = {lo, hi}; bf16x2_t b = __builtin_convertvector(v, bf16x2_t); return __builtin_bit_cast(unsigned, b); }
DI float bflo(unsigned w) { return __uint_as_float(w << 16); }
DI float bfhi(unsigned w) { return __uint_as_float(w & 0xffff0000u); }
DI void unpack8(const u32x4 w, float (&f)[8]) { f[0] = bflo(w.x); f[1] = bfhi(w.x); f[2] = bflo(w.y); f[3] = bfhi(w.y); f[4] = bflo(w.z); f[5] = bfhi(w.z); f[6] = bflo(w.w); f[7] = bfhi(w.w); }
DI u32x4 pack8(const float (&f)[8]) { u32x4 w; w.x = cvtpk(f[0], f[1]); w.y = cvtpk(f[2], f[3]); w.z = cvtpk(f[4], f[5]); w.w = cvtpk(f[6], f[7]); return w; }
DI unsigned cvt4_fp8(float a, float b, float c, float d) { int w = __builtin_amdgcn_cvt_pk_fp8_f32(a, b, 0, false); w = __builtin_amdgcn_cvt_pk_fp8_f32(c, d, w, true); return (unsigned)w; }
DI float fexp2(float x) { return __builtin_amdgcn_exp2f(x); }
DI float frcp(float x) { return __builtin_amdgcn_rcpf(x); }
DI float sigmoid_f(float x) { return frcp(1.f + fexp2(-1.44269504f * x)); }
DI int lane_id() { int l; asm volatile("v_mbcnt_lo_u32_b32 %0, -1, 0\n\tv_mbcnt_hi_u32_b32 %0, -1, %0" : "=v"(l)); return l; }
DI int crow(int reg, int h) { return (reg & 3) + 8 * (reg >> 2) + 4 * h; }
#define MFMA32(a, b, c) __builtin_amdgcn_mfma_f32_32x32x16_bf16((a), (b), (c), 0, 0, 0)

__device__ const float INV_FREQ[32] = {1.0f, 0.7498942017555237f, 0.5623413324356079f, 0.4216965138912201f, 0.3162277638912201f, 0.23713737726211548f, 0.17782793939113617f, 0.1333521455526352f,
    0.10000000149011612f, 0.0749894231557846f, 0.05623413249850273f, 0.04216964915394783f, 0.03162277489900589f, 0.023713737726211548f, 0.017782794311642647f, 0.013335213996469975f,
    0.009999999776482582f, 0.007498942315578461f, 0.005623413249850273f, 0.0042169648222625256f, 0.003162277629598975f, 0.0023713738191872835f, 0.0017782794311642647f, 0.0013335214462131262f,
    0.0010000000474974513f, 0.0007498941849917173f, 0.000562341301701963f, 0.0004216965171508491f, 0.0003162277571391314f, 0.00023713737027719617f, 0.00017782794020604342f, 0.0001333521504420787f};

namespace pg8 {
constexpr int BM = 256, BK = 64, HALF = 128, HTB = HALF * BK * 2, STAGE_BYTES = 8 * HTB, NXCD = 8, WGM = 8;
__host__ __device__ __forceinline__ int lds_byte(int r, int c) { const int st = (r >> 4) * 2 + (c >> 5), rr = r & 15, cc = c & 31, ob = rr * 64 + cc * 2; return st * 1024 + (ob ^ (((ob >> 9) & 1) << 5)); }
__host__ __device__ __forceinline__ void stage_rc(int b, int& R, int& C) { const int st = b / 1024, sb = b % 1024, swz = sb ^ (((sb >> 9) & 1) << 5); R = (st >> 1) * 16 + swz / 64; C = (st & 1) * 32 + (swz % 64) / 2; }
__host__ __device__ __forceinline__ int perm32(int rho) { const int n = rho >> 4, i = rho & 15; return 8 * (i >> 2) + 4 * n + (i & 3); }

struct Unit { int pm, pn, z; const char* a; const char* b; };
DI const char* uni(const char* p) { const unsigned long long v = (unsigned long long)p; const unsigned lo = __builtin_amdgcn_readfirstlane((unsigned)v), hi = __builtin_amdgcn_readfirstlane((unsigned)(v >> 32)); return (const char*)(((unsigned long long)hi << 32) | lo); }

struct TileOrder {
    int nM, nN, nwg, G, c;
    DI void init(int nM_, int nN_, int G_, int c_) { nM = nM_; nN = nN_; nwg = nM * nN; G = G_; c = c_; }
    DI bool tile(int i, int& pm, int& pn) const {
        const long L = (long)i * G + c; if (L >= nwg) return false;
        int wgid = (int)L; { const int q = nwg / NXCD, r = nwg % NXCD, xcd = wgid % NXCD, off = wgid / NXCD; wgid = (xcd < r ? xcd * (q + 1) : r * (q + 1) + (xcd - r) * q) + off; }
        const int nig = WGM * nN, gid = wgid / nig, fm = gid * WGM, gsz = (nM - fm) < WGM ? (nM - fm) : WGM;
        pm = fm + ((wgid % nig) % gsz); pn = (wgid % nig) / gsz; return true;
    }
};

template <class Epi, class Sched, bool F8 = false, bool HN = false>
DI void gemm_phase(LAS unsigned char* lds, const int K, const int lda, const Sched& S, const Epi& E, const int wid_in) {
    int wid = wid_in; asm volatile("" : "+s"(wid));
    int lane = lane_id(); asm volatile("" : "+v"(lane));
    const int tid = wid * 64 + lane, wr = wid >> 2, wc = wid & 3, fr = lane & 15, fq = lane >> 4;
    constexpr int ESZ = F8 ? 1 : 2; const int nt = (K * ESZ) / (BK * 2);
    unsigned voffA, voffB;
    { int R, C; stage_rc(tid * 16, R, C); const int Rb = Epi::PERM ? ((R & ~31) + perm32(R & 31)) : R;
      voffA = (unsigned)(R * lda * ESZ + C * 2); voffB = (unsigned)(Rb * K * ESZ + C * 2); }
    const size_t i1voffA = (size_t)64 * lda * ESZ, i1voffB = (size_t)64 * K * ESZ;
    const size_t kstep = (size_t)(BK * 2);
    const size_t hstepA = (size_t)HALF * lda * ESZ, hstepB = (size_t)HALF * K * ESZ;
    const unsigned ldsw = (unsigned)wid * 1024u;
    constexpr int PIECE = F8 ? 16 : 1024;
    const int aoff = lds_byte(wr * 64 + fr, F8 ? fq * 16 : fq * 8), boff = lds_byte(wc * 32 + fr, F8 ? fq * 16 : fq * 8);
#define PG8_SA(b, h) (((b) * 2 + (h)) * HTB)
#define PG8_SB(b, h) ((4 + (b) * 2 + (h)) * HTB)
#define PG8_STAGE(bufoff, gbase, voff) do { _Pragma("unroll") for (int _i = 0; _i < 2; ++_i) { asm volatile("" : "+v"(voff));     \
        __builtin_amdgcn_global_load_lds((const GAS unsigned*)((const GAS char*)(gbase) + (_i ? i1##voff : (size_t)0) + voff), (LAS unsigned*)(lds + (bufoff) + ldsw + _i * 8192), 16, 0, 0); } } while (0)
#define PG8_LD16(off) (*(const LAS u32x4*)(lds + (off)))
#define PG8_LD16B(off) (*(const LAS u32x4*)(ldsB + (off)))
#define PG8_SBR(b, h) (((b) * 2 + (h)) * HTB)
#define PG8_LDA(dst, b, h) do { _Pragma("unroll") for (int m = 0; m < 4; ++m) { if constexpr (F8) dst##8[m] = __builtin_bit_cast(i32x8, __builtin_shufflevector(PG8_LD16(PG8_SA(b, h) + aoff + m * 2048), PG8_LD16(PG8_SA(b, h) + aoff + PIECE + m * 2048), 0, 1, 2, 3, 4, 5, 6, 7)); \
        else { _Pragma("unroll") for (int k = 0; k < 2; ++k) dst[m][k] = *(const LAS bf16x8*)(lds + PG8_SA(b, h) + aoff + k * PIECE + m * 2048); } } } while (0)
#define PG8_LDB(dst, b, h) do { _Pragma("unroll") for (int n = 0; n < 2; ++n) { if constexpr (F8) dst##8[n] = __builtin_bit_cast(i32x8, __builtin_shufflevector(PG8_LD16B(PG8_SBR(b, h) + n * 2048), PG8_LD16B(PG8_SBR(b, h) + PIECE + n * 2048), 0, 1, 2, 3, 4, 5, 6, 7)); \
        else { _Pragma("unroll") for (int k = 0; k < 2; ++k) dst[n][k] = *(const LAS bf16x8*)(ldsB + PG8_SBR(b, h) + k * PIECE + n * 2048); } } } while (0)
#define PG8_MMA(ai, bj, At, Bt) do { if constexpr (HN && (bj) == 1) break; __builtin_amdgcn_s_setprio(1); _Pragma("unroll") for (int m = 0; m < 4; ++m) _Pragma("unroll") for (int n = 0; n < 2; ++n) { \
        if constexpr (F8) acc[ai][bj][m][n] = __builtin_amdgcn_mfma_scale_f32_16x16x128_f8f6f4(Bt##8[n], At##8[m], acc[ai][bj][m][n], 0, 0, 0, 0, 0, 0);     \
        else { _Pragma("unroll") for (int k = 0; k < 2; ++k) acc[ai][bj][m][n] = __builtin_amdgcn_mfma_f32_16x16x32_bf16(Bt[n][k], At[m][k], acc[ai][bj][m][n], 0, 0, 0); } } __builtin_amdgcn_s_setprio(0); } while (0)
#define PG8_WAIT_V(n) asm volatile("s_waitcnt vmcnt(" #n ")" ::: "memory")
#define PG8_WAIT_L(n) asm volatile("s_waitcnt lgkmcnt(" #n ")" ::: "memory")
#define PG8_BAR __builtin_amdgcn_s_barrier()
#define PG8_SCHED __builtin_amdgcn_sched_barrier(0)
    const LAS unsigned char* ldsB = lds + 4 * HTB + boff;
    Unit cur, nxt; int ui = 0;
    if (!S.next(0, cur)) return;
    typename Epi::State est;
    if constexpr (Epi::PRE) { int le = lane_id(); asm volatile("" : "+v"(le)); E.pre(est, cur, 0, wr, wc, le & 15, le >> 4); }
    f32x4 acc[2][2][4][2];
#pragma unroll
    for (int a = 0; a < 2; ++a)
#pragma unroll
        for (int b = 0; b < 2; ++b)
#pragma unroll
            for (int m = 0; m < 4; ++m)
#pragma unroll
                for (int n = 0; n < 2; ++n) acc[a][b][m][n] = (f32x4){0.f, 0.f, 0.f, 0.f};
    bf16x8 At[4][2], B0[2][2], B1[2][2]; i32x8 At8[4], B08[2], B18[2];
    const char* cA = cur.a; const char* cB = cur.b;
#define PG8_WAIT_K() do { if constexpr (HN) PG8_WAIT_V(6); else PG8_WAIT_V(8); } while (0)
    PG8_STAGE(PG8_SB(0, 0), cB, voffB); if constexpr (!HN) PG8_STAGE(PG8_SB(0, 1), cB + hstepB, voffB); PG8_STAGE(PG8_SA(0, 0), cA, voffA); PG8_STAGE(PG8_SA(0, 1), cA + hstepA, voffA);
    if (wr == 1) PG8_BAR;
    PG8_WAIT_V(2); PG8_BAR;
    PG8_STAGE(PG8_SB(1, 0), cB + kstep, voffB); PG8_STAGE(PG8_SA(1, 0), cA + kstep, voffA); if constexpr (!HN) PG8_STAGE(PG8_SB(1, 1), cB + hstepB + kstep, voffB);
    if constexpr (HN) PG8_WAIT_V(4); else PG8_WAIT_V(6);
    PG8_BAR;
    for (;;) {
        const bool has_next = S.next(ui + 1, nxt);
        const char* nA = has_next ? nxt.a : cA; const char* nB = has_next ? nxt.b : cB;
#pragma nounroll
        for (int t = 0; t < nt; t += 2) {
            const bool last = (t == nt - 2);
            const char* a1 = cA + (size_t)(t + 1) * kstep;
            const char* a2 = last ? nA : cA + (size_t)(t + 2) * kstep; const char* b2 = last ? nB : cB + (size_t)(t + 2) * kstep;
            asm volatile("" : "+s"(a1), "+s"(a2), "+s"(b2));
            const char* a3 = a2 + kstep; const char* b3 = b2 + kstep;
            PG8_LDB(B0, 0, 0); if constexpr (!HN) PG8_LDB(B1, 0, 1); PG8_SCHED; PG8_LDA(At, 0, 0); PG8_STAGE(PG8_SA(1, 1), a1 + hstepA, voffA);
            PG8_WAIT_K(); PG8_WAIT_L(0); PG8_BAR; PG8_MMA(0, 0, At, B0); PG8_MMA(0, 1, At, B1); PG8_BAR; PG8_SCHED;
            PG8_LDA(At, 0, 1); PG8_STAGE(PG8_SB(0, 0), b2, voffB); if constexpr (!HN) PG8_STAGE(PG8_SB(0, 1), b2 + hstepB, voffB); PG8_STAGE(PG8_SA(0, 0), a2, voffA);
            PG8_WAIT_K(); PG8_WAIT_L(0); PG8_BAR; PG8_MMA(1, 0, At, B0); PG8_MMA(1, 1, At, B1); PG8_BAR; PG8_SCHED;
            PG8_LDB(B0, 1, 0); if constexpr (!HN) PG8_LDB(B1, 1, 1); PG8_SCHED; PG8_LDA(At, 1, 0); PG8_STAGE(PG8_SA(0, 1), a2 + hstepA, voffA);
            PG8_WAIT_K(); PG8_WAIT_L(0); PG8_BAR; PG8_MMA(0, 0, At, B0); PG8_MMA(0, 1, At, B1); PG8_BAR; PG8_SCHED;
            PG8_LDA(At, 1, 1); PG8_STAGE(PG8_SB(1, 0), b3, voffB); if constexpr (!HN) PG8_STAGE(PG8_SB(1, 1), b3 + hstepB, voffB); PG8_STAGE(PG8_SA(1, 0), a3, voffA);
            PG8_WAIT_K(); PG8_WAIT_L(0); PG8_BAR; PG8_MMA(1, 0, At, B0); PG8_MMA(1, 1, At, B1); PG8_BAR; PG8_SCHED;
            if constexpr (Epi::KHOOK) { if ((t & 3) == 2 && !last) { int le = lane_id(); asm volatile("" : "+v"(le)); E.khook(acc, cur, t >> 2, wr, wc, le & 15, le >> 4, est); } }
        }
        if (wr == 0) PG8_BAR;
        { int le = lane_id(); asm volatile("" : "+v"(le));
          if constexpr (Epi::PRE) { E(acc, cur, wr, wc, le & 15, le >> 4, est); if (has_next) E.pre(est, nxt, 0, wr, wc, le & 15, le >> 4); }
          else E(acc, cur, wr, wc, le & 15, le >> 4); }
        if (!has_next) break;
#pragma unroll
        for (int a = 0; a < 2; ++a)
#pragma unroll
            for (int b = 0; b < (HN ? 1 : 2); ++b)
#pragma unroll
                for (int m = 0; m < 4; ++m)
#pragma unroll
                    for (int n = 0; n < 2; ++n) acc[a][b][m][n] = (f32x4){0.f, 0.f, 0.f, 0.f};
        cur = nxt; cA = nA; cB = nB; ++ui;
        if (wr == 1) PG8_BAR;
    }
    PG8_WAIT_V(0);
    PG8_BAR;
#undef PG8_SA
#undef PG8_SB
#undef PG8_STAGE
#undef PG8_LDA
#undef PG8_LDB
#undef PG8_MMA
#undef PG8_LD16
#undef PG8_LD16B
#undef PG8_SBR
#undef PG8_WAIT_V
#undef PG8_WAIT_K
#undef PG8_WAIT_L
#undef PG8_BAR
#undef PG8_SCHED
}

struct OrdStd {
    TileOrder to; const char* A; const char* B; size_t atile, btile;
    DI bool next(int i, Unit& u) const { if (!to.tile(i, u.pm, u.pn)) return false; u.z = 0; u.a = A + (size_t)u.pm * atile; u.b = B + (size_t)u.pn * btile; return true; }
};
struct OrdKV {
    TileOrder to; const char* A; const char* B;
    DI bool next(int i, Unit& u) const { if (!to.tile(i, u.pm, u.pn)) return false; const int l = u.pm >> 4; u.z = l; u.a = A + (size_t)u.pm * (256 * 1024 * 2); u.b = B + (size_t)l * (512 * 1024 * 2) + (size_t)u.pn * (256 * 1024 * 2); return true; }
};
struct OrdMerge {
    int G, c, ntiles; const char* A; const char* B;
    DI bool next(int i, Unit& u) const { const int tl = i * G + c; if (tl >= ntiles) return false; u.z = 0; u.pm = tl >> 3; u.pn = tl & 7;
        u.a = A + (size_t)u.pm * (256 * 1024 * 2); u.b = B + (size_t)u.pn * (128 * 1024 * 2); return true; }
};
struct OrdMoe {
    TileOrder to; const char* A; const char* B; size_t atile, btile, bexp; int off[9];
    DI bool next(int i, Unit& u) const { if (!to.tile(i, u.pm, u.pn)) return false; const int r0 = u.pm * 256; int e = 0;
#pragma unroll
        for (int k = 1; k < 8; ++k) e += (r0 >= off[k]) ? 1 : 0;
        u.z = e; u.a = uni(A + (size_t)u.pm * atile); u.b = uni(B + (size_t)e * bexp + (size_t)u.pn * btile); return true; }
};

DI float row_rstd(const float* ssq, size_t row, int fq, int lane) {
    const f32x4 a = *(const f32x4*)(ssq + row * 16 + 4 * fq); float s = (a.x + a.y) + (a.z + a.w); s += shx16(s, lane); s += shx32(s, lane); return 1.f / sqrtf(s * (1.f / D) + EPS); }
template <bool G8> struct EpiCat {
    static constexpr bool PERM = true; static constexpr bool PRE = false; static constexpr bool KHOOK = false; struct State {};
    bf16* U; bf16* Gt; const float* ssq;
    DI void operator()(const f32x4 (&acc)[2][2][4][2], const Unit& u, int wr, int wc, int fr, int fq) const {
        const bool isg = G8 || u.pn >= 10; bf16* base = isg ? Gt : U; const int ldc = isg ? 4096 : DIN; const int colt = G8 ? u.pn * 256 : (isg ? (u.pn - 10) * 256 : u.pn * 256);
        const int row0 = u.pm * BM + wr * 64 + fr, col0 = colt + wc * 32 + 8 * fq;
#pragma unroll
        for (int ai = 0; ai < 2; ++ai)
#pragma unroll
            for (int m = 0; m < 4; ++m) { const size_t row = (size_t)(row0 + ai * HALF + m * 16); bf16* rowp = base + row * ldc + col0; const float rs = row_rstd(ssq, row, fq, fr + 16 * fq) * (G8 ? W8_INV : 1.f);
#pragma unroll
                for (int bj = 0; bj < 2; ++bj) { f32x4 v0 = acc[ai][bj][m][0] * rs, v1 = acc[ai][bj][m][1] * rs;
                    if (isg) {
#pragma unroll
                        for (int j = 0; j < 4; ++j) { v0[j] = sigmoid_f(v0[j]); v1[j] = sigmoid_f(v1[j]); } }
                    u32x4 w; w.x = cvtpk(v0[0], v0[1]); w.y = cvtpk(v0[2], v0[3]); w.z = cvtpk(v1[0], v1[1]); w.w = cvtpk(v1[2], v1[3]);
                    *(u32x4*)(rowp + bj * HALF) = w; } }
    }
};
template <bool S8> struct EpiBf16 {
    static constexpr bool PERM = true; static constexpr bool PRE = false; static constexpr bool KHOOK = false; struct State {}; static constexpr float sc = S8 ? W8_INV : 1.f;
    bf16* O; int ldc; const float* ssq;
    DI void operator()(const f32x4 (&acc)[2][2][4][2], const Unit& u, int wr, int wc, int fr, int fq) const {
        const int row0 = u.pm * BM + wr * 64 + fr, col0 = u.pn * BM + wc * 32 + 8 * fq;
#pragma unroll
        for (int ai = 0; ai < 2; ++ai)
#pragma unroll
            for (int m = 0; m < 4; ++m) { const size_t row = (size_t)(row0 + ai * HALF + m * 16); bf16* rowp = O + row * ldc + col0; const float s2 = ssq ? sc * row_rstd(ssq, row, fq, fr + 16 * fq) : sc;
#pragma unroll
                for (int bj = 0; bj < 2; ++bj) { const f32x4 v0 = acc[ai][bj][m][0] * s2, v1 = acc[ai][bj][m][1] * s2;
                    u32x4 w; w.x = cvtpk(v0[0], v0[1]); w.y = cvtpk(v0[2], v0[3]); w.z = cvtpk(v1[0], v1[1]); w.w = cvtpk(v1[2], v1[3]);
                    *(u32x4*)(rowp + bj * HALF) = w; } }
    }
};
struct EpiMerge {
    static constexpr bool PERM = true; static constexpr bool PRE = true; static constexpr bool KHOOK = true; struct State { u32x4 gw[2][4]; };
    const bf16* Gt; bf16* Mg;
    DI void pre(State& st, const Unit& u, int z, int wr, int wc, int fr, int fq) const {
        const int row0 = u.pm * BM + wr * 64 + fr, col0 = u.pn * HALF + wc * 32 + 8 * fq;
#pragma unroll
        for (int ai = 0; ai < 2; ++ai)
#pragma unroll
            for (int m = 0; m < 4; ++m) st.gw[ai][m] = *(const u32x4*)(Gt + (size_t)(row0 + ai * HALF + m * 16) * 4096 + z * 1024 + col0);
    }
    template <bool FIRST, bool LAST> DI void gate(f32x4 (&acc)[2][2][4][2], const Unit& u, int wr, int wc, int fr, int fq, State& st) const {
        const int row0 = u.pm * BM + wr * 64 + fr, col0 = u.pn * HALF + wc * 32 + 8 * fq;
#pragma unroll
        for (int ai = 0; ai < 2; ++ai)
#pragma unroll
            for (int m = 0; m < 4; ++m) { float g[8]; unpack8(st.gw[ai][m], g); const f32x4 v0 = acc[ai][0][m][0], v1 = acc[ai][0][m][1];
                f32x4 t0 = (f32x4){g[0] * v0[0], g[1] * v0[1], g[2] * v0[2], g[3] * v0[3]}, t1 = (f32x4){g[4] * v1[0], g[5] * v1[1], g[6] * v1[2], g[7] * v1[3]};
                if (!FIRST) { t0 += acc[ai][1][m][0]; t1 += acc[ai][1][m][1]; }
                acc[ai][1][m][0] = t0; acc[ai][1][m][1] = t1; acc[ai][0][m][0] = (f32x4){0.f, 0.f, 0.f, 0.f}; acc[ai][0][m][1] = (f32x4){0.f, 0.f, 0.f, 0.f};
                if (LAST) { u32x4 w; w.x = cvtpk(t0[0], t0[1]); w.y = cvtpk(t0[2], t0[3]); w.z = cvtpk(t1[0], t1[1]); w.w = cvtpk(t1[2], t1[3]);
                    *(u32x4*)(Mg + (size_t)(row0 + ai * HALF + m * 16) * 1024 + col0) = w; } }
    }
    DI void khook(f32x4 (&acc)[2][2][4][2], const Unit& u, int z, int wr, int wc, int fr, int fq, State& st) const {
        if (z == 0) gate<true, false>(acc, u, wr, wc, fr, fq, st); else gate<false, false>(acc, u, wr, wc, fr, fq, st);
        pre(st, u, z + 1, wr, wc, fr, fq);
    }
    DI void operator()(f32x4 (&acc)[2][2][4][2], const Unit& u, int wr, int wc, int fr, int fq, State& st) const { gate<false, true>(acc, u, wr, wc, fr, fq, st); }
};
template <bool XB, bool S8> struct EpiRes {
    static constexpr bool PERM = true; static constexpr bool PRE = false; static constexpr bool KHOOK = false; struct State {};
    static constexpr float sc = S8 ? W8_INV : 1.f;
    static constexpr int MB = S8 ? 1 : 2;
    const float* base; float* out; int xbm; void* xb; float* ssq; unsigned char* xb8;
    DI void operator()(const f32x4 (&acc)[2][2][4][2], const Unit& u, int wr, int wc, int fr, int fq) const {
        const int row0 = u.pm * BM + wr * 64 + fr, col0 = u.pn * BM + wc * 32 + 8 * fq, lane = fr + 16 * fq;
#pragma unroll
        for (int ai = 0; ai < 2; ++ai)
#pragma unroll
            for (int m0 = 0; m0 < 4; m0 += MB) {
                f32x4 bsv[MB][2][2];
#pragma unroll
                for (int mm = 0; mm < MB; ++mm)
#pragma unroll
                    for (int bj = 0; bj < 2; ++bj) { const size_t off = (size_t)(row0 + ai * HALF + (m0 + mm) * 16) * D + col0 + bj * HALF; bsv[mm][bj][0] = *(const f32x4*)(base + off); bsv[mm][bj][1] = *(const f32x4*)(base + off + 4); }
#pragma unroll
                for (int mm = 0; mm < MB; ++mm) { const int m = m0 + mm; const size_t row = (size_t)(row0 + ai * HALF + m * 16), off = row * D + col0; float s = 0.f;
#pragma unroll
                    for (int bj = 0; bj < 2; ++bj) {
                        const f32x4 v0 = bsv[mm][bj][0] + acc[ai][bj][m][0] * sc, v1 = bsv[mm][bj][1] + acc[ai][bj][m][1] * sc;
                        *(f32x4*)(out + off + bj * HALF) = v0; *(f32x4*)(out + off + bj * HALF + 4) = v1;
                        if constexpr (XB) { s += ((v0.x * v0.x + v0.y * v0.y) + (v0.z * v0.z + v0.w * v0.w)) + ((v1.x * v1.x + v1.y * v1.y) + (v1.z * v1.z + v1.w * v1.w));
                            if (xbm & 1) { u32x4 w; w.x = cvtpk(v0.x, v0.y); w.y = cvtpk(v0.z, v0.w); w.z = cvtpk(v1.x, v1.y); w.w = cvtpk(v1.z, v1.w); *(u32x4*)((bf16*)xb + off + bj * HALF) = w; }
                            if (xbm & 2) { u32x2 w; w.x = cvt4_fp8(v0.x, v0.y, v0.z, v0.w); w.y = cvt4_fp8(v1.x, v1.y, v1.z, v1.w); *(u32x2*)(xb8 + off + bj * HALF) = w; } } }
                    if constexpr (XB) { s += shx16(s, lane); s += shx32(s, lane); if (xbm != 0 && fq == 0) ssq[row * 16 + u.pn * 4 + wc] = s; } }
                asm volatile("" ::: "memory"); }
    }
};
template <bool F8O> struct EpiGU {
    static constexpr bool PERM = true; static constexpr bool PRE = false; static constexpr bool KHOOK = false; struct State {};
    static constexpr float sc = F8O ? W8_INV : 1.f;
    void* O; const float* ssq;
    DI void operator()(const f32x4 (&acc)[2][2][4][2], const Unit& u, int wr, int wc, int fr, int fq) const {
        const int row0 = u.pm * BM + wr * 64 + fr, col0 = u.pn * HALF + wc * 32 + 8 * fq;
#pragma unroll
        for (int ai = 0; ai < 2; ++ai)
#pragma unroll
            for (int m = 0; m < 4; ++m) { const size_t row = (size_t)(row0 + ai * HALF + m * 16), eo = row * DFF + col0; const float s2 = ssq ? sc * row_rstd(ssq, row, fq, fr + 16 * fq) : sc;
                float r[8];
#pragma unroll
                for (int n = 0; n < 2; ++n)
#pragma unroll
                    for (int j = 0; j < 4; ++j) { const float g = acc[ai][0][m][n][j] * s2, uu = acc[ai][1][m][n][j] * s2; r[4 * n + j] = g * sigmoid_f(g) * uu; }
                if constexpr (F8O) { u32x2 w; w.x = cvt4_fp8(r[0], r[1], r[2], r[3]); w.y = cvt4_fp8(r[4], r[5], r[6], r[7]); *(u32x2*)((unsigned char*)O + eo) = w; }
                else *(u32x4*)((bf16*)O + eo) = pack8(r); }
    }
};
}

#define XB_TMO      128
#define XB_XCNT(j)  (256  + 64 * (j))
#define XB_XSUB(j)  (1280 + 64 * (j))
#define XB_XGEN(j)  (2304 + 64 * (j))
#define XB_TOP      3328
#define XB_TOPGEN   3392
#define XCD_BAR_WORDS 3456
#define XB_SPIN_CAP (1u << 22)
DI unsigned xb_ld(unsigned* p)              { return __hip_atomic_load(p, __ATOMIC_RELAXED, __HIP_MEMORY_SCOPE_AGENT); }
DI unsigned xb_add(unsigned* p, unsigned v) { return __hip_atomic_fetch_add(p, v, __ATOMIC_RELAXED, __HIP_MEMORY_SCOPE_AGENT); }
DI unsigned xb_xcc_id() { return (unsigned)__builtin_amdgcn_s_getreg((3 << 11) | 20) & 0xFu; }
#define XB_SPIN(cond, bar) do { unsigned _sp = 0; while (cond) { __builtin_amdgcn_s_sleep(1); \
    if ((++_sp & 255u) == 0u) { if (xb_ld(&(bar)[XB_TMO])) break; if (_sp > XB_SPIN_CAP) { atomicAdd(&(bar)[XB_TMO], 1u); break; } } } } while (0)
struct XcdBarrier { unsigned* bar; unsigned x; volatile LAS unsigned* st; };
DI XcdBarrier xcd_barrier_post(unsigned* bar, volatile LAS unsigned* st) {
    XcdBarrier b; b.bar = bar; b.x = xb_xcc_id(); b.st = st;
    if (threadIdx.x == 0) (void)xb_add(&bar[XB_XCNT(b.x)], 1u);
    return b;
}
DI void xcd_barrier_complete(unsigned* bar, unsigned x, unsigned& nloc, unsigned& nx) {
    const unsigned G = gridDim.x * gridDim.y * gridDim.z;
    unsigned sum, cnt, mine, sp = 0u;
    for (;;) {
        sum = 0u; cnt = 0u; mine = 0u;
#pragma unroll
        for (unsigned j = 0; j < 16; ++j) { const unsigned c = xb_ld(&bar[XB_XCNT(j)]); sum += c; cnt += (c > 0u) ? 1u : 0u; mine = (j == x) ? c : mine; }
        if (sum == G) break;
        __builtin_amdgcn_s_sleep(1);
        if ((++sp & 255u) == 0u) { if (xb_ld(&bar[XB_TMO])) break; if (sp > XB_SPIN_CAP) { atomicAdd(&bar[XB_TMO], 1u); break; } }
    }
    nloc = mine > 0u ? mine : 1u; nx = cnt > 0u ? cnt : 1u;
}
__device__ __noinline__ void xcd_barrier_fn(GAS unsigned* gbar, unsigned bx, volatile LAS unsigned* bst, int wave) {
    XcdBarrier b; b.bar = (unsigned*)gbar; b.x = bx; b.st = bst; const bool t0 = (wave == 0) && (lane_id() == 0);
    asm volatile("s_waitcnt vmcnt(0)" ::: "memory");
    __syncthreads();
    if (t0) {
        unsigned* bar = b.bar;
        __builtin_amdgcn_s_waitcnt(0);
        unsigned nloc = b.st[0], nx = b.st[1];
        if (nloc == 0u) { xcd_barrier_complete(bar, b.x, nloc, nx); b.st[0] = nloc; b.st[1] = nx; }
        const unsigned old = xb_add(&bar[XB_XSUB(b.x)], 1u);
        const unsigned gen = old / nloc;
        if (old + 1u == (gen + 1u) * nloc) {
            __builtin_amdgcn_fence(__ATOMIC_RELEASE, "agent");
            asm volatile("s_waitcnt vmcnt(0)" ::: "memory");
            const unsigned og = xb_add(&bar[XB_TOP], 1u);
            const unsigned tg = og / nx;
            if (og + 1u == (tg + 1u) * nx) xb_add(&bar[XB_TOPGEN], 1u);
            else XB_SPIN(xb_ld(&bar[XB_TOPGEN]) == tg, bar);
            __builtin_amdgcn_fence(__ATOMIC_ACQUIRE, "agent");
            xb_add(&bar[XB_XGEN(b.x)], 1u);
            asm volatile("s_waitcnt vmcnt(0)" ::: "memory");
        } else {
            XB_SPIN(xb_ld(&bar[XB_XGEN(b.x)]) == gen, bar);
            __builtin_amdgcn_fence(__ATOMIC_ACQUIRE, "agent");
            asm volatile("s_waitcnt vmcnt(0)" ::: "memory");
        }
    }
    __syncthreads();
}

template <bool F8>
DI void tr_item_t(const float* W, int ldw, int k0, int n0, void* WT, int ldwt, int drow0, LAS float* scr, int lane, const float* gain) {
    const int c4 = 4 * (lane & 7), r8 = lane >> 3;
#pragma unroll
    for (int i = 0; i < 8; ++i) { const int kk = r8 + 8 * i; const f32x4 v = *(const f32x4*)(W + (size_t)(k0 + kk) * ldw + n0 + c4);
        LAS float* d = scr + kk * 33 + c4; d[0] = v.x; d[1] = v.y; d[2] = v.z; d[3] = v.w; }
    asm volatile("s_waitcnt lgkmcnt(0)" ::: "memory");
    const int c = lane & 7;
    float gs[8];
    if (gain) { const f32x4 g0 = *(const f32x4*)(gain + k0 + 8 * c), g1 = *(const f32x4*)(gain + k0 + 8 * c + 4); gs[0] = g0.x; gs[1] = g0.y; gs[2] = g0.z; gs[3] = g0.w; gs[4] = g1.x; gs[5] = g1.y; gs[6] = g1.z; gs[7] = g1.w; }
    else {
#pragma unroll
        for (int i = 0; i < 8; ++i) gs[i] = 1.f; }
    if (F8) {
#pragma unroll
        for (int i = 0; i < 8; ++i) gs[i] *= W8_SCALE; }
#pragma unroll
    for (int j = 0; j < 4; ++j) { const int n = (lane >> 3) + 8 * j; const LAS float* s = scr + (8 * c) * 33 + n;
        if (F8) { u32x2 o; o.x = cvt4_fp8(s[0 * 33] * gs[0], s[1 * 33] * gs[1], s[2 * 33] * gs[2], s[3 * 33] * gs[3]); o.y = cvt4_fp8(s[4 * 33] * gs[4], s[5 * 33] * gs[5], s[6 * 33] * gs[6], s[7 * 33] * gs[7]);
            *(u32x2*)((unsigned char*)WT + (size_t)(drow0 + n) * ldwt + k0 + 8 * c) = o; }
        else { u32x4 o; o.x = cvtpk(s[0 * 33] * gs[0], s[1 * 33] * gs[1]); o.y = cvtpk(s[2 * 33] * gs[2], s[3 * 33] * gs[3]); o.z = cvtpk(s[4 * 33] * gs[4], s[5 * 33] * gs[5]); o.w = cvtpk(s[6 * 33] * gs[6], s[7 * 33] * gs[7]);
            *(u32x4*)((bf16*)WT + (size_t)(drow0 + n) * ldwt + k0 + 8 * c) = o; } }
    asm volatile("s_waitcnt lgkmcnt(0)" ::: "memory");
}
DI int gu_row(int n) { return n < DFF ? (n >> 7) * 256 + (n & 127) : ((n - DFF) >> 7) * 256 + 128 + ((n - DFF) & 127); }
template <bool F8 = false>
DI void tr_matrix(unsigned& ibase, const float* W, int K, int N, void* WT, int row_off, int gu, LAS float* scr, int gw, int NGW, int lane, const float* gain = nullptr, int ldwt = 0) {
    const int nblk = N >> 5, nit = (K >> 6) * nblk; const int first = (int)(((unsigned)gw + (unsigned)NGW - ibase % (unsigned)NGW) % (unsigned)NGW); ibase += (unsigned)nit;
    for (int it = first; it < nit; it += NGW) { const int kb = it / nblk, nb = it - kb * nblk, n0 = nb * 32;
        tr_item_t<F8>(W, N, kb * 64, n0, WT, ldwt ? ldwt : K, gu ? gu_row(n0) : row_off + n0, scr, lane, gain); }
}
DI void rms_row_bf16(const float* xrow, const float* gain, bf16* orow, int lane) {
    const f32x4* xr = (const f32x4*)xrow + lane; const f32x4* gr = (const f32x4*)gain + lane;
    f32x4 v[4]; float s = 0.f;
#pragma unroll
    for (int j = 0; j < 4; ++j) { v[j] = xr[64 * j]; s += (v[j].x * v[j].x + v[j].y * v[j].y) + (v[j].z * v[j].z + v[j].w * v[j].w); }
    const float rstd = 1.f / sqrtf(wave_sum(s, lane) * (1.f / D) + EPS);
    u32x2* o8 = (u32x2*)orow + lane;
#pragma unroll
    for (int j = 0; j < 4; ++j) { const f32x4 g = gr[64 * j]; u32x2 w; w.x = cvtpk(v[j].x * rstd * g.x, v[j].y * rstd * g.y); w.y = cvtpk(v[j].z * rstd * g.z, v[j].w * rstd * g.w); o8[64 * j] = w; }
}

DI void rms_row_fp8(const float* xrow, const float* gain, unsigned char* orow, int lane) {
    const f32x4* xr = (const f32x4*)xrow + lane; const f32x4* gr = (const f32x4*)gain + lane;
    f32x4 v[4]; float s = 0.f;
#pragma unroll
    for (int j = 0; j < 4; ++j) { v[j] = xr[64 * j]; s += (v[j].x * v[j].x + v[j].y * v[j].y) + (v[j].z * v[j].z + v[j].w * v[j].w); }
    const float rstd = 1.f / sqrtf(wave_sum(s, lane) * (1.f / D) + EPS);
    unsigned* o4 = (unsigned*)orow + lane;
#pragma unroll
    for (int j = 0; j < 4; ++j) { const f32x4 g = gr[64 * j]; o4[64 * j] = cvt4_fp8(v[j].x * rstd * g.x, v[j].y * rstd * g.y, v[j].z * rstd * g.z, v[j].w * rstd * g.w); }
}

struct KVStage { u32x4 k[4], v[4]; };
DI void kv_load(KVStage& st, const bf16* Kp, int kpitch, const bf16* Vp, int vpitch, int tid) {
#pragma unroll
    for (int i = 0; i < 4; ++i) { const int id = tid + 512 * i, row = id >> 3, c8 = id & 7;
        st.k[i] = *(const u32x4*)(Kp + (size_t)row * kpitch + 8 * c8); st.v[i] = *(const u32x4*)(Vp + (size_t)row * vpitch + 8 * c8); }
}
DI void kv_write(const KVStage& st, LAS bf16* Ksm, LAS bf16* Vtm, int tid) {
#pragma unroll
    for (int i = 0; i < 4; ++i) { const int id = tid + 512 * i, row = id >> 3, c8 = id & 7;
        *(LAS u32x4*)(Ksm + row * KS + 8 * c8) = st.k[i];
        const unsigned w0 = st.v[i].x, w1 = st.v[i].y, w2 = st.v[i].z, w3 = st.v[i].w;
        LAS bf16* vp = Vtm + (8 * c8) * VS + row;
        vp[0 * VS] = (bf16)(w0 & 0xffffu); vp[1 * VS] = (bf16)(w0 >> 16); vp[2 * VS] = (bf16)(w1 & 0xffffu); vp[3 * VS] = (bf16)(w1 >> 16);
        vp[4 * VS] = (bf16)(w2 & 0xffffu); vp[5 * VS] = (bf16)(w2 >> 16); vp[6 * VS] = (bf16)(w3 & 0xffffu); vp[7 * VS] = (bf16)(w3 >> 16); }
}
DI void qk_subtile(const LAS bf16* Ksm, int ktl, const bf16x8 (&qf)[4], int r, int h, f32x16& z0, f32x16& z1) {
#pragma unroll
    for (int i = 0; i < 16; ++i) { z0[i] = 0.f; z1[i] = 0.f; }
#pragma unroll
    for (int s = 0; s < 4; ++s) {
        const bf16x8 k0 = *(const LAS bf16x8*)(Ksm + (64 * ktl + r) * KS + 16 * s + 8 * h);
        const bf16x8 k1 = *(const LAS bf16x8*)(Ksm + (64 * ktl + 32 + r) * KS + 16 * s + 8 * h);
        z0 = MFMA32(k0, qf[s], z0); z1 = MFMA32(k1, qf[s], z1); }
}
template <int ST> DI bf16x8 pack_step(const f32x16& x) {
    u32x4 p; p.x = cvtpk(x[8 * ST + 0], x[8 * ST + 1]); p.y = cvtpk(x[8 * ST + 2], x[8 * ST + 3]); p.z = cvtpk(x[8 * ST + 4], x[8 * ST + 5]); p.w = cvtpk(x[8 * ST + 6], x[8 * ST + 7]);
    return __builtin_bit_cast(bf16x8, p);
}
DI void pv_subtile(const LAS bf16* Vtm, int ktl, const f32x16& p0, const f32x16& p1, int r, int h, f32x16 (&o)[2]) {
    const bf16x8 pf[4] = {pack_step<0>(p0), pack_step<1>(p0), pack_step<0>(p1), pack_step<1>(p1)};
#pragma unroll
    for (int ts = 0; ts < 4; ++ts) {
#pragma unroll
        for (int dt = 0; dt < 2; ++dt) {
            const LAS bf16* vp = Vtm + (32 * dt + r) * VS + 64 * ktl + 16 * ts + 4 * h;
            const s16x4 lo = *(const LAS s16x4*)vp, hi = *(const LAS s16x4*)(vp + 8);
            const bf16x8 vf = __builtin_shufflevector(lo, hi, 0, 1, 2, 3, 4, 5, 6, 7);
            o[dt] = MFMA32(vf, pf[ts], o[dt]); } }
}
template <int T, int GI> DI void sb_group(f32x16& z, float& c, int h, bool need_mask, int krel, int lane) {
    float s[4], m[4];
#pragma unroll
    for (int i = 0; i < 4; ++i) { const float e = fexp2(fminf(-z[4 * GI + i], 126.f)); s[i] = frcp(1.f + e); m[i] = e * s[i];
        if (need_mask) { const bool ok = (krel + 32 * T + 8 * GI + 4 * h + i) < 0; s[i] = ok ? s[i] : 0.f; m[i] = ok ? m[i] : 1.f; } }
    const float w2 = m[3], w1 = m[3] * m[2], w0 = w1 * m[1], Gm = w0 * m[0];
    const float Gp = shx32(Gm, lane);
    const float mc = h ? c : c * Gp;
    z[4 * GI + 3] = s[3] * mc; z[4 * GI + 2] = s[2] * w2 * mc; z[4 * GI + 1] = s[1] * w1 * mc; z[4 * GI + 0] = s[0] * w0 * mc;
    c *= Gm * Gp;
}
DI void sb_transform(f32x16& z0, f32x16& z1, float& c, int h, bool need_mask, int krel, int lane) {
    sb_group<1, 3>(z1, c, h, need_mask, krel, lane); sb_group<1, 2>(z1, c, h, need_mask, krel, lane); sb_group<1, 1>(z1, c, h, need_mask, krel, lane); sb_group<1, 0>(z1, c, h, need_mask, krel, lane);
    sb_group<0, 3>(z0, c, h, need_mask, krel, lane); sb_group<0, 2>(z0, c, h, need_mask, krel, lane); sb_group<0, 1>(z0, c, h, need_mask, krel, lane); sb_group<0, 0>(z0, c, h, need_mask, krel, lane);
}
DI void store_ot(const f32x16 (&o)[2], bf16* orow, int h, float sc) {
#pragma unroll
    for (int dt = 0; dt < 2; ++dt)
#pragma unroll
        for (int g = 0; g < 4; ++g) { u32x2 w; w.x = cvtpk(o[dt][4 * g] * sc, o[dt][4 * g + 1] * sc); w.y = cvtpk(o[dt][4 * g + 2] * sc, o[dt][4 * g + 3] * sc);
            *(u32x2*)(orow + 32 * dt + 8 * g + 4 * h) = w; }
}

DI void sb_unit(const bf16* U, bf16* Y, int bl, int hd, int qb, LAS unsigned char* lds, int tid, int wave, int lane) {
    LAS bf16* Ksm = (LAS bf16*)(lds + L_KS); LAS bf16* Vtm = (LAS bf16*)(lds + L_VT);
    const int r = lane & 31, h = lane >> 5;
    const size_t tok0 = (size_t)bl * SEQ; const int tq = qb * 256 + 32 * wave + r;
    bf16x8 qf[4];
    { const bf16* qrow = U + (tok0 + tq) * DIN + UC_SBQ + 64 * hd;
#pragma unroll
      for (int s = 0; s < 4; ++s) { const u32x4 w = *(const u32x4*)(qrow + 16 * s + 8 * h); float f[8]; unpack8(w, f);
#pragma unroll
          for (int j = 0; j < 8; ++j) f[j] *= (0.125f * 1.44269504f);
          qf[s] = __builtin_bit_cast(bf16x8, pack8(f)); } }
    f32x16 o[2];
#pragma unroll
    for (int i = 0; i < 16; ++i) { o[0][i] = 0.f; o[1][i] = 0.f; }
    float c = 1.f;
    const bf16* Kb = U + tok0 * DIN + UC_SBK + 64 * hd; const bf16* Vb = U + tok0 * DIN + UC_SBV + 64 * hd;
    KVStage st; kv_load(st, Kb + (size_t)(256 * qb) * DIN, DIN, Vb + (size_t)(256 * qb) * DIN, DIN, tid);
    for (int kb = qb; kb >= 0; --kb) {
        { volatile LAS unsigned* fl = (volatile LAS unsigned*)(lds + MISC_OFF) + 2;
          if (lane == 0 && __builtin_amdgcn_ballot_w64(c != 0.f) != 0ull) fl[kb & 1] = 1u;
          __syncthreads();
          const unsigned live = fl[kb & 1];
          if (tid == 0) fl[(kb + 1) & 1] = 0u;
          if (live == 0u) break; }
        kv_write(st, Ksm, Vtm, tid);
        __syncthreads();
        if (kb > 0) kv_load(st, Kb + (size_t)(256 * (kb - 1)) * DIN, DIN, Vb + (size_t)(256 * (kb - 1)) * DIN, DIN, tid);
        const bool diag = (kb == qb);
        const int khi = diag ? ((32 * wave + 31) >> 6) : 3;
        for (int ktl = khi; ktl >= 0; --ktl) {
            if (__builtin_amdgcn_ballot_w64(c != 0.f) == 0ull) break;
            f32x16 z0, z1; qk_subtile(Ksm, ktl, qf, r, h, z0, z1);
            const bool need_mask = diag && (64 * ktl + 63 >= 32 * wave);
            sb_transform(z0, z1, c, h, need_mask, 256 * kb + 64 * ktl - tq, lane);
            pv_subtile(Vtm, ktl, z0, z1, r, h, o);
        }
    }
    store_ot(o, Y + (tok0 + tq) * D + YC_SB + 64 * hd, h, 1.f);
}

DI void xa_unit(const bf16* QB, const bf16* kvl, const float* gq, float kmax, bf16* OB, int bl, int bglob, int hd, int qblk, LAS unsigned char* lds, int tid, int wave, int lane) {
    LAS bf16* Ksm = (LAS bf16*)(lds + L_KS); LAS bf16* Vtm = (LAS bf16*)(lds + L_VT);
    const int r = lane & 31, h = lane >> 5;
    const size_t row = (size_t)bl * SEQ + qblk * 256 + 32 * wave + r;
    __syncthreads();
    { KVStage st; const bf16* Kp = kvl + (size_t)bglob * NMEM * 512 + 64 * hd; kv_load(st, Kp, 512, Kp + 256, 512, tid); kv_write(st, Ksm, Vtm, tid); }
    float qv[4][8]; float ss = 0.f;
    { const bf16* qrow = QB + row * 256 + 64 * hd;
#pragma unroll
      for (int s = 0; s < 4; ++s) { const u32x4 w = *(const u32x4*)(qrow + 16 * s + 8 * h); unpack8(w, qv[s]);
#pragma unroll
          for (int j = 0; j < 8; ++j) ss += qv[s][j] * qv[s][j]; } }
    ss += shx32(ss, lane);
    const float rq = 1.f / sqrtf(ss * (1.f / 64.f) + EPS) * (0.125f * 1.44269504f);
    bf16x8 qf[4]; float qn2 = 0.f;
#pragma unroll
    for (int s = 0; s < 4; ++s) {
#pragma unroll
        for (int j = 0; j < 8; ++j) { qv[s][j] *= rq * gq[16 * s + 8 * h + j]; qn2 += qv[s][j] * qv[s][j]; }
        qf[s] = __builtin_bit_cast(bf16x8, pack8(qv[s])); }
    qn2 += shx32(qn2, lane);
    const float bnd = sqrtf(qn2) * kmax * 1.02f + 0.5f;
    f32x16 o[2];
#pragma unroll
    for (int i = 0; i < 16; ++i) { o[0][i] = 0.f; o[1][i] = 0.f; }
    float l = 0.f;
    __syncthreads();
    for (int ktl = 0; ktl < 4; ++ktl) {
        f32x16 z0, z1; qk_subtile(Ksm, ktl, qf, r, h, z0, z1);
#pragma unroll
        for (int i = 0; i < 16; ++i) { z0[i] = fexp2(z0[i] - bnd); z1[i] = fexp2(z1[i] - bnd); l += z0[i] + z1[i]; }
        pv_subtile(Vtm, ktl, z0, z1, r, h, o);
    }
    l += shx32(l, lane);
    store_ot(o, OB + row * 256 + 64 * hd, h, 1.f / l);
}

template <bool ROWM, bool TRANS>
DI void ret_stage(const bf16* U, const f32x2* rot, size_t trow0, int gtok, int hd, float lg, LAS bf16* Ksm, LAS bf16* Ktm, LAS bf16* Vtm, int tid) {
    const int m = tid >> 1, hf = tid & 1; const size_t trow = trow0 + m;
    const bf16* kp = U + trow * DIN + UC_RK + 64 * hd + 16 * hf; const f32x2* rp = rot + (size_t)(gtok + m) * 32 + 16 * hf;
    const float sk = fexp2(-(float)m * lg) * 0.125f;
    float x1[16], x2[16];
    { const u32x4 a0 = *(const u32x4*)kp, a1 = *(const u32x4*)(kp + 8), b0 = *(const u32x4*)(kp + 32), b1 = *(const u32x4*)(kp + 40);
      float t[8]; unpack8(a0, t);
#pragma unroll
      for (int j = 0; j < 8; ++j) x1[j] = t[j];
      unpack8(a1, t);
#pragma unroll
      for (int j = 0; j < 8; ++j) x1[8 + j] = t[j];
      unpack8(b0, t);
#pragma unroll
      for (int j = 0; j < 8; ++j) x2[j] = t[j];
      unpack8(b1, t);
#pragma unroll
      for (int j = 0; j < 8; ++j) x2[8 + j] = t[j]; }
    float o1[16], o2[16];
#pragma unroll
    for (int j = 0; j < 16; ++j) { const f32x2 cs = rp[j]; o1[j] = (x1[j] * cs.x - x2[j] * cs.y) * sk; o2[j] = (x1[j] * cs.y + x2[j] * cs.x) * sk; }
    if (ROWM) { LAS bf16* kr = Ksm + m * KS + 16 * hf; float t[8];
#pragma unroll
        for (int j = 0; j < 8; ++j) t[j] = o1[j];
        *(LAS u32x4*)kr = pack8(t);
#pragma unroll
        for (int j = 0; j < 8; ++j) t[j] = o1[8 + j];
        *(LAS u32x4*)(kr + 8) = pack8(t);
#pragma unroll
        for (int j = 0; j < 8; ++j) t[j] = o2[j];
        *(LAS u32x4*)(kr + 32) = pack8(t);
#pragma unroll
        for (int j = 0; j < 8; ++j) t[j] = o2[8 + j];
        *(LAS u32x4*)(kr + 40) = pack8(t); }
    if (TRANS) {
#pragma unroll
        for (int j = 0; j < 16; ++j) { Ktm[(16 * hf + j) * VS + m] = (bf16)(cvtpk(o1[j], 0.f) & 0xffffu); Ktm[(32 + 16 * hf + j) * VS + m] = (bf16)(cvtpk(o2[j], 0.f) & 0xffffu); } }
    const bf16* vp = U + trow * DIN + UC_RV + 64 * hd + 32 * hf;
#pragma unroll
    for (int q = 0; q < 4; ++q) { const u32x4 w = *(const u32x4*)(vp + 8 * q); LAS bf16* d = Vtm + (32 * hf + 8 * q) * VS + m;
        d[0 * VS] = (bf16)(w.x & 0xffffu); d[1 * VS] = (bf16)(w.x >> 16); d[2 * VS] = (bf16)(w.y & 0xffffu); d[3 * VS] = (bf16)(w.y >> 16);
        d[4 * VS] = (bf16)(w.z & 0xffffu); d[5 * VS] = (bf16)(w.z >> 16); d[6 * VS] = (bf16)(w.w & 0xffffu); d[7 * VS] = (bf16)(w.w >> 16); }
}
DI float ret_lg(int hd) { const float gam = 1.f - fexp2(-5.f - (float)hd); return __log2f(gam); }
DI void retkv_unit(const bf16* U, float* KVS, const f32x2* rot, int bl, int gtok0, int hd, int ch, LAS unsigned char* lds, int tid, int wave, int lane) {
    LAS bf16* Vtm = (LAS bf16*)(lds + L_VT); LAS bf16* Ktm = (LAS bf16*)(lds + L_KT);
    const int r = lane & 31, h = lane >> 5; const float lg = ret_lg(hd);
    __syncthreads();
    ret_stage<false, true>(U, rot, (size_t)bl * SEQ + ch * 256, gtok0 + ch * 256, hd, lg, nullptr, Ktm, Vtm, tid);
    __syncthreads();
    if (wave < 4) { const int dti = wave >> 1, eti = wave & 1;
        f32x16 kv;
#pragma unroll
        for (int i = 0; i < 16; ++i) kv[i] = 0.f;
#pragma unroll 4
        for (int s = 0; s < 16; ++s) { const bf16x8 af = *(const LAS bf16x8*)(Ktm + (32 * dti + r) * VS + 16 * s + 8 * h); const bf16x8 bfr = *(const LAS bf16x8*)(Vtm + (32 * eti + r) * VS + 16 * s + 8 * h);
            kv = MFMA32(af, bfr, kv); }
        float* dst = KVS + (size_t)((bl * 4 + hd) * 16 + ch) * 4096 + 32 * eti + r;
#pragma unroll
        for (int i = 0; i < 16; ++i) dst[(32 * dti + crow(i, h)) * 64] = kv[i]; }
}
DI void reto_unit(const bf16* U, bf16* Y, const float* KVS, const f32x2* rot, int bl, int gtok0, int hd, int ch, LAS unsigned char* lds, int tid, int wave, int lane) {
    LAS bf16* Ksm = (LAS bf16*)(lds + L_KS); LAS bf16* Vtm = (LAS bf16*)(lds + L_VT); LAS bf16* Stm = (LAS bf16*)(lds + L_ST);
    const int r = lane & 31, h = lane >> 5; const float lg = ret_lg(hd);
    const size_t tok0 = (size_t)bl * SEQ; const int n0 = ch * 256;
    __syncthreads();
    { const int d = tid >> 3, e0 = 8 * (tid & 7); float acc[8];
#pragma unroll
      for (int j = 0; j < 8; ++j) acc[j] = 0.f;
      const float* src = KVS + (size_t)((bl * 4 + hd) * 16) * 4096 + d * 64 + e0;
#pragma unroll 4
      for (int cp = 0; cp < ch; ++cp) { const float w = fexp2((256.f * (float)(ch - 1 - cp) + 256.f) * lg); const f32x4 a = *(const f32x4*)(src + (size_t)cp * 4096), b = *(const f32x4*)(src + (size_t)cp * 4096 + 4);
          acc[0] += w * a.x; acc[1] += w * a.y; acc[2] += w * a.z; acc[3] += w * a.w; acc[4] += w * b.x; acc[5] += w * b.y; acc[6] += w * b.z; acc[7] += w * b.w; }
#pragma unroll
      for (int j = 0; j < 8; ++j) Stm[(e0 + j) * KS + d] = (bf16)(cvtpk(acc[j], 0.f) & 0xffffu); }
    ret_stage<true, false>(U, rot, tok0 + n0, gtok0 + n0, hd, lg, Ksm, nullptr, Vtm, tid);
    bf16x8 qf[4];
    { const int nl = 32 * wave + r; const size_t trow = tok0 + n0 + nl;
      const bf16* qp = U + trow * DIN + UC_RQ + 64 * hd + 8 * h; const f32x2* rp = rot + (size_t)(gtok0 + n0 + nl) * 32 + 8 * h;
      const float sq = fexp2((float)nl * lg);
      float a[4][8];
#pragma unroll
      for (int s = 0; s < 4; ++s) { const u32x4 w = *(const u32x4*)(qp + 16 * s); unpack8(w, a[s]); }
      float b[4][8];
#pragma unroll
      for (int j = 0; j < 8; ++j) { const f32x2 c0 = rp[j], c1 = rp[16 + j];
          b[0][j] = (a[0][j] * c0.x - a[2][j] * c0.y) * sq; b[2][j] = (a[0][j] * c0.y + a[2][j] * c0.x) * sq;
          b[1][j] = (a[1][j] * c1.x - a[3][j] * c1.y) * sq; b[3][j] = (a[1][j] * c1.y + a[3][j] * c1.x) * sq; }
#pragma unroll
      for (int s = 0; s < 4; ++s) qf[s] = __builtin_bit_cast(bf16x8, pack8(b[s])); }
    __syncthreads();
    f32x16 o[2];
#pragma unroll
    for (int i = 0; i < 16; ++i) { o[0][i] = 0.f; o[1][i] = 0.f; }
    const int khi = (32 * wave + 31) >> 6;
    for (int ktl = 0; ktl <= khi; ++ktl) {
        f32x16 z0, z1; qk_subtile(Ksm, ktl, qf, r, h, z0, z1);
        if (64 * ktl + 63 > 32 * wave) {
            const int krel = 64 * ktl - (32 * wave + r);
#pragma unroll
            for (int i = 0; i < 16; ++i) { const int kk = krel + crow(i, h); z0[i] = (kk <= 0) ? z0[i] : 0.f; z1[i] = (kk + 32 <= 0) ? z1[i] : 0.f; } }
        pv_subtile(Vtm, ktl, z0, z1, r, h, o);
    }
#pragma unroll
    for (int s = 0; s < 4; ++s)
#pragma unroll
        for (int dt = 0; dt < 2; ++dt) { const bf16x8 af = *(const LAS bf16x8*)(Stm + (32 * dt + r) * KS + 16 * s + 8 * h); o[dt] = MFMA32(af, qf[s], o[dt]); }
    { float sm = 0.f;
#pragma unroll
      for (int i = 0; i < 16; ++i) sm += o[0][i] + o[1][i];
      sm += shx32(sm, lane); const float mean = sm * (1.f / 64.f); float vq = 0.f;
#pragma unroll
      for (int i = 0; i < 16; ++i) { const float d0 = o[0][i] - mean, d1 = o[1][i] - mean; vq += d0 * d0 + d1 * d1; }
      vq += shx32(vq, lane); const float rstd = 1.f / sqrtf(vq * (1.f / 64.f) + EPS);
      const size_t trow = tok0 + n0 + 32 * wave + r;
      const bf16* gp = U + trow * DIN + UC_RG + 64 * hd; bf16* yp = Y + trow * D + YC_RET + 64 * hd;
#pragma unroll
      for (int dt = 0; dt < 2; ++dt)
#pragma unroll
          for (int g = 0; g < 4; ++g) { const int e0 = 32 * dt + 8 * g + 4 * h; const u32x2 gw = *(const u32x2*)(gp + e0);
              const float g0 = bflo(gw.x), g1 = bfhi(gw.x), g2 = bflo(gw.y), g3 = bfhi(gw.y);
              u32x2 w; w.x = cvtpk(g0 * sigmoid_f(g0) * (o[dt][4 * g] - mean) * rstd, g1 * sigmoid_f(g1) * (o[dt][4 * g + 1] - mean) * rstd);
              w.y = cvtpk(g2 * sigmoid_f(g2) * (o[dt][4 * g + 2] - mean) * rstd, g3 * sigmoid_f(g3) * (o[dt][4 * g + 3] - mean) * rstd);
              *(u32x2*)(yp + e0) = w; } }
}

DI void conv_unit(const bf16* U, bf16* Y, const float* cw, const float* cb, const float* lng, const float* lnb, int bl, int tile, LAS unsigned char* lds, int tid, int wave, int lane) {
    LAS float* vs = (LAS float*)lds;
    const int t0 = tile * 64; const size_t tok0 = (size_t)bl * SEQ;
    __syncthreads();
#pragma unroll
    for (int it = 0; it < 6; ++it) { const int id = tid + it * NTHR; if (id >= 94 * 32) break; const int rr = id >> 5, c8 = id & 31, t = t0 - 30 + rr; float v[8];
        if (t >= 0) { const bf16* p = U + (tok0 + t) * DIN + 8 * c8; const u32x4 aw = *(const u32x4*)(p + UC_CA), gw = *(const u32x4*)(p + UC_CG); float a[8], g[8]; unpack8(aw, a); unpack8(gw, g);
#pragma unroll
            for (int j = 0; j < 8; ++j) v[j] = a[j] * sigmoid_f(g[j]); }
        else {
#pragma unroll
            for (int j = 0; j < 8; ++j) v[j] = 0.f; }
        LAS f32x4* d = (LAS f32x4*)(vs + rr * 256 + 8 * c8); d[0] = (f32x4){v[0], v[1], v[2], v[3]}; d[1] = (f32x4){v[4], v[5], v[6], v[7]}; }
    __syncthreads();
    const int c = tid & 255, half = tid >> 8;
    float acc[32];
    { float wj[31], win[62];
#pragma unroll
      for (int j = 0; j < 31; ++j) wj[j] = cw[j * 256 + c];
      const LAS float* vp = vs + (32 * half) * 256 + c;
#pragma unroll
      for (int i = 0; i < 62; ++i) win[i] = vp[i * 256];
      const float bias = cb[c];
#pragma unroll
      for (int i = 0; i < 32; ++i) { float a = bias;
#pragma unroll
          for (int j = 0; j < 31; ++j) a += wj[j] * win[i + j];
          acc[i] = a; } }
    __syncthreads();
#pragma unroll
    for (int i = 0; i < 32; ++i) vs[(32 * half + i) * 256 + c] = acc[i];
    __syncthreads();
    const f32x4 g4 = *(const f32x4*)(lng + 4 * lane), b4 = *(const f32x4*)(lnb + 4 * lane);
#pragma unroll
    for (int i = 0; i < 8; ++i) { const int tt = 8 * wave + i; const f32x4 v = *(const LAS f32x4*)(vs + tt * 256 + 4 * lane);
        const float mean = wave_sum((v.x + v.y) + (v.z + v.w), lane) * (1.f / 256.f);
        const f32x4 dv = v - mean; const float var = wave_sum((dv.x * dv.x + dv.y * dv.y) + (dv.z * dv.z + dv.w * dv.w), lane) * (1.f / 256.f);
        const float rstd = 1.f / sqrtf(var + EPS); const f32x4 xn = dv * rstd * g4 + b4;
        u32x2 w; w.x = cvtpk(xn.x * sigmoid_f(xn.x), xn.y * sigmoid_f(xn.y)); w.y = cvtpk(xn.z * sigmoid_f(xn.z), xn.w * sigmoid_f(xn.w));
        *(u32x2*)(Y + (tok0 + t0 + tt) * D + YC_CONV + 4 * lane) = w; }
}

DI void pool_unit(const bf16* U, bf16* Y, int bl, int tile, LAS unsigned char* lds, int tid) {
    LAS float* us = (LAS float*)lds;
    const int t0 = tile * 64; const size_t tok0 = (size_t)bl * SEQ;
    __syncthreads();
#pragma unroll
    for (int it = 0; it < 5; ++it) { const int id = tid + it * NTHR; if (id >= 79 * 32) break; const int rr = id >> 5, c8 = id & 31, t = t0 - 15 + rr; float v[8];
        if (t >= 0) { const u32x4 w = *(const u32x4*)(U + (tok0 + t) * DIN + UC_POOL + 8 * c8); unpack8(w, v); }
        else {
#pragma unroll
            for (int j = 0; j < 8; ++j) v[j] = 0.f; }
        LAS f32x4* d = (LAS f32x4*)(us + rr * 256 + 8 * c8); d[0] = (f32x4){v[0], v[1], v[2], v[3]}; d[1] = (f32x4){v[4], v[5], v[6], v[7]}; }
    __syncthreads();
    const int c = tid & 255, half = tid >> 8; const int gi = c >> 6, w = 2 << gi;
    float v[47];
    { const LAS float* p = us + (32 * half) * 256 + c;
#pragma unroll
      for (int i = 0; i < 47; ++i) v[i] = p[i * 256]; }
    float s[47];
#pragma unroll
    for (int i = 0; i < 47; ++i) s[i] = v[i] + (i >= 1 ? v[i - 1] : 0.f);
    if (gi >= 1) {
#pragma unroll
        for (int i = 46; i >= 0; --i) s[i] = s[i] + (i >= 2 ? s[i - 2] : 0.f); }
    if (gi >= 2) {
#pragma unroll
        for (int i = 46; i >= 0; --i) s[i] = s[i] + (i >= 4 ? s[i - 4] : 0.f); }
    if (gi >= 3) {
#pragma unroll
        for (int i = 46; i >= 0; --i) s[i] = s[i] + (i >= 8 ? s[i - 8] : 0.f); }
#pragma unroll
    for (int i = 0; i < 32; ++i) { const int t = t0 + 32 * half + i;
        const int n = (t + 1 < w) ? (t + 1) : w; const float d = s[15 + i] * __builtin_amdgcn_rcpf((float)n) - v[15 + i];
        Y[(tok0 + t) * D + YC_POOL + c] = (bf16)(cvtpk(d, 0.f) & 0xffffu); }
}

struct Args { const void* in[27]; float* out; unsigned char* ws; };
static_assert(sizeof(Args) == 29 * 8, "Args has no padding");
typedef const __attribute__((address_space(4))) Args* KArgs;
DI KArgs KA() { KArgs p = (KArgs)__builtin_amdgcn_kernarg_segment_ptr(); asm volatile("" : "+s"(p)); return p; }
#define KIN(T, k) ((const T*)KA()->in[k])
#define PH DI
#define PHN __device__ __noinline__
enum { I_X = 0, I_MEM, I_POS, I_NMIXG, I_WIN, I_CONVW, I_CONVB, I_CLNG, I_CLNB, I_POOLW, I_POOLS, I_WGATE, I_WBR, I_WOUT, I_NXAG, I_NMEMG, I_WQ, I_WKV, I_QG, I_KG, I_WO, I_NFFNG, I_FGU, I_FDN, I_ROUTER, I_MGU, I_MDN };

constexpr unsigned F8MASK = FFN_FP8_MASK;
constexpr bool DENSE_ANY8 = (F8MASK & 0x5) != 0, DENSE_ANYB = (F8MASK & 0x5) != 0x5, MOE_ANY8 = (F8MASK & 0xA) != 0, MOE_ANYB = (F8MASK & 0xA) != 0xA;
struct Ids { int tid, lane, wave, G, wg, gw, NGW; };
DI Ids ids(int wave) { Ids i; i.lane = lane_id(); asm volatile("" : "+v"(i.lane)); asm volatile("" : "+s"(wave)); i.wave = wave; i.tid = wave * 64 + i.lane; i.G = gridDim.x; i.wg = blockIdx.x; asm volatile("" : "+s"(i.G), "+s"(i.wg)); i.gw = i.wg * NWAVES + i.wave; i.NGW = i.G * NWAVES; return i; }

PHN unsigned ph_w_layer(KArgs ka, int wv, LAS unsigned char* lds, int l, unsigned ib) {
    const Ids t = ids(__builtin_amdgcn_readfirstlane(wv));     unsigned char* ws = ka->ws; LAS float* scr = (LAS float*)(lds + t.wave * 16384);
    bf16* wc = (bf16*)(ws + WS_WCAT) + (size_t)l * NCAT * D;
    const float* gmix = ((const float*)ka->in[I_NMIXG]) + l * D;
    tr_matrix(ib, ((const float*)ka->in[I_WIN]) + (size_t)l * D * DIN, D, DIN, wc, 0, 0, scr, t.gw, t.NGW, t.lane, gmix);
    for (int i = 0; i < 4; ++i) { if (GATE_FP8) tr_matrix<true>(ib, ((const float*)ka->in[I_WGATE]) + (size_t)(l * 4 + i) * D * D, D, D, (unsigned char*)(wc + (size_t)DIN * D), i * D, 0, scr, t.gw, t.NGW, t.lane, gmix);
        else tr_matrix(ib, ((const float*)ka->in[I_WGATE]) + (size_t)(l * 4 + i) * D * D, D, D, wc, DIN + i * D, 0, scr, t.gw, t.NGW, t.lane, gmix); }
    for (int i = 0; i < 4; ++i) if (i != 1) tr_matrix(ib, ((const float*)ka->in[I_WBR]) + (size_t)(l * 4 + i) * 256 * D, 256, D, (bf16*)(ws + WS_WB) + (size_t)l * D * D + 256 * i, 0, 0, scr, t.gw, t.NGW, t.lane, nullptr, D);
    tr_matrix(ib, ((const float*)ka->in[I_WOUT]) + (size_t)l * D * D, D, D, (bf16*)(ws + WS_WOUT) + (size_t)l * D * D, 0, 0, scr, t.gw, t.NGW, t.lane);
    tr_matrix(ib, ((const float*)ka->in[I_WQ]) + (size_t)l * D * 256, D, 256, (bf16*)(ws + WS_WQ) + (size_t)l * 256 * D, 0, 0, scr, t.gw, t.NGW, t.lane, ((const float*)ka->in[I_NXAG]) + l * D);
    tr_matrix(ib, ((const float*)ka->in[I_WKV]) + (size_t)l * D * 512, D, 512, (bf16*)(ws + WS_WKV) + (size_t)l * 512 * D, 0, 0, scr, t.gw, t.NGW, t.lane);
    tr_matrix(ib, ((const float*)ka->in[I_WO]) + (size_t)l * 256 * D, 256, D, (bf16*)(ws + WS_WO) + (size_t)l * D * 256, 0, 0, scr, t.gw, t.NGW, t.lane);
    return ib;
}
PHN unsigned ph_w_ffn(KArgs ka, int wv, LAS unsigned char* lds, int s, unsigned ib) {
    const Ids t = ids(__builtin_amdgcn_readfirstlane(wv));     unsigned char* ws = ka->ws; LAS float* scr = (LAS float*)(lds + t.wave * 16384);
    if (s < 2) { const bool f8 = (F8MASK >> (2 * s)) & 1u;
        const float* gu = ((const float*)ka->in[I_FGU]) + (size_t)s * D * NGU; const float* dn = ((const float*)ka->in[I_FDN]) + (size_t)s * DFF * D;
        unsigned char* wgu = ws + WS_WGUD + (size_t)s * NGU * D * 2; unsigned char* wdn = ws + WS_WDND + (size_t)s * D * DFF * 2;
        const float* gf = ((const float*)ka->in[I_NFFNG]) + (2 * s) * D;
        if (f8) { if constexpr (DENSE_ANY8) { tr_matrix<true>(ib, gu, D, NGU, wgu, 0, 1, scr, t.gw, t.NGW, t.lane, gf); tr_matrix<true>(ib, dn, DFF, D, wdn, 0, 0, scr, t.gw, t.NGW, t.lane); } }
        else { if constexpr (DENSE_ANYB) { tr_matrix<false>(ib, gu, D, NGU, wgu, 0, 1, scr, t.gw, t.NGW, t.lane, gf); tr_matrix<false>(ib, dn, DFF, D, wdn, 0, 0, scr, t.gw, t.NGW, t.lane); } }
    } else { const int k = s - 2; const bool f8 = (F8MASK >> (2 * (k >> 3) + 1)) & 1u;
        const float* gu = ((const float*)ka->in[I_MGU]) + (size_t)k * D * NGU; const float* dn = ((const float*)ka->in[I_MDN]) + (size_t)k * DFF * D;
        unsigned char* wgu = ws + WS_WGUM + (size_t)k * NGU * D * 2; unsigned char* wdn = ws + WS_WDNM + (size_t)k * D * DFF * 2;
        if (f8) { if constexpr (MOE_ANY8) { tr_matrix<true>(ib, gu, D, NGU, wgu, 0, 1, scr, t.gw, t.NGW, t.lane); tr_matrix<true>(ib, dn, DFF, D, wdn, 0, 0, scr, t.gw, t.NGW, t.lane); } }
        else { if constexpr (MOE_ANYB) { tr_matrix<false>(ib, gu, D, NGU, wgu, 0, 1, scr, t.gw, t.NGW, t.lane); tr_matrix<false>(ib, dn, DFF, D, wdn, 0, 0, scr, t.gw, t.NGW, t.lane); } }
    }
    return ib;
}
PHN void ph_misc0(KArgs ka, int wv) {
    const Ids t = ids(__builtin_amdgcn_readfirstlane(wv));     unsigned char* ws = ka->ws;
    { const float* pool_w = ((const float*)ka->in[I_POOLW]); const float* pool_scale = ((const float*)ka->in[I_POOLS]); const float* w_branch = ((const float*)ka->in[I_WBR]); bf16* WB = (bf16*)(ws + WS_WB);
      for (int idx = t.wg * NTHR + t.tid; idx < DEPTH * 1024 * 256; idx += t.G * NTHR) {
          const int l = idx >> 18, n = (idx >> 8) & 1023, gc = idx & 255, g = gc >> 6;
          const float* pw = pool_w + ((size_t)(l * 4) * 64 + gc) * 64; const float* ps = pool_scale + l * 256 + 64 * g; const float* wb = w_branch + ((size_t)(l * 4 + 1) * 256 + 64 * g) * D + n;
          float s = 0.f;
          for (int d = 0; d < 64; ++d) s += pw[d] * ps[d] * wb[(size_t)d * D];
          WB[(size_t)l * D * D + (size_t)n * D + 256 + gc] = (bf16)(cvtpk(s, 0.f) & 0xffffu); } }
    { const float* mem = ((const float*)ka->in[I_MEM]); const float* gm = ((const float*)ka->in[I_NMEMG]); bf16* MEMH = (bf16*)(ws + WS_MEMH);
      for (int it = t.gw; it < DEPTH * MMEM; it += t.NGW) { const int l = it / MMEM, rw = it - l * MMEM; rms_row_bf16(mem + (size_t)rw * D, gm + l * D, MEMH + (size_t)it * D, t.lane); } }
    { const int* positions = ((const int*)ka->in[I_POS]); f32x2* ROT = (f32x2*)(ws + WS_ROT);
      for (int idx = t.wg * NTHR + t.tid; idx < MTOT * 32; idx += t.G * NTHR) { const int tok = idx >> 5, i = idx & 31;
          const float ang = (float)positions[tok] * INV_FREQ[i]; double rev = (double)ang * 0.15915494309189535; rev -= floor(rev); const float rv = (float)rev;
          ROT[idx] = (f32x2){__builtin_amdgcn_cosf(rv), __builtin_amdgcn_sinf(rv)}; } }
}
PH void ph_kv(int wv, LAS unsigned char* lds) {
    const Ids t = ids(wv); unsigned char* ws = KA()->ws;
    pg8::OrdKV S; S.to.init(DEPTH * (MMEM / 256), 2, t.G, t.wg); S.A = (const char*)(ws + WS_MEMH); S.B = (const char*)(ws + WS_WKV);
    pg8::EpiBf16<false> E{(bf16*)(ws + WS_KV), 512, nullptr};
    pg8::gemm_phase<pg8::EpiBf16<false>, pg8::OrdKV>(lds, D, D, S, E, t.wave);
}
PHN void ph_knorm(KArgs ka, int wv) {
    const Ids t = ids(__builtin_amdgcn_readfirstlane(wv));     unsigned char* ws = ka->ws; unsigned* ctl = (unsigned*)(ws + WS_CTL); bf16* KV = (bf16*)(ws + WS_KV); const float* xa_kg = ((const float*)ka->in[I_KG]);
    for (int it = t.gw; it < DEPTH * MMEM; it += t.NGW) { const int l = it / MMEM, rw = it - l * MMEM, b = rw >> 8; const int lane = t.lane;
        if (lane < 32) { bf16* kp = KV + (size_t)it * 512 + 8 * lane; const u32x4 w = *(const u32x4*)kp; float f[8]; unpack8(w, f); float ss = 0.f;
#pragma unroll
            for (int j = 0; j < 8; ++j) ss += f[j] * f[j];
            ss += SHX(ss, 1, lane); ss += SHX(ss, 2, lane); ss += SHX(ss, 4, lane);
            const float rs = 1.f / sqrtf(ss * (1.f / 64.f) + EPS); const float* gk = xa_kg + l * 64 + 8 * (lane & 7); float n2 = 0.f;
#pragma unroll
            for (int j = 0; j < 8; ++j) { f[j] *= rs * gk[j]; n2 += f[j] * f[j]; }
            *(u32x4*)kp = pack8(f);
            n2 += SHX(n2, 1, lane); n2 += SHX(n2, 2, lane); n2 += SHX(n2, 4, lane);
            if ((lane & 7) == 0) atomicMax(ctl + CW_KMAX + (l * NB + b) * 4 + (lane >> 3), __float_as_uint(n2 * 1.02f)); } }
}
PHN void ph_xprep(KArgs ka, int wv, int g, int from_in) {
    const Ids t = ids(__builtin_amdgcn_readfirstlane(wv));
    unsigned char* ws = ka->ws; const size_t grow = (size_t)g * MG;
    const float* src = from_in ? (((const float*)ka->in[I_X]) + grow * D) : (ka->out + grow * D);
    bf16* XB = (bf16*)(ws + WS_HB); float* ssq = (float*)(ws + WS_SSQ); const int lane = t.lane;
    for (int m = t.gw; m < MG; m += t.NGW) {
        const f32x4* xr = (const f32x4*)(src + (size_t)m * D) + lane; f32x4 v[4]; float s = 0.f;
#pragma unroll
        for (int j = 0; j < 4; ++j) { v[j] = xr[64 * j]; s += (v[j].x * v[j].x + v[j].y * v[j].y) + (v[j].z * v[j].z + v[j].w * v[j].w); }
        s = wave_sum(s, lane);
        u32x2* o8 = (u32x2*)(XB + (size_t)m * D) + lane;
#pragma unroll
        for (int j = 0; j < 4; ++j) { u32x2 w; w.x = cvtpk(v[j].x, v[j].y); w.y = cvtpk(v[j].z, v[j].w); o8[64 * j] = w; }
        if (GATE_FP8) { unsigned* o4 = (unsigned*)(ws + WS_XB8 + (size_t)m * D) + lane;
#pragma unroll
            for (int j = 0; j < 4; ++j) o4[64 * j] = cvt4_fp8(v[j].x, v[j].y, v[j].z, v[j].w); }
        if (lane < 16) ssq[(size_t)m * 16 + lane] = lane == 0 ? s : 0.f; }
}
PH void ph_gemm1(int wv, LAS unsigned char* lds, int l) {
    const Ids t = ids(wv); unsigned char* ws = KA()->ws; bf16* wcat = (bf16*)(ws + WS_WCAT) + (size_t)l * NCAT * D;
    { pg8::OrdStd S; S.to.init(MG / 256, (GATE_FP8 ? DIN : NCAT) / 256, t.G, t.wg); S.A = (const char*)(ws + WS_HB); S.B = (const char*)wcat; S.atile = 256 * D * 2; S.btile = 256 * D * 2;
      pg8::EpiCat<false> E{(bf16*)(ws + WS_U), (bf16*)(ws + WS_GATES), (const float*)(ws + WS_SSQ)};
      pg8::gemm_phase<pg8::EpiCat<false>, pg8::OrdStd>(lds, D, D, S, E, t.wave); }
    if constexpr (GATE_FP8 != 0) {
      pg8::OrdStd S; S.to.init(MG / 256, 4096 / 256, t.G, t.wg); S.A = (const char*)(ws + WS_XB8); S.B = (const char*)(wcat + (size_t)DIN * D); S.atile = 256 * D; S.btile = 256 * D;
      pg8::EpiCat<true> E{(bf16*)(ws + WS_U), (bf16*)(ws + WS_GATES), (const float*)(ws + WS_SSQ)};
      pg8::gemm_phase<pg8::EpiCat<true>, pg8::OrdStd, true>(lds, D, D, S, E, t.wave); }
}
constexpr int NSB = BG * 4 * 16, NRC = BG * 4 * 16, NCONV = BG * 64, NPOOL = BG * 64;
PH void ph_mix(int wv, LAS unsigned char* lds, int g, int l, int part, int rep = 0, int jlo = 0, int jhi = 1 << 30) {
    const Ids t = ids(wv); unsigned char* ws = KA()->ws; unsigned* ctl = (unsigned*)(ws + WS_CTL);
    volatile LAS unsigned* MISC = (volatile LAS unsigned*)(lds + MISC_OFF);
    unsigned* qctr = ctl + CW_QCTR + 64 * ((g * 4 + l) * 2 + part + 16 * rep);
    const bf16* UB = (const bf16*)(ws + WS_U); bf16* YB = (bf16*)(ws + WS_Y); float* KVS = (float*)(ws + WS_KVS); const f32x2* ROT = (const f32x2*)(ws + WS_ROT);
    const int NUQ = part == 0 ? (NSB + NRC + NPOOL) : (NRC + NCONV);
    (void)qctr; (void)MISC;
    for (int j = t.wg; j < NUQ; j += t.G) {
        if (j < jlo || j >= jhi) continue;
        if (part == 0) {
            if (j < NSB) { __syncthreads(); if (t.tid == 0) { MISC[2] = 0u; MISC[3] = 0u; } __syncthreads(); sb_unit(UB, YB, (j >> 2) & 7, j & 3, 15 - (j >> 5), lds, t.tid, t.wave, t.lane); }
            else if (j < NSB + NRC) { const int k = j - NSB, bl = k >> 6; retkv_unit(UB, KVS, ROT, bl, (g * BG + bl) * SEQ, (k >> 4) & 3, k & 15, lds, t.tid, t.wave, t.lane); }
            else { const int k = j - (NSB + NRC); pool_unit(UB, YB, k >> 6, k & 63, lds, t.tid); }
        } else {
            if (j < NRC) { const int bl = j >> 6; reto_unit(UB, YB, KVS, ROT, bl, (g * BG + bl) * SEQ, (j >> 4) & 3, j & 15, lds, t.tid, t.wave, t.lane); }
            else { const int k = j - NRC;
                conv_unit(UB, YB, KIN(float, I_CONVW) + (size_t)l * 31 * 256, KIN(float, I_CONVB) + l * 256, KIN(float, I_CLNG) + l * 256, KIN(float, I_CLNB) + l * 256, k >> 6, k & 63, lds, t.tid, t.wave, t.lane); }
        }
    }
}
PH void ph_merge(int wv, LAS unsigned char* lds, int l) {
    const Ids t = ids(wv); unsigned char* ws = KA()->ws;
    pg8::OrdMerge S; S.G = t.G; S.c = t.wg; S.ntiles = (MG / 256) * 8; S.A = (const char*)(ws + WS_Y); S.B = (const char*)((bf16*)(ws + WS_WB) + (size_t)l * D * D);
    pg8::EpiMerge E{(const bf16*)(ws + WS_GATES), (bf16*)(ws + WS_MERGED)};
    pg8::gemm_phase<pg8::EpiMerge, pg8::OrdMerge, false, true>(lds, D, D, S, E, t.wave);
}
PH void ph_res(int wv, LAS unsigned char* lds, int g, int l, int which, int xbm) {
    const Ids t = ids(wv); unsigned char* ws = KA()->ws; const size_t grow = (size_t)g * MG; float* xo = KA()->out + grow * D;
    const float* xi = (which == 0 && l == 0) ? (KIN(float, I_X) + grow * D) : xo;
    int K; const char* A; const char* B;
    if (which == 0) { K = D; A = (const char*)(ws + WS_MERGED); B = (const char*)((bf16*)(ws + WS_WOUT) + (size_t)l * D * D); }
    else { K = 256; A = (const char*)(ws + WS_OB); B = (const char*)((bf16*)(ws + WS_WO) + (size_t)l * D * 256); }
    pg8::OrdStd S; S.to.init(MG / 256, 4, t.G, t.wg); S.A = A; S.B = B; S.atile = (size_t)256 * K * 2; S.btile = (size_t)256 * K * 2;
    pg8::EpiRes<true, false> E{xi, xo, xbm, (void*)(ws + WS_HB), (float*)(ws + WS_SSQ), ws + WS_HB};
    pg8::gemm_phase<pg8::EpiRes<true, false>, pg8::OrdStd>(lds, K, K, S, E, t.wave);
}
template <bool F8> PH void ph_down(int wv, LAS unsigned char* lds, int g, int l, int xbm) {
    constexpr int FE = F8 ? 1 : 2;
    const Ids t = ids(wv); unsigned char* ws = KA()->ws; float* xo = KA()->out + (size_t)g * MG * D;
    pg8::OrdStd S; S.to.init(MG / 256, 4, t.G, t.wg); S.A = (const char*)(ws + WS_ACT); S.B = (const char*)(ws + WS_WDND + (size_t)(l >> 1) * D * DFF * 2); S.atile = (size_t)256 * DFF * FE; S.btile = (size_t)256 * DFF * FE;
    pg8::EpiRes<true, F8> E{xo, xo, xbm, (void*)(ws + WS_HB), (float*)(ws + WS_SSQ), ws + WS_XB8};
    pg8::gemm_phase<pg8::EpiRes<true, F8>, pg8::OrdStd, F8>(lds, DFF, DFF, S, E, t.wave);
}
PH void ph_q(int wv, LAS unsigned char* lds, int l) {
    const Ids t = ids(wv); unsigned char* ws = KA()->ws;
    pg8::OrdStd S; S.to.init(MG / 256, 1, t.G, t.wg); S.A = (const char*)(ws + WS_HB); S.B = (const char*)((bf16*)(ws + WS_WQ) + (size_t)l * 256 * D); S.atile = 256 * D * 2; S.btile = 256 * D * 2;
    pg8::EpiBf16<false> E{(bf16*)(ws + WS_QB), 256, (const float*)(ws + WS_SSQ)};
    pg8::gemm_phase<pg8::EpiBf16<false>, pg8::OrdStd>(lds, D, D, S, E, t.wave);
}
PH void ph_xa(int wv, LAS unsigned char* lds, int g, int l) {
    const Ids t = ids(wv); unsigned char* ws = KA()->ws; const unsigned* ctl = (const unsigned*)(ws + WS_CTL);
    for (int j = t.wg; j < BG * 4 * 16; j += t.G) { const int bl = j >> 6, hd = (j >> 4) & 3, qblk = j & 15, bglob = g * BG + bl;
        const float kmax = sqrtf(__uint_as_float(ctl[CW_KMAX + (l * NB + bglob) * 4 + hd]));
        xa_unit((const bf16*)(ws + WS_QB), (const bf16*)(ws + WS_KV) + (size_t)l * MMEM * 512, KIN(float, I_QG) + l * 64, kmax, (bf16*)(ws + WS_OB), bl, bglob, hd, qblk, lds, t.tid, t.wave, t.lane); }
}
template <bool F8> PH void ph_gu(int wv, LAS unsigned char* lds, int l) {
    constexpr int FE = F8 ? 1 : 2;
    const Ids t = ids(wv); unsigned char* ws = KA()->ws;
    pg8::OrdStd S; S.to.init(MG / 256, NGU / 256, t.G, t.wg); S.A = (const char*)(ws + WS_HB); S.B = (const char*)(ws + WS_WGUD + (size_t)(l >> 1) * NGU * D * 2); S.atile = 256 * D * FE; S.btile = 256 * D * FE;
    pg8::EpiGU<F8> E{(void*)(ws + WS_ACT), (const float*)(ws + WS_SSQ)};
    pg8::gemm_phase<pg8::EpiGU<F8>, pg8::OrdStd, F8>(lds, D, D, S, E, t.wave);
}
struct MoeCtx { int rpw, r_lo, r_hi; };
DI MoeCtx moe_ctx(const Ids& t) { MoeCtx c; c.rpw = (MG + t.G - 1) / t.G; c.r_lo = t.wg * c.rpw; c.r_hi = (c.r_lo + c.rpw < MG) ? (c.r_lo + c.rpw) : MG; return c; }
template <bool F8> PH void ph_route(int wv, LAS unsigned char* lds, int g, int l) {
    constexpr int FE = F8 ? 1 : 2;
    const Ids t = ids(wv); unsigned char* ws = KA()->ws; unsigned* ctl = (unsigned*)(ws + WS_CTL); const int l2 = l >> 1, inst = g * 2 + l2;
    unsigned* wgcnt = ctl + CW_WGCNT + inst * 8192; const MoeCtx mc = moe_ctx(t);
    volatile LAS unsigned* LC = (volatile LAS unsigned*)(lds + MISC_OFF) + 16;
    const float* xo = KA()->out + (size_t)g * MG * D; bf16* HB = (bf16*)(ws + WS_HB);
    int* R_E = (int*)(ws + WS_ROUTE); float* R_W1 = (float*)(R_E + MG); float* R_W2 = R_W1 + MG;
    if (t.tid < 16) LC[t.tid] = 0u;
    __syncthreads();
    const float* rt = KIN(float, I_ROUTER) + (size_t)l2 * D * NEXP; const float* gn = KIN(float, I_NFFNG) + l * D; const int lane = t.lane;
    for (int m = mc.r_lo + t.wave; m < mc.r_hi; m += NWAVES) {
        const f32x4* xr = (const f32x4*)(xo + (size_t)m * D) + lane; const f32x4* gr = (const f32x4*)gn + lane;
        f32x4 v[4]; float s = 0.f;
#pragma unroll
        for (int j = 0; j < 4; ++j) { v[j] = xr[64 * j]; s += (v[j].x * v[j].x + v[j].y * v[j].y) + (v[j].z * v[j].z + v[j].w * v[j].w); }
        const float rstd = 1.f / sqrtf(wave_sum(s, lane) * (1.f / D) + EPS);
        float lg[8];
#pragma unroll
        for (int e = 0; e < 8; ++e) lg[e] = 0.f;
        u32x2* o8 = (u32x2*)(HB + (size_t)m * D) + lane; unsigned* o4 = (unsigned*)((unsigned char*)HB + (size_t)m * D) + lane;
#pragma unroll
        for (int j = 0; j < 4; ++j) { const f32x4 gg = gr[64 * j]; const f32x4 hn = v[j] * rstd * gg;
            if (F8) o4[64 * j] = cvt4_fp8(hn.x, hn.y, hn.z, hn.w);
            else { u32x2 w; w.x = cvtpk(hn.x, hn.y); w.y = cvtpk(hn.z, hn.w); o8[64 * j] = w; }
            const f32x4* rp = (const f32x4*)(rt + (size_t)(4 * lane + 256 * j) * NEXP);
#pragma unroll
            for (int q = 0; q < 4; ++q) { const f32x4 r0 = rp[2 * q], r1 = rp[2 * q + 1]; const float hv = hn[q];
                lg[0] += hv * r0.x; lg[1] += hv * r0.y; lg[2] += hv * r0.z; lg[3] += hv * r0.w; lg[4] += hv * r1.x; lg[5] += hv * r1.y; lg[6] += hv * r1.z; lg[7] += hv * r1.w; } }
#pragma unroll
        for (int e = 0; e < 8; ++e) lg[e] = wave_sum(lg[e], lane);
        float v1 = lg[0]; int i1 = 0;
#pragma unroll
        for (int e = 1; e < 8; ++e) if (lg[e] > v1) { v1 = lg[e]; i1 = e; }
        float v2 = -3.0e38f; int i2 = -1;
#pragma unroll
        for (int e = 0; e < 8; ++e) if (e != i1 && (i2 < 0 || lg[e] > v2)) { v2 = lg[e]; i2 = e; }
        const float w1 = 1.f / (1.f + __expf(v2 - v1));
        if (lane == 0) { R_E[m] = i1 | (i2 << 8); R_W1[m] = w1; R_W2[m] = 1.f - w1;
            __hip_atomic_fetch_add((LAS unsigned*)&LC[i1], 1u, __ATOMIC_RELAXED, __HIP_MEMORY_SCOPE_WORKGROUP); __hip_atomic_fetch_add((LAS unsigned*)&LC[i2], 1u, __ATOMIC_RELAXED, __HIP_MEMORY_SCOPE_WORKGROUP); }
    }
    __syncthreads();
    if (t.tid < 8) wgcnt[t.wg * 8 + t.tid] = LC[t.tid];
}
template <bool F8> PHN void ph_gather(KArgs ka, int wv, LAS unsigned char* lds, int g, int l) {
    constexpr int FE = F8 ? 1 : 2;
    const Ids t = ids(__builtin_amdgcn_readfirstlane(wv));     unsigned char* ws = ka->ws; unsigned* ctl = (unsigned*)(ws + WS_CTL); const int l2 = l >> 1, inst = g * 2 + l2;
    unsigned* wgcnt = ctl + CW_WGCNT + inst * 8192; unsigned* moff = ctl + CW_MOFF + 64 * inst; const MoeCtx mc = moe_ctx(t);
    volatile LAS unsigned* LC = (volatile LAS unsigned*)(lds + MISC_OFF) + 16;
    const bf16* HB = (const bf16*)(ws + WS_HB); bf16* HP = (bf16*)(ws + WS_HP);
    const int* R_E = (const int*)(ws + WS_ROUTE); int* R_S1 = (int*)(ws + WS_ROUTE) + 3 * MG; int* R_S2 = R_S1 + MG;
    if (t.tid < 16) LC[t.tid] = 0u;
    __syncthreads();
    for (int idx = t.tid; idx < t.G * 8; idx += NTHR) { const unsigned v = wgcnt[idx]; const int e = idx & 7;
        __hip_atomic_fetch_add((LAS unsigned*)&LC[8 + e], v, __ATOMIC_RELAXED, __HIP_MEMORY_SCOPE_WORKGROUP);
        if ((idx >> 3) < t.wg) __hip_atomic_fetch_add((LAS unsigned*)&LC[e], v, __ATOMIC_RELAXED, __HIP_MEMORY_SCOPE_WORKGROUP); }
    __syncthreads();
    if (t.tid == 0) { unsigned o = 0;
        for (int e = 0; e < 8; ++e) { const unsigned tot = LC[8 + e]; if (t.wg == 0) moff[e] = o; LC[e] = LC[e] + o; o += (tot + 255u) & ~255u; }
        if (t.wg == 0) moff[8] = o; }
    __syncthreads();
    const int lane = t.lane;
    for (int m = mc.r_lo + t.wave; m < mc.r_hi; m += NWAVES) {
        int s1 = 0, s2 = 0;
        if (lane == 0) { const int ee = R_E[m];
            s1 = (int)__hip_atomic_fetch_add((LAS unsigned*)&LC[ee & 255], 1u, __ATOMIC_RELAXED, __HIP_MEMORY_SCOPE_WORKGROUP);
            s2 = (int)__hip_atomic_fetch_add((LAS unsigned*)&LC[ee >> 8], 1u, __ATOMIC_RELAXED, __HIP_MEMORY_SCOPE_WORKGROUP);
            R_S1[m] = s1; R_S2[m] = s2; }
        s1 = __builtin_amdgcn_readfirstlane(s1); s2 = __builtin_amdgcn_readfirstlane(s2);
        if (F8) { const u32x4 a = *((const u32x4*)((const unsigned char*)HB + (size_t)m * D) + lane);
            *((u32x4*)((unsigned char*)HP + (size_t)s1 * D) + lane) = a; *((u32x4*)((unsigned char*)HP + (size_t)s2 * D) + lane) = a; }
        else { const u32x4* src = (const u32x4*)(HB + (size_t)m * D) + lane; const u32x4 a = src[0], b = src[64];
            u32x4* d1 = (u32x4*)(HP + (size_t)s1 * D) + lane; u32x4* d2 = (u32x4*)(HP + (size_t)s2 * D) + lane;
            d1[0] = a; d1[64] = b; d2[0] = a; d2[64] = b; } }
}
template <bool F8> PH void ph_moe_gu(int wv, LAS unsigned char* lds, int g, int l) {
    constexpr int FE = F8 ? 1 : 2;
    const Ids t = ids(wv); unsigned char* ws = KA()->ws; const unsigned* ctl = (const unsigned*)(ws + WS_CTL); const int l2 = l >> 1, inst = g * 2 + l2; const unsigned* moff = ctl + CW_MOFF + 64 * inst;
    pg8::OrdMoe S;
#pragma unroll
    for (int e = 0; e < 9; ++e) S.off[e] = __builtin_amdgcn_readfirstlane((int)moff[e]);
    S.to.init(S.off[8] >> 8, NGU / 256, t.G, t.wg); S.A = (const char*)(ws + WS_HP); S.B = (const char*)(ws + WS_WGUM + (size_t)l2 * NEXP * NGU * D * 2); S.atile = 256 * D * FE; S.btile = 256 * D * FE; S.bexp = (size_t)NGU * D * 2;
    pg8::EpiGU<F8> E{(void*)(ws + WS_ACT), nullptr};
    pg8::gemm_phase<pg8::EpiGU<F8>, pg8::OrdMoe, F8>(lds, D, D, S, E, t.wave);
}
template <bool F8> PH void ph_moe_dn(int wv, LAS unsigned char* lds, int g, int l) {
    constexpr int FE = F8 ? 1 : 2;
    const Ids t = ids(wv); unsigned char* ws = KA()->ws; const unsigned* ctl = (const unsigned*)(ws + WS_CTL); const int l2 = l >> 1, inst = g * 2 + l2; const unsigned* moff = ctl + CW_MOFF + 64 * inst;
    pg8::OrdMoe S;
#pragma unroll
    for (int e = 0; e < 9; ++e) S.off[e] = __builtin_amdgcn_readfirstlane((int)moff[e]);
    S.to.init(S.off[8] >> 8, 4, t.G, t.wg); S.A = (const char*)(ws + WS_ACT); S.B = (const char*)(ws + WS_WDNM + (size_t)l2 * NEXP * D * DFF * 2); S.atile = (size_t)256 * DFF * FE; S.btile = (size_t)256 * DFF * FE; S.bexp = (size_t)D * DFF * 2;
    pg8::EpiBf16<F8> E{(bf16*)(ws + WS_HP), D, nullptr};
    pg8::gemm_phase<pg8::EpiBf16<F8>, pg8::OrdMoe, F8>(lds, DFF, DFF, S, E, t.wave);
}
PHN void ph_combine(KArgs ka, int wv, int g, int xbm) {
    const Ids t = ids(__builtin_amdgcn_readfirstlane(wv));     unsigned char* ws = ka->ws; float* xo = ka->out + (size_t)g * MG * D; const bf16* HP = (const bf16*)(ws + WS_HP);
    const int* R_E = (const int*)(ws + WS_ROUTE); const float* R_W1 = (const float*)(R_E + MG); const float* R_W2 = R_W1 + MG; const int* R_S1 = (const int*)(R_W2 + MG); const int* R_S2 = R_S1 + MG;
    const int lane = t.lane;
    bf16* XB = (bf16*)(ws + WS_HB); float* ssq = (float*)(ws + WS_SSQ);
    for (int m = t.gw; m < MG; m += t.NGW) { const int s1 = R_S1[m], s2 = R_S2[m]; const float w1 = R_W1[m], w2 = R_W2[m]; float ssum = 0.f;
        f32x4* xr = (f32x4*)(xo + (size_t)m * D) + 2 * lane; const u32x4* p1 = (const u32x4*)(HP + (size_t)s1 * D) + lane; const u32x4* p2 = (const u32x4*)(HP + (size_t)s2 * D) + lane;
#pragma unroll
        for (int j = 0; j < 2; ++j) { float a[8], b[8]; unpack8(p1[64 * j], a); unpack8(p2[64 * j], b); f32x4 x0 = xr[128 * j], x1 = xr[128 * j + 1];
            x0.x += w1 * a[0] + w2 * b[0]; x0.y += w1 * a[1] + w2 * b[1]; x0.z += w1 * a[2] + w2 * b[2]; x0.w += w1 * a[3] + w2 * b[3];
            x1.x += w1 * a[4] + w2 * b[4]; x1.y += w1 * a[5] + w2 * b[5]; x1.z += w1 * a[6] + w2 * b[6]; x1.w += w1 * a[7] + w2 * b[7];
            xr[128 * j] = x0; xr[128 * j + 1] = x1;
            if (xbm) { ssum += (x0.x * x0.x + x0.y * x0.y) + (x0.z * x0.z + x0.w * x0.w) + (x1.x * x1.x + x1.y * x1.y) + (x1.z * x1.z + x1.w * x1.w);
                u32x4 w; w.x = cvtpk(x0.x, x0.y); w.y = cvtpk(x0.z, x0.w); w.z = cvtpk(x1.x, x1.y); w.w = cvtpk(x1.z, x1.w); *((u32x4*)(XB + (size_t)m * D) + lane + 64 * j) = w;
                if (GATE_FP8) { u32x2 w8; w8.x = cvt4_fp8(x0.x, x0.y, x0.z, x0.w); w8.y = cvt4_fp8(x1.x, x1.y, x1.z, x1.w); *((u32x2*)(ws + WS_XB8 + (size_t)m * D) + lane + 64 * j) = w8; } } }
        if (xbm) { ssum = wave_sum(ssum, lane); if (lane < 16) ssq[(size_t)m * 16 + lane] = lane == 0 ? ssum : 0.f; } }
}

__global__ void __launch_bounds__(NTHR, 2) trunk_fwd(Args args) {
    extern __shared__ __attribute__((aligned(16))) unsigned char lds_raw[];
    LAS unsigned char* lds = (LAS unsigned char*)lds_raw;
    volatile LAS unsigned* MISC = (volatile LAS unsigned*)(lds + MISC_OFF);
    const int tid = threadIdx.x; int wave = __builtin_amdgcn_readfirstlane(tid >> 6); asm volatile("" : "+s"(wave));
    unsigned* ctl = (unsigned*)(args.ws + WS_CTL);
    for (int u = tid; u < (LDS_BYTES - LDSCTL_OFF) / 4; u += NTHR) ((LAS unsigned*)(lds + LDSCTL_OFF))[u] = 0u;
    __syncthreads();
    XcdBarrier bar; bar.bar = ctl + CW_BAR; bar.x = xb_xcc_id(); bar.st = MISC + 8;
    if (tid == 0) (void)xb_add(&bar.bar[XB_XCNT(bar.x)], 1u);
#define WV() ({ int _w = wave; asm volatile("" : "+s"(_w)); _w; })
#define GRID_BAR() xcd_barrier_fn((GAS unsigned*)bar.bar, bar.x, bar.st, WV())
    unsigned ib = 0;
    for (int l = 0; l < DEPTH; ++l) ib = ph_w_layer(KA(), WV(), lds, l, ib);
    for (int s = 0; s < 2 + 2 * NEXP; ++s) ib = ph_w_ffn(KA(), WV(), lds, s, ib);
    ph_misc0(KA(), WV());
#ifdef DUP_PRO
    for (int l = 0; l < DEPTH; ++l) ib = ph_w_layer(KA(), WV(), lds, l, ib);
    for (int s = 0; s < 2 + 2 * NEXP; ++s) ib = ph_w_ffn(KA(), WV(), lds, s, ib);
    ph_misc0(KA(), WV());
#endif
    GRID_BAR();
    ph_kv(wave, lds);
    GRID_BAR();
    ph_knorm(KA(), WV());
    GRID_BAR();
    for (int g = 0; g < NG; ++g) {
        for (int l = 0; l < DEPTH; ++l) {
            if (l == 0) { ph_xprep(KA(), WV(), g, 1); GRID_BAR(); }
            ph_gemm1(wave, lds, l); GRID_BAR();
#ifdef DUP_G1
            ph_gemm1(wave, lds, l); GRID_BAR();
#endif
            ph_mix(wave, lds, g, l, 0); GRID_BAR();
            ph_mix(wave, lds, g, l, 1); GRID_BAR();
#ifdef DUP_MIX_LO
            ph_mix(wave, lds, g, l, DUP_MIX_PART, 1, DUP_MIX_LO, DUP_MIX_HI); GRID_BAR();
#endif
            ph_merge(wave, lds, l); GRID_BAR();
#ifdef DUP_BAR
            GRID_BAR(); GRID_BAR(); GRID_BAR(); GRID_BAR(); GRID_BAR(); GRID_BAR(); GRID_BAR(); GRID_BAR();
#endif
#ifdef DUP_MERGE
            ph_merge(wave, lds, l); GRID_BAR();
#endif
            ph_res(wave, lds, g, l, 0, 1); GRID_BAR();
            ph_q(wave, lds, l); GRID_BAR();
            ph_xa(wave, lds, g, l); GRID_BAR();
            const bool f8 = (F8MASK >> l) & 1u; const int nxt = (l + 1 < DEPTH) ? 1 : 0;
            if ((l & 1) == 0) {
                ph_res(wave, lds, g, l, 1, f8 ? 2 : 1); GRID_BAR();
                if (f8) { if constexpr (DENSE_ANY8) { ph_gu<true>(wave, lds, l); GRID_BAR(); ph_down<true>(wave, lds, g, l, nxt ? (GATE_FP8 ? 3 : 1) : 0); GRID_BAR(); } }
                else { if constexpr (DENSE_ANYB) { ph_gu<false>(wave, lds, l); GRID_BAR(); ph_down<false>(wave, lds, g, l, nxt ? (GATE_FP8 ? 3 : 1) : 0); GRID_BAR(); } }
            } else {
                ph_res(wave, lds, g, l, 1, 0); GRID_BAR();
                if (f8) { if constexpr (MOE_ANY8) { ph_route<true>(wave, lds, g, l); GRID_BAR(); ph_gather<true>(KA(), WV(), lds, g, l); GRID_BAR(); ph_moe_gu<true>(wave, lds, g, l); GRID_BAR(); ph_moe_dn<true>(wave, lds, g, l); GRID_BAR(); } }
                else { if constexpr (MOE_ANYB) { ph_route<false>(wave, lds, g, l); GRID_BAR(); ph_gather<false>(KA(), WV(), lds, g, l); GRID_BAR(); ph_moe_gu<false>(wave, lds, g, l); GRID_BAR(); ph_moe_dn<false>(wave, lds, g, l); GRID_BAR(); } }
                ph_combine(KA(), WV(), g, nxt); GRID_BAR();
            }
        }
    }
}

extern "C" void kernel_launch(void* const* d_in, const int* in_sizes, int n_in, void* d_out, int out_size, void* d_ws, size_t ws_size, hipStream_t stream) {
    static int grid = 0;
    if (grid == 0) {
        if (n_in != 27 || in_sizes[0] != MTOT * D || out_size != MTOT * D || ws_size < WS_END) { fprintf(stderr, "kernel_launch: unexpected problem (n_in %d, in0 %d, out %d, ws %zu < %zu)\n", n_in, n_in > 0 ? in_sizes[0] : -1, out_size, ws_size, (size_t)WS_END); grid = -1; return; }
        int dev = 0, cus = 0, per_cu = 0;
        if (hipGetDevice(&dev) != hipSuccess || hipDeviceGetAttribute(&cus, hipDeviceAttributeMultiprocessorCount, dev) != hipSuccess) { grid = -1; return; }
        if (hipFuncSetAttribute((const void*)trunk_fwd, hipFuncAttributeMaxDynamicSharedMemorySize, LDS_BYTES) != hipSuccess) { fprintf(stderr, "kernel_launch: hipFuncSetAttribute failed\n"); grid = -1; return; }
        if (hipOccupancyMaxActiveBlocksPerMultiprocessor(&per_cu, (const void*)trunk_fwd, NTHR, LDS_BYTES) != hipSuccess || per_cu < 1) fprintf(stderr, "kernel_launch: occupancy query reports %d\n", per_cu);
        (void)hipGetLastError();
        grid = cus;
    }
    if (grid < 0) return;
    if (hipMemsetAsync((char*)d_ws + WS_CTL, 0, CTL_ZERO_BYTES, stream) != hipSuccess) return;
    Args a{};
    for (int i = 0; i < 27; ++i) a.in[i] = d_in[i];
    a.out = (float*)d_out; a.ws = (unsigned char*)d_ws;
    hipLaunchKernelGGL(trunk_fwd, dim3(grid), dim3(NTHR), LDS_BYTES, stream, a);
}
```

```cpp
#include <hip/hip_runtime.h>
#include <cstdio>
#include <cstdint>

#define DI __device__ __forceinline__
#define LAS __attribute__((address_space(3)))
#define GAS __attribute__((address_space(1)))
typedef unsigned short bf16;
typedef short bf16x8 __attribute__((ext_vector_type(8)));
typedef short s16x4 __attribute__((ext_vector_type(4)));
typedef float f32x2 __attribute__((ext_vector_type(2)));
typedef float f32x4 __attribute__((ext_vector_type(4)));
typedef float f32x16 __attribute__((ext_vector_type(16)));
typedef unsigned u32x2 __attribute__((ext_vector_type(2)));
typedef unsigned u32x4 __attribute__((ext_vector_type(4)));
typedef __bf16 bf16x2_t __attribute__((ext_vector_type(2)));
typedef GAS unsigned gu32;
typedef int i32x8 __attribute__((ext_vector_type(8)));
#ifndef GATE_FP8
#define GATE_FP8 1
#endif
#ifndef FFN_FP8_MASK
#define FFN_FP8_MASK 0xE
#endif
constexpr float W8_SCALE = 64.f, W8_INV = 1.f / 64.f;

constexpr int NB = 16, SEQ = 4096, D = 1024, DEPTH = 4, NG = 2, BG = NB / NG, MG = BG * SEQ, MTOT = NB * SEQ;
constexpr int DIN = 2560, NCAT = DIN + 4096, DFF = 2816, NGU = 2 * DFF, NEXP = 8, NMEM = 256, MMEM = NB * NMEM;
constexpr int MOE_SLOTS = 2 * MG + NEXP * 256;
constexpr float EPS = 1e-6f;
constexpr int NWAVES = 8, NTHR = 512;
constexpr int UC_CA = 0, UC_CG = 256, UC_POOL = 512, UC_SBQ = 768, UC_SBK = 1024, UC_SBV = 1280, UC_RQ = 1536, UC_RK = 1792, UC_RV = 2048, UC_RG = 2304;
constexpr int YC_CONV = 0, YC_POOL = 256, YC_SB = 512, YC_RET = 768;

constexpr size_t MiB = 1u << 20;
constexpr size_t WS_CTL = 0, CTL_ZERO_BYTES = 256 * 1024;
constexpr size_t WS_WCAT = 1 * MiB;
constexpr size_t WS_WB = 53 * MiB;
constexpr size_t WS_WOUT = 61 * MiB;
constexpr size_t WS_WQ = 69 * MiB;
constexpr size_t WS_WKV = 71 * MiB;
constexpr size_t WS_WO = 75 * MiB;
constexpr size_t WS_WGUD = 77 * MiB;
constexpr size_t WS_WDND = 99 * MiB;
constexpr size_t WS_WGUM = 110 * MiB;
constexpr size_t WS_WDNM = 286 * MiB;
constexpr size_t WS_ROT = 374 * MiB;
constexpr size_t WS_MEMH = 390 * MiB;
constexpr size_t WS_KV = 422 * MiB;
constexpr size_t WS_HB = 438 * MiB;
constexpr size_t WS_U = 502 * MiB;
constexpr size_t WS_GATES = 662 * MiB;
constexpr size_t WS_Y = 918 * MiB;
constexpr size_t WS_MERGED = 982 * MiB;
constexpr size_t WS_QB = 1046 * MiB;
constexpr size_t WS_OB = 1062 * MiB;
constexpr size_t WS_ROUTE = 1078 * MiB;
constexpr size_t WS_KVS = 1079 * MiB;
constexpr size_t WS_SSQ = 1087 * MiB;
constexpr size_t WS_XB8 = 1089 * MiB;
constexpr size_t WS_END = 1121 * MiB;
constexpr size_t WS_ACT = WS_U, WS_HP = WS_Y;
static_assert((size_t)MOE_SLOTS * DFF * 2 <= WS_Y - WS_U, "act overlay");
static_assert((size_t)MOE_SLOTS * D * 2 <= WS_ROUTE - WS_Y, "hp overlay");
constexpr int CW_TMO = 0, CW_CODE = 1;
constexpr int CW_BAR = 4096;
constexpr int CW_QCTR = 8192;
constexpr int CW_KMAX = 10240;
constexpr int CW_MOFF = 10752;
constexpr int CW_WGCNT = 16384;

constexpr int RING_BYTES = 131072;
constexpr int LDSCTL_OFF = RING_BYTES, MISC_OFF = LDSCTL_OFF + 320;
constexpr int LDS_BYTES = 147456;
constexpr int KS = 72, VS = 264;
constexpr int L_KS = 0, L_VT = 36864, L_KT = 70656, L_ST = 104448;

#define SHX(x, m, lane) __builtin_bit_cast(float, __builtin_amdgcn_ds_bpermute((((lane) ^ (m)) << 2), __builtin_bit_cast(int, (float)(x))))
DI float shx32(float x, int lane) { const auto r = __builtin_amdgcn_permlane32_swap(__builtin_bit_cast(unsigned, x), __builtin_bit_cast(unsigned, x), false, false); return __builtin_bit_cast(float, (lane & 32) ? r[0] : r[1]); }
DI float shx16(float x, int lane) { const auto r = __builtin_amdgcn_permlane16_swap(__builtin_bit_cast(unsigned, x), __builtin_bit_cast(unsigned, x), false, false); return __builtin_bit_cast(float, (lane & 16) ? r[0] : r[1]); }
DI float wave_sum(float v, int lane) {
#pragma unroll
    for (int o = 1; o < 64; o <<= 1) v += SHX(v, o, lane);
    return v;
}
DI unsigned cvtpk(float lo, float hi) { f32x2 v = {lo, hi}; bf16x2_t b = __builtin_convertvector(v, bf16x2_t); return __builtin_bit_cast(unsigned, b); }
DI float bflo(unsigned w) { return __uint_as_float(w << 16); }
DI float bfhi(unsigned w) { return __uint_as_float(w & 0xffff0000u); }
DI void unpack8(const u32x4 w, float (&f)[8]) { f[0] = bflo(w.x); f[1] = bfhi(w.x); f[2] = bflo(w.y); f[3] = bfhi(w.y); f[4] = bflo(w.z); f[5] = bfhi(w.z); f[6] = bflo(w.w); f[7] = bfhi(w.w); }
DI u32x4 pack8(const float (&f)[8]) { u32x4 w; w.x = cvtpk(f[0], f[1]); w.y = cvtpk(f[2], f[3]); w.z = cvtpk(f[4], f[5]); w.w = cvtpk(f[6], f[7]); return w; }
DI float sat8(float x) { return __builtin_amdgcn_fmed3f(x, -448.f, 448.f); }
DI unsigned cvt4_fp8(float a, float b, float c, float d) { int w = __builtin_amdgcn_cvt_pk_fp8_f32(sat8(a), sat8(b), 0, false); w = __builtin_amdgcn_cvt_pk_fp8_f32(sat8(c), sat8(d), w, true); return (unsigned)w; }
DI float fexp2(float x) { return __builtin_amdgcn_exp2f(x); }
DI float frcp(float x) { return __builtin_amdgcn_rcpf(x); }
DI float sigmoid_f(float x) { return frcp(1.f + fexp2(-1.44269504f * x)); }
DI int lane_id() { int l; asm volatile("v_mbcnt_lo_u32_b32 %0, -1, 0\n\tv_mbcnt_hi_u32_b32 %0, -1, %0" : "=v"(l)); return l; }
DI int crow(int reg, int h) { return (reg & 3) + 8 * (reg >> 2) + 4 * h; }
#define MFMA32(a, b, c) __builtin_amdgcn_mfma_f32_32x32x16_bf16((a), (b), (c), 0, 0, 0)

__device__ const float INV_FREQ[32] = {1.0f, 0.7498942017555237f, 0.5623413324356079f, 0.4216965138912201f, 0.3162277638912201f, 0.23713737726211548f, 0.17782793939113617f, 0.1333521455526352f,
    0.10000000149011612f, 0.0749894231557846f, 0.05623413249850273f, 0.04216964915394783f, 0.03162277489900589f, 0.023713737726211548f, 0.017782794311642647f, 0.013335213996469975f,
    0.009999999776482582f, 0.007498942315578461f, 0.005623413249850273f, 0.0042169648222625256f, 0.003162277629598975f, 0.0023713738191872835f, 0.0017782794311642647f, 0.0013335214462131262f,
    0.0010000000474974513f, 0.0007498941849917173f, 0.000562341301701963f, 0.0004216965171508491f, 0.0003162277571391314f, 0.00023713737027719617f, 0.00017782794020604342f, 0.0001333521504420787f};

namespace pg8 {
constexpr int BM = 256, BK = 64, HALF = 128, HTB = HALF * BK * 2, STAGE_BYTES = 8 * HTB, NXCD = 8, WGM = 8;
__host__ __device__ __forceinline__ int lds_byte(int r, int c) { const int st = (r >> 4) * 2 + (c >> 5), rr = r & 15, cc = c & 31, ob = rr * 64 + cc * 2; return st * 1024 + (ob ^ (((ob >> 9) & 1) << 5)); }
__host__ __device__ __forceinline__ void stage_rc(int b, int& R, int& C) { const int st = b / 1024, sb = b % 1024, swz = sb ^ (((sb >> 9) & 1) << 5); R = (st >> 1) * 16 + swz / 64; C = (st & 1) * 32 + (swz % 64) / 2; }
__host__ __device__ __forceinline__ int perm32(int rho) { const int n = rho >> 4, i = rho & 15; return 8 * (i >> 2) + 4 * n + (i & 3); }

struct Unit { int pm, pn, z; const char* a; const char* b; };
DI const char* uni(const char* p) { const unsigned long long v = (unsigned long long)p; const unsigned lo = __builtin_amdgcn_readfirstlane((unsigned)v), hi = __builtin_amdgcn_readfirstlane((unsigned)(v >> 32)); return (const char*)(((unsigned long long)hi << 32) | lo); }

struct TileOrder {
    int nM, nN, nwg, G, c;
    DI void init(int nM_, int nN_, int G_, int c_) { nM = nM_; nN = nN_; nwg = nM * nN; G = G_; c = c_; }
    DI bool tile(int i, int& pm, int& pn) const {
        const long L = (long)i * G + c; if (L >= nwg) return false;
        int wgid = (int)L; { const int q = nwg / NXCD, r = nwg % NXCD, xcd = wgid % NXCD, off = wgid / NXCD; wgid = (xcd < r ? xcd * (q + 1) : r * (q + 1) + (xcd - r) * q) + off; }
        const int nig = WGM * nN, gid = wgid / nig, fm = gid * WGM, gsz = (nM - fm) < WGM ? (nM - fm) : WGM;
        pm = fm + ((wgid % nig) % gsz); pn = (wgid % nig) / gsz; return true;
    }
};

template <class Epi, class Sched, bool F8 = false, bool HN = false>
DI void gemm_phase(LAS unsigned char* lds, const int K, const int lda, const Sched& S, const Epi& E, const int wid_in) {
    int wid = wid_in; asm volatile("" : "+s"(wid));
    int lane = lane_id(); asm volatile("" : "+v"(lane));
    const int tid = wid * 64 + lane, wr = wid >> 2, wc = wid & 3, fr = lane & 15, fq = lane >> 4;
    constexpr int ESZ = F8 ? 1 : 2; const int nt = (K * ESZ) / (BK * 2);
    unsigned voffA, voffB;
    { int R, C; stage_rc(tid * 16, R, C); const int Rb = Epi::PERM ? ((R & ~31) + perm32(R & 31)) : R;
      voffA = (unsigned)(R * lda * ESZ + C * 2); voffB = (unsigned)(Rb * K * ESZ + C * 2); }
    const size_t i1voffA = (size_t)64 * lda * ESZ, i1voffB = (size_t)64 * K * ESZ;
    const size_t kstep = (size_t)(BK * 2);
    const size_t hstepA = (size_t)HALF * lda * ESZ, hstepB = (size_t)HALF * K * ESZ;
    const unsigned ldsw = (unsigned)wid * 1024u;
    constexpr int PIECE = F8 ? 16 : 1024;
    const int aoff = lds_byte(wr * 64 + fr, F8 ? fq * 16 : fq * 8), boff = lds_byte(wc * 32 + fr, F8 ? fq * 16 : fq * 8);
#define PG8_SA(b, h) (((b) * 2 + (h)) * HTB)
#define PG8_SB(b, h) ((4 + (b) * 2 + (h)) * HTB)
#define PG8_STAGE(bufoff, gbase, voff) do { _Pragma("unroll") for (int _i = 0; _i < 2; ++_i) { asm volatile("" : "+v"(voff));     \
        __builtin_amdgcn_global_load_lds((const GAS unsigned*)((const GAS char*)(gbase) + (_i ? i1##voff : (size_t)0) + voff), (LAS unsigned*)(lds + (bufoff) + ldsw + _i * 8192), 16, 0, 0); } } while (0)
#define PG8_LD16(off) (*(const LAS u32x4*)(lds + (off)))
#define PG8_LD16B(off) (*(const LAS u32x4*)(ldsB + (off)))
#define PG8_SBR(b, h) (((b) * 2 + (h)) * HTB)
#define PG8_LDA(dst, b, h) do { _Pragma("unroll") for (int m = 0; m < 4; ++m) { if constexpr (F8) dst##8[m] = __builtin_bit_cast(i32x8, __builtin_shufflevector(PG8_LD16(PG8_SA(b, h) + aoff + m * 2048), PG8_LD16(PG8_SA(b, h) + aoff + PIECE + m * 2048), 0, 1, 2, 3, 4, 5, 6, 7)); \
        else { _Pragma("unroll") for (int k = 0; k < 2; ++k) dst[m][k] = *(const LAS bf16x8*)(lds + PG8_SA(b, h) + aoff + k * PIECE + m * 2048); } } } while (0)
#define PG8_LDB(dst, b, h) do { _Pragma("unroll") for (int n = 0; n < 2; ++n) { if constexpr (F8) dst##8[n] = __builtin_bit_cast(i32x8, __builtin_shufflevector(PG8_LD16B(PG8_SBR(b, h) + n * 2048), PG8_LD16B(PG8_SBR(b, h) + PIECE + n * 2048), 0, 1, 2, 3, 4, 5, 6, 7)); \
        else { _Pragma("unroll") for (int k = 0; k < 2; ++k) dst[n][k] = *(const LAS bf16x8*)(ldsB + PG8_SBR(b, h) + k * PIECE + n * 2048); } } } while (0)
#define PG8_MMA(ai, bj, At, Bt) do { if constexpr (HN && (bj) == 1) break; __builtin_amdgcn_s_setprio(1); _Pragma("unroll") for (int m = 0; m < 4; ++m) _Pragma("unroll") for (int n = 0; n < 2; ++n) { \
        if constexpr (F8) acc[ai][bj][m][n] = __builtin_amdgcn_mfma_scale_f32_16x16x128_f8f6f4(Bt##8[n], At##8[m], acc[ai][bj][m][n], 0, 0, 0, 0, 0, 0);     \
        else { _Pragma("unroll") for (int k = 0; k < 2; ++k) acc[ai][bj][m][n] = __builtin_amdgcn_mfma_f32_16x16x32_bf16(Bt[n][k], At[m][k], acc[ai][bj][m][n], 0, 0, 0); } } __builtin_amdgcn_s_setprio(0); } while (0)
#define PG8_WAIT_V(n) asm volatile("s_waitcnt vmcnt(" #n ")" ::: "memory")
#define PG8_WAIT_L(n) asm volatile("s_waitcnt lgkmcnt(" #n ")" ::: "memory")
#define PG8_BAR __builtin_amdgcn_s_barrier()
#define PG8_SCHED __builtin_amdgcn_sched_barrier(0)
    const LAS unsigned char* ldsB = lds + 4 * HTB + boff;
    Unit cur, nxt; int ui = 0;
    if (!S.next(0, cur)) return;
    typename Epi::State est;
    if constexpr (Epi::PRE) { int le = lane_id(); asm volatile("" : "+v"(le)); E.pre(est, cur, 0, wr, wc, le & 15, le >> 4); }
    f32x4 acc[2][2][4][2];
#pragma unroll
    for (int a = 0; a < 2; ++a)
#pragma unroll
        for (int b = 0; b < 2; ++b)
#pragma unroll
            for (int m = 0; m < 4; ++m)
#pragma unroll
                for (int n = 0; n < 2; ++n) acc[a][b][m][n] = (f32x4){0.f, 0.f, 0.f, 0.f};
    bf16x8 At[4][2], B0[2][2], B1[2][2]; i32x8 At8[4], B08[2], B18[2];
    const char* cA = cur.a; const char* cB = cur.b;
#define PG8_WAIT_K() do { if constexpr (HN) PG8_WAIT_V(6); else PG8_WAIT_V(8); } while (0)
    PG8_STAGE(PG8_SB(0, 0), cB, voffB); if constexpr (!HN) PG8_STAGE(PG8_SB(0, 1), cB + hstepB, voffB); PG8_STAGE(PG8_SA(0, 0), cA, voffA); PG8_STAGE(PG8_SA(0, 1), cA + hstepA, voffA);
    if (wr == 1) PG8_BAR;
    PG8_WAIT_V(2); PG8_BAR;
    PG8_STAGE(PG8_SB(1, 0), cB + kstep, voffB); PG8_STAGE(PG8_SA(1, 0), cA + kstep, voffA); if constexpr (!HN) PG8_STAGE(PG8_SB(1, 1), cB + hstepB + kstep, voffB);
    if constexpr (HN) PG8_WAIT_V(4); else PG8_WAIT_V(6);
    PG8_BAR;
    for (;;) {
        const bool has_next = S.next(ui + 1, nxt);
        const char* nA = has_next ? nxt.a : cA; const char* nB = has_next ? nxt.b : cB;
#pragma nounroll
        for (int t = 0; t < nt; t += 2) {
            const bool last = (t == nt - 2);
            const char* a1 = cA + (size_t)(t + 1) * kstep;
            const char* a2 = last ? nA : cA + (size_t)(t + 2) * kstep; const char* b2 = last ? nB : cB + (size_t)(t + 2) * kstep;
            asm volatile("" : "+s"(a1), "+s"(a2), "+s"(b2));
            const char* a3 = a2 + kstep; const char* b3 = b2 + kstep;
            PG8_LDB(B0, 0, 0); if constexpr (!HN) PG8_LDB(B1, 0, 1); PG8_SCHED; PG8_LDA(At, 0, 0); PG8_STAGE(PG8_SA(1, 1), a1 + hstepA, voffA);
            PG8_WAIT_K(); PG8_WAIT_L(0); PG8_BAR; PG8_MMA(0, 0, At, B0); PG8_MMA(0, 1, At, B1); PG8_BAR; PG8_SCHED;
            PG8_LDA(At, 0, 1); PG8_STAGE(PG8_SB(0, 0), b2, voffB); if constexpr (!HN) PG8_STAGE(PG8_SB(0, 1), b2 + hstepB, voffB); PG8_STAGE(PG8_SA(0, 0), a2, voffA);
            PG8_WAIT_K(); PG8_WAIT_L(0); PG8_BAR; PG8_MMA(1, 0, At, B0); PG8_MMA(1, 1, At, B1); PG8_BAR; PG8_SCHED;
            PG8_LDB(B0, 1, 0); if constexpr (!HN) PG8_LDB(B1, 1, 1); PG8_SCHED; PG8_LDA(At, 1, 0); PG8_STAGE(PG8_SA(0, 1), a2 + hstepA, voffA);
            PG8_WAIT_K(); PG8_WAIT_L(0); PG8_BAR; PG8_MMA(0, 0, At, B0); PG8_MMA(0, 1, At, B1); PG8_BAR; PG8_SCHED;
            PG8_LDA(At, 1, 1); PG8_STAGE(PG8_SB(1, 0), b3, voffB); if constexpr (!HN) PG8_STAGE(PG8_SB(1, 1), b3 + hstepB, voffB); PG8_STAGE(PG8_SA(1, 0), a3, voffA);
            PG8_WAIT_K(); PG8_WAIT_L(0); PG8_BAR; PG8_MMA(1, 0, At, B0); PG8_MMA(1, 1, At, B1); PG8_BAR; PG8_SCHED;
            if constexpr (Epi::KHOOK) { if ((t & 3) == 2 && !last) { int le = lane_id(); asm volatile("" : "+v"(le)); E.khook(acc, cur, t >> 2, wr, wc, le & 15, le >> 4, est); } }
        }
        if (wr == 0) PG8_BAR;
        { int le = lane_id(); asm volatile("" : "+v"(le));
          if constexpr (Epi::PRE) { E(acc, cur, wr, wc, le & 15, le >> 4, est); if (has_next) E.pre(est, nxt, 0, wr, wc, le & 15, le >> 4); }
          else E(acc, cur, wr, wc, le & 15, le >> 4); }
        if (!has_next) break;
#pragma unroll
        for (int a = 0; a < 2; ++a)
#pragma unroll
            for (int b = 0; b < (HN ? 1 : 2); ++b)
#pragma unroll
                for (int m = 0; m < 4; ++m)
#pragma unroll
                    for (int n = 0; n < 2; ++n) acc[a][b][m][n] = (f32x4){0.f, 0.f, 0.f, 0.f};
        cur = nxt; cA = nA; cB = nB; ++ui;
        if (wr == 1) PG8_BAR;
    }
    PG8_WAIT_V(0);
    PG8_BAR;
#undef PG8_SA
#undef PG8_SB
#undef PG8_STAGE
#undef PG8_LDA
#undef PG8_LDB
#undef PG8_MMA
#undef PG8_LD16
#undef PG8_LD16B
#undef PG8_SBR
#undef PG8_WAIT_V
#undef PG8_WAIT_K
#undef PG8_WAIT_L
#undef PG8_BAR
#undef PG8_SCHED
}

struct OrdStd {
    TileOrder to; const char* A; const char* B; size_t atile, btile;
    DI bool next(int i, Unit& u) const { if (!to.tile(i, u.pm, u.pn)) return false; u.z = 0; u.a = A + (size_t)u.pm * atile; u.b = B + (size_t)u.pn * btile; return true; }
};
struct OrdKV {
    TileOrder to; const char* A; const char* B;
    DI bool next(int i, Unit& u) const { if (!to.tile(i, u.pm, u.pn)) return false; const int l = u.pm >> 4; u.z = l; u.a = A + (size_t)u.pm * (256 * 1024 * 2); u.b = B + (size_t)l * (512 * 1024 * 2) + (size_t)u.pn * (256 * 1024 * 2); return true; }
};
struct OrdMerge {
    int G, c, ntiles; const char* A; const char* B;
    DI bool next(int i, Unit& u) const { const int tl = i * G + c; if (tl >= ntiles) return false; u.z = 0; u.pm = tl >> 3; u.pn = tl & 7;
        u.a = A + (size_t)u.pm * (256 * 1024 * 2); u.b = B + (size_t)u.pn * (128 * 1024 * 2); return true; }
};
struct OrdMoe {
    TileOrder to; const char* A; const char* B; size_t atile, btile, bexp; int off[9];
    DI bool next(int i, Unit& u) const { if (!to.tile(i, u.pm, u.pn)) return false; const int r0 = u.pm * 256; int e = 0;
#pragma unroll
        for (int k = 1; k < 8; ++k) e += (r0 >= off[k]) ? 1 : 0;
        u.z = e; u.a = uni(A + (size_t)u.pm * atile); u.b = uni(B + (size_t)e * bexp + (size_t)u.pn * btile); return true; }
};

DI float row_rstd(const float* ssq, size_t row, int fq, int lane) {
    const f32x4 a = *(const f32x4*)(ssq + row * 16 + 4 * fq); float s = (a.x + a.y) + (a.z + a.w); s += shx16(s, lane); s += shx32(s, lane); return 1.f / sqrtf(s * (1.f / D) + EPS); }
template <bool G8> struct EpiCat {
    static constexpr bool PERM = true; static constexpr bool PRE = false; static constexpr bool KHOOK = false; struct State {};
    bf16* U; bf16* Gt; const float* ssq;
    DI void operator()(const f32x4 (&acc)[2][2][4][2], const Unit& u, int wr, int wc, int fr, int fq) const {
        const bool isg = G8 || u.pn >= 10; bf16* base = isg ? Gt : U; const int ldc = isg ? 4096 : DIN; const int colt = G8 ? u.pn * 256 : (isg ? (u.pn - 10) * 256 : u.pn * 256);
        const int row0 = u.pm * BM + wr * 64 + fr, col0 = colt + wc * 32 + 8 * fq;
#pragma unroll
        for (int ai = 0; ai < 2; ++ai)
#pragma unroll
            for (int m = 0; m < 4; ++m) { const size_t row = (size_t)(row0 + ai * HALF + m * 16); bf16* rowp = base + row * ldc + col0; const float rs = row_rstd(ssq, row, fq, fr + 16 * fq) * (G8 ? W8_INV : 1.f);
#pragma unroll
                for (int bj = 0; bj < 2; ++bj) { f32x4 v0 = acc[ai][bj][m][0] * rs, v1 = acc[ai][bj][m][1] * rs;
                    if (isg) {
#pragma unroll
                        for (int j = 0; j < 4; ++j) { v0[j] = sigmoid_f(v0[j]); v1[j] = sigmoid_f(v1[j]); } }
                    u32x4 w; w.x = cvtpk(v0[0], v0[1]); w.y = cvtpk(v0[2], v0[3]); w.z = cvtpk(v1[0], v1[1]); w.w = cvtpk(v1[2], v1[3]);
                    *(u32x4*)(rowp + bj * HALF) = w; } }
    }
};
template <bool S8> struct EpiBf16 {
    static constexpr bool PERM = true; static constexpr bool PRE = false; static constexpr bool KHOOK = false; struct State {}; static constexpr float sc = S8 ? W8_INV : 1.f;
    bf16* O; int ldc; const float* ssq;
    DI void operator()(const f32x4 (&acc)[2][2][4][2], const Unit& u, int wr, int wc, int fr, int fq) const {
        const int row0 = u.pm * BM + wr * 64 + fr, col0 = u.pn * BM + wc * 32 + 8 * fq;
#pragma unroll
        for (int ai = 0; ai < 2; ++ai)
#pragma unroll
            for (int m = 0; m < 4; ++m) { const size_t row = (size_t)(row0 + ai * HALF + m * 16); bf16* rowp = O + row * ldc + col0; const float s2 = ssq ? sc * row_rstd(ssq, row, fq, fr + 16 * fq) : sc;
#pragma unroll
                for (int bj = 0; bj < 2; ++bj) { const f32x4 v0 = acc[ai][bj][m][0] * s2, v1 = acc[ai][bj][m][1] * s2;
                    u32x4 w; w.x = cvtpk(v0[0], v0[1]); w.y = cvtpk(v0[2], v0[3]); w.z = cvtpk(v1[0], v1[1]); w.w = cvtpk(v1[2], v1[3]);
                    *(u32x4*)(rowp + bj * HALF) = w; } }
    }
};
struct EpiMerge {
    static constexpr bool PERM = true; static constexpr bool PRE = true; static constexpr bool KHOOK = true; struct State { u32x4 gw[2][4]; };
    const bf16* Gt; bf16* Mg;
    DI void pre(State& st, const Unit& u, int z, int wr, int wc, int fr, int fq) const {
        const int row0 = u.pm * BM + wr * 64 + fr, col0 = u.pn * HALF + wc * 32 + 8 * fq;
#pragma unroll
        for (int ai = 0; ai < 2; ++ai)
#pragma unroll
            for (int m = 0; m < 4; ++m) st.gw[ai][m] = *(const u32x4*)(Gt + (size_t)(row0 + ai * HALF + m * 16) * 4096 + z * 1024 + col0);
    }
    template <bool FIRST, bool LAST> DI void gate(f32x4 (&acc)[2][2][4][2], const Unit& u, int wr, int wc, int fr, int fq, State& st) const {
        const int row0 = u.pm * BM + wr * 64 + fr, col0 = u.pn * HALF + wc * 32 + 8 * fq;
#pragma unroll
        for (int ai = 0; ai < 2; ++ai)
#pragma unroll
            for (int m = 0; m < 4; ++m) { float g[8]; unpack8(st.gw[ai][m], g); const f32x4 v0 = acc[ai][0][m][0], v1 = acc[ai][0][m][1];
                f32x4 t0 = (f32x4){g[0] * v0[0], g[1] * v0[1], g[2] * v0[2], g[3] * v0[3]}, t1 = (f32x4){g[4] * v1[0], g[5] * v1[1], g[6] * v1[2], g[7] * v1[3]};
                if (!FIRST) { t0 += acc[ai][1][m][0]; t1 += acc[ai][1][m][1]; }
                acc[ai][1][m][0] = t0; acc[ai][1][m][1] = t1; acc[ai][0][m][0] = (f32x4){0.f, 0.f, 0.f, 0.f}; acc[ai][0][m][1] = (f32x4){0.f, 0.f, 0.f, 0.f};
                if (LAST) { u32x4 w; w.x = cvtpk(t0[0], t0[1]); w.y = cvtpk(t0[2], t0[3]); w.z = cvtpk(t1[0], t1[1]); w.w = cvtpk(t1[2], t1[3]);
                    *(u32x4*)(Mg + (size_t)(row0 + ai * HALF + m * 16) * 1024 + col0) = w; } }
    }
    DI void khook(f32x4 (&acc)[2][2][4][2], const Unit& u, int z, int wr, int wc, int fr, int fq, State& st) const {
        if (z == 0) gate<true, false>(acc, u, wr, wc, fr, fq, st); else gate<false, false>(acc, u, wr, wc, fr, fq, st);
        pre(st, u, z + 1, wr, wc, fr, fq);
    }
    DI void operator()(f32x4 (&acc)[2][2][4][2], const Unit& u, int wr, int wc, int fr, int fq, State& st) const { gate<false, true>(acc, u, wr, wc, fr, fq, st); }
};
template <bool XB, bool S8> struct EpiRes {
    static constexpr bool PERM = true; static constexpr bool PRE = false; static constexpr bool KHOOK = false; struct State {};
    static constexpr float sc = S8 ? W8_INV : 1.f;
    static constexpr int MB = S8 ? 1 : 2;
    const float* base; float* out; int xbm; void* xb; float* ssq; unsigned char* xb8;
    DI void operator()(const f32x4 (&acc)[2][2][4][2], const Unit& u, int wr, int wc, int fr, int fq) const {
        const int row0 = u.pm * BM + wr * 64 + fr, col0 = u.pn * BM + wc * 32 + 8 * fq, lane = fr + 16 * fq;
#pragma unroll
        for (int ai = 0; ai < 2; ++ai)
#pragma unroll
            for (int m0 = 0; m0 < 4; m0 += MB) {
                f32x4 bsv[MB][2][2];
#pragma unroll
                for (int mm = 0; mm < MB; ++mm)
#pragma unroll
                    for (int bj = 0; bj < 2; ++bj) { const size_t off = (size_t)(row0 + ai * HALF + (m0 + mm) * 16) * D + col0 + bj * HALF; bsv[mm][bj][0] = *(const f32x4*)(base + off); bsv[mm][bj][1] = *(const f32x4*)(base + off + 4); }
#pragma unroll
                for (int mm = 0; mm < MB; ++mm) { const int m = m0 + mm; const size_t row = (size_t)(row0 + ai * HALF + m * 16), off = row * D + col0; float s = 0.f;
#pragma unroll
                    for (int bj = 0; bj < 2; ++bj) {
                        const f32x4 v0 = bsv[mm][bj][0] + acc[ai][bj][m][0] * sc, v1 = bsv[mm][bj][1] + acc[ai][bj][m][1] * sc;
                        *(f32x4*)(out + off + bj * HALF) = v0; *(f32x4*)(out + off + bj * HALF + 4) = v1;
                        if constexpr (XB) { s += ((v0.x * v0.x + v0.y * v0.y) + (v0.z * v0.z + v0.w * v0.w)) + ((v1.x * v1.x + v1.y * v1.y) + (v1.z * v1.z + v1.w * v1.w));
                            if (xbm & 1) { u32x4 w; w.x = cvtpk(v0.x, v0.y); w.y = cvtpk(v0.z, v0.w); w.z = cvtpk(v1.x, v1.y); w.w = cvtpk(v1.z, v1.w); *(u32x4*)((bf16*)xb + off + bj * HALF) = w; }
                            if (xbm & 2) { u32x2 w; w.x = cvt4_fp8(v0.x, v0.y, v0.z, v0.w); w.y = cvt4_fp8(v1.x, v1.y, v1.z, v1.w); *(u32x2*)(xb8 + off + bj * HALF) = w; } } }
                    if constexpr (XB) { s += shx16(s, lane); s += shx32(s, lane); if (xbm != 0 && fq == 0) ssq[row * 16 + u.pn * 4 + wc] = s; } }
                asm volatile("" ::: "memory"); }
    }
};
template <bool F8O> struct EpiGU {
    static constexpr bool PERM = true; static constexpr bool PRE = false; static constexpr bool KHOOK = false; struct State {};
    static constexpr float sc = F8O ? W8_INV : 1.f;
    void* O; const float* ssq;
    DI void operator()(const f32x4 (&acc)[2][2][4][2], const Unit& u, int wr, int wc, int fr, int fq) const {
        const int row0 = u.pm * BM + wr * 64 + fr, col0 = u.pn * HALF + wc * 32 + 8 * fq;
#pragma unroll
        for (int ai = 0; ai < 2; ++ai)
#pragma unroll
            for (int m = 0; m < 4; ++m) { const size_t row = (size_t)(row0 + ai * HALF + m * 16), eo = row * DFF + col0; const float s2 = ssq ? sc * row_rstd(ssq, row, fq, fr + 16 * fq) : sc;
                float r[8];
#pragma unroll
                for (int n = 0; n < 2; ++n)
#pragma unroll
                    for (int j = 0; j < 4; ++j) { const float g = acc[ai][0][m][n][j] * s2, uu = acc[ai][1][m][n][j] * s2; r[4 * n + j] = g * sigmoid_f(g) * uu; }
                if constexpr (F8O) { u32x2 w; w.x = cvt4_fp8(r[0], r[1], r[2], r[3]); w.y = cvt4_fp8(r[4], r[5], r[6], r[7]); *(u32x2*)((unsigned char*)O + eo) = w; }
                else *(u32x4*)((bf16*)O + eo) = pack8(r); }
    }
};
}

#define XB_TMO      128
#define XB_XCNT(j)  (256  + 64 * (j))
#define XB_XSUB(j)  (1280 + 64 * (j))
#define XB_XGEN(j)  (2304 + 64 * (j))
#define XB_TOP      3328
#define XB_TOPGEN   3392
#define XCD_BAR_WORDS 3456
#define XB_SPIN_CAP (1u << 22)
DI unsigned xb_ld(unsigned* p)              { return __hip_atomic_load(p, __ATOMIC_RELAXED, __HIP_MEMORY_SCOPE_AGENT); }
DI unsigned xb_add(unsigned* p, unsigned v) { return __hip_atomic_fetch_add(p, v, __ATOMIC_RELAXED, __HIP_MEMORY_SCOPE_AGENT); }
DI unsigned xb_xcc_id() { return (unsigned)__builtin_amdgcn_s_getreg((3 << 11) | 20) & 0xFu; }
#define XB_SPIN(cond, bar) do { unsigned _sp = 0; while (cond) { __builtin_amdgcn_s_sleep(1); \
    if ((++_sp & 255u) == 0u) { if (xb_ld(&(bar)[XB_TMO])) break; if (_sp > XB_SPIN_CAP) { atomicAdd(&(bar)[XB_TMO], 1u); break; } } } } while (0)
struct XcdBarrier { unsigned* bar; unsigned x; volatile LAS unsigned* st; };
DI XcdBarrier xcd_barrier_post(unsigned* bar, volatile LAS unsigned* st) {
    XcdBarrier b; b.bar = bar; b.x = xb_xcc_id(); b.st = st;
    if (threadIdx.x == 0) (void)xb_add(&bar[XB_XCNT(b.x)], 1u);
    return b;
}
DI void xcd_barrier_complete(unsigned* bar, unsigned x, unsigned& nloc, unsigned& nx) {
    const unsigned G = gridDim.x * gridDim.y * gridDim.z;
    unsigned sum, cnt, mine, sp = 0u;
    for (;;) {
        sum = 0u; cnt = 0u; mine = 0u;
#pragma unroll
        for (unsigned j = 0; j < 16; ++j) { const unsigned c = xb_ld(&bar[XB_XCNT(j)]); sum += c; cnt += (c > 0u) ? 1u : 0u; mine = (j == x) ? c : mine; }
        if (sum == G) break;
        __builtin_amdgcn_s_sleep(1);
        if ((++sp & 255u) == 0u) { if (xb_ld(&bar[XB_TMO])) break; if (sp > XB_SPIN_CAP) { atomicAdd(&bar[XB_TMO], 1u); break; } }
    }
    nloc = mine > 0u ? mine : 1u; nx = cnt > 0u ? cnt : 1u;
}
__device__ __noinline__ void xcd_barrier_fn(GAS unsigned* gbar, unsigned bx, volatile LAS unsigned* bst, int wave) {
    XcdBarrier b; b.bar = (unsigned*)gbar; b.x = bx; b.st = bst; const bool t0 = (wave == 0) && (lane_id() == 0);
    asm volatile("s_waitcnt vmcnt(0)" ::: "memory");
    __syncthreads();
    if (t0) {
        unsigned* bar = b.bar;
        __builtin_amdgcn_s_waitcnt(0);
        unsigned nloc = b.st[0], nx = b.st[1];
        if (nloc == 0u) { xcd_barrier_complete(bar, b.x, nloc, nx); b.st[0] = nloc; b.st[1] = nx; }
        const unsigned old = xb_add(&bar[XB_XSUB(b.x)], 1u);
        const unsigned gen = old / nloc;
        if (old + 1u == (gen + 1u) * nloc) {
            __builtin_amdgcn_fence(__ATOMIC_RELEASE, "agent");
            asm volatile("s_waitcnt vmcnt(0)" ::: "memory");
            const unsigned og = xb_add(&bar[XB_TOP], 1u);
            const unsigned tg = og / nx;
            if (og + 1u == (tg + 1u) * nx) xb_add(&bar[XB_TOPGEN], 1u);
            else XB_SPIN(xb_ld(&bar[XB_TOPGEN]) == tg, bar);
            __builtin_amdgcn_fence(__ATOMIC_ACQUIRE, "agent");
            xb_add(&bar[XB_XGEN(b.x)], 1u);
            asm volatile("s_waitcnt vmcnt(0)" ::: "memory");
        } else {
            XB_SPIN(xb_ld(&bar[XB_XGEN(b.x)]) == gen, bar);
            __builtin_amdgcn_fence(__ATOMIC_ACQUIRE, "agent");
            asm volatile("s_waitcnt vmcnt(0)" ::: "memory");
        }
    }
    __syncthreads();
}

template <bool F8>
DI void tr_item_t(const float* W, int ldw, int k0, int n0, void* WT, int ldwt, int drow0, LAS float* scr, int lane, const float* gain) {
    const int c4 = 4 * (lane & 7), r8 = lane >> 3;
#pragma unroll
    for (int i = 0; i < 8; ++i) { const int kk = r8 + 8 * i; const f32x4 v = *(const f32x4*)(W + (size_t)(k0 + kk) * ldw + n0 + c4);
        LAS float* d = scr + kk * 33 + c4; d[0] = v.x; d[1] = v.y; d[2] = v.z; d[3] = v.w; }
    asm volatile("s_waitcnt lgkmcnt(0)" ::: "memory");
    const int c = lane & 7;
    float gs[8];
    if (gain) { const f32x4 g0 = *(const f32x4*)(gain + k0 + 8 * c), g1 = *(const f32x4*)(gain + k0 + 8 * c + 4); gs[0] = g0.x; gs[1] = g0.y; gs[2] = g0.z; gs[3] = g0.w; gs[4] = g1.x; gs[5] = g1.y; gs[6] = g1.z; gs[7] = g1.w; }
    else {
#pragma unroll
        for (int i = 0; i < 8; ++i) gs[i] = 1.f; }
    if (F8) {
#pragma unroll
        for (int i = 0; i < 8; ++i) gs[i] *= W8_SCALE; }
#pragma unroll
    for (int j = 0; j < 4; ++j) { const int n = (lane >> 3) + 8 * j; const LAS float* s = scr + (8 * c) * 33 + n;
        if (F8) { u32x2 o; o.x = cvt4_fp8(s[0 * 33] * gs[0], s[1 * 33] * gs[1], s[2 * 33] * gs[2], s[3 * 33] * gs[3]); o.y = cvt4_fp8(s[4 * 33] * gs[4], s[5 * 33] * gs[5], s[6 * 33] * gs[6], s[7 * 33] * gs[7]);
            *(u32x2*)((unsigned char*)WT + (size_t)(drow0 + n) * ldwt + k0 + 8 * c) = o; }
        else { u32x4 o; o.x = cvtpk(s[0 * 33] * gs[0], s[1 * 33] * gs[1]); o.y = cvtpk(s[2 * 33] * gs[2], s[3 * 33] * gs[3]); o.z = cvtpk(s[4 * 33] * gs[4], s[5 * 33] * gs[5]); o.w = cvtpk(s[6 * 33] * gs[6], s[7 * 33] * gs[7]);
            *(u32x4*)((bf16*)WT + (size_t)(drow0 + n) * ldwt + k0 + 8 * c) = o; } }
    asm volatile("s_waitcnt lgkmcnt(0)" ::: "memory");
}
DI int gu_row(int n) { return n < DFF ? (n >> 7) * 256 + (n & 127) : ((n - DFF) >> 7) * 256 + 128 + ((n - DFF) & 127); }
template <bool F8 = false>
DI void tr_matrix(unsigned& ibase, const float* W, int K, int N, void* WT, int row_off, int gu, LAS float* scr, int gw, int NGW, int lane, const float* gain = nullptr, int ldwt = 0) {
    const int nblk = N >> 5, nit = (K >> 6) * nblk; const int first = (int)(((unsigned)gw + (unsigned)NGW - ibase % (unsigned)NGW) % (unsigned)NGW); ibase += (unsigned)nit;
    for (int it = first; it < nit; it += NGW) { const int kb = it / nblk, nb = it - kb * nblk, n0 = nb * 32;
        tr_item_t<F8>(W, N, kb * 64, n0, WT, ldwt ? ldwt : K, gu ? gu_row(n0) : row_off + n0, scr, lane, gain); }
}
DI void rms_row_bf16(const float* xrow, const float* gain, bf16* orow, int lane) {
    const f32x4* xr = (const f32x4*)xrow + lane; const f32x4* gr = (const f32x4*)gain + lane;
    f32x4 v[4]; float s = 0.f;
#pragma unroll
    for (int j = 0; j < 4; ++j) { v[j] = xr[64 * j]; s += (v[j].x * v[j].x + v[j].y * v[j].y) + (v[j].z * v[j].z + v[j].w * v[j].w); }
    const float rstd = 1.f / sqrtf(wave_sum(s, lane) * (1.f / D) + EPS);
    u32x2* o8 = (u32x2*)orow + lane;
#pragma unroll
    for (int j = 0; j < 4; ++j) { const f32x4 g = gr[64 * j]; u32x2 w; w.x = cvtpk(v[j].x * rstd * g.x, v[j].y * rstd * g.y); w.y = cvtpk(v[j].z * rstd * g.z, v[j].w * rstd * g.w); o8[64 * j] = w; }
}

DI void rms_row_fp8(const float* xrow, const float* gain, unsigned char* orow, int lane) {
    const f32x4* xr = (const f32x4*)xrow + lane; const f32x4* gr = (const f32x4*)gain + lane;
    f32x4 v[4]; float s = 0.f;
#pragma unroll
    for (int j = 0; j < 4; ++j) { v[j] = xr[64 * j]; s += (v[j].x * v[j].x + v[j].y * v[j].y) + (v[j].z * v[j].z + v[j].w * v[j].w); }
    const float rstd = 1.f / sqrtf(wave_sum(s, lane) * (1.f / D) + EPS);
    unsigned* o4 = (unsigned*)orow + lane;
#pragma unroll
    for (int j = 0; j < 4; ++j) { const f32x4 g = gr[64 * j]; o4[64 * j] = cvt4_fp8(v[j].x * rstd * g.x, v[j].y * rstd * g.y, v[j].z * rstd * g.z, v[j].w * rstd * g.w); }
}

struct KVStage { u32x4 k[4], v[4]; };
DI void kv_load(KVStage& st, const bf16* Kp, int kpitch, const bf16* Vp, int vpitch, int tid) {
#pragma unroll
    for (int i = 0; i < 4; ++i) { const int id = tid + 512 * i, row = id >> 3, c8 = id & 7;
        st.k[i] = *(const u32x4*)(Kp + (size_t)row * kpitch + 8 * c8); st.v[i] = *(const u32x4*)(Vp + (size_t)row * vpitch + 8 * c8); }
}
DI void kv_write(const KVStage& st, LAS bf16* Ksm, LAS bf16* Vtm, int tid) {
#pragma unroll
    for (int i = 0; i < 4; ++i) { const int id = tid + 512 * i, row = id >> 3, c8 = id & 7;
        *(LAS u32x4*)(Ksm + row * KS + 8 * c8) = st.k[i];
        const unsigned w0 = st.v[i].x, w1 = st.v[i].y, w2 = st.v[i].z, w3 = st.v[i].w;
        LAS bf16* vp = Vtm + (8 * c8) * VS + row;
        vp[0 * VS] = (bf16)(w0 & 0xffffu); vp[1 * VS] = (bf16)(w0 >> 16); vp[2 * VS] = (bf16)(w1 & 0xffffu); vp[3 * VS] = (bf16)(w1 >> 16);
        vp[4 * VS] = (bf16)(w2 & 0xffffu); vp[5 * VS] = (bf16)(w2 >> 16); vp[6 * VS] = (bf16)(w3 & 0xffffu); vp[7 * VS] = (bf16)(w3 >> 16); }
}
DI void qk_subtile(const LAS bf16* Ksm, int ktl, const bf16x8 (&qf)[4], int r, int h, f32x16& z0, f32x16& z1) {
#pragma unroll
    for (int i = 0; i < 16; ++i) { z0[i] = 0.f; z1[i] = 0.f; }
#pragma unroll
    for (int s = 0; s < 4; ++s) {
        const bf16x8 k0 = *(const LAS bf16x8*)(Ksm + (64 * ktl + r) * KS + 16 * s + 8 * h);
        const bf16x8 k1 = *(const LAS bf16x8*)(Ksm + (64 * ktl + 32 + r) * KS + 16 * s + 8 * h);
        z0 = MFMA32(k0, qf[s], z0); z1 = MFMA32(k1, qf[s], z1); }
}
template <int ST> DI bf16x8 pack_step(const f32x16& x) {
    u32x4 p; p.x = cvtpk(x[8 * ST + 0], x[8 * ST + 1]); p.y = cvtpk(x[8 * ST + 2], x[8 * ST + 3]); p.z = cvtpk(x[8 * ST + 4], x[8 * ST + 5]); p.w = cvtpk(x[8 * ST + 6], x[8 * ST + 7]);
    return __builtin_bit_cast(bf16x8, p);
}
DI void pv_subtile(const LAS bf16* Vtm, int ktl, const f32x16& p0, const f32x16& p1, int r, int h, f32x16 (&o)[2]) {
    const bf16x8 pf[4] = {pack_step<0>(p0), pack_step<1>(p0), pack_step<0>(p1), pack_step<1>(p1)};
#pragma unroll
    for (int ts = 0; ts < 4; ++ts) {
#pragma unroll
        for (int dt = 0; dt < 2; ++dt) {
            const LAS bf16* vp = Vtm + (32 * dt + r) * VS + 64 * ktl + 16 * ts + 4 * h;
            const s16x4 lo = *(const LAS s16x4*)vp, hi = *(const LAS s16x4*)(vp + 8);
            const bf16x8 vf = __builtin_shufflevector(lo, hi, 0, 1, 2, 3, 4, 5, 6, 7);
            o[dt] = MFMA32(vf, pf[ts], o[dt]); } }
}
template <int T, int GI> DI void sb_group(f32x16& z, float& c, int h, bool need_mask, int krel, int lane) {
    float s[4], m[4];
#pragma unroll
    for (int i = 0; i < 4; ++i) { const float e = fexp2(fminf(-z[4 * GI + i], 126.f)); s[i] = frcp(1.f + e); m[i] = e * s[i];
        if (need_mask) { const bool ok = (krel + 32 * T + 8 * GI + 4 * h + i) < 0; s[i] = ok ? s[i] : 0.f; m[i] = ok ? m[i] : 1.f; } }
    const float w2 = m[3], w1 = m[3] * m[2], w0 = w1 * m[1], Gm = w0 * m[0];
    const float Gp = shx32(Gm, lane);
    const float mc = h ? c : c * Gp;
    z[4 * GI + 3] = s[3] * mc; z[4 * GI + 2] = s[2] * w2 * mc; z[4 * GI + 1] = s[1] * w1 * mc; z[4 * GI + 0] = s[0] * w0 * mc;
    c *= Gm * Gp;
}
DI void sb_transform(f32x16& z0, f32x16& z1, float& c, int h, bool need_mask, int krel, int lane) {
    sb_group<1, 3>(z1, c, h, need_mask, krel, lane); sb_group<1, 2>(z1, c, h, need_mask, krel, lane); sb_group<1, 1>(z1, c, h, need_mask, krel, lane); sb_group<1, 0>(z1, c, h, need_mask, krel, lane);
    sb_group<0, 3>(z0, c, h, need_mask, krel, lane); sb_group<0, 2>(z0, c, h, need_mask, krel, lane); sb_group<0, 1>(z0, c, h, need_mask, krel, lane); sb_group<0, 0>(z0, c, h, need_mask, krel, lane);
}
DI void store_ot(const f32x16 (&o)[2], bf16* orow, int h, float sc) {
#pragma unroll
    for (int dt = 0; dt < 2; ++dt)
#pragma unroll
        for (int g = 0; g < 4; ++g) { u32x2 w; w.x = cvtpk(o[dt][4 * g] * sc, o[dt][4 * g + 1] * sc); w.y = cvtpk(o[dt][4 * g + 2] * sc, o[dt][4 * g + 3] * sc);
            *(u32x2*)(orow + 32 * dt + 8 * g + 4 * h) = w; }
}

DI void sb_unit(const bf16* U, bf16* Y, int bl, int hd, int qb, LAS unsigned char* lds, int tid, int wave, int lane) {
    LAS bf16* Ksm = (LAS bf16*)(lds + L_KS); LAS bf16* Vtm = (LAS bf16*)(lds + L_VT);
    const int r = lane & 31, h = lane >> 5;
    const size_t tok0 = (size_t)bl * SEQ; const int tq = qb * 256 + 32 * wave + r;
    bf16x8 qf[4];
    { const bf16* qrow = U + (tok0 + tq) * DIN + UC_SBQ + 64 * hd;
#pragma unroll
      for (int s = 0; s < 4; ++s) { const u32x4 w = *(const u32x4*)(qrow + 16 * s + 8 * h); float f[8]; unpack8(w, f);
#pragma unroll
          for (int j = 0; j < 8; ++j) f[j] *= (0.125f * 1.44269504f);
          qf[s] = __builtin_bit_cast(bf16x8, pack8(f)); } }
    f32x16 o[2];
#pragma unroll
    for (int i = 0; i < 16; ++i) { o[0][i] = 0.f; o[1][i] = 0.f; }
    float c = 1.f;
    const bf16* Kb = U + tok0 * DIN + UC_SBK + 64 * hd; const bf16* Vb = U + tok0 * DIN + UC_SBV + 64 * hd;
    KVStage st; kv_load(st, Kb + (size_t)(256 * qb) * DIN, DIN, Vb + (size_t)(256 * qb) * DIN, DIN, tid);
    for (int kb = qb; kb >= 0; --kb) {
        { volatile LAS unsigned* fl = (volatile LAS unsigned*)(lds + MISC_OFF) + 2;
          if (lane == 0 && __builtin_amdgcn_ballot_w64(c != 0.f) != 0ull) fl[kb & 1] = 1u;
          __syncthreads();
          const unsigned live = fl[kb & 1];
          if (tid == 0) fl[(kb + 1) & 1] = 0u;
          if (live == 0u) break; }
        kv_write(st, Ksm, Vtm, tid);
        __syncthreads();
        if (kb > 0) kv_load(st, Kb + (size_t)(256 * (kb - 1)) * DIN, DIN, Vb + (size_t)(256 * (kb - 1)) * DIN, DIN, tid);
        const bool diag = (kb == qb);
        const int khi = diag ? ((32 * wave + 31) >> 6) : 3;
        for (int ktl = khi; ktl >= 0; --ktl) {
            if (__builtin_amdgcn_ballot_w64(c != 0.f) == 0ull) break;
            f32x16 z0, z1; qk_subtile(Ksm, ktl, qf, r, h, z0, z1);
            const bool need_mask = diag && (64 * ktl + 63 >= 32 * wave);
            sb_transform(z0, z1, c, h, need_mask, 256 * kb + 64 * ktl - tq, lane);
            pv_subtile(Vtm, ktl, z0, z1, r, h, o);
        }
    }
    store_ot(o, Y + (tok0 + tq) * D + YC_SB + 64 * hd, h, 1.f);
}

DI void xa_unit(const bf16* QB, const bf16* kvl, const float* gq, float kmax, bf16* OB, int bl, int bglob, int hd, int qblk, LAS unsigned char* lds, int tid, int wave, int lane) {
    LAS bf16* Ksm = (LAS bf16*)(lds + L_KS); LAS bf16* Vtm = (LAS bf16*)(lds + L_VT);
    const int r = lane & 31, h = lane >> 5;
    const size_t row = (size_t)bl * SEQ + qblk * 256 + 32 * wave + r;
    __syncthreads();
    { KVStage st; const bf16* Kp = kvl + (size_t)bglob * NMEM * 512 + 64 * hd; kv_load(st, Kp, 512, Kp + 256, 512, tid); kv_write(st, Ksm, Vtm, tid); }
    float qv[4][8]; float ss = 0.f;
    { const bf16* qrow = QB + row * 256 + 64 * hd;
#pragma unroll
      for (int s = 0; s < 4; ++s) { const u32x4 w = *(const u32x4*)(qrow + 16 * s + 8 * h); unpack8(w, qv[s]);
#pragma unroll
          for (int j = 0; j < 8; ++j) ss += qv[s][j] * qv[s][j]; } }
    ss += shx32(ss, lane);
    const float rq = 1.f / sqrtf(ss * (1.f / 64.f) + EPS) * (0.125f * 1.44269504f);
    bf16x8 qf[4]; float qn2 = 0.f;
#pragma unroll
    for (int s = 0; s < 4; ++s) {
#pragma unroll
        for (int j = 0; j < 8; ++j) { qv[s][j] *= rq * gq[16 * s + 8 * h + j]; qn2 += qv[s][j] * qv[s][j]; }
        qf[s] = __builtin_bit_cast(bf16x8, pack8(qv[s])); }
    qn2 += shx32(qn2, lane);
    const float bnd = sqrtf(qn2) * kmax * 1.02f + 0.5f;
    f32x16 o[2];
#pragma unroll
    for (int i = 0; i < 16; ++i) { o[0][i] = 0.f; o[1][i] = 0.f; }
    float l = 0.f;
    __syncthreads();
    for (int ktl = 0; ktl < 4; ++ktl) {
        f32x16 z0, z1; qk_subtile(Ksm, ktl, qf, r, h, z0, z1);
#pragma unroll
        for (int i = 0; i < 16; ++i) { z0[i] = fexp2(z0[i] - bnd); z1[i] = fexp2(z1[i] - bnd); l += z0[i] + z1[i]; }
        pv_subtile(Vtm, ktl, z0, z1, r, h, o);
    }
    l += shx32(l, lane);
    store_ot(o, OB + row * 256 + 64 * hd, h, 1.f / l);
}

template <bool ROWM, bool TRANS>
DI void ret_stage(const bf16* U, const f32x2* rot, size_t trow0, int gtok, int hd, float lg, LAS bf16* Ksm, LAS bf16* Ktm, LAS bf16* Vtm, int tid) {
    const int m = tid >> 1, hf = tid & 1; const size_t trow = trow0 + m;
    const bf16* kp = U + trow * DIN + UC_RK + 64 * hd + 16 * hf; const f32x2* rp = rot + (size_t)(gtok + m) * 32 + 16 * hf;
    const float sk = fexp2(-(float)m * lg) * 0.125f;
    float x1[16], x2[16];
    { const u32x4 a0 = *(const u32x4*)kp, a1 = *(const u32x4*)(kp + 8), b0 = *(const u32x4*)(kp + 32), b1 = *(const u32x4*)(kp + 40);
      float t[8]; unpack8(a0, t);
#pragma unroll
      for (int j = 0; j < 8; ++j) x1[j] = t[j];
      unpack8(a1, t);
#pragma unroll
      for (int j = 0; j < 8; ++j) x1[8 + j] = t[j];
      unpack8(b0, t);
#pragma unroll
      for (int j = 0; j < 8; ++j) x2[j] = t[j];
      unpack8(b1, t);
#pragma unroll
      for (int j = 0; j < 8; ++j) x2[8 + j] = t[j]; }
    float o1[16], o2[16];
#pragma unroll
    for (int j = 0; j < 16; ++j) { const f32x2 cs = rp[j]; o1[j] = (x1[j] * cs.x - x2[j] * cs.y) * sk; o2[j] = (x1[j] * cs.y + x2[j] * cs.x) * sk; }
    if (ROWM) { LAS bf16* kr = Ksm + m * KS + 16 * hf; float t[8];
#pragma unroll
        for (int j = 0; j < 8; ++j) t[j] = o1[j];
        *(LAS u32x4*)kr = pack8(t);
#pragma unroll
        for (int j = 0; j < 8; ++j) t[j] = o1[8 + j];
        *(LAS u32x4*)(kr + 8) = pack8(t);
#pragma unroll
        for (int j = 0; j < 8; ++j) t[j] = o2[j];
        *(LAS u32x4*)(kr + 32) = pack8(t);
#pragma unroll
        for (int j = 0; j < 8; ++j) t[j] = o2[8 + j];
        *(LAS u32x4*)(kr + 40) = pack8(t); }
    if (TRANS) {
#pragma unroll
        for (int j = 0; j < 16; ++j) { Ktm[(16 * hf + j) * VS + m] = (bf16)(cvtpk(o1[j], 0.f) & 0xffffu); Ktm[(32 + 16 * hf + j) * VS + m] = (bf16)(cvtpk(o2[j], 0.f) & 0xffffu); } }
    const bf16* vp = U + trow * DIN + UC_RV + 64 * hd + 32 * hf;
#pragma unroll
    for (int q = 0; q < 4; ++q) { const u32x4 w = *(const u32x4*)(vp + 8 * q); LAS bf16* d = Vtm + (32 * hf + 8 * q) * VS + m;
        d[0 * VS] = (bf16)(w.x & 0xffffu); d[1 * VS] = (bf16)(w.x >> 16); d[2 * VS] = (bf16)(w.y & 0xffffu); d[3 * VS] = (bf16)(w.y >> 16);
        d[4 * VS] = (bf16)(w.z & 0xffffu); d[5 * VS] = (bf16)(w.z >> 16); d[6 * VS] = (bf16)(w.w & 0xffffu); d[7 * VS] = (bf16)(w.w >> 16); }
}
DI float ret_lg(int hd) { const float gam = 1.f - fexp2(-5.f - (float)hd); return __log2f(gam); }
DI void retkv_unit(const bf16* U, float* KVS, const f32x2* rot, int bl, int gtok0, int hd, int ch, LAS unsigned char* lds, int tid, int wave, int lane) {
    LAS bf16* Vtm = (LAS bf16*)(lds + L_VT); LAS bf16* Ktm = (LAS bf16*)(lds + L_KT);
    const int r = lane & 31, h = lane >> 5; const float lg = ret_lg(hd);
    __syncthreads();
    ret_stage<false, true>(U, rot, (size_t)bl * SEQ + ch * 256, gtok0 + ch * 256, hd, lg, nullptr, Ktm, Vtm, tid);
    __syncthreads();
    if (wave < 4) { const int dti = wave >> 1, eti = wave & 1;
        f32x16 kv;
#pragma unroll
        for (int i = 0; i < 16; ++i) kv[i] = 0.f;
#pragma unroll 4
        for (int s = 0; s < 16; ++s) { const bf16x8 af = *(const LAS bf16x8*)(Ktm + (32 * dti + r) * VS + 16 * s + 8 * h); const bf16x8 bfr = *(const LAS bf16x8*)(Vtm + (32 * eti + r) * VS + 16 * s + 8 * h);
            kv = MFMA32(af, bfr, kv); }
        float* dst = KVS + (size_t)((bl * 4 + hd) * 16 + ch) * 4096 + 32 * eti + r;
#pragma unroll
        for (int i = 0; i < 16; ++i) dst[(32 * dti + crow(i, h)) * 64] = kv[i]; }
}
DI void reto_unit(const bf16* U, bf16* Y, const float* KVS, const f32x2* rot, int bl, int gtok0, int hd, int ch, LAS unsigned char* lds, int tid, int wave, int lane) {
    LAS bf16* Ksm = (LAS bf16*)(lds + L_KS); LAS bf16* Vtm = (LAS bf16*)(lds + L_VT); LAS bf16* Stm = (LAS bf16*)(lds + L_ST);
    const int r = lane & 31, h = lane >> 5; const float lg = ret_lg(hd);
    const size_t tok0 = (size_t)bl * SEQ; const int n0 = ch * 256;
    __syncthreads();
    { const int d = tid >> 3, e0 = 8 * (tid & 7); float acc[8];
#pragma unroll
      for (int j = 0; j < 8; ++j) acc[j] = 0.f;
      const float* src = KVS + (size_t)((bl * 4 + hd) * 16) * 4096 + d * 64 + e0;
#pragma unroll 4
      for (int cp = 0; cp < ch; ++cp) { const float w = fexp2((256.f * (float)(ch - 1 - cp) + 256.f) * lg); const f32x4 a = *(const f32x4*)(src + (size_t)cp * 4096), b = *(const f32x4*)(src + (size_t)cp * 4096 + 4);
          acc[0] += w * a.x; acc[1] += w * a.y; acc[2] += w * a.z; acc[3] += w * a.w; acc[4] += w * b.x; acc[5] += w * b.y; acc[6] += w * b.z; acc[7] += w * b.w; }
#pragma unroll
      for (int j = 0; j < 8; ++j) Stm[(e0 + j) * KS + d] = (bf16)(cvtpk(acc[j], 0.f) & 0xffffu); }
    ret_stage<true, false>(U, rot, tok0 + n0, gtok0 + n0, hd, lg, Ksm, nullptr, Vtm, tid);
    bf16x8 qf[4];
    { const int nl = 32 * wave + r; const size_t trow = tok0 + n0 + nl;
      const bf16* qp = U + trow * DIN + UC_RQ + 64 * hd + 8 * h; const f32x2* rp = rot + (size_t)(gtok0 + n0 + nl) * 32 + 8 * h;
      const float sq = fexp2((float)nl * lg);
      float a[4][8];
#pragma unroll
      for (int s = 0; s < 4; ++s) { const u32x4 w = *(const u32x4*)(qp + 16 * s); unpack8(w, a[s]); }
      float b[4][8];
#pragma unroll
      for (int j = 0; j < 8; ++j) { const f32x2 c0 = rp[j], c1 = rp[16 + j];
          b[0][j] = (a[0][j] * c0.x - a[2][j] * c0.y) * sq; b[2][j] = (a[0][j] * c0.y + a[2][j] * c0.x) * sq;
          b[1][j] = (a[1][j] * c1.x - a[3][j] * c1.y) * sq; b[3][j] = (a[1][j] * c1.y + a[3][j] * c1.x) * sq; }
#pragma unroll
      for (int s = 0; s < 4; ++s) qf[s] = __builtin_bit_cast(bf16x8, pack8(b[s])); }
    __syncthreads();
    f32x16 o[2];
#pragma unroll
    for (int i = 0; i < 16; ++i) { o[0][i] = 0.f; o[1][i] = 0.f; }
    const int khi = (32 * wave + 31) >> 6;
    for (int ktl = 0; ktl <= khi; ++ktl) {
        f32x16 z0, z1; qk_subtile(Ksm, ktl, qf, r, h, z0, z1);
        if (64 * ktl + 63 > 32 * wave) {
            const int krel = 64 * ktl - (32 * wave + r);
#pragma unroll
            for (int i = 0; i < 16; ++i) { const int kk = krel + crow(i, h); z0[i] = (kk <= 0) ? z0[i] : 0.f; z1[i] = (kk + 32 <= 0) ? z1[i] : 0.f; } }
        pv_subtile(Vtm, ktl, z0, z1, r, h, o);
    }
#pragma unroll
    for (int s = 0; s < 4; ++s)
#pragma unroll
        for (int dt = 0; dt < 2; ++dt) { const bf16x8 af = *(const LAS bf16x8*)(Stm + (32 * dt + r) * KS + 16 * s + 8 * h); o[dt] = MFMA32(af, qf[s], o[dt]); }
    { float sm = 0.f;
#pragma unroll
      for (int i = 0; i < 16; ++i) sm += o[0][i] + o[1][i];
      sm += shx32(sm, lane); const float mean = sm * (1.f / 64.f); float vq = 0.f;
#pragma unroll
      for (int i = 0; i < 16; ++i) { const float d0 = o[0][i] - mean, d1 = o[1][i] - mean; vq += d0 * d0 + d1 * d1; }
      vq += shx32(vq, lane); const float rstd = 1.f / sqrtf(vq * (1.f / 64.f) + EPS);
      const size_t trow = tok0 + n0 + 32 * wave + r;
      const bf16* gp = U + trow * DIN + UC_RG + 64 * hd; bf16* yp = Y + trow * D + YC_RET + 64 * hd;
#pragma unroll
      for (int dt = 0; dt < 2; ++dt)
#pragma unroll
          for (int g = 0; g < 4; ++g) { const int e0 = 32 * dt + 8 * g + 4 * h; const u32x2 gw = *(const u32x2*)(gp + e0);
              const float g0 = bflo(gw.x), g1 = bfhi(gw.x), g2 = bflo(gw.y), g3 = bfhi(gw.y);
              u32x2 w; w.x = cvtpk(g0 * sigmoid_f(g0) * (o[dt][4 * g] - mean) * rstd, g1 * sigmoid_f(g1) * (o[dt][4 * g + 1] - mean) * rstd);
              w.y = cvtpk(g2 * sigmoid_f(g2) * (o[dt][4 * g + 2] - mean) * rstd, g3 * sigmoid_f(g3) * (o[dt][4 * g + 3] - mean) * rstd);
              *(u32x2*)(yp + e0) = w; } }
}

DI void conv_unit(const bf16* U, bf16* Y, const float* cw, const float* cb, const float* lng, const float* lnb, int bl, int tile, LAS unsigned char* lds, int tid, int wave, int lane) {
    LAS float* vs = (LAS float*)lds;
    const int t0 = tile * 64; const size_t tok0 = (size_t)bl * SEQ;
    __syncthreads();
#pragma unroll
    for (int it = 0; it < 6; ++it) { const int id = tid + it * NTHR; if (id >= 94 * 32) break; const int rr = id >> 5, c8 = id & 31, t = t0 - 30 + rr; float v[8];
        if (t >= 0) { const bf16* p = U + (tok0 + t) * DIN + 8 * c8; const u32x4 aw = *(const u32x4*)(p + UC_CA), gw = *(const u32x4*)(p + UC_CG); float a[8], g[8]; unpack8(aw, a); unpack8(gw, g);
#pragma unroll
            for (int j = 0; j < 8; ++j) v[j] = a[j] * sigmoid_f(g[j]); }
        else {
#pragma unroll
            for (int j = 0; j < 8; ++j) v[j] = 0.f; }
        LAS f32x4* d = (LAS f32x4*)(vs + rr * 256 + 8 * c8); d[0] = (f32x4){v[0], v[1], v[2], v[3]}; d[1] = (f32x4){v[4], v[5], v[6], v[7]}; }
    __syncthreads();
    const int c = tid & 255, half = tid >> 8;
    float acc[32];
    { float wj[31], win[62];
#pragma unroll
      for (int j = 0; j < 31; ++j) wj[j] = cw[j * 256 + c];
      const LAS float* vp = vs + (32 * half) * 256 + c;
#pragma unroll
      for (int i = 0; i < 62; ++i) win[i] = vp[i * 256];
      const float bias = cb[c];
#pragma unroll
      for (int i = 0; i < 32; ++i) { float a = bias;
#pragma unroll
          for (int j = 0; j < 31; ++j) a += wj[j] * win[i + j];
          acc[i] = a; } }
    __syncthreads();
#pragma unroll
    for (int i = 0; i < 32; ++i) vs[(32 * half + i) * 256 + c] = acc[i];
    __syncthreads();
    const f32x4 g4 = *(const f32x4*)(lng + 4 * lane), b4 = *(const f32x4*)(lnb + 4 * lane);
#pragma unroll
    for (int i = 0; i < 8; ++i) { const int tt = 8 * wave + i; const f32x4 v = *(const LAS f32x4*)(vs + tt * 256 + 4 * lane);
        const float mean = wave_sum((v.x + v.y) + (v.z + v.w), lane) * (1.f / 256.f);
        const f32x4 dv = v - mean; const float var = wave_sum((dv.x * dv.x + dv.y * dv.y) + (dv.z * dv.z + dv.w * dv.w), lane) * (1.f / 256.f);
        const float rstd = 1.f / sqrtf(var + EPS); const f32x4 xn = dv * rstd * g4 + b4;
        u32x2 w; w.x = cvtpk(xn.x * sigmoid_f(xn.x), xn.y * sigmoid_f(xn.y)); w.y = cvtpk(xn.z * sigmoid_f(xn.z), xn.w * sigmoid_f(xn.w));
        *(u32x2*)(Y + (tok0 + t0 + tt) * D + YC_CONV + 4 * lane) = w; }
}

DI void pool_unit(const bf16* U, bf16* Y, int bl, int tile, LAS unsigned char* lds, int tid) {
    LAS float* us = (LAS float*)lds;
    const int t0 = tile * 64; const size_t tok0 = (size_t)bl * SEQ;
    __syncthreads();
#pragma unroll
    for (int it = 0; it < 5; ++it) { const int id = tid + it * NTHR; if (id >= 79 * 32) break; const int rr = id >> 5, c8 = id & 31, t = t0 - 15 + rr; float v[8];
        if (t >= 0) { const u32x4 w = *(const u32x4*)(U + (tok0 + t) * DIN + UC_POOL + 8 * c8); unpack8(w, v); }
        else {
#pragma unroll
            for (int j = 0; j < 8; ++j) v[j] = 0.f; }
        LAS f32x4* d = (LAS f32x4*)(us + rr * 256 + 8 * c8); d[0] = (f32x4){v[0], v[1], v[2], v[3]}; d[1] = (f32x4){v[4], v[5], v[6], v[7]}; }
    __syncthreads();
    const int c = tid & 255, half = tid >> 8; const int gi = c >> 6, w = 2 << gi;
    float v[47];
    { const LAS float* p = us + (32 * half) * 256 + c;
#pragma unroll
      for (int i = 0; i < 47; ++i) v[i] = p[i * 256]; }
    float s[47];
#pragma unroll
    for (int i = 0; i < 47; ++i) s[i] = v[i] + (i >= 1 ? v[i - 1] : 0.f);
    if (gi >= 1) {
#pragma unroll
        for (int i = 46; i >= 0; --i) s[i] = s[i] + (i >= 2 ? s[i - 2] : 0.f); }
    if (gi >= 2) {
#pragma unroll
        for (int i = 46; i >= 0; --i) s[i] = s[i] + (i >= 4 ? s[i - 4] : 0.f); }
    if (gi >= 3) {
#pragma unroll
        for (int i = 46; i >= 0; --i) s[i] = s[i] + (i >= 8 ? s[i - 8] : 0.f); }
#pragma unroll
    for (int i = 0; i < 32; ++i) { const int t = t0 + 32 * half + i;
        const int n = (t + 1 < w) ? (t + 1) : w; const float d = s[15 + i] * __builtin_amdgcn_rcpf((float)n) - v[15 + i];
        Y[(tok0 + t) * D + YC_POOL + c] = (bf16)(cvtpk(d, 0.f) & 0xffffu); }
}

struct Args { const void* in[27]; float* out; unsigned char* ws; };
static_assert(sizeof(Args) == 29 * 8, "Args has no padding");
typedef const __attribute__((address_space(4))) Args* KArgs;
DI KArgs KA() { KArgs p = (KArgs)__builtin_amdgcn_kernarg_segment_ptr(); asm volatile("" : "+s"(p)); return p; }
#define KIN(T, k) ((const T*)KA()->in[k])
#define PH DI
#define PHN __device__ __noinline__
enum { I_X = 0, I_MEM, I_POS, I_NMIXG, I_WIN, I_CONVW, I_CONVB, I_CLNG, I_CLNB, I_POOLW, I_POOLS, I_WGATE, I_WBR, I_WOUT, I_NXAG, I_NMEMG, I_WQ, I_WKV, I_QG, I_KG, I_WO, I_NFFNG, I_FGU, I_FDN, I_ROUTER, I_MGU, I_MDN };

constexpr unsigned F8MASK = FFN_FP8_MASK;
constexpr bool DENSE_ANY8 = (F8MASK & 0x5) != 0, DENSE_ANYB = (F8MASK & 0x5) != 0x5, MOE_ANY8 = (F8MASK & 0xA) != 0, MOE_ANYB = (F8MASK & 0xA) != 0xA;
struct Ids { int tid, lane, wave, G, wg, gw, NGW; };
DI Ids ids(int wave) { Ids i; i.lane = lane_id(); asm volatile("" : "+v"(i.lane)); asm volatile("" : "+s"(wave)); i.wave = wave; i.tid = wave * 64 + i.lane; i.G = gridDim.x; i.wg = blockIdx.x; asm volatile("" : "+s"(i.G), "+s"(i.wg)); i.gw = i.wg * NWAVES + i.wave; i.NGW = i.G * NWAVES; return i; }

PHN unsigned ph_w_layer(KArgs ka, int wv, LAS unsigned char* lds, int l, unsigned ib) {
    const Ids t = ids(__builtin_amdgcn_readfirstlane(wv));     unsigned char* ws = ka->ws; LAS float* scr = (LAS float*)(lds + t.wave * 16384);
    bf16* wc = (bf16*)(ws + WS_WCAT) + (size_t)l * NCAT * D;
    const float* gmix = ((const float*)ka->in[I_NMIXG]) + l * D;
    tr_matrix(ib, ((const float*)ka->in[I_WIN]) + (size_t)l * D * DIN, D, DIN, wc, 0, 0, scr, t.gw, t.NGW, t.lane, gmix);
    for (int i = 0; i < 4; ++i) { if (GATE_FP8) tr_matrix<true>(ib, ((const float*)ka->in[I_WGATE]) + (size_t)(l * 4 + i) * D * D, D, D, (unsigned char*)(wc + (size_t)DIN * D), i * D, 0, scr, t.gw, t.NGW, t.lane, gmix);
        else tr_matrix(ib, ((const float*)ka->in[I_WGATE]) + (size_t)(l * 4 + i) * D * D, D, D, wc, DIN + i * D, 0, scr, t.gw, t.NGW, t.lane, gmix); }
    for (int i = 0; i < 4; ++i) if (i != 1) tr_matrix(ib, ((const float*)ka->in[I_WBR]) + (size_t)(l * 4 + i) * 256 * D, 256, D, (bf16*)(ws + WS_WB) + (size_t)l * D * D + 256 * i, 0, 0, scr, t.gw, t.NGW, t.lane, nullptr, D);
    tr_matrix(ib, ((const float*)ka->in[I_WOUT]) + (size_t)l * D * D, D, D, (bf16*)(ws + WS_WOUT) + (size_t)l * D * D, 0, 0, scr, t.gw, t.NGW, t.lane);
    tr_matrix(ib, ((const float*)ka->in[I_WQ]) + (size_t)l * D * 256, D, 256, (bf16*)(ws + WS_WQ) + (size_t)l * 256 * D, 0, 0, scr, t.gw, t.NGW, t.lane, ((const float*)ka->in[I_NXAG]) + l * D);
    tr_matrix(ib, ((const float*)ka->in[I_WKV]) + (size_t)l * D * 512, D, 512, (bf16*)(ws + WS_WKV) + (size_t)l * 512 * D, 0, 0, scr, t.gw, t.NGW, t.lane);
    tr_matrix(ib, ((const float*)ka->in[I_WO]) + (size_t)l * 256 * D, 256, D, (bf16*)(ws + WS_WO) + (size_t)l * D * 256, 0, 0, scr, t.gw, t.NGW, t.lane);
    return ib;
}
PHN unsigned ph_w_ffn(KArgs ka, int wv, LAS unsigned char* lds, int s, unsigned ib) {
    const Ids t = ids(__builtin_amdgcn_readfirstlane(wv));     unsigned char* ws = ka->ws; LAS float* scr = (LAS float*)(lds + t.wave * 16384);
    if (s < 2) { const bool f8 = (F8MASK >> (2 * s)) & 1u;
        const float* gu = ((const float*)ka->in[I_FGU]) + (size_t)s * D * NGU; const float* dn = ((const float*)ka->in[I_FDN]) + (size_t)s * DFF * D;
        unsigned char* wgu = ws + WS_WGUD + (size_t)s * NGU * D * 2; unsigned char* wdn = ws + WS_WDND + (size_t)s * D * DFF * 2;
        const float* gf = ((const float*)ka->in[I_NFFNG]) + (2 * s) * D;
        if (f8) { if constexpr (DENSE_ANY8) { tr_matrix<true>(ib, gu, D, NGU, wgu, 0, 1, scr, t.gw, t.NGW, t.lane, gf); tr_matrix<true>(ib, dn, DFF, D, wdn, 0, 0, scr, t.gw, t.NGW, t.lane); } }
        else { if constexpr (DENSE_ANYB) { tr_matrix<false>(ib, gu, D, NGU, wgu, 0, 1, scr, t.gw, t.NGW, t.lane, gf); tr_matrix<false>(ib, dn, DFF, D, wdn, 0, 0, scr, t.gw, t.NGW, t.lane); } }
    } else { const int k = s - 2; const bool f8 = (F8MASK >> (2 * (k >> 3) + 1)) & 1u;
        const float* gu = ((const float*)ka->in[I_MGU]) + (size_t)k * D * NGU; const float* dn = ((const float*)ka->in[I_MDN]) + (size_t)k * DFF * D;
        unsigned char* wgu = ws + WS_WGUM + (size_t)k * NGU * D * 2; unsigned char* wdn = ws + WS_WDNM + (size_t)k * D * DFF * 2;
        if (f8) { if constexpr (MOE_ANY8) { tr_matrix<true>(ib, gu, D, NGU, wgu, 0, 1, scr, t.gw, t.NGW, t.lane); tr_matrix<true>(ib, dn, DFF, D, wdn, 0, 0, scr, t.gw, t.NGW, t.lane); } }
        else { if constexpr (MOE_ANYB) { tr_matrix<false>(ib, gu, D, NGU, wgu, 0, 1, scr, t.gw, t.NGW, t.lane); tr_matrix<false>(ib, dn, DFF, D, wdn, 0, 0, scr, t.gw, t.NGW, t.lane); } }
    }
    return ib;
}
PHN void ph_misc0(KArgs ka, int wv) {
    const Ids t = ids(__builtin_amdgcn_readfirstlane(wv));     unsigned char* ws = ka->ws;
    { const float* pool_w = ((const float*)ka->in[I_POOLW]); const float* pool_scale = ((const float*)ka->in[I_POOLS]); const float* w_branch = ((const float*)ka->in[I_WBR]); bf16* WB = (bf16*)(ws + WS_WB);
      for (int idx = t.wg * NTHR + t.tid; idx < DEPTH * 1024 * 256; idx += t.G * NTHR) {
          const int l = idx >> 18, n = (idx >> 8) & 1023, gc = idx & 255, g = gc >> 6;
          const float* pw = pool_w + ((size_t)(l * 4) * 64 + gc) * 64; const float* ps = pool_scale + l * 256 + 64 * g; const float* wb = w_branch + ((size_t)(l * 4 + 1) * 256 + 64 * g) * D + n;
          float s = 0.f;
          for (int d = 0; d < 64; ++d) s += pw[d] * ps[d] * wb[(size_t)d * D];
          WB[(size_t)l * D * D + (size_t)n * D + 256 + gc] = (bf16)(cvtpk(s, 0.f) & 0xffffu); } }
    { const float* mem = ((const float*)ka->in[I_MEM]); const float* gm = ((const float*)ka->in[I_NMEMG]); bf16* MEMH = (bf16*)(ws + WS_MEMH);
      for (int it = t.gw; it < DEPTH * MMEM; it += t.NGW) { const int l = it / MMEM, rw = it - l * MMEM; rms_row_bf16(mem + (size_t)rw * D, gm + l * D, MEMH + (size_t)it * D, t.lane); } }
    { const int* positions = ((const int*)ka->in[I_POS]); f32x2* ROT = (f32x2*)(ws + WS_ROT);
      for (int idx = t.wg * NTHR + t.tid; idx < MTOT * 32; idx += t.G * NTHR) { const int tok = idx >> 5, i = idx & 31;
          const float ang = (float)positions[tok] * INV_FREQ[i]; double rev = (double)ang * 0.15915494309189535; rev -= floor(rev); const float rv = (float)rev;
          ROT[idx] = (f32x2){__builtin_amdgcn_cosf(rv), __builtin_amdgcn_sinf(rv)}; } }
}
PH void ph_kv(int wv, LAS unsigned char* lds) {
    const Ids t = ids(wv); unsigned char* ws = KA()->ws;
    pg8::OrdKV S; S.to.init(DEPTH * (MMEM / 256), 2, t.G, t.wg); S.A = (const char*)(ws + WS_MEMH); S.B = (const char*)(ws + WS_WKV);
    pg8::EpiBf16<false> E{(bf16*)(ws + WS_KV), 512, nullptr};
    pg8::gemm_phase<pg8::EpiBf16<false>, pg8::OrdKV>(lds, D, D, S, E, t.wave);
}
PHN void ph_knorm(KArgs ka, int wv) {
    const Ids t = ids(__builtin_amdgcn_readfirstlane(wv));     unsigned char* ws = ka->ws; unsigned* ctl = (unsigned*)(ws + WS_CTL); bf16* KV = (bf16*)(ws + WS_KV); const float* xa_kg = ((const float*)ka->in[I_KG]);
    for (int it = t.gw; it < DEPTH * MMEM; it += t.NGW) { const int l = it / MMEM, rw = it - l * MMEM, b = rw >> 8; const int lane = t.lane;
        if (lane < 32) { bf16* kp = KV + (size_t)it * 512 + 8 * lane; const u32x4 w = *(const u32x4*)kp; float f[8]; unpack8(w, f); float ss = 0.f;
#pragma unroll
            for (int j = 0; j < 8; ++j) ss += f[j] * f[j];
            ss += SHX(ss, 1, lane); ss += SHX(ss, 2, lane); ss += SHX(ss, 4, lane);
            const float rs = 1.f / sqrtf(ss * (1.f / 64.f) + EPS); const float* gk = xa_kg + l * 64 + 8 * (lane & 7); float n2 = 0.f;
#pragma unroll
            for (int j = 0; j < 8; ++j) { f[j] *= rs * gk[j]; n2 += f[j] * f[j]; }
            *(u32x4*)kp = pack8(f);
            n2 += SHX(n2, 1, lane); n2 += SHX(n2, 2, lane); n2 += SHX(n2, 4, lane);
            if ((lane & 7) == 0) atomicMax(ctl + CW_KMAX + (l * NB + b) * 4 + (lane >> 3), __float_as_uint(n2 * 1.02f)); } }
}
PHN void ph_xprep(KArgs ka, int wv, int g, int from_in) {
    const Ids t = ids(__builtin_amdgcn_readfirstlane(wv));
    unsigned char* ws = ka->ws; const size_t grow = (size_t)g * MG;
    const float* src = from_in ? (((const float*)ka->in[I_X]) + grow * D) : (ka->out + grow * D);
    bf16* XB = (bf16*)(ws + WS_HB); float* ssq = (float*)(ws + WS_SSQ); const int lane = t.lane;
    for (int m = t.gw; m < MG; m += t.NGW) {
        const f32x4* xr = (const f32x4*)(src + (size_t)m * D) + lane; f32x4 v[4]; float s = 0.f;
#pragma unroll
        for (int j = 0; j < 4; ++j) { v[j] = xr[64 * j]; s += (v[j].x * v[j].x + v[j].y * v[j].y) + (v[j].z * v[j].z + v[j].w * v[j].w); }
        s = wave_sum(s, lane);
        u32x2* o8 = (u32x2*)(XB + (size_t)m * D) + lane;
#pragma unroll
        for (int j = 0; j < 4; ++j) { u32x2 w; w.x = cvtpk(v[j].x, v[j].y); w.y = cvtpk(v[j].z, v[j].w); o8[64 * j] = w; }
        if (GATE_FP8) { unsigned* o4 = (unsigned*)(ws + WS_XB8 + (size_t)m * D) + lane;
#pragma unroll
            for (int j = 0; j < 4; ++j) o4[64 * j] = cvt4_fp8(v[j].x, v[j].y, v[j].z, v[j].w); }
        if (lane < 16) ssq[(size_t)m * 16 + lane] = lane == 0 ? s : 0.f; }
}
PH void ph_gemm1(int wv, LAS unsigned char* lds, int l) {
    const Ids t = ids(wv); unsigned char* ws = KA()->ws; bf16* wcat = (bf16*)(ws + WS_WCAT) + (size_t)l * NCAT * D;
    { pg8::OrdStd S; S.to.init(MG / 256, (GATE_FP8 ? DIN : NCAT) / 256, t.G, t.wg); S.A = (const char*)(ws + WS_HB); S.B = (const char*)wcat; S.atile = 256 * D * 2; S.btile = 256 * D * 2;
      pg8::EpiCat<false> E{(bf16*)(ws + WS_U), (bf16*)(ws + WS_GATES), (const float*)(ws + WS_SSQ)};
      pg8::gemm_phase<pg8::EpiCat<false>, pg8::OrdStd>(lds, D, D, S, E, t.wave); }
    if constexpr (GATE_FP8 != 0) {
      pg8::OrdStd S; S.to.init(MG / 256, 4096 / 256, t.G, t.wg); S.A = (const char*)(ws + WS_XB8); S.B = (const char*)(wcat + (size_t)DIN * D); S.atile = 256 * D; S.btile = 256 * D;
      pg8::EpiCat<true> E{(bf16*)(ws + WS_U), (bf16*)(ws + WS_GATES), (const float*)(ws + WS_SSQ)};
      pg8::gemm_phase<pg8::EpiCat<true>, pg8::OrdStd, true>(lds, D, D, S, E, t.wave); }
}
constexpr int NSB = BG * 4 * 16, NRC = BG * 4 * 16, NCONV = BG * 64, NPOOL = BG * 64;
PH void ph_mix(int wv, LAS unsigned char* lds, int g, int l, int part, int rep = 0, int jlo = 0, int jhi = 1 << 30) {
    const Ids t = ids(wv); unsigned char* ws = KA()->ws; unsigned* ctl = (unsigned*)(ws + WS_CTL);
    volatile LAS unsigned* MISC = (volatile LAS unsigned*)(lds + MISC_OFF);
    unsigned* qctr = ctl + CW_QCTR + 64 * ((g * 4 + l) * 2 + part + 16 * rep);
    const bf16* UB = (const bf16*)(ws + WS_U); bf16* YB = (bf16*)(ws + WS_Y); float* KVS = (float*)(ws + WS_KVS); const f32x2* ROT = (const f32x2*)(ws + WS_ROT);
    const int NUQ = part == 0 ? (NSB + NRC + NPOOL) : (NRC + NCONV);
    (void)qctr; (void)MISC;
    for (int j = t.wg; j < NUQ; j += t.G) {
        if (j < jlo || j >= jhi) continue;
        if (part == 0) {
            if (j < NSB) { __syncthreads(); if (t.tid == 0) { MISC[2] = 0u; MISC[3] = 0u; } __syncthreads(); sb_unit(UB, YB, (j >> 2) & 7, j & 3, 15 - (j >> 5), lds, t.tid, t.wave, t.lane); }
            else if (j < NSB + NRC) { const int k = j - NSB, bl = k >> 6; retkv_unit(UB, KVS, ROT, bl, (g * BG + bl) * SEQ, (k >> 4) & 3, k & 15, lds, t.tid, t.wave, t.lane); }
            else { const int k = j - (NSB + NRC); pool_unit(UB, YB, k >> 6, k & 63, lds, t.tid); }
        } else {
            if (j < NRC) { const int bl = j >> 6; reto_unit(UB, YB, KVS, ROT, bl, (g * BG + bl) * SEQ, (j >> 4) & 3, j & 15, lds, t.tid, t.wave, t.lane); }
            else { const int k = j - NRC;
                conv_unit(UB, YB, KIN(float, I_CONVW) + (size_t)l * 31 * 256, KIN(float, I_CONVB) + l * 256, KIN(float, I_CLNG) + l * 256, KIN(float, I_CLNB) + l * 256, k >> 6, k & 63, lds, t.tid, t.wave, t.lane); }
        }
    }
}
PH void ph_merge(int wv, LAS unsigned char* lds, int l) {
    const Ids t = ids(wv); unsigned char* ws = KA()->ws;
    pg8::OrdMerge S; S.G = t.G; S.c = t.wg; S.ntiles = (MG / 256) * 8; S.A = (const char*)(ws + WS_Y); S.B = (const char*)((bf16*)(ws + WS_WB) + (size_t)l * D * D);
    pg8::EpiMerge E{(const bf16*)(ws + WS_GATES), (bf16*)(ws + WS_MERGED)};
    pg8::gemm_phase<pg8::EpiMerge, pg8::OrdMerge, false, true>(lds, D, D, S, E, t.wave);
}
PH void ph_res(int wv, LAS unsigned char* lds, int g, int l, int which, int xbm) {
    const Ids t = ids(wv); unsigned char* ws = KA()->ws; const size_t grow = (size_t)g * MG; float* xo = KA()->out + grow * D;
    const float* xi = (which == 0 && l == 0) ? (KIN(float, I_X) + grow * D) : xo;
    int K; const char* A; const char* B;
    if (which == 0) { K = D; A = (const char*)(ws + WS_MERGED); B = (const char*)((bf16*)(ws + WS_WOUT) + (size_t)l * D * D); }
    else { K = 256; A = (const char*)(ws + WS_OB); B = (const char*)((bf16*)(ws + WS_WO) + (size_t)l * D * 256); }
    pg8::OrdStd S; S.to.init(MG / 256, 4, t.G, t.wg); S.A = A; S.B = B; S.atile = (size_t)256 * K * 2; S.btile = (size_t)256 * K * 2;
    pg8::EpiRes<true, false> E{xi, xo, xbm, (void*)(ws + WS_HB), (float*)(ws + WS_SSQ), ws + WS_HB};
    pg8::gemm_phase<pg8::EpiRes<true, false>, pg8::OrdStd>(lds, K, K, S, E, t.wave);
}
template <bool F8> PH void ph_down(int wv, LAS unsigned char* lds, int g, int l, int xbm) {
    constexpr int FE = F8 ? 1 : 2;
    const Ids t = ids(wv); unsigned char* ws = KA()->ws; float* xo = KA()->out + (size_t)g * MG * D;
    pg8::OrdStd S; S.to.init(MG / 256, 4, t.G, t.wg); S.A = (const char*)(ws + WS_ACT); S.B = (const char*)(ws + WS_WDND + (size_t)(l >> 1) * D * DFF * 2); S.atile = (size_t)256 * DFF * FE; S.btile = (size_t)256 * DFF * FE;
    pg8::EpiRes<true, F8> E{xo, xo, xbm, (void*)(ws + WS_HB), (float*)(ws + WS_SSQ), ws + WS_XB8};
    pg8::gemm_phase<pg8::EpiRes<true, F8>, pg8::OrdStd, F8>(lds, DFF, DFF, S, E, t.wave);
}
PH void ph_q(int wv, LAS unsigned char* lds, int l) {
    const Ids t = ids(wv); unsigned char* ws = KA()->ws;
    pg8::OrdStd S; S.to.init(MG / 256, 1, t.G, t.wg); S.A = (const char*)(ws + WS_HB); S.B = (const char*)((bf16*)(ws + WS_WQ) + (size_t)l * 256 * D); S.atile = 256 * D * 2; S.btile = 256 * D * 2;
    pg8::EpiBf16<false> E{(bf16*)(ws + WS_QB), 256, (const float*)(ws + WS_SSQ)};
    pg8::gemm_phase<pg8::EpiBf16<false>, pg8::OrdStd>(lds, D, D, S, E, t.wave);
}
PH void ph_xa(int wv, LAS unsigned char* lds, int g, int l) {
    const Ids t = ids(wv); unsigned char* ws = KA()->ws; const unsigned* ctl = (const unsigned*)(ws + WS_CTL);
    for (int j = t.wg; j < BG * 4 * 16; j += t.G) { const int bl = j >> 6, hd = (j >> 4) & 3, qblk = j & 15, bglob = g * BG + bl;
        const float kmax = sqrtf(__uint_as_float(ctl[CW_KMAX + (l * NB + bglob) * 4 + hd]));
        xa_unit((const bf16*)(ws + WS_QB), (const bf16*)(ws + WS_KV) + (size_t)l * MMEM * 512, KIN(float, I_QG) + l * 64, kmax, (bf16*)(ws + WS_OB), bl, bglob, hd, qblk, lds, t.tid, t.wave, t.lane); }
}
template <bool F8> PH void ph_gu(int wv, LAS unsigned char* lds, int l) {
    constexpr int FE = F8 ? 1 : 2;
    const Ids t = ids(wv); unsigned char* ws = KA()->ws;
    pg8::OrdStd S; S.to.init(MG / 256, NGU / 256, t.G, t.wg); S.A = (const char*)(ws + WS_HB); S.B = (const char*)(ws + WS_WGUD + (size_t)(l >> 1) * NGU * D * 2); S.atile = 256 * D * FE; S.btile = 256 * D * FE;
    pg8::EpiGU<F8> E{(void*)(ws + WS_ACT), (const float*)(ws + WS_SSQ)};
    pg8::gemm_phase<pg8::EpiGU<F8>, pg8::OrdStd, F8>(lds, D, D, S, E, t.wave);
}
struct MoeCtx { int rpw, r_lo, r_hi; };
DI MoeCtx moe_ctx(const Ids& t) { MoeCtx c; c.rpw = (MG + t.G - 1) / t.G; c.r_lo = t.wg * c.rpw; c.r_hi = (c.r_lo + c.rpw < MG) ? (c.r_lo + c.rpw) : MG; return c; }
template <bool F8> PH void ph_route(int wv, LAS unsigned char* lds, int g, int l) {
    constexpr int FE = F8 ? 1 : 2;
    const Ids t = ids(wv); unsigned char* ws = KA()->ws; unsigned* ctl = (unsigned*)(ws + WS_CTL); const int l2 = l >> 1, inst = g * 2 + l2;
    unsigned* wgcnt = ctl + CW_WGCNT + inst * 8192; const MoeCtx mc = moe_ctx(t);
    volatile LAS unsigned* LC = (volatile LAS unsigned*)(lds + MISC_OFF) + 16;
    const float* xo = KA()->out + (size_t)g * MG * D; bf16* HB = (bf16*)(ws + WS_HB);
    int* R_E = (int*)(ws + WS_ROUTE); float* R_W1 = (float*)(R_E + MG); float* R_W2 = R_W1 + MG;
    if (t.tid < 16) LC[t.tid] = 0u;
    __syncthreads();
    const float* rt = KIN(float, I_ROUTER) + (size_t)l2 * D * NEXP; const float* gn = KIN(float, I_NFFNG) + l * D; const int lane = t.lane;
    for (int m = mc.r_lo + t.wave; m < mc.r_hi; m += NWAVES) {
        const f32x4* xr = (const f32x4*)(xo + (size_t)m * D) + lane; const f32x4* gr = (const f32x4*)gn + lane;
        f32x4 v[4]; float s = 0.f;
#pragma unroll
        for (int j = 0; j < 4; ++j) { v[j] = xr[64 * j]; s += (v[j].x * v[j].x + v[j].y * v[j].y) + (v[j].z * v[j].z + v[j].w * v[j].w); }
        const float rstd = 1.f / sqrtf(wave_sum(s, lane) * (1.f / D) + EPS);
        float lg[8];
#pragma unroll
        for (int e = 0; e < 8; ++e) lg[e] = 0.f;
        u32x2* o8 = (u32x2*)(HB + (size_t)m * D) + lane; unsigned* o4 = (unsigned*)((unsigned char*)HB + (size_t)m * D) + lane;
#pragma unroll
        for (int j = 0; j < 4; ++j) { const f32x4 gg = gr[64 * j]; const f32x4 hn = v[j] * rstd * gg;
            if (F8) o4[64 * j] = cvt4_fp8(hn.x, hn.y, hn.z, hn.w);
            else { u32x2 w; w.x = cvtpk(hn.x, hn.y); w.y = cvtpk(hn.z, hn.w); o8[64 * j] = w; }
            const f32x4* rp = (const f32x4*)(rt + (size_t)(4 * lane + 256 * j) * NEXP);
#pragma unroll
            for (int q = 0; q < 4; ++q) { const f32x4 r0 = rp[2 * q], r1 = rp[2 * q + 1]; const float hv = hn[q];
                lg[0] += hv * r0.x; lg[1] += hv * r0.y; lg[2] += hv * r0.z; lg[3] += hv * r0.w; lg[4] += hv * r1.x; lg[5] += hv * r1.y; lg[6] += hv * r1.z; lg[7] += hv * r1.w; } }
#pragma unroll
        for (int e = 0; e < 8; ++e) lg[e] = wave_sum(lg[e], lane);
        float v1 = lg[0]; int i1 = 0;
#pragma unroll
        for (int e = 1; e < 8; ++e) if (lg[e] > v1) { v1 = lg[e]; i1 = e; }
        float v2 = -3.0e38f; int i2 = -1;
#pragma unroll
        for (int e = 0; e < 8; ++e) if (e != i1 && (i2 < 0 || lg[e] > v2)) { v2 = lg[e]; i2 = e; }
        const float w1 = 1.f / (1.f + __expf(v2 - v1));
        if (lane == 0) { R_E[m] = i1 | (i2 << 8); R_W1[m] = w1; R_W2[m] = 1.f - w1;
            __hip_atomic_fetch_add((LAS unsigned*)&LC[i1], 1u, __ATOMIC_RELAXED, __HIP_MEMORY_SCOPE_WORKGROUP); __hip_atomic_fetch_add((LAS unsigned*)&LC[i2], 1u, __ATOMIC_RELAXED, __HIP_MEMORY_SCOPE_WORKGROUP); }
    }
    __syncthreads();
    if (t.tid < 8) wgcnt[t.wg * 8 + t.tid] = LC[t.tid];
}
template <bool F8> PHN void ph_gather(KArgs ka, int wv, LAS unsigned char* lds, int g, int l) {
    constexpr int FE = F8 ? 1 : 2;
    const Ids t = ids(__builtin_amdgcn_readfirstlane(wv));     unsigned char* ws = ka->ws; unsigned* ctl = (unsigned*)(ws + WS_CTL); const int l2 = l >> 1, inst = g * 2 + l2;
    unsigned* wgcnt = ctl + CW_WGCNT + inst * 8192; unsigned* moff = ctl + CW_MOFF + 64 * inst; const MoeCtx mc = moe_ctx(t);
    volatile LAS unsigned* LC = (volatile LAS unsigned*)(lds + MISC_OFF) + 16;
    const bf16* HB = (const bf16*)(ws + WS_HB); bf16* HP = (bf16*)(ws + WS_HP);
    const int* R_E = (const int*)(ws + WS_ROUTE); int* R_S1 = (int*)(ws + WS_ROUTE) + 3 * MG; int* R_S2 = R_S1 + MG;
    if (t.tid < 16) LC[t.tid] = 0u;
    __syncthreads();
    for (int idx = t.tid; idx < t.G * 8; idx += NTHR) { const unsigned v = wgcnt[idx]; const int e = idx & 7;
        __hip_atomic_fetch_add((LAS unsigned*)&LC[8 + e], v, __ATOMIC_RELAXED, __HIP_MEMORY_SCOPE_WORKGROUP);
        if ((idx >> 3) < t.wg) __hip_atomic_fetch_add((LAS unsigned*)&LC[e], v, __ATOMIC_RELAXED, __HIP_MEMORY_SCOPE_WORKGROUP); }
    __syncthreads();
    if (t.tid == 0) { unsigned o = 0;
        for (int e = 0; e < 8; ++e) { const unsigned tot = LC[8 + e]; if (t.wg == 0) moff[e] = o; LC[e] = LC[e] + o; o += (tot + 255u) & ~255u; }
        if (t.wg == 0) moff[8] = o; }
    __syncthreads();
    const int lane = t.lane;
    for (int m = mc.r_lo + t.wave; m < mc.r_hi; m += NWAVES) {
        int s1 = 0, s2 = 0;
        if (lane == 0) { const int ee = R_E[m];
            s1 = (int)__hip_atomic_fetch_add((LAS unsigned*)&LC[ee & 255], 1u, __ATOMIC_RELAXED, __HIP_MEMORY_SCOPE_WORKGROUP);
            s2 = (int)__hip_atomic_fetch_add((LAS unsigned*)&LC[ee >> 8], 1u, __ATOMIC_RELAXED, __HIP_MEMORY_SCOPE_WORKGROUP);
            R_S1[m] = s1; R_S2[m] = s2; }
        s1 = __builtin_amdgcn_readfirstlane(s1); s2 = __builtin_amdgcn_readfirstlane(s2);
        if (F8) { const u32x4 a = *((const u32x4*)((const unsigned char*)HB + (size_t)m * D) + lane);
            *((u32x4*)((unsigned char*)HP + (size_t)s1 * D) + lane) = a; *((u32x4*)((unsigned char*)HP + (size_t)s2 * D) + lane) = a; }
        else { const u32x4* src = (const u32x4*)(HB + (size_t)m * D) + lane; const u32x4 a = src[0], b = src[64];
            u32x4* d1 = (u32x4*)(HP + (size_t)s1 * D) + lane; u32x4* d2 = (u32x4*)(HP + (size_t)s2 * D) + lane;
            d1[0] = a; d1[64] = b; d2[0] = a; d2[64] = b; } }
}
template <bool F8> PH void ph_moe_gu(int wv, LAS unsigned char* lds, int g, int l) {
    constexpr int FE = F8 ? 1 : 2;
    const Ids t = ids(wv); unsigned char* ws = KA()->ws; const unsigned* ctl = (const unsigned*)(ws + WS_CTL); const int l2 = l >> 1, inst = g * 2 + l2; const unsigned* moff = ctl + CW_MOFF + 64 * inst;
    pg8::OrdMoe S;
#pragma unroll
    for (int e = 0; e < 9; ++e) S.off[e] = __builtin_amdgcn_readfirstlane((int)moff[e]);
    S.to.init(S.off[8] >> 8, NGU / 256, t.G, t.wg); S.A = (const char*)(ws + WS_HP); S.B = (const char*)(ws + WS_WGUM + (size_t)l2 * NEXP * NGU * D * 2); S.atile = 256 * D * FE; S.btile = 256 * D * FE; S.bexp = (size_t)NGU * D * 2;
    pg8::EpiGU<F8> E{(void*)(ws + WS_ACT), nullptr};
    pg8::gemm_phase<pg8::EpiGU<F8>, pg8::OrdMoe, F8>(lds, D, D, S, E, t.wave);
}
template <bool F8> PH void ph_moe_dn(int wv, LAS unsigned char* lds, int g, int l) {
    constexpr int FE = F8 ? 1 : 2;
    const Ids t = ids(wv); unsigned char* ws = KA()->ws; const unsigned* ctl = (const unsigned*)(ws + WS_CTL); const int l2 = l >> 1, inst = g * 2 + l2; const unsigned* moff = ctl + CW_MOFF + 64 * inst;
    pg8::OrdMoe S;
#pragma unroll
    for (int e = 0; e < 9; ++e) S.off[e] = __builtin_amdgcn_readfirstlane((int)moff[e]);
    S.to.init(S.off[8] >> 8, 4, t.G, t.wg); S.A = (const char*)(ws + WS_ACT); S.B = (const char*)(ws + WS_WDNM + (size_t)l2 * NEXP * D * DFF * 2); S.atile = (size_t)256 * DFF * FE; S.btile = (size_t)256 * DFF * FE; S.bexp = (size_t)D * DFF * 2;
    pg8::EpiBf16<F8> E{(bf16*)(ws + WS_HP), D, nullptr};
    pg8::gemm_phase<pg8::EpiBf16<F8>, pg8::OrdMoe, F8>(lds, DFF, DFF, S, E, t.wave);
}
PHN void ph_combine(KArgs ka, int wv, int g, int xbm) {
    const Ids t = ids(__builtin_amdgcn_readfirstlane(wv));     unsigned char* ws = ka->ws; float* xo = ka->out + (size_t)g * MG * D; const bf16* HP = (const bf16*)(ws + WS_HP);
    const int* R_E = (const int*)(ws + WS_ROUTE); const float* R_W1 = (const float*)(R_E + MG); const float* R_W2 = R_W1 + MG; const int* R_S1 = (const int*)(R_W2 + MG); const int* R_S2 = R_S1 + MG;
    const int lane = t.lane;
    bf16* XB = (bf16*)(ws + WS_HB); float* ssq = (float*)(ws + WS_SSQ);
    for (int m = t.gw; m < MG; m += t.NGW) { const int s1 = R_S1[m], s2 = R_S2[m]; const float w1 = R_W1[m], w2 = R_W2[m]; float ssum = 0.f;
        f32x4* xr = (f32x4*)(xo + (size_t)m * D) + 2 * lane; const u32x4* p1 = (const u32x4*)(HP + (size_t)s1 * D) + lane; const u32x4* p2 = (const u32x4*)(HP + (size_t)s2 * D) + lane;
#pragma unroll
        for (int j = 0; j < 2; ++j) { float a[8], b[8]; unpack8(p1[64 * j], a); unpack8(p2[64 * j], b); f32x4 x0 = xr[128 * j], x1 = xr[128 * j + 1];
            x0.x += w1 * a[0] + w2 * b[0]; x0.y += w1 * a[1] + w2 * b[1]; x0.z += w1 * a[2] + w2 * b[2]; x0.w += w1 * a[3] + w2 * b[3];
            x1.x += w1 * a[4] + w2 * b[4]; x1.y += w1 * a[5] + w2 * b[5]; x1.z += w1 * a[6] + w2 * b[6]; x1.w += w1 * a[7] + w2 * b[7];
            xr[128 * j] = x0; xr[128 * j + 1] = x1;
            if (xbm) { ssum += (x0.x * x0.x + x0.y * x0.y) + (x0.z * x0.z + x0.w * x0.w) + (x1.x * x1.x + x1.y * x1.y) + (x1.z * x1.z + x1.w * x1.w);
                u32x4 w; w.x = cvtpk(x0.x, x0.y); w.y = cvtpk(x0.z, x0.w); w.z = cvtpk(x1.x, x1.y); w.w = cvtpk(x1.z, x1.w); *((u32x4*)(XB + (size_t)m * D) + lane + 64 * j) = w;
                if (GATE_FP8) { u32x2 w8; w8.x = cvt4_fp8(x0.x, x0.y, x0.z, x0.w); w8.y = cvt4_fp8(x1.x, x1.y, x1.z, x1.w); *((u32x2*)(ws + WS_XB8 + (size_t)m * D) + lane + 64 * j) = w8; } } }
        if (xbm) { ssum = wave_sum(ssum, lane); if (lane < 16) ssq[(size_t)m * 16 + lane] = lane == 0 ? ssum : 0.f; } }
}

__global__ void __launch_bounds__(NTHR, 2) trunk_fwd(Args args) {
    extern __shared__ __attribute__((aligned(16))) unsigned char lds_raw[];
    LAS unsigned char* lds = (LAS unsigned char*)lds_raw;
    volatile LAS unsigned* MISC = (volatile LAS unsigned*)(lds + MISC_OFF);
    const int tid = threadIdx.x; int wave = __builtin_amdgcn_readfirstlane(tid >> 6); asm volatile("" : "+s"(wave));
    unsigned* ctl = (unsigned*)(args.ws + WS_CTL);
    for (int u = tid; u < (LDS_BYTES - LDSCTL_OFF) / 4; u += NTHR) ((LAS unsigned*)(lds + LDSCTL_OFF))[u] = 0u;
    __syncthreads();
    XcdBarrier bar; bar.bar = ctl + CW_BAR; bar.x = xb_xcc_id(); bar.st = MISC + 8;
    if (tid == 0) (void)xb_add(&bar.bar[XB_XCNT(bar.x)], 1u);
#define WV() ({ int _w = wave; asm volatile("" : "+s"(_w)); _w; })
#define GRID_BAR() xcd_barrier_fn((GAS unsigned*)bar.bar, bar.x, bar.st, WV())
    unsigned ib = 0;
    for (int l = 0; l < DEPTH; ++l) ib = ph_w_layer(KA(), WV(), lds, l, ib);
    for (int s = 0; s < 2 + 2 * NEXP; ++s) ib = ph_w_ffn(KA(), WV(), lds, s, ib);
    ph_misc0(KA(), WV());
#ifdef DUP_PRO
    for (int l = 0; l < DEPTH; ++l) ib = ph_w_layer(KA(), WV(), lds, l, ib);
    for (int s = 0; s < 2 + 2 * NEXP; ++s) ib = ph_w_ffn(KA(), WV(), lds, s, ib);
    ph_misc0(KA(), WV());
#endif
    GRID_BAR();
    ph_kv(wave, lds);
    GRID_BAR();
    ph_knorm(KA(), WV());
    GRID_BAR();
    for (int g = 0; g < NG; ++g) {
        for (int l = 0; l < DEPTH; ++l) {
            if (l == 0) { ph_xprep(KA(), WV(), g, 1); GRID_BAR(); }
            ph_gemm1(wave, lds, l); GRID_BAR();
#ifdef DUP_G1
            ph_gemm1(wave, lds, l); GRID_BAR();
#endif
            ph_mix(wave, lds, g, l, 0); GRID_BAR();
            ph_mix(wave, lds, g, l, 1); GRID_BAR();
#ifdef DUP_MIX_LO
            ph_mix(wave, lds, g, l, DUP_MIX_PART, 1, DUP_MIX_LO, DUP_MIX_HI); GRID_BAR();
#endif
            ph_merge(wave, lds, l); GRID_BAR();
#ifdef DUP_BAR
            GRID_BAR(); GRID_BAR(); GRID_BAR(); GRID_BAR(); GRID_BAR(); GRID_BAR(); GRID_BAR(); GRID_BAR();
#endif
#ifdef DUP_MERGE
            ph_merge(wave, lds, l); GRID_BAR();
#endif
            ph_res(wave, lds, g, l, 0, 1); GRID_BAR();
            ph_q(wave, lds, l); GRID_BAR();
            ph_xa(wave, lds, g, l); GRID_BAR();
            const bool f8 = (F8MASK >> l) & 1u; const int nxt = (l + 1 < DEPTH) ? 1 : 0;
            if ((l & 1) == 0) {
                ph_res(wave, lds, g, l, 1, f8 ? 2 : 1); GRID_BAR();
                if (f8) { if constexpr (DENSE_ANY8) { ph_gu<true>(wave, lds, l); GRID_BAR(); ph_down<true>(wave, lds, g, l, nxt ? (GATE_FP8 ? 3 : 1) : 0); GRID_BAR(); } }
                else { if constexpr (DENSE_ANYB) { ph_gu<false>(wave, lds, l); GRID_BAR(); ph_down<false>(wave, lds, g, l, nxt ? (GATE_FP8 ? 3 : 1) : 0); GRID_BAR(); } }
            } else {
                ph_res(wave, lds, g, l, 1, 0); GRID_BAR();
                if (f8) { if constexpr (MOE_ANY8) { ph_route<true>(wave, lds, g, l); GRID_BAR(); ph_gather<true>(KA(), WV(), lds, g, l); GRID_BAR(); ph_moe_gu<true>(wave, lds, g, l); GRID_BAR(); ph_moe_dn<true>(wave, lds, g, l); GRID_BAR(); } }
                else { if constexpr (MOE_ANYB) { ph_route<false>(wave, lds, g, l); GRID_BAR(); ph_gather<false>(KA(), WV(), lds, g, l); GRID_BAR(); ph_moe_gu<false>(wave, lds, g, l); GRID_BAR(); ph_moe_dn<false>(wave, lds, g, l); GRID_BAR(); } }
                ph_combine(KA(), WV(), g, nxt); GRID_BAR();
            }
        }
    }
}

extern "C" void kernel_launch(void* const* d_in, const int* in_sizes, int n_in, void* d_out, int out_size, void* d_ws, size_t ws_size, hipStream_t stream) {
    static int grid = 0;
    if (grid == 0) {
        if (n_in != 27 || in_sizes[0] != MTOT * D || out_size != MTOT * D || ws_size < WS_END) { fprintf(stderr, "kernel_launch: unexpected problem (n_in %d, in0 %d, out %d, ws %zu < %zu)\n", n_in, n_in > 0 ? in_sizes[0] : -1, out_size, ws_size, (size_t)WS_END); grid = -1; return; }
        int dev = 0, cus = 0, per_cu = 0;
        if (hipGetDevice(&dev) != hipSuccess || hipDeviceGetAttribute(&cus, hipDeviceAttributeMultiprocessorCount, dev) != hipSuccess) { grid = -1; return; }
        if (hipFuncSetAttribute((const void*)trunk_fwd, hipFuncAttributeMaxDynamicSharedMemorySize, LDS_BYTES) != hipSuccess) { fprintf(stderr, "kernel_launch: hipFuncSetAttribute failed\n"); grid = -1; return; }
        if (hipOccupancyMaxActiveBlocksPerMultiprocessor(&per_cu, (const void*)trunk_fwd, NTHR, LDS_BYTES) != hipSuccess || per_cu < 1) fprintf(stderr, "kernel_launch: occupancy query reports %d\n", per_cu);
        (void)hipGetLastError();
        grid = cus;
    }
    if (grid < 0) return;
    if (hipMemsetAsync((char*)d_ws + WS_CTL, 0, CTL_ZERO_BYTES, stream) != hipSuccess) return;
    Args a{};
    for (int i = 0; i < 27; ++i) a.in[i] = d_in[i];
    a.out = (float*)d_out; a.ws = (unsigned char*)d_ws;
    hipLaunchKernelGGL(trunk_fwd, dim3(grid), dim3(NTHR), LDS_BYTES, stream, a);
}
```

```cpp
#include <hip/hip_runtime.h>
#include <cstdio>
#include <cstdint>

#define DI __device__ __forceinline__
#define LAS __attribute__((address_space(3)))
#define GAS __attribute__((address_space(1)))
typedef unsigned short bf16;
typedef short bf16x8 __attribute__((ext_vector_type(8)));
typedef short s16x4 __attribute__((ext_vector_type(4)));
typedef float f32x2 __attribute__((ext_vector_type(2)));
typedef float f32x4 __attribute__((ext_vector_type(4)));
typedef float f32x16 __attribute__((ext_vector_type(16)));
typedef unsigned u32x2 __attribute__((ext_vector_type(2)));
typedef unsigned u32x4 __attribute__((ext_vector_type(4)));
typedef __bf16 bf16x2_t __attribute__((ext_vector_type(2)));
typedef GAS unsigned gu32;
typedef int i32x8 __attribute__((ext_vector_type(8)));
#ifndef GATE_FP8
#define U_FP8_MASK 0xC
#define MERGE_FP8_MASK 0xC
#define OUT_FP8_MASK 0xC
#define WSUM_DPP 1
#define GATE_SPLIT 0
#define LOCAL_SYNC 1
#define GATE_FP8 1
#endif
#ifndef FFN_FP8_MASK
#define FFN_FP8_MASK 0xE
#endif
constexpr float W8_SCALE = 64.f, W8_INV = 1.f / 64.f;

constexpr int NB = 16, SEQ = 4096, D = 1024, DEPTH = 4, NG = 2, BG = NB / NG, MG = BG * SEQ, MTOT = NB * SEQ;
constexpr int DIN = 2560, NCAT = DIN + 4096, DFF = 2816, NGU = 2 * DFF, NEXP = 8, NMEM = 256, MMEM = NB * NMEM;
constexpr int MOE_SLOTS = 2 * MG + NEXP * 256;
constexpr float EPS = 1e-6f;
constexpr int NWAVES = 8, NTHR = 512;
constexpr int UC_CA = 0, UC_CG = 256, UC_POOL = 512, UC_SBQ = 768, UC_SBK = 1024, UC_SBV = 1280, UC_RQ = 1536, UC_RK = 1792, UC_RV = 2048, UC_RG = 2304;
constexpr int YC_CONV = 0, YC_POOL = 256, YC_SB = 512, YC_RET = 768;

constexpr size_t MiB = 1u << 20;
constexpr size_t WS_CTL = 0, CTL_ZERO_BYTES = 256 * 1024;
constexpr size_t WS_WCAT = 1 * MiB;
constexpr size_t WS_WB = 53 * MiB;
constexpr size_t WS_WOUT = 61 * MiB;
constexpr size_t WS_WQ = 69 * MiB;
constexpr size_t WS_WKV = 71 * MiB;
constexpr size_t WS_WO = 75 * MiB;
constexpr size_t WS_WGUD = 77 * MiB;
constexpr size_t WS_WDND = 99 * MiB;
constexpr size_t WS_WGUM = 110 * MiB;
constexpr size_t WS_WDNM = 286 * MiB;
constexpr size_t WS_ROT = 374 * MiB;
constexpr size_t WS_MEMH = 390 * MiB;
constexpr size_t WS_KV = 422 * MiB;
constexpr size_t WS_HB = 438 * MiB;
constexpr size_t WS_U = 502 * MiB;
constexpr size_t WS_GATES = 662 * MiB;
constexpr size_t WS_Y = 922 * MiB;
constexpr size_t WS_MERGED = 986 * MiB;
constexpr size_t WS_QB_OLD = 1050 * MiB;
constexpr size_t WS_OB_OLD = 1066 * MiB;
constexpr size_t WS_ROUTE = 1082 * MiB;
constexpr size_t WS_KVS = 1083 * MiB;
constexpr size_t WS_SSQ = 1091 * MiB;
constexpr size_t WS_XB8 = 1093 * MiB;
constexpr size_t WS_XB = 1125 * MiB;
constexpr size_t WS_END_MAIN = 1189 * MiB;
constexpr size_t WS_HPX = WS_END_MAIN + 176 * MiB;
constexpr size_t WS_QB = WS_QB_OLD;
constexpr size_t WS_OB = WS_HPX + 12 * MiB;
constexpr size_t WS_END = WS_OB + 16 * MiB;
constexpr size_t WS_ACT = WS_U, WS_HP = WS_GATES + 128 * MiB;
constexpr size_t WS_ACTD = WS_END_MAIN;
static_assert((size_t)MOE_SLOTS * DFF * 2 <= WS_Y - WS_U, "act overlay");
static_assert(GATE_FP8 && WS_HP + (size_t)MOE_SLOTS * D * 2 <= WS_Y && WS_ACT + (size_t)MOE_SLOTS * DFF <= WS_HP, "hp / act placement (fp8 experts, 8-bit gates)");
constexpr int CW_TMO = 0, CW_CODE = 1;
constexpr int CW_BAR = 4096;
constexpr int CW_QCTR = 8192;
constexpr int CW_KMAX = 10240;
constexpr int CW_MOFF = 10752;
constexpr int CW_WGCNT = 16384;

constexpr int RING_BYTES = 131072;
constexpr int LDSCTL_OFF = RING_BYTES, MISC_OFF = LDSCTL_OFF + 320;
constexpr int LDS_BYTES = 147456;
constexpr int KS = 72, VS = 96;
constexpr int L_KS = 0, L_VT = 36864, L_ST = 86016;

#define SHX(x, m, lane) __builtin_bit_cast(float, __builtin_amdgcn_ds_bpermute((((lane) ^ (m)) << 2), __builtin_bit_cast(int, (float)(x))))
DI float shx32(float x, int lane) { const auto r = __builtin_amdgcn_permlane32_swap(__builtin_bit_cast(unsigned, x), __builtin_bit_cast(unsigned, x), false, false); return __builtin_bit_cast(float, (lane & 32) ? r[0] : r[1]); }
DI float shx16(float x, int lane) { const auto r = __builtin_amdgcn_permlane16_swap(__builtin_bit_cast(unsigned, x), __builtin_bit_cast(unsigned, x), false, false); return __builtin_bit_cast(float, (lane & 16) ? r[0] : r[1]); }
template <int CTRL> DI float dppx(float v) { return __builtin_bit_cast(float, __builtin_amdgcn_update_dpp(0, __builtin_bit_cast(int, v), CTRL, 0xf, 0xf, true)); }
DI float row_sum16(float v) { v += dppx<0xB1>(v); v += dppx<0x4E>(v); v += dppx<0x141>(v); v += dppx<0x140>(v); return v; }
DI float fold32(float a, float b) { asm volatile("s_nop 1\n\tv_permlane32_swap_b32 %0, %1\n\ts_nop 1" : "+v"(a), "+v"(b)); return a + b; }
DI float fold16(float a, float b) { asm volatile("s_nop 1\n\tv_permlane16_swap_b32 %0, %1\n\ts_nop 1" : "+v"(a), "+v"(b)); return a + b; }
DI float wave_sum(float v, int lane) {
#if WSUM_DPP
    v = row_sum16(v); v += shx16(v, lane); v += shx32(v, lane);
#else
#pragma unroll
    for (int o = 1; o < 64; o <<= 1) v += SHX(v, o, lane);
#endif
    return v;
}
DI unsigned cvtpk(float lo, float hi) { f32x2 v = {lo, hi}; bf16x2_t b = __builtin_convertvector(v, bf16x2_t); return __builtin_bit_cast(unsigned, b); }
DI float bflo(unsigned w) { return __uint_as_float(w << 16); }
DI float bfhi(unsigned w) { return __uint_as_float(w & 0xffff0000u); }
DI void unpack8(const u32x4 w, float (&f)[8]) { f[0] = bflo(w.x); f[1] = bfhi(w.x); f[2] = bflo(w.y); f[3] = bfhi(w.y); f[4] = bflo(w.z); f[5] = bfhi(w.z); f[6] = bflo(w.w); f[7] = bfhi(w.w); }
DI u32x4 pack8(const float (&f)[8]) { u32x4 w; w.x = cvtpk(f[0], f[1]); w.y = cvtpk(f[2], f[3]); w.z = cvtpk(f[4], f[5]); w.w = cvtpk(f[6], f[7]); return w; }
DI float sat8(float x) { return __builtin_amdgcn_fmed3f(x, -448.f, 448.f); }
DI unsigned cvt4_fp8(float a, float b, float c, float d) { int w = __builtin_amdgcn_cvt_pk_fp8_f32(sat8(a), sat8(b), 0, false); w = __builtin_amdgcn_cvt_pk_fp8_f32(sat8(c), sat8(d), w, true); return (unsigned)w; }
DI unsigned pack4_u8(float a, float b, float c, float d) {
    const unsigned q0 = (unsigned)(a * 255.f + 0.5f), q1 = (unsigned)(b * 255.f + 0.5f), q2 = (unsigned)(c * 255.f + 0.5f), q3 = (unsigned)(d * 255.f + 0.5f); return q0 | (q1 << 8) | (q2 << 16) | (q3 << 24); }
DI float fexp2(float x) { return __builtin_amdgcn_exp2f(x); }
DI float frcp(float x) { return __builtin_amdgcn_rcpf(x); }
DI float sigmoid_f(float x) { return frcp(1.f + fexp2(-1.44269504f * x)); }
DI int lane_id() { int l; asm volatile("v_mbcnt_lo_u32_b32 %0, -1, 0\n\tv_mbcnt_hi_u32_b32 %0, -1, %0" : "=v"(l)); return l; }
DI int crow(int reg, int h) { return (reg & 3) + 8 * (reg >> 2) + 4 * h; }
#define MFMA32(a, b, c) __builtin_amdgcn_mfma_f32_32x32x16_bf16((a), (b), (c), 0, 0, 0)

__device__ const float INV_FREQ[32] = {1.0f, 0.7498942017555237f, 0.5623413324356079f, 0.4216965138912201f, 0.3162277638912201f, 0.23713737726211548f, 0.17782793939113617f, 0.1333521455526352f,
    0.10000000149011612f, 0.0749894231557846f, 0.05623413249850273f, 0.04216964915394783f, 0.03162277489900589f, 0.023713737726211548f, 0.017782794311642647f, 0.013335213996469975f,
    0.009999999776482582f, 0.007498942315578461f, 0.005623413249850273f, 0.0042169648222625256f, 0.003162277629598975f, 0.0023713738191872835f, 0.0017782794311642647f, 0.0013335214462131262f,
    0.0010000000474974513f, 0.0007498941849917173f, 0.000562341301701963f, 0.0004216965171508491f, 0.0003162277571391314f, 0.00023713737027719617f, 0.00017782794020604342f, 0.0001333521504420787f};

namespace pg8 {
constexpr int BM = 256, BK = 64, HALF = 128, HTB = HALF * BK * 2, STAGE_BYTES = 8 * HTB, NXCD = 8, WGM = 8;
__host__ __device__ __forceinline__ int lds_byte(int r, int c) { const int st = (r >> 4) * 2 + (c >> 5), rr = r & 15, cc = c & 31, ob = rr * 64 + cc * 2; return st * 1024 + (ob ^ (((ob >> 9) & 1) << 5)); }
__host__ __device__ __forceinline__ void stage_rc(int b, int& R, int& C) { const int st = b / 1024, sb = b % 1024, swz = sb ^ (((sb >> 9) & 1) << 5); R = (st >> 1) * 16 + swz / 64; C = (st & 1) * 32 + (swz % 64) / 2; }
__host__ __device__ __forceinline__ int perm32(int rho) { const int n = rho >> 4, i = rho & 15; return 8 * (i >> 2) + 4 * n + (i & 3); }

struct Unit { int pm, pn, z; const char* a; const char* b; };
DI const char* uni(const char* p) { const unsigned long long v = (unsigned long long)p; const unsigned lo = __builtin_amdgcn_readfirstlane((unsigned)v), hi = __builtin_amdgcn_readfirstlane((unsigned)(v >> 32)); return (const char*)(((unsigned long long)hi << 32) | lo); }

struct TileOrder {
    int nM, nN, nwg, G, c;
    DI void init(int nM_, int nN_, int G_, int c_) { nM = nM_; nN = nN_; nwg = nM * nN; G = G_; c = c_; }
    DI bool tile(int i, int& pm, int& pn) const {
        const long L = (long)i * G + c; if (L >= nwg) return false;
        int wgid = (int)L; { const int q = nwg / NXCD, r = nwg % NXCD, xcd = wgid % NXCD, off = wgid / NXCD; wgid = (xcd < r ? xcd * (q + 1) : r * (q + 1) + (xcd - r) * q) + off; }
        const int nig = WGM * nN, gid = wgid / nig, fm = gid * WGM, gsz = (nM - fm) < WGM ? (nM - fm) : WGM;
        pm = fm + ((wgid % nig) % gsz); pn = (wgid % nig) / gsz; return true;
    }
};

template <class E, class = void> struct epi_ktop_t { static constexpr bool value = false; };
template <class E> struct epi_ktop_t<E, decltype((void)E::KTOP)> { static constexpr bool value = E::KTOP; };
template <class E> constexpr bool epi_ktop() { return epi_ktop_t<E>::value; }
template <class Epi, class Sched, bool F8 = false, bool HN = false>
DI void gemm_phase(LAS unsigned char* lds, const int K, const int lda, const Sched& S, const Epi& E, const int wid_in, const int kext = 0) {
    int wid = wid_in; asm volatile("" : "+s"(wid));
    int lane = lane_id(); asm volatile("" : "+v"(lane));
    const int tid = wid * 64 + lane, wr = wid >> 2, wc = wid & 3, fr = lane & 15, fq = lane >> 4;
    constexpr int ESZ = F8 ? 1 : 2; const int nt = ((kext ? kext : K) * ESZ) / (BK * 2);
    unsigned voffA, voffB;
    { int R, C; stage_rc(2 * wid * 1024 + lane * 16, R, C); const int Rb = Epi::PERM ? ((R & ~31) + perm32(R & 31)) : R;
      voffA = (unsigned)(R * lda * ESZ + C * 2); voffB = (unsigned)(Rb * K * ESZ + C * 2); }
    unsigned voffA2 = voffA + 64u, voffB2 = voffB + 64u;
    const size_t kstep = (size_t)(BK * 2);
    const size_t hstepA = (size_t)HALF * lda * ESZ, hstepB = (size_t)HALF * K * ESZ;
    const unsigned ldsw = (unsigned)wid * 2048u;
    constexpr int PIECE = F8 ? 16 : 1024;
    const int aoff = lds_byte(wr * 64 + fr, F8 ? fq * 16 : fq * 8) + ((F8 && (fq & 1)) ? 16 : 0), boff = lds_byte(wc * 32 + fr, F8 ? fq * 16 : fq * 8) + ((F8 && (fq & 1)) ? 16 : 0);
    const int aoffx = aoff ^ 16, boffx = boff ^ 16;
#define PG8_SA(b, h) (((b) * 2 + (h)) * HTB)
#define PG8_SB(b, h) ((4 + (b) * 2 + (h)) * HTB)
#define PG8_STAGE(bufoff, gbase, voff) do { asm volatile("" : "+v"(voff), "+v"(voff##2));     \
        __builtin_amdgcn_global_load_lds((const GAS unsigned*)((const GAS char*)(gbase) + voff), (LAS unsigned*)(lds + (bufoff) + ldsw), 16, 0, 0); \
        __builtin_amdgcn_global_load_lds((const GAS unsigned*)((const GAS char*)(gbase) + voff##2), (LAS unsigned*)(lds + (bufoff) + ldsw + 1024), 16, 0, 0); } while (0)
#define PG8_LD16(off) (*(const LAS u32x4*)(lds + (off)))
#define PG8_LD16B(off) (*(const LAS u32x4*)(ldsB + (off)))
#define PG8_LD16BX(off) (*(const LAS u32x4*)(ldsBx + (off)))
#define PG8_SBR(b, h) (((b) * 2 + (h)) * HTB)
#define PG8_LDA(dst, b, h) do { _Pragma("unroll") for (int m = 0; m < 4; ++m) { if constexpr (F8) dst##8[m] = __builtin_bit_cast(i32x8, __builtin_shufflevector(PG8_LD16(PG8_SA(b, h) + aoff + m * 2048), PG8_LD16(PG8_SA(b, h) + aoffx + m * 2048), 0, 1, 2, 3, 4, 5, 6, 7)); \
        else { _Pragma("unroll") for (int k = 0; k < 2; ++k) dst[m][k] = *(const LAS bf16x8*)(lds + PG8_SA(b, h) + aoff + k * PIECE + m * 2048); } } } while (0)
#define PG8_LDB(dst, b, h) do { _Pragma("unroll") for (int n = 0; n < 2; ++n) { if constexpr (F8) dst##8[n] = __builtin_bit_cast(i32x8, __builtin_shufflevector(PG8_LD16B(PG8_SBR(b, h) + n * 2048), PG8_LD16BX(PG8_SBR(b, h) + n * 2048), 0, 1, 2, 3, 4, 5, 6, 7)); \
        else { _Pragma("unroll") for (int k = 0; k < 2; ++k) dst[n][k] = *(const LAS bf16x8*)(ldsB + PG8_SBR(b, h) + k * PIECE + n * 2048); } } } while (0)
#define PG8_MMA(ai, bj, At, Bt) do { if constexpr (HN && (bj) == 1) break; __builtin_amdgcn_s_setprio(1); _Pragma("unroll") for (int m = 0; m < 4; ++m) _Pragma("unroll") for (int n = 0; n < 2; ++n) { \
        if constexpr (F8) acc[ai][bj][m][n] = __builtin_amdgcn_mfma_scale_f32_16x16x128_f8f6f4(Bt##8[n], At##8[m], acc[ai][bj][m][n], 0, 0, 0, 0, 0, 0);     \
        else { _Pragma("unroll") for (int k = 0; k < 2; ++k) acc[ai][bj][m][n] = __builtin_amdgcn_mfma_f32_16x16x32_bf16(Bt[n][k], At[m][k], acc[ai][bj][m][n], 0, 0, 0); } } __builtin_amdgcn_s_setprio(0); } while (0)
#define PG8_WAIT_V(n) asm volatile("s_waitcnt vmcnt(" #n ")" ::: "memory")
#define PG8_WAIT_L(n) asm volatile("s_waitcnt lgkmcnt(" #n ")" ::: "memory")
#define PG8_BAR __builtin_amdgcn_s_barrier()
#define PG8_SCHED __builtin_amdgcn_sched_barrier(0)
    const LAS unsigned char* ldsB = lds + 4 * HTB + boff; const LAS unsigned char* ldsBx = lds + 4 * HTB + boffx; (void)ldsBx; (void)aoffx;
    Unit cur, nxt; int ui = 0;
    if (!S.next(0, cur)) return;
    typename Epi::State est;
    if constexpr (Epi::PRE) { int le = lane_id(); asm volatile("" : "+v"(le)); E.pre(est, cur, 0, wr, wc, le & 15, le >> 4); }
    f32x4 acc[2][2][4][2];
#pragma unroll
    for (int a = 0; a < 2; ++a)
#pragma unroll
        for (int b = 0; b < 2; ++b)
#pragma unroll
            for (int m = 0; m < 4; ++m)
#pragma unroll
                for (int n = 0; n < 2; ++n) acc[a][b][m][n] = (f32x4){0.f, 0.f, 0.f, 0.f};
    bf16x8 At[4][2], B0[2][2], B1[2][2]; i32x8 At8[4], B08[2], B18[2];
    const char* cA = cur.a; const char* cB = cur.b;
#define PG8_WAIT_K() do { if constexpr (HN) PG8_WAIT_V(6); else PG8_WAIT_V(8); } while (0)
    PG8_STAGE(PG8_SB(0, 0), cB, voffB); if constexpr (!HN) PG8_STAGE(PG8_SB(0, 1), cB + hstepB, voffB); PG8_STAGE(PG8_SA(0, 0), cA, voffA); PG8_STAGE(PG8_SA(0, 1), cA + hstepA, voffA);
    if (wr == 1) PG8_BAR;
    PG8_WAIT_V(2); PG8_BAR;
    PG8_STAGE(PG8_SB(1, 0), cB + kstep, voffB); PG8_STAGE(PG8_SA(1, 0), cA + kstep, voffA); if constexpr (!HN) PG8_STAGE(PG8_SB(1, 1), cB + hstepB + kstep, voffB);
    if constexpr (HN) PG8_WAIT_V(4); else PG8_WAIT_V(6);
    PG8_BAR;
    for (;;) {
        const bool has_next = S.next(ui + 1, nxt);
        const char* nA = has_next ? nxt.a : cA; const char* nB = has_next ? nxt.b : cB;
#pragma nounroll
        for (int t = 0; t < nt; t += 2) {
            const bool last = (t == nt - 2);
            if constexpr (epi_ktop<Epi>()) { if (F8 || (t & 3) == 2) { int le = lane_id(); asm volatile("" : "+v"(le)); E.ktop(est, cur, F8 ? (t >> 1) : (t >> 2), wr, wc, le & 15, le >> 4); } }
            const char* a1 = cA + (size_t)(t + 1) * kstep;
            const char* a2 = last ? nA : cA + (size_t)(t + 2) * kstep; const char* b2 = last ? nB : cB + (size_t)(t + 2) * kstep;
            asm volatile("" : "+s"(a1), "+s"(a2), "+s"(b2));
            const char* a3 = a2 + kstep; const char* b3 = b2 + kstep;
            PG8_LDB(B0, 0, 0); if constexpr (!HN) PG8_LDB(B1, 0, 1); PG8_SCHED; PG8_LDA(At, 0, 0); PG8_STAGE(PG8_SA(1, 1), a1 + hstepA, voffA);
            PG8_WAIT_K(); PG8_WAIT_L(0); PG8_BAR; PG8_MMA(0, 0, At, B0); PG8_MMA(0, 1, At, B1); PG8_BAR; PG8_SCHED;
            PG8_LDA(At, 0, 1); PG8_STAGE(PG8_SB(0, 0), b2, voffB); if constexpr (!HN) PG8_STAGE(PG8_SB(0, 1), b2 + hstepB, voffB); PG8_STAGE(PG8_SA(0, 0), a2, voffA);
            PG8_WAIT_K(); PG8_WAIT_L(0); PG8_BAR; PG8_MMA(1, 0, At, B0); PG8_MMA(1, 1, At, B1); PG8_BAR; PG8_SCHED;
            PG8_LDB(B0, 1, 0); if constexpr (!HN) PG8_LDB(B1, 1, 1); PG8_SCHED; PG8_LDA(At, 1, 0); PG8_STAGE(PG8_SA(0, 1), a2 + hstepA, voffA);
            PG8_WAIT_K(); PG8_WAIT_L(0); PG8_BAR; PG8_MMA(0, 0, At, B0); PG8_MMA(0, 1, At, B1); PG8_BAR; PG8_SCHED;
            PG8_LDA(At, 1, 1); PG8_STAGE(PG8_SB(1, 0), b3, voffB); if constexpr (!HN) PG8_STAGE(PG8_SB(1, 1), b3 + hstepB, voffB); PG8_STAGE(PG8_SA(1, 0), a3, voffA);
            PG8_WAIT_K(); PG8_WAIT_L(0); PG8_BAR; PG8_MMA(1, 0, At, B0); PG8_MMA(1, 1, At, B1); PG8_BAR; PG8_SCHED;
            if constexpr (Epi::KHOOK) { if ((F8 || (t & 3) == 2) && !last) { int le = lane_id(); asm volatile("" : "+v"(le)); E.khook(acc, cur, F8 ? (t >> 1) : (t >> 2), wr, wc, le & 15, le >> 4, est); } }
        }
        if (wr == 0) PG8_BAR;
        { int le = lane_id(); asm volatile("" : "+v"(le));
          if constexpr (Epi::PRE) { E(acc, cur, wr, wc, le & 15, le >> 4, est); if (has_next) E.pre(est, nxt, 0, wr, wc, le & 15, le >> 4); }
          else if constexpr (epi_ktop<Epi>()) E(acc, cur, wr, wc, le & 15, le >> 4, est);
          else E(acc, cur, wr, wc, le & 15, le >> 4); }
        if (!has_next) break;
#pragma unroll
        for (int a = 0; a < 2; ++a)
#pragma unroll
            for (int b = 0; b < (HN ? 1 : 2); ++b)
#pragma unroll
                for (int m = 0; m < 4; ++m)
#pragma unroll
                    for (int n = 0; n < 2; ++n) acc[a][b][m][n] = (f32x4){0.f, 0.f, 0.f, 0.f};
        cur = nxt; cA = nA; cB = nB; ++ui;
        if (wr == 1) PG8_BAR;
    }
    PG8_WAIT_V(0);
    PG8_BAR;
#undef PG8_SA
#undef PG8_SB
#undef PG8_STAGE
#undef PG8_LDA
#undef PG8_LDB
#undef PG8_MMA
#undef PG8_LD16
#undef PG8_LD16B
#undef PG8_LD16BX
#undef PG8_SBR
#undef PG8_WAIT_V
#undef PG8_WAIT_K
#undef PG8_WAIT_L
#undef PG8_BAR
#undef PG8_SCHED
}

struct OrdStd {
    TileOrder to; const char* A; const char* B; size_t atile, btile; int i0 = 0, ni = 1 << 30;
    DI bool next(int i, Unit& u) const { if (i >= ni || !to.tile(i + i0, u.pm, u.pn)) return false; u.z = 0; u.a = A + (size_t)u.pm * atile; u.b = B + (size_t)u.pn * btile; return true; }
};
struct OrdQ {
    TileOrder to; const char* A; const char* B;
    DI bool next(int i, Unit& u) const { if (!to.tile(i, u.pm, u.pn)) return false; u.z = 0; u.a = A + (size_t)u.pm * (256 * D * 2) + (size_t)u.pn * 1024; u.b = B + (size_t)u.pn * 1024; return true; }
};
struct OrdKV {
    TileOrder to; const char* A; const char* B;
    DI bool next(int i, Unit& u) const { if (!to.tile(i, u.pm, u.pn)) return false; const int l = u.pm >> 4; u.z = l; u.a = A + (size_t)u.pm * (256 * 1024 * 2); u.b = B + (size_t)l * (512 * 1024 * 2) + (size_t)u.pn * (256 * 1024 * 2); return true; }
};
struct OrdMerge {
    int G, c, ntiles; const char* A; const char* B; int esz;
    DI bool next(int i, Unit& u) const { const int NV = (G & 7) ? 1 : 8, v = c % NV, r = c / NV, per = G / NV, ntl = ntiles / NV; const int tq = i * per + r; if (tq >= ntl) return false; const int tl = v * ntl + tq; u.z = 0; u.pm = tl >> 3; u.pn = tl & 7;
        u.a = A + (size_t)u.pm * (256 * 1024) * esz; u.b = B + (size_t)u.pn * (128 * 1024) * esz; return true; }
};
struct OrdMoe {
    TileOrder to; const char* A; const char* B; size_t atile, btile, bexp; int off[9]; int pm0 = 0; size_t koff = 0;
    DI bool next(int i, Unit& u) const { if (!to.tile(i, u.pm, u.pn)) return false; u.pm += pm0; const int r0 = u.pm * 256; int e = 0;
#pragma unroll
        for (int k = 1; k < 8; ++k) e += (r0 >= off[k]) ? 1 : 0;
        u.z = e; u.a = uni(A + (size_t)u.pm * atile + koff); u.b = uni(B + (size_t)e * bexp + (size_t)u.pn * btile + koff); return true; }
};

DI float row_rstd(const float* ssq, size_t row, int fq, int lane) {
    const f32x4 a = *(const f32x4*)(ssq + row * 16 + 4 * fq); float s = (a.x + a.y) + (a.z + a.w); s += shx16(s, lane); s += shx32(s, lane); return __builtin_amdgcn_rsqf(s * (1.f / D) + EPS); }
DI u32x4 pair16(u32x2 a, u32x2 b) {
    asm volatile("s_nop 1\n\tv_permlane16_swap_b32 %0, %1\n\ts_nop 1" : "+v"(a.x), "+v"(b.x));
    asm volatile("s_nop 1\n\tv_permlane16_swap_b32 %0, %1\n\ts_nop 1" : "+v"(a.y), "+v"(b.y));
    return (u32x4){a.x, a.y, b.x, b.y};
}
DI void rows_rstd(float (&rs)[2][4], const float* ssq, int row0, int fq, int lane, float mul) {
    f32x4 a[2][4];
#pragma unroll
    for (int ai = 0; ai < 2; ++ai)
#pragma unroll
        for (int m = 0; m < 4; ++m) a[ai][m] = *(const f32x4*)(ssq + (size_t)(row0 + ai * HALF + m * 16) * 16 + 4 * fq);
#pragma unroll
    for (int ai = 0; ai < 2; ++ai)
#pragma unroll
        for (int m = 0; m < 4; ++m) { float s = (a[ai][m].x + a[ai][m].y) + (a[ai][m].z + a[ai][m].w); s += shx16(s, lane); s += shx32(s, lane); rs[ai][m] = __builtin_amdgcn_rsqf(s * (1.f / D) + EPS) * mul; }
}
DI unsigned pack4_lowbytes(float a, float b, float c, float d) {
    const unsigned ab = __builtin_amdgcn_perm(__float_as_uint(b), __float_as_uint(a), 0x0c0c0400u), cd = __builtin_amdgcn_perm(__float_as_uint(d), __float_as_uint(c), 0x04000c0cu); return ab | cd; }
template <bool G8, bool S8 = false> struct EpiCat {
    static constexpr bool PERM = true; static constexpr bool PRE = false; static constexpr bool KHOOK = false; struct State {};
    bf16* U; bf16* Gt; const float* ssq;
    DI void operator()(const f32x4 (&acc)[2][2][4][2], const Unit& u, int wr, int wc, int fr, int fq) const {
        const bool isg = G8 || u.pn >= 10; bf16* base = isg ? Gt : U; const int ldc = isg ? 4096 : DIN; const int colt = G8 ? u.pn * 256 : (isg ? (u.pn - 10) * 256 : u.pn * 256);
        const int row0 = u.pm * BM + wr * 64 + fr, col0 = colt + wc * 32 + 8 * fq;
        if constexpr (G8) {
            unsigned char* g8 = (unsigned char*)Gt; float rsv[2][4]; rows_rstd(rsv, ssq, row0, fq, fr + 16 * fq, -1.44269504f * W8_INV);
#define G8Q(x) (frcp(__builtin_fmaf(fexp2((x) * rs), 1.f / 255.f, 1.f / 255.f)) + 12582912.f)
            const int colp = colt + wc * 32 + 16 * (fq >> 1);
#pragma unroll
            for (int ai = 0; ai < 2; ++ai)
#pragma unroll
                for (int mp = 0; mp < 2; ++mp) { const size_t row = (size_t)(row0 + ai * HALF + (2 * mp + (fq & 1)) * 16);
#pragma unroll
                    for (int bj = 0; bj < 2; ++bj) { u32x2 w[2];
#pragma unroll
                        for (int k = 0; k < 2; ++k) { const int m = 2 * mp + k; const float rs = rsv[ai][m]; const f32x4 v0 = acc[ai][bj][m][0], v1 = acc[ai][bj][m][1];
                            w[k].x = pack4_lowbytes(G8Q(v0[0]), G8Q(v0[1]), G8Q(v0[2]), G8Q(v0[3])); w[k].y = pack4_lowbytes(G8Q(v1[0]), G8Q(v1[1]), G8Q(v1[2]), G8Q(v1[3])); }
                        *(u32x4*)(g8 + row * 4096 + colp + bj * HALF) = pair16(w[0], w[1]); } }
#undef G8Q
            return; }
        float rsv[2][4]; rows_rstd(rsv, ssq, row0, fq, fr + 16 * fq, (G8 || S8) ? W8_INV : 1.f);
#pragma unroll
        for (int ai = 0; ai < 2; ++ai)
#pragma unroll
            for (int m = 0; m < 4; ++m) { const size_t row = (size_t)(row0 + ai * HALF + m * 16); bf16* rowp = base + row * ldc + col0; const float rs = rsv[ai][m];
#pragma unroll
                for (int bj = 0; bj < 2; ++bj) { f32x4 v0 = acc[ai][bj][m][0] * rs, v1 = acc[ai][bj][m][1] * rs;
                    if (isg) {
#pragma unroll
                        for (int j = 0; j < 4; ++j) { v0[j] = sigmoid_f(v0[j]); v1[j] = sigmoid_f(v1[j]); } }
                    u32x4 w; w.x = cvtpk(v0[0], v0[1]); w.y = cvtpk(v0[2], v0[3]); w.z = cvtpk(v1[0], v1[1]); w.w = cvtpk(v1[2], v1[3]);
                    *(u32x4*)(rowp + bj * HALF) = w; } }
    }
};
template <bool S8> struct EpiBf16 {
    static constexpr bool PERM = true; static constexpr bool PRE = false; static constexpr bool KHOOK = false; struct State {}; static constexpr float sc = S8 ? W8_INV : 1.f;
    bf16* O; int ldc; const float* ssq;
    DI void operator()(const f32x4 (&acc)[2][2][4][2], const Unit& u, int wr, int wc, int fr, int fq) const {
        const int row0 = u.pm * BM + wr * 64 + fr, col0 = u.pn * BM + wc * 32 + 8 * fq;
        float rsv[2][4];
        if (ssq) rows_rstd(rsv, ssq, row0, fq, fr + 16 * fq, sc);
#pragma unroll
        for (int ai = 0; ai < 2; ++ai)
#pragma unroll
            for (int m = 0; m < 4; ++m) { const size_t row = (size_t)(row0 + ai * HALF + m * 16); bf16* rowp = O + row * ldc + col0; const float s2 = ssq ? rsv[ai][m] : sc;
#pragma unroll
                for (int bj = 0; bj < 2; ++bj) { const f32x4 v0 = acc[ai][bj][m][0] * s2, v1 = acc[ai][bj][m][1] * s2;
                    u32x4 w; w.x = cvtpk(v0[0], v0[1]); w.y = cvtpk(v0[2], v0[3]); w.z = cvtpk(v1[0], v1[1]); w.w = cvtpk(v1[2], v1[3]);
                    *(u32x4*)(rowp + bj * HALF) = w; } }
    }
};
struct EpiMerge {
    static constexpr bool PERM = true; static constexpr bool PRE = false; static constexpr bool KHOOK = true; static constexpr bool KTOP = GATE_FP8 != 0; struct State { u32x2 gw[2][4]; u32x4 gb[2][4]; };
    const bf16* Gt; bf16* Mg; int m8; float ksc;
    DI void ktop(State& st, const Unit& u, int z, int wr, int wc, int fr, int fq) const {
        const int row0 = u.pm * BM + wr * 64 + fr, col0 = u.pn * HALF + wc * 32 + 8 * fq;
#pragma unroll
        for (int ai = 0; ai < 2; ++ai)
#pragma unroll
            for (int m = 0; m < 4; ++m) { const unsigned char* p = (const unsigned char*)Gt + (size_t)(row0 + ai * HALF + m * 16) * 4096 + z * 1024 + col0;
                asm volatile("global_load_dwordx2 %0, %1, off" : "=v"(st.gw[ai][m]) : "v"(p) : "memory"); }
    }
    DI void pre(State& st, const Unit& u, int z, int wr, int wc, int fr, int fq) const {
        const int row0 = u.pm * BM + wr * 64 + fr, col0 = u.pn * HALF + wc * 32 + 8 * fq;
#pragma unroll
        for (int ai = 0; ai < 2; ++ai)
#pragma unroll
            for (int m = 0; m < 4; ++m) { if (GATE_FP8) st.gw[ai][m] = *(const u32x2*)((const unsigned char*)Gt + (size_t)(row0 + ai * HALF + m * 16) * 4096 + z * 1024 + col0);
                else st.gb[ai][m] = *(const u32x4*)(Gt + (size_t)(row0 + ai * HALF + m * 16) * 4096 + z * 1024 + col0); }
    }
    template <bool FIRST, bool LAST> DI void gate(f32x4 (&acc)[2][2][4][2], const Unit& u, int wr, int wc, int fr, int fq, State& st) const {
        const int row0 = u.pm * BM + wr * 64 + fr, col0 = u.pn * HALF + wc * 32 + 8 * fq;
        u32x2 mw[2][4];
#pragma unroll
        for (int ai = 0; ai < 2; ++ai)
#pragma unroll
            for (int m = 0; m < 4; ++m) { float g[8];
                if (GATE_FP8) { const unsigned a = st.gw[ai][m].x, b = st.gw[ai][m].y;
                    g[0] = (float)(a & 0xffu); g[1] = (float)((a >> 8) & 0xffu); g[2] = (float)((a >> 16) & 0xffu); g[3] = (float)(a >> 24);
                    g[4] = (float)(b & 0xffu); g[5] = (float)((b >> 8) & 0xffu); g[6] = (float)((b >> 16) & 0xffu); g[7] = (float)(b >> 24); }
                else unpack8(st.gb[ai][m], g);
                const f32x4 v0 = acc[ai][0][m][0], v1 = acc[ai][0][m][1];
                f32x4 t0, t1;
                if (FIRST) { t0 = (f32x4){g[0] * v0[0], g[1] * v0[1], g[2] * v0[2], g[3] * v0[3]}; t1 = (f32x4){g[4] * v1[0], g[5] * v1[1], g[6] * v1[2], g[7] * v1[3]}; }
                else { const f32x4 r0 = acc[ai][1][m][0], r1 = acc[ai][1][m][1];
                    t0 = (f32x4){__builtin_fmaf(g[0], v0[0], r0[0]), __builtin_fmaf(g[1], v0[1], r0[1]), __builtin_fmaf(g[2], v0[2], r0[2]), __builtin_fmaf(g[3], v0[3], r0[3])};
                    t1 = (f32x4){__builtin_fmaf(g[4], v1[0], r1[0]), __builtin_fmaf(g[5], v1[1], r1[1]), __builtin_fmaf(g[6], v1[2], r1[2]), __builtin_fmaf(g[7], v1[3], r1[3])}; }
                acc[ai][1][m][0] = t0; acc[ai][1][m][1] = t1; acc[ai][0][m][0] = (f32x4){0.f, 0.f, 0.f, 0.f}; acc[ai][0][m][1] = (f32x4){0.f, 0.f, 0.f, 0.f};
                if (LAST && GATE_FP8) { t0 *= ksc; t1 *= ksc; }
                if (LAST) { if (m8) { mw[ai][m].x = cvt4_fp8(t0[0] * 4.f, t0[1] * 4.f, t0[2] * 4.f, t0[3] * 4.f); mw[ai][m].y = cvt4_fp8(t1[0] * 4.f, t1[1] * 4.f, t1[2] * 4.f, t1[3] * 4.f); }
                    else { u32x4 w; w.x = cvtpk(t0[0], t0[1]); w.y = cvtpk(t0[2], t0[3]); w.z = cvtpk(t1[0], t1[1]); w.w = cvtpk(t1[2], t1[3]);
                        *(u32x4*)(Mg + (size_t)(row0 + ai * HALF + m * 16) * 1024 + col0) = w; } } }
        if (LAST) { if (m8) {
#pragma unroll
            for (int ai = 0; ai < 2; ++ai)
#pragma unroll
                for (int mp = 0; mp < 2; ++mp) *(u32x4*)((unsigned char*)Mg + (size_t)(row0 + ai * HALF + (2 * mp + (fq & 1)) * 16) * 1024 + u.pn * HALF + wc * 32 + 16 * (fq >> 1)) = pair16(mw[ai][2 * mp], mw[ai][2 * mp + 1]); } }
    }
    DI void khook(f32x4 (&acc)[2][2][4][2], const Unit& u, int z, int wr, int wc, int fr, int fq, State& st) const {
        if (z == 0) gate<true, false>(acc, u, wr, wc, fr, fq, st); else gate<false, false>(acc, u, wr, wc, fr, fq, st);
        if (!KTOP) pre(st, u, z + 1, wr, wc, fr, fq);
    }
    DI void operator()(f32x4 (&acc)[2][2][4][2], const Unit& u, int wr, int wc, int fr, int fq, State& st) const { gate<false, true>(acc, u, wr, wc, fr, fq, st); }
};
template <bool XB, bool S8, int ASH = 0> struct EpiRes {
    static constexpr bool PERM = true; static constexpr bool PRE = false; static constexpr bool KHOOK = false; struct State {};
    static constexpr float sc = (S8 ? W8_INV : 1.f) / (float)(1 << ASH);
    bf16* xres; int xbm; float* ssq; unsigned char* xb8;
    DI void operator()(const f32x4 (&acc)[2][2][4][2], const Unit& u, int wr, int wc, int fr, int fq) const {
        const int row0 = u.pm * BM + wr * 64 + fr, col0 = u.pn * BM + wc * 32 + 8 * fq, lane = fr + 16 * fq;
#pragma unroll
        for (int ai = 0; ai < 2; ++ai) {
            u32x4 bsv[4][2];
#pragma unroll
            for (int m = 0; m < 4; ++m)
#pragma unroll
                for (int bj = 0; bj < 2; ++bj) bsv[m][bj] = *(const u32x4*)(xres + (size_t)(row0 + ai * HALF + m * 16) * D + col0 + bj * HALF);
            u32x2 c8[4][2];
#pragma unroll
            for (int m = 0; m < 4; ++m) { const size_t row = (size_t)(row0 + ai * HALF + m * 16), off = row * D + col0; float s = 0.f;
#pragma unroll
                for (int bj = 0; bj < 2; ++bj) { float b[8]; unpack8(bsv[m][bj], b);
                    const f32x4 v0 = (f32x4){b[0], b[1], b[2], b[3]} + acc[ai][bj][m][0] * sc, v1 = (f32x4){b[4], b[5], b[6], b[7]} + acc[ai][bj][m][1] * sc;
                    u32x4 w; w.x = cvtpk(v0.x, v0.y); w.y = cvtpk(v0.z, v0.w); w.z = cvtpk(v1.x, v1.y); w.w = cvtpk(v1.z, v1.w); *(u32x4*)(xres + off + bj * HALF) = w;
                    s += ((v0.x * v0.x + v0.y * v0.y) + (v0.z * v0.z + v0.w * v0.w)) + ((v1.x * v1.x + v1.y * v1.y) + (v1.z * v1.z + v1.w * v1.w));
                    if (xbm & 2) { c8[m][bj].x = cvt4_fp8(v0.x, v0.y, v0.z, v0.w); c8[m][bj].y = cvt4_fp8(v1.x, v1.y, v1.z, v1.w); } }
                s += shx16(s, lane); s += shx32(s, lane); if (fq == 0) ssq[row * 16 + u.pn * 4 + wc] = s; }
            if (xbm & 2) {
#pragma unroll
                for (int mp = 0; mp < 2; ++mp) { const size_t row = (size_t)(row0 + ai * HALF + (2 * mp + (fq & 1)) * 16);
#pragma unroll
                    for (int bj = 0; bj < 2; ++bj) *(u32x4*)(xb8 + row * D + u.pn * BM + wc * 32 + 16 * (fq >> 1) + bj * HALF) = pair16(c8[2 * mp][bj], c8[2 * mp + 1][bj]); } }
            asm volatile("" ::: "memory"); }
    }
};
template <bool F8O, bool RS = true> struct EpiGU {
    static constexpr bool PERM = true; static constexpr bool PRE = false; static constexpr bool KHOOK = false; struct State {};
    static constexpr float sc = F8O ? W8_INV : 1.f;
    void* O; const float* ssq;
    DI void operator()(const f32x4 (&acc)[2][2][4][2], const Unit& u, int wr, int wc, int fr, int fq) const {
        const int row0 = u.pm * BM + wr * 64 + fr, col0 = u.pn * HALF + wc * 32 + 8 * fq;
        float rsv[2][4];
        if (ssq) rows_rstd(rsv, ssq, row0, fq, fr + 16 * fq, sc);
#pragma unroll
        for (int ai = 0; ai < 2; ++ai) { u32x2 w8[4];
#pragma unroll
            for (int m = 0; m < 4; ++m) { const size_t row = (size_t)(row0 + ai * HALF + m * 16), eo = row * DFF + col0; const float s2 = ssq ? rsv[ai][m] : sc;
                float r[8];
#pragma unroll
                for (int n = 0; n < 2; ++n)
#pragma unroll
                    for (int j = 0; j < 4; ++j) {
                        if constexpr (RS) { const float g = acc[ai][0][m][n][j] * s2, uu = acc[ai][1][m][n][j] * s2; r[4 * n + j] = g * sigmoid_f(g) * uu; }
                        else { const float a = acc[ai][0][m][n][j], b = acc[ai][1][m][n][j]; r[4 * n + j] = (a * b) * frcp(1.f + fexp2(a * (-1.44269504f * sc))) * (sc * sc); } }
                if constexpr (F8O) { w8[m].x = cvt4_fp8(r[0], r[1], r[2], r[3]); w8[m].y = cvt4_fp8(r[4], r[5], r[6], r[7]); }
                else *(u32x4*)((bf16*)O + eo) = pack8(r); }
            if constexpr (F8O) {
#pragma unroll
                for (int mp = 0; mp < 2; ++mp) { const size_t row = (size_t)(row0 + ai * HALF + (2 * mp + (fq & 1)) * 16);
                    *(u32x4*)((unsigned char*)O + row * DFF + u.pn * HALF + wc * 32 + 16 * (fq >> 1)) = pair16(w8[2 * mp], w8[2 * mp + 1]); } } }
    }
};
}

#define XB_TMO      128
#define XB_XCNT(j)  (256  + 64 * (j))
#define XB_XSUB(j)  (1280 + 64 * (j))
#define XB_XGEN(j)  (2304 + 64 * (j))
#define XB_TOP      3328
#define XB_TOPGEN   3392
#define XCD_BAR_WORDS 3456
#define XB_SPIN_CAP (1u << 22)
DI unsigned xb_ld(unsigned* p)              { return __hip_atomic_load(p, __ATOMIC_RELAXED, __HIP_MEMORY_SCOPE_AGENT); }
DI unsigned xb_add(unsigned* p, unsigned v) { return __hip_atomic_fetch_add(p, v, __ATOMIC_RELAXED, __HIP_MEMORY_SCOPE_AGENT); }
DI unsigned xb_xcc_id() { return (unsigned)__builtin_amdgcn_s_getreg((3 << 11) | 20) & 0xFu; }
#define XB_SPIN(cond, bar) do { unsigned _sp = 0; while (cond) { __builtin_amdgcn_s_sleep(1); \
    if ((++_sp & 255u) == 0u) { if (xb_ld(&(bar)[XB_TMO])) break; if (_sp > XB_SPIN_CAP) { atomicAdd(&(bar)[XB_TMO], 1u); break; } } } } while (0)
struct XcdBarrier { unsigned* bar; unsigned x; volatile LAS unsigned* st; };
DI XcdBarrier xcd_barrier_post(unsigned* bar, volatile LAS unsigned* st) {
    XcdBarrier b; b.bar = bar; b.x = xb_xcc_id(); b.st = st;
    if (threadIdx.x == 0) (void)xb_add(&bar[XB_XCNT(b.x)], 1u);
    return b;
}
DI void xcd_barrier_complete(unsigned* bar, unsigned x, unsigned& nloc, unsigned& nx) {
    const unsigned G = gridDim.x * gridDim.y * gridDim.z;
    unsigned sum, cnt, mine, sp = 0u;
    for (;;) {
        sum = 0u; cnt = 0u; mine = 0u;
#pragma unroll
        for (unsigned j = 0; j < 16; ++j) { const unsigned c = xb_ld(&bar[XB_XCNT(j)]); sum += c; cnt += (c > 0u) ? 1u : 0u; mine = (j == x) ? c : mine; }
        if (sum == G) break;
        __builtin_amdgcn_s_sleep(1);
        if ((++sp & 255u) == 0u) { if (xb_ld(&bar[XB_TMO])) break; if (sp > XB_SPIN_CAP) { atomicAdd(&bar[XB_TMO], 1u); break; } }
    }
    nloc = mine > 0u ? mine : 1u; nx = cnt > 0u ? cnt : 1u;
}
__device__ __noinline__ void xcd_barrier_fn(GAS unsigned* gbar, unsigned bx, volatile LAS unsigned* bst, int wave) {
    XcdBarrier b; b.bar = (unsigned*)gbar; b.x = bx; b.st = bst; const bool t0 = (wave == 0) && (lane_id() == 0);
    asm volatile("s_waitcnt vmcnt(0)" ::: "memory");
    __syncthreads();
    if (t0) {
        unsigned* bar = b.bar;
        __builtin_amdgcn_s_waitcnt(0);
        unsigned nloc = b.st[0], nx = b.st[1];
        if (nloc == 0u) { xcd_barrier_complete(bar, b.x, nloc, nx); b.st[0] = nloc; b.st[1] = nx; }
        const unsigned old = xb_add(&bar[XB_XSUB(b.x)], 1u);
        const unsigned gen = old / nloc;
        if (old + 1u == (gen + 1u) * nloc) {
            __builtin_amdgcn_fence(__ATOMIC_RELEASE, "agent");
            asm volatile("s_waitcnt vmcnt(0)" ::: "memory");
            const unsigned og = xb_add(&bar[XB_TOP], 1u);
            const unsigned tg = og / nx;
            if (og + 1u == (tg + 1u) * nx) xb_add(&bar[XB_TOPGEN], 1u);
            else XB_SPIN(xb_ld(&bar[XB_TOPGEN]) == tg, bar);
            __builtin_amdgcn_fence(__ATOMIC_ACQUIRE, "agent");
            xb_add(&bar[XB_XGEN(b.x)], 1u);
            asm volatile("s_waitcnt vmcnt(0)" ::: "memory");
        } else {
            XB_SPIN(xb_ld(&bar[XB_XGEN(b.x)]) == gen, bar);
            __builtin_amdgcn_fence(__ATOMIC_ACQUIRE, "agent");
            asm volatile("s_waitcnt vmcnt(0)" ::: "memory");
        }
    }
    __syncthreads();
}

#define XB_XMASK(v) (3456 + (v))
#define XB_LOC(v)   (3520 + 64 * (v))
__device__ __noinline__ void lbar_fn(GAS unsigned* gbar, unsigned bx, volatile LAS unsigned* bst, int wave, int wgv, int per) {
    const bool t0 = (wave == 0) && (lane_id() == 0);
    asm volatile("s_waitcnt vmcnt(0)" ::: "memory");
    __syncthreads();
    if (bst[4] == 0u) {
        if (t0) { XcdBarrier b; b.bar = (unsigned*)gbar; b.x = bx; b.st = bst; unsigned* bar = b.bar;
            __builtin_amdgcn_s_waitcnt(0);
            unsigned nloc = b.st[0], nx = b.st[1];
            if (nloc == 0u) { xcd_barrier_complete(bar, b.x, nloc, nx); b.st[0] = nloc; b.st[1] = nx; }
            const unsigned old = xb_add(&bar[XB_XSUB(b.x)], 1u);
            const unsigned gen = old / nloc;
            if (old + 1u == (gen + 1u) * nloc) {
                __builtin_amdgcn_fence(__ATOMIC_RELEASE, "agent");
                asm volatile("s_waitcnt vmcnt(0)" ::: "memory");
                const unsigned og = xb_add(&bar[XB_TOP], 1u);
                const unsigned tg = og / nx;
                if (og + 1u == (tg + 1u) * nx) xb_add(&bar[XB_TOPGEN], 1u);
                else XB_SPIN(xb_ld(&bar[XB_TOPGEN]) == tg, bar);
                __builtin_amdgcn_fence(__ATOMIC_ACQUIRE, "agent");
                xb_add(&bar[XB_XGEN(b.x)], 1u);
                asm volatile("s_waitcnt vmcnt(0)" ::: "memory");
            } else {
                XB_SPIN(xb_ld(&bar[XB_XGEN(b.x)]) == gen, bar);
                __builtin_amdgcn_fence(__ATOMIC_ACQUIRE, "agent");
                asm volatile("s_waitcnt vmcnt(0)" ::: "memory");
            } }
    } else if (t0) {
        unsigned* bar = (unsigned*)gbar; unsigned* cnt = bar + XB_LOC(wgv & 7);
        __builtin_amdgcn_s_waitcnt(0);
        const unsigned gen = bst[5] + 1u; bst[5] = gen; const unsigned target = gen * (unsigned)per;
        (void)xb_add(cnt, 1u);
        asm volatile("buffer_inv sc1" ::: "memory");
        XB_SPIN(xb_ld(cnt) < target, bar);
        asm volatile("s_waitcnt vmcnt(0)" ::: "memory");
    }
    __syncthreads();
}

DI void stagger_ticks(int wg, int step_ticks) {
    const unsigned long long t0 = __builtin_amdgcn_s_memrealtime(); const unsigned long long dt = (unsigned long long)(((unsigned)wg >> 3) & 7u) * (unsigned)step_ticks;
    while (__builtin_amdgcn_s_memrealtime() - t0 < dt) __builtin_amdgcn_s_sleep(8);
}
struct TrIn { f32x4 v[8]; f32x4 g0, g1; };
DI void tr_load(TrIn& in, const float* W, int ldw, int k0, int n0, int lane, const float* gain) {
    const int c4 = 4 * (lane & 7), r8 = lane >> 3;
#pragma unroll
    for (int i = 0; i < 8; ++i) in.v[i] = *(const f32x4*)(W + (size_t)(k0 + r8 + 8 * i) * ldw + n0 + c4);
    if (gain) { in.g0 = *(const f32x4*)(gain + k0 + 8 * (lane & 7)); in.g1 = *(const f32x4*)(gain + k0 + 8 * (lane & 7) + 4); }
}
template <bool F8>
DI void tr_store(const TrIn& in, int k0, void* WT, int ldwt, int drow0, LAS float* scr, int lane, bool has_gain) {
    const int c4 = 4 * (lane & 7), r8 = lane >> 3;
#pragma unroll
    for (int i = 0; i < 8; ++i) { const int kk = r8 + 8 * i; const f32x4 v = in.v[i];
        LAS float* d = scr + kk * 33 + c4; d[0] = v.x; d[1] = v.y; d[2] = v.z; d[3] = v.w; }
    asm volatile("s_waitcnt lgkmcnt(0)" ::: "memory");
    const int c = lane & 7;
    float gs[8];
    if (has_gain) { gs[0] = in.g0.x; gs[1] = in.g0.y; gs[2] = in.g0.z; gs[3] = in.g0.w; gs[4] = in.g1.x; gs[5] = in.g1.y; gs[6] = in.g1.z; gs[7] = in.g1.w; }
    else {
#pragma unroll
        for (int i = 0; i < 8; ++i) gs[i] = 1.f; }
    if (F8) {
#pragma unroll
        for (int i = 0; i < 8; ++i) gs[i] *= W8_SCALE; }
#pragma unroll
    for (int j = 0; j < 4; ++j) { const int n = (lane >> 3) + 8 * j; const LAS float* s = scr + (8 * c) * 33 + n;
        if (F8) { u32x2 o; o.x = cvt4_fp8(s[0 * 33] * gs[0], s[1 * 33] * gs[1], s[2 * 33] * gs[2], s[3 * 33] * gs[3]); o.y = cvt4_fp8(s[4 * 33] * gs[4], s[5 * 33] * gs[5], s[6 * 33] * gs[6], s[7 * 33] * gs[7]);
            *(u32x2*)((unsigned char*)WT + (size_t)(drow0 + n) * ldwt + k0 + 8 * c) = o; }
        else { u32x4 o; o.x = cvtpk(s[0 * 33] * gs[0], s[1 * 33] * gs[1]); o.y = cvtpk(s[2 * 33] * gs[2], s[3 * 33] * gs[3]); o.z = cvtpk(s[4 * 33] * gs[4], s[5 * 33] * gs[5]); o.w = cvtpk(s[6 * 33] * gs[6], s[7 * 33] * gs[7]);
            *(u32x4*)((bf16*)WT + (size_t)(drow0 + n) * ldwt + k0 + 8 * c) = o; } }
    asm volatile("s_waitcnt lgkmcnt(0)" ::: "memory");
}
DI int gu_row(int n) { return n < DFF ? (n >> 7) * 256 + (n & 127) : ((n - DFF) >> 7) * 256 + 128 + ((n - DFF) & 127); }
template <bool F8 = false>
DI void tr_matrix(unsigned& ibase, const float* W, int K, int N, void* WT, int row_off, int gu, LAS float* scr, int gw, int NGW, int lane, const float* gain = nullptr, int ldwt = 0) {
    const int nblk = N >> 5, nit = (K >> 6) * nblk; const int first = (int)(((unsigned)gw + (unsigned)NGW - ibase % (unsigned)NGW) % (unsigned)NGW); ibase += (unsigned)nit;
    if (first >= nit) return;
    TrIn cur; int it = first; { const int kb = it / nblk, nb = it - kb * nblk; tr_load(cur, W, N, kb * 64, nb * 32, lane, gain); }
    for (;;) {
        const int itn = it + NGW; const bool hn = itn < nit; TrIn nx;
        if (hn) { const int kb = itn / nblk, nb = itn - kb * nblk; tr_load(nx, W, N, kb * 64, nb * 32, lane, gain); }
        { const int kb = it / nblk, nb = it - kb * nblk, n0 = nb * 32; tr_store<F8>(cur, kb * 64, WT, ldwt ? ldwt : K, gu ? gu_row(n0) : row_off + n0, scr, lane, gain != nullptr); }
        if (!hn) break;
        cur = nx; it = itn; }
}
DI void rms_row_bf16(const float* xrow, const float* gain, bf16* orow, int lane) {
    const f32x4* xr = (const f32x4*)xrow + lane; const f32x4* gr = (const f32x4*)gain + lane;
    f32x4 v[4]; float s = 0.f;
#pragma unroll
    for (int j = 0; j < 4; ++j) { v[j] = xr[64 * j]; s += (v[j].x * v[j].x + v[j].y * v[j].y) + (v[j].z * v[j].z + v[j].w * v[j].w); }
    const float rstd = 1.f / sqrtf(wave_sum(s, lane) * (1.f / D) + EPS);
    u32x2* o8 = (u32x2*)orow + lane;
#pragma unroll
    for (int j = 0; j < 4; ++j) { const f32x4 g = gr[64 * j]; u32x2 w; w.x = cvtpk(v[j].x * rstd * g.x, v[j].y * rstd * g.y); w.y = cvtpk(v[j].z * rstd * g.z, v[j].w * rstd * g.w); o8[64 * j] = w; }
}

DI void rms_row_fp8(const float* xrow, const float* gain, unsigned char* orow, int lane) {
    const f32x4* xr = (const f32x4*)xrow + lane; const f32x4* gr = (const f32x4*)gain + lane;
    f32x4 v[4]; float s = 0.f;
#pragma unroll
    for (int j = 0; j < 4; ++j) { v[j] = xr[64 * j]; s += (v[j].x * v[j].x + v[j].y * v[j].y) + (v[j].z * v[j].z + v[j].w * v[j].w); }
    const float rstd = 1.f / sqrtf(wave_sum(s, lane) * (1.f / D) + EPS);
    unsigned* o4 = (unsigned*)orow + lane;
#pragma unroll
    for (int j = 0; j < 4; ++j) { const f32x4 g = gr[64 * j]; o4[64 * j] = cvt4_fp8(v[j].x * rstd * g.x, v[j].y * rstd * g.y, v[j].z * rstd * g.z, v[j].w * rstd * g.w); }
}

struct KVStage { u32x4 k[4], v[4]; };
DI void kv_load(KVStage& st, const bf16* Kp, int kpitch, const bf16* Vp, int vpitch, int tid) {
#pragma unroll
    for (int i = 0; i < 4; ++i) { const int id = tid + 512 * i, row = id >> 3, c8 = id & 7;
        st.k[i] = *(const u32x4*)(Kp + (size_t)row * kpitch + 8 * c8); st.v[i] = *(const u32x4*)(Vp + (size_t)row * vpitch + 8 * c8); }
}
DI void kv_write(const KVStage& st, LAS bf16* Ksm, LAS bf16* Vsm, int tid) {
#pragma unroll
    for (int i = 0; i < 4; ++i) { const int id = tid + 512 * i, row = id >> 3, c8 = id & 7;
        *(LAS u32x4*)(Ksm + row * KS + 8 * c8) = st.k[i]; *(LAS u32x4*)(Vsm + row * VS + 8 * c8) = st.v[i]; }
}
typedef short v4i16_t __attribute__((ext_vector_type(4)));
DI s16x4 trd(const LAS bf16* p) { return __builtin_bit_cast(s16x4, __builtin_amdgcn_ds_read_tr16_b64_v4i16((LAS v4i16_t*)p)); }
DI int tr_lane_off(int lane, int rs, int hmul) { return (hmul * (lane >> 5) + ((lane & 15) >> 2)) * rs + 16 * ((lane >> 4) & 1) + 4 * (lane & 3); }
DI void qk_subtile(const LAS bf16* Ksm, int ktl, const bf16x8 (&qf)[4], int r, int h, f32x16& z0, f32x16& z1) {
#pragma unroll
    for (int i = 0; i < 16; ++i) { z0[i] = 0.f; z1[i] = 0.f; }
#pragma unroll
    for (int s = 0; s < 4; ++s) {
        const bf16x8 k0 = *(const LAS bf16x8*)(Ksm + (64 * ktl + r) * KS + 16 * s + 8 * h);
        const bf16x8 k1 = *(const LAS bf16x8*)(Ksm + (64 * ktl + 32 + r) * KS + 16 * s + 8 * h);
        z0 = MFMA32(k0, qf[s], z0); z1 = MFMA32(k1, qf[s], z1); }
}
template <int ST> DI bf16x8 pack_step(const f32x16& x) {
    u32x4 p; p.x = cvtpk(x[8 * ST + 0], x[8 * ST + 1]); p.y = cvtpk(x[8 * ST + 2], x[8 * ST + 3]); p.z = cvtpk(x[8 * ST + 4], x[8 * ST + 5]); p.w = cvtpk(x[8 * ST + 6], x[8 * ST + 7]);
    return __builtin_bit_cast(bf16x8, p);
}
DI void pv_subtile(const LAS bf16* Vsm, int ktl, const f32x16& p0, const f32x16& p1, int lane, f32x16 (&o)[2]) {
    const bf16x8 pf[4] = {pack_step<0>(p0), pack_step<1>(p0), pack_step<0>(p1), pack_step<1>(p1)};
    const LAS bf16* vb = Vsm + tr_lane_off(lane, VS, 4) + 64 * ktl * VS;
#pragma unroll
    for (int ts = 0; ts < 4; ++ts) {
#pragma unroll
        for (int dt = 0; dt < 2; ++dt) {
            const s16x4 lo = trd(vb + (16 * ts) * VS + 32 * dt), hi = trd(vb + (16 * ts + 8) * VS + 32 * dt);
            const bf16x8 vf = __builtin_shufflevector(lo, hi, 0, 1, 2, 3, 4, 5, 6, 7);
            o[dt] = MFMA32(vf, pf[ts], o[dt]); } }
}
template <int T, int GI> DI void sb_group(f32x16& z, float& c, int h, int lane) {
    float s[4], m[4];
#pragma unroll
    for (int i = 0; i < 4; ++i) { const float e = fexp2(-z[4 * GI + i]); s[i] = frcp(1.f + e); m[i] = 1.f - s[i]; }
    const float w2 = m[3], w1 = m[3] * m[2], w0 = w1 * m[1], Gm = w0 * m[0];
    const float Gp = shx32(Gm, lane);
    const float mc = h ? c : c * Gp;
    z[4 * GI + 3] = s[3] * mc; z[4 * GI + 2] = s[2] * w2 * mc; z[4 * GI + 1] = s[1] * w1 * mc; z[4 * GI + 0] = s[0] * w0 * mc;
    c *= Gm * Gp;
}
DI void sb_transform(f32x16& z0, f32x16& z1, float& c, int h, bool need_mask, int krel, int lane) {
    if (need_mask) {
        const float ninf = -__builtin_inff();
#pragma unroll
        for (int i = 0; i < 16; ++i) { const int kk = krel + crow(i, h); z0[i] = (kk < 0) ? z0[i] : ninf; z1[i] = (kk + 32 < 0) ? z1[i] : ninf; } }
    sb_group<1, 3>(z1, c, h, lane); sb_group<1, 2>(z1, c, h, lane); sb_group<1, 1>(z1, c, h, lane); sb_group<1, 0>(z1, c, h, lane);
    sb_group<0, 3>(z0, c, h, lane); sb_group<0, 2>(z0, c, h, lane); sb_group<0, 1>(z0, c, h, lane); sb_group<0, 0>(z0, c, h, lane);
}
DI void store_ot(const f32x16 (&o)[2], bf16* orow, int h, float sc) {
#pragma unroll
    for (int dt = 0; dt < 2; ++dt)
#pragma unroll
        for (int g = 0; g < 4; ++g) { u32x2 w; w.x = cvtpk(o[dt][4 * g] * sc, o[dt][4 * g + 1] * sc); w.y = cvtpk(o[dt][4 * g + 2] * sc, o[dt][4 * g + 3] * sc);
            *(u32x2*)(orow + 32 * dt + 8 * g + 4 * h) = w; }
}

DI void store_ot8(const f32x16 (&o)[2], unsigned char* orow, int h, float sc) {
#pragma unroll
    for (int dt = 0; dt < 2; ++dt)
#pragma unroll
        for (int g = 0; g < 4; ++g) *(unsigned*)(orow + 32 * dt + 8 * g + 4 * h) = cvt4_fp8(o[dt][4 * g] * sc, o[dt][4 * g + 1] * sc, o[dt][4 * g + 2] * sc, o[dt][4 * g + 3] * sc);
}
constexpr float Y8_SCALE = 8.f;
DI void store_ot_rows(const f32x16 (&o)[2], LAS bf16* wt, bf16* g0, size_t pitch, int lane, float sc) {
    const int r = lane & 31, h = lane >> 5;
#pragma unroll
    for (int dt = 0; dt < 2; ++dt)
#pragma unroll
        for (int g = 0; g < 4; ++g) { u32x2 w; w.x = cvtpk(o[dt][4 * g] * sc, o[dt][4 * g + 1] * sc); w.y = cvtpk(o[dt][4 * g + 2] * sc, o[dt][4 * g + 3] * sc);
            *(LAS u32x2*)(wt + r * KS + 32 * dt + 8 * g + 4 * h) = w; }
    asm volatile("s_waitcnt lgkmcnt(0)" ::: "memory");
#pragma unroll
    for (int i = 0; i < 4; ++i) { const int p = lane + 64 * i, row = p >> 3, c = p & 7; *(u32x4*)(g0 + (size_t)row * pitch + 8 * c) = *(const LAS u32x4*)(wt + row * KS + 8 * c); }
}
DI void store_ot_rows8(const f32x16 (&o)[2], LAS bf16* wt, unsigned char* g0, size_t pitch, int lane, float sc) {
    const int r = lane & 31, h = lane >> 5; LAS unsigned char* wb = (LAS unsigned char*)wt;
#pragma unroll
    for (int dt = 0; dt < 2; ++dt)
#pragma unroll
        for (int g = 0; g < 4; ++g) *(LAS unsigned*)(wb + r * (2 * KS) + 32 * dt + 8 * g + 4 * h) = cvt4_fp8(o[dt][4 * g] * sc, o[dt][4 * g + 1] * sc, o[dt][4 * g + 2] * sc, o[dt][4 * g + 3] * sc);
    asm volatile("s_waitcnt lgkmcnt(0)" ::: "memory");
#pragma unroll
    for (int i = 0; i < 2; ++i) { const int p = lane + 64 * i, row = p >> 2, c = p & 3; *(u32x4*)(g0 + (size_t)row * pitch + 16 * c) = *(const LAS u32x4*)(wb + row * (2 * KS) + 16 * c); }
}
DI void sb_unit(const bf16* U, bf16* Y, int y8, int bl, int hd, int qb, LAS unsigned char* lds, int tid, int wave, int lane) {
    LAS bf16* Ksm = (LAS bf16*)(lds + L_KS); LAS bf16* Vtm = (LAS bf16*)(lds + L_VT);
    const int r = lane & 31, h = lane >> 5;
    const size_t tok0 = (size_t)bl * SEQ; const int tq = qb * 256 + 32 * wave + r;
    const bf16* Kb = U + tok0 * DIN + UC_SBK + 64 * hd; const bf16* Vb = U + tok0 * DIN + UC_SBV + 64 * hd;
    KVStage st; kv_load(st, Kb + (size_t)(256 * qb) * DIN, DIN, Vb + (size_t)(256 * qb) * DIN, DIN, tid);
    bf16x8 qf[4];
    { const bf16* qrow = U + (tok0 + tq) * DIN + UC_SBQ + 64 * hd; u32x4 qw[4];
#pragma unroll
      for (int s = 0; s < 4; ++s) qw[s] = *(const u32x4*)(qrow + 16 * s + 8 * h);
#pragma unroll
      for (int s = 0; s < 4; ++s) { float f[8]; unpack8(qw[s], f);
#pragma unroll
          for (int j = 0; j < 8; ++j) f[j] *= (0.125f * 1.44269504f);
          qf[s] = __builtin_bit_cast(bf16x8, pack8(f)); } }
    f32x16 o[2];
#pragma unroll
    for (int i = 0; i < 16; ++i) { o[0][i] = 0.f; o[1][i] = 0.f; }
    float c = 1.f;
    for (int kb = qb; kb >= 0; --kb) {
        { volatile LAS unsigned* fl = (volatile LAS unsigned*)(lds + MISC_OFF) + 2;
          if (lane == 0 && __builtin_amdgcn_ballot_w64(c != 0.f) != 0ull) fl[kb & 1] = 1u;
          __syncthreads();
          const unsigned live = fl[kb & 1];
          if (tid == 0) fl[(kb + 1) & 1] = 0u;
          if (live == 0u) break; }
        kv_write(st, Ksm, Vtm, tid);
        __syncthreads();
        if (kb > 0) kv_load(st, Kb + (size_t)(256 * (kb - 1)) * DIN, DIN, Vb + (size_t)(256 * (kb - 1)) * DIN, DIN, tid);
        const bool diag = (kb == qb);
        const int khi = diag ? ((32 * wave + 31) >> 6) : 3;
        for (int ktl = khi; ktl >= 0; --ktl) {
            if (__builtin_amdgcn_ballot_w64(c != 0.f) == 0ull) break;
            f32x16 z0, z1; qk_subtile(Ksm, ktl, qf, r, h, z0, z1);
            const bool need_mask = diag && (64 * ktl + 63 >= 32 * wave);
            sb_transform(z0, z1, c, h, need_mask, 256 * kb + 64 * ktl - tq, lane);
            pv_subtile(Vtm, ktl, z0, z1, lane, o);
        }
    }
    __syncthreads();
    { const size_t q0 = tok0 + (size_t)qb * 256 + 32 * wave;
      int y8s = y8; asm volatile("" : "+s"(y8s));
      if (y8s) store_ot_rows8(o, Ksm + 32 * wave * KS, (unsigned char*)Y + q0 * D + YC_SB + 64 * hd, D, lane, Y8_SCALE); else store_ot_rows(o, Ksm + 32 * wave * KS, Y + q0 * D + YC_SB + 64 * hd, D, lane, 1.f); }
}

DI void xa_unit(const bf16* QB, const bf16* kvl, const float* gq, float kmax, bf16* OB, int bl, int bglob, int hd, int qblk, LAS unsigned char* lds, int tid, int wave, int lane) {
    LAS bf16* Ksm = (LAS bf16*)(lds + L_KS); LAS bf16* Vtm = (LAS bf16*)(lds + L_VT);
    const int r = lane & 31, h = lane >> 5;
    const size_t row = (size_t)bl * SEQ + qblk * 256 + 32 * wave + r;
    __syncthreads();
    u32x4 qw[4], qw2[4];
    { KVStage st; const bf16* Kp = kvl + (size_t)bglob * NMEM * 512 + 64 * hd; kv_load(st, Kp, 512, Kp + 256, 512, tid);
      const bf16* qrow = QB + row * 512 + 64 * hd;
#pragma unroll
      for (int s = 0; s < 4; ++s) { qw[s] = *(const u32x4*)(qrow + 16 * s + 8 * h); qw2[s] = *(const u32x4*)(qrow + 256 + 16 * s + 8 * h); }
      kv_write(st, Ksm, Vtm, tid); }
    float qv[4][8]; float ss = 0.f;
    {
#pragma unroll
      for (int s = 0; s < 4; ++s) { float p2[8]; unpack8(qw[s], qv[s]); unpack8(qw2[s], p2);
#pragma unroll
          for (int j = 0; j < 8; ++j) { qv[s][j] += p2[j]; ss += qv[s][j] * qv[s][j]; } } }
    ss += shx32(ss, lane);
    const float rq = 1.f / sqrtf(ss * (1.f / 64.f) + EPS) * (0.125f * 1.44269504f);
    bf16x8 qf[4]; float qn2 = 0.f;
#pragma unroll
    for (int s = 0; s < 4; ++s) {
#pragma unroll
        for (int j = 0; j < 8; ++j) { qv[s][j] *= rq * gq[16 * s + 8 * h + j]; qn2 += qv[s][j] * qv[s][j]; }
        qf[s] = __builtin_bit_cast(bf16x8, pack8(qv[s])); }
    qn2 += shx32(qn2, lane);
    const float bnd = sqrtf(qn2) * kmax * 1.02f + 0.5f;
    f32x16 o[2];
#pragma unroll
    for (int i = 0; i < 16; ++i) { o[0][i] = 0.f; o[1][i] = 0.f; }
    float l = 0.f;
    __syncthreads();
    for (int ktl = 0; ktl < 4; ++ktl) {
        f32x16 z0, z1; qk_subtile(Ksm, ktl, qf, r, h, z0, z1);
#pragma unroll
        for (int i = 0; i < 16; ++i) { z0[i] = fexp2(z0[i] - bnd); z1[i] = fexp2(z1[i] - bnd); l += z0[i] + z1[i]; }
        pv_subtile(Vtm, ktl, z0, z1, lane, o);
    }
    l += shx32(l, lane);
    __syncthreads();
    store_ot_rows(o, Ksm + 32 * wave * KS, OB + ((size_t)bl * SEQ + qblk * 256 + 32 * wave) * 256 + 64 * hd, 256, lane, 1.f / l);
}

DI void ret_stage(const bf16* U, const f32x2* rot, size_t trow0, int gtok, int hd, float lg, LAS bf16* Ksm, LAS bf16* Vtm, int tid) {
    const int m = tid >> 1, hf = tid & 1; const size_t trow = trow0 + m;
    const bf16* kp = U + trow * DIN + UC_RK + 64 * hd + 16 * hf; const f32x2* rp = rot + (size_t)(gtok + m) * 32 + 16 * hf;
    const float sk = fexp2(-(float)m * lg) * 0.125f;
    const u32x4 a0 = *(const u32x4*)kp, a1 = *(const u32x4*)(kp + 8), b0 = *(const u32x4*)(kp + 32), b1 = *(const u32x4*)(kp + 40);
    f32x4 cs4[8];
#pragma unroll
    for (int j = 0; j < 8; ++j) cs4[j] = *((const f32x4*)rp + j);
    const bf16* vp = U + trow * DIN + UC_RV + 64 * hd + 32 * hf; u32x4 vv[4];
#pragma unroll
    for (int q = 0; q < 4; ++q) vv[q] = *(const u32x4*)(vp + 8 * q);
    float x1[16], x2[16];
    { float t[8]; unpack8(a0, t);
#pragma unroll
      for (int j = 0; j < 8; ++j) x1[j] = t[j];
      unpack8(a1, t);
#pragma unroll
      for (int j = 0; j < 8; ++j) x1[8 + j] = t[j];
      unpack8(b0, t);
#pragma unroll
      for (int j = 0; j < 8; ++j) x2[j] = t[j];
      unpack8(b1, t);
#pragma unroll
      for (int j = 0; j < 8; ++j) x2[8 + j] = t[j]; }
    float o1[16], o2[16];
#pragma unroll
    for (int j = 0; j < 16; ++j) { const f32x2 cs = (j & 1) ? (f32x2){cs4[j >> 1].z, cs4[j >> 1].w} : (f32x2){cs4[j >> 1].x, cs4[j >> 1].y}; o1[j] = (x1[j] * cs.x - x2[j] * cs.y) * sk; o2[j] = (x1[j] * cs.y + x2[j] * cs.x) * sk; }
    { LAS bf16* kr = Ksm + m * KS + 16 * hf; float t[8];
#pragma unroll
        for (int j = 0; j < 8; ++j) t[j] = o1[j];
        *(LAS u32x4*)kr = pack8(t);
#pragma unroll
        for (int j = 0; j < 8; ++j) t[j] = o1[8 + j];
        *(LAS u32x4*)(kr + 8) = pack8(t);
#pragma unroll
        for (int j = 0; j < 8; ++j) t[j] = o2[j];
        *(LAS u32x4*)(kr + 32) = pack8(t);
#pragma unroll
        for (int j = 0; j < 8; ++j) t[j] = o2[8 + j];
        *(LAS u32x4*)(kr + 40) = pack8(t); }
#pragma unroll
    for (int q = 0; q < 4; ++q) *(LAS u32x4*)(Vtm + m * VS + 32 * hf + 8 * q) = vv[q];
}
DI float ret_lg(int hd) { const float gam = 1.f - fexp2(-5.f - (float)hd); return __log2f(gam); }
DI void retkv_unit(const bf16* U, float* KVS, const f32x2* rot, int bl, int gtok0, int hd, int ch, LAS unsigned char* lds, int tid, int wave, int lane) {
    LAS bf16* Ksm = (LAS bf16*)(lds + L_KS); LAS bf16* Vtm = (LAS bf16*)(lds + L_VT);
    const int r = lane & 31, h = lane >> 5; const float lg = ret_lg(hd);
    __syncthreads();
    ret_stage(U, rot, (size_t)bl * SEQ + ch * 256, gtok0 + ch * 256, hd, lg, Ksm, Vtm, tid);
    __syncthreads();
    if (wave < 4) { const int dti = wave >> 1, eti = wave & 1;
        f32x16 kv;
#pragma unroll
        for (int i = 0; i < 16; ++i) kv[i] = 0.f;
        const LAS bf16* ka = Ksm + tr_lane_off(lane, KS, 8) + 32 * dti; const LAS bf16* vb = Vtm + tr_lane_off(lane, VS, 8) + 32 * eti;
#pragma unroll 4
        for (int s = 0; s < 16; ++s) {
            const s16x4 a0 = trd(ka + (16 * s) * KS), a1 = trd(ka + (16 * s + 4) * KS), b0 = trd(vb + (16 * s) * VS), b1 = trd(vb + (16 * s + 4) * VS);
            kv = MFMA32(__builtin_shufflevector(a0, a1, 0, 1, 2, 3, 4, 5, 6, 7), __builtin_shufflevector(b0, b1, 0, 1, 2, 3, 4, 5, 6, 7), kv); }
        float* dst = KVS + (size_t)((bl * 4 + hd) * 16 + ch) * 4096 + 32 * eti + r;
#pragma unroll
        for (int i = 0; i < 16; ++i) dst[(32 * dti + crow(i, h)) * 64] = kv[i]; }
}
DI void reto_unit(const bf16* U, bf16* Y, int y8, const float* KVS, const f32x2* rot, int bl, int gtok0, int hd, int ch, LAS unsigned char* lds, int tid, int wave, int lane) {
    LAS bf16* Ksm = (LAS bf16*)(lds + L_KS); LAS bf16* Vtm = (LAS bf16*)(lds + L_VT); LAS bf16* Stm = (LAS bf16*)(lds + L_ST);
    const int r = lane & 31, h = lane >> 5; const float lg = ret_lg(hd);
    const size_t tok0 = (size_t)bl * SEQ; const int n0 = ch * 256;
    __syncthreads();
    { const int d = tid >> 3, e0 = 8 * (tid & 7); float acc[8];
#pragma unroll
      for (int j = 0; j < 8; ++j) acc[j] = 0.f;
      const float* src = KVS + (size_t)((bl * 4 + hd) * 16) * 4096 + d * 64 + e0;
      for (int cp0 = 0; cp0 < ch; cp0 += 8) {
          f32x4 a[8], b[8];
#pragma unroll
          for (int k = 0; k < 8; ++k) { const int cp = (cp0 + k < ch) ? (cp0 + k) : (ch - 1); a[k] = *(const f32x4*)(src + (size_t)cp * 4096); b[k] = *(const f32x4*)(src + (size_t)cp * 4096 + 4); }
#pragma unroll
          for (int k = 0; k < 8; ++k) { const int cp = cp0 + k; const float w = (cp < ch) ? fexp2((256.f * (float)(ch - 1 - cp) + 256.f) * lg) : 0.f;
              acc[0] += w * a[k].x; acc[1] += w * a[k].y; acc[2] += w * a[k].z; acc[3] += w * a[k].w; acc[4] += w * b[k].x; acc[5] += w * b[k].y; acc[6] += w * b[k].z; acc[7] += w * b[k].w; } }
#pragma unroll
      for (int j = 0; j < 8; ++j) Stm[(e0 + j) * KS + d] = (bf16)(cvtpk(acc[j], 0.f) & 0xffffu); }
    ret_stage(U, rot, tok0 + n0, gtok0 + n0, hd, lg, Ksm, Vtm, tid);
    bf16x8 qf[4];
    { const int nl = 32 * wave + r; const size_t trow = tok0 + n0 + nl;
      const bf16* qp = U + trow * DIN + UC_RQ + 64 * hd + 8 * h; const f32x2* rp = rot + (size_t)(gtok0 + n0 + nl) * 32 + 8 * h;
      const float sq = fexp2((float)nl * lg);
      float a[4][8];
#pragma unroll
      for (int s = 0; s < 4; ++s) { const u32x4 w = *(const u32x4*)(qp + 16 * s); unpack8(w, a[s]); }
      float b[4][8];
#pragma unroll
      for (int j = 0; j < 8; ++j) { const f32x2 c0 = rp[j], c1 = rp[16 + j];
          b[0][j] = (a[0][j] * c0.x - a[2][j] * c0.y) * sq; b[2][j] = (a[0][j] * c0.y + a[2][j] * c0.x) * sq;
          b[1][j] = (a[1][j] * c1.x - a[3][j] * c1.y) * sq; b[3][j] = (a[1][j] * c1.y + a[3][j] * c1.x) * sq; }
#pragma unroll
      for (int s = 0; s < 4; ++s) qf[s] = __builtin_bit_cast(bf16x8, pack8(b[s])); }
    __syncthreads();
    f32x16 o[2];
#pragma unroll
    for (int i = 0; i < 16; ++i) { o[0][i] = 0.f; o[1][i] = 0.f; }
    const int khi = (32 * wave + 31) >> 6;
    for (int ktl = 0; ktl <= khi; ++ktl) {
        f32x16 z0, z1; qk_subtile(Ksm, ktl, qf, r, h, z0, z1);
        if (64 * ktl + 63 > 32 * wave) {
            const int krel = 64 * ktl - (32 * wave + r);
#pragma unroll
            for (int i = 0; i < 16; ++i) { const int kk = krel + crow(i, h); z0[i] = (kk <= 0) ? z0[i] : 0.f; z1[i] = (kk + 32 <= 0) ? z1[i] : 0.f; } }
        pv_subtile(Vtm, ktl, z0, z1, lane, o);
    }
#pragma unroll
    for (int s = 0; s < 4; ++s)
#pragma unroll
        for (int dt = 0; dt < 2; ++dt) { const bf16x8 af = *(const LAS bf16x8*)(Stm + (32 * dt + r) * KS + 16 * s + 8 * h); o[dt] = MFMA32(af, qf[s], o[dt]); }
    { float sm = 0.f;
#pragma unroll
      for (int i = 0; i < 16; ++i) sm += o[0][i] + o[1][i];
      sm += shx32(sm, lane); const float mean = sm * (1.f / 64.f); float vq = 0.f;
#pragma unroll
      for (int i = 0; i < 16; ++i) { const float d0 = o[0][i] - mean, d1 = o[1][i] - mean; vq += d0 * d0 + d1 * d1; }
      vq += shx32(vq, lane); const float rstd = 1.f / sqrtf(vq * (1.f / 64.f) + EPS);
      const size_t trow = tok0 + n0 + 32 * wave + r;
      const bf16* gp = U + trow * DIN + UC_RG + 64 * hd; bf16* yp = Y + trow * D + YC_RET + 64 * hd;
#pragma unroll
      for (int dt = 0; dt < 2; ++dt)
#pragma unroll
          for (int g = 0; g < 4; ++g) { const int e0 = 32 * dt + 8 * g + 4 * h; const u32x2 gw = *(const u32x2*)(gp + e0);
              const float g0 = bflo(gw.x), g1 = bfhi(gw.x), g2 = bflo(gw.y), g3 = bfhi(gw.y);
              const float r0 = g0 * sigmoid_f(g0) * (o[dt][4 * g] - mean) * rstd, r1 = g1 * sigmoid_f(g1) * (o[dt][4 * g + 1] - mean) * rstd, r2 = g2 * sigmoid_f(g2) * (o[dt][4 * g + 2] - mean) * rstd, r3 = g3 * sigmoid_f(g3) * (o[dt][4 * g + 3] - mean) * rstd;
              int y8s = y8; asm volatile("" : "+s"(y8s));
              if (y8s) *(unsigned*)((unsigned char*)Y + trow * D + YC_RET + 64 * hd + e0) = cvt4_fp8(r0 * Y8_SCALE, r1 * Y8_SCALE, r2 * Y8_SCALE, r3 * Y8_SCALE);
              else { u32x2 w; w.x = cvtpk(r0, r1); w.y = cvtpk(r2, r3); *(u32x2*)(yp + e0) = w; } } }
}

DI void conv_unit(const bf16* U, bf16* Y, int y8, const float* cw, const float* cb, const float* lng, const float* lnb, int bl, int tile, LAS unsigned char* lds, int tid, int wave, int lane) {
    LAS float* vs = (LAS float*)lds;
    const int t0 = tile * 64; const size_t tok0 = (size_t)bl * SEQ;
    __syncthreads();
#pragma unroll
    for (int it = 0; it < 6; ++it) { const int id = tid + it * NTHR; if (id >= 94 * 32) break; const int rr = id >> 5, c8 = id & 31, t = t0 - 30 + rr; float v[8];
        if (t >= 0) { const bf16* p = U + (tok0 + t) * DIN + 8 * c8; const u32x4 aw = *(const u32x4*)(p + UC_CA), gw = *(const u32x4*)(p + UC_CG); float a[8], g[8]; unpack8(aw, a); unpack8(gw, g);
#pragma unroll
            for (int j = 0; j < 8; ++j) v[j] = a[j] * sigmoid_f(g[j]); }
        else {
#pragma unroll
            for (int j = 0; j < 8; ++j) v[j] = 0.f; }
        LAS f32x4* d = (LAS f32x4*)(vs + rr * 256 + 8 * c8); d[0] = (f32x4){v[0], v[1], v[2], v[3]}; d[1] = (f32x4){v[4], v[5], v[6], v[7]}; }
    __syncthreads();
    const int c = tid & 255, half = tid >> 8;
    float acc[32];
    { float wj[31], win[62];
#pragma unroll
      for (int j = 0; j < 31; ++j) wj[j] = cw[j * 256 + c];
      const LAS float* vp = vs + (32 * half) * 256 + c;
#pragma unroll
      for (int i = 0; i < 62; ++i) win[i] = vp[i * 256];
      const float bias = cb[c];
#pragma unroll
      for (int i = 0; i < 32; ++i) { float a = bias;
#pragma unroll
          for (int j = 0; j < 31; ++j) a += wj[j] * win[i + j];
          acc[i] = a; } }
    __syncthreads();
#pragma unroll
    for (int i = 0; i < 32; ++i) vs[(32 * half + i) * 256 + c] = acc[i];
    __syncthreads();
    const f32x4 g4 = *(const f32x4*)(lng + 4 * lane), b4 = *(const f32x4*)(lnb + 4 * lane);
#pragma unroll
    for (int i = 0; i < 8; ++i) { const int tt = 8 * wave + i; const f32x4 v = *(const LAS f32x4*)(vs + tt * 256 + 4 * lane);
        const float mean = wave_sum((v.x + v.y) + (v.z + v.w), lane) * (1.f / 256.f);
        const f32x4 dv = v - mean; const float var = wave_sum((dv.x * dv.x + dv.y * dv.y) + (dv.z * dv.z + dv.w * dv.w), lane) * (1.f / 256.f);
        const float rstd = 1.f / sqrtf(var + EPS); const f32x4 xn = dv * rstd * g4 + b4;
        const float c0 = xn.x * sigmoid_f(xn.x), c1 = xn.y * sigmoid_f(xn.y), c2 = xn.z * sigmoid_f(xn.z), c3 = xn.w * sigmoid_f(xn.w);
        int y8s = y8; asm volatile("" : "+s"(y8s));
        if (y8s) *(unsigned*)((unsigned char*)Y + (tok0 + t0 + tt) * D + YC_CONV + 4 * lane) = cvt4_fp8(c0 * Y8_SCALE, c1 * Y8_SCALE, c2 * Y8_SCALE, c3 * Y8_SCALE);
        else { u32x2 w; w.x = cvtpk(c0, c1); w.y = cvtpk(c2, c3); *(u32x2*)(Y + (tok0 + t0 + tt) * D + YC_CONV + 4 * lane) = w; } }
}

DI void pool_unit(const bf16* U, bf16* Y, int y8, int bl, int tile, LAS unsigned char* lds, int tid) {
    LAS float* us = (LAS float*)lds;
    const int t0 = tile * 64; const size_t tok0 = (size_t)bl * SEQ;
    __syncthreads();
#pragma unroll
    for (int it = 0; it < 5; ++it) { const int id = tid + it * NTHR; if (id >= 79 * 32) break; const int rr = id >> 5, c8 = id & 31, t = t0 - 15 + rr; float v[8];
        if (t >= 0) { const u32x4 w = *(const u32x4*)(U + (tok0 + t) * DIN + UC_POOL + 8 * c8); unpack8(w, v); }
        else {
#pragma unroll
            for (int j = 0; j < 8; ++j) v[j] = 0.f; }
        LAS f32x4* d = (LAS f32x4*)(us + rr * 256 + 8 * c8); d[0] = (f32x4){v[0], v[1], v[2], v[3]}; d[1] = (f32x4){v[4], v[5], v[6], v[7]}; }
    __syncthreads();
    const int c = tid & 255, half = tid >> 8; const int gi = c >> 6, w = 2 << gi;
    float v[47];
    { const LAS float* p = us + (32 * half) * 256 + c;
#pragma unroll
      for (int i = 0; i < 47; ++i) v[i] = p[i * 256]; }
    float s[47];
#pragma unroll
    for (int i = 0; i < 47; ++i) s[i] = v[i] + (i >= 1 ? v[i - 1] : 0.f);
    if (gi >= 1) {
#pragma unroll
        for (int i = 46; i >= 0; --i) s[i] = s[i] + (i >= 2 ? s[i - 2] : 0.f); }
    if (gi >= 2) {
#pragma unroll
        for (int i = 46; i >= 0; --i) s[i] = s[i] + (i >= 4 ? s[i - 4] : 0.f); }
    if (gi >= 3) {
#pragma unroll
        for (int i = 46; i >= 0; --i) s[i] = s[i] + (i >= 8 ? s[i - 8] : 0.f); }
#pragma unroll
    for (int i = 0; i < 32; ++i) { const int t = t0 + 32 * half + i;
        const int n = (t + 1 < w) ? (t + 1) : w; const float d = s[15 + i] * __builtin_amdgcn_rcpf((float)n) - v[15 + i];
        int y8s = y8; asm volatile("" : "+s"(y8s));
        if (y8s) ((unsigned char*)Y)[(tok0 + t) * D + YC_POOL + c] = (unsigned char)(cvt4_fp8(d * Y8_SCALE, 0.f, 0.f, 0.f) & 0xffu);
        else Y[(tok0 + t) * D + YC_POOL + c] = (bf16)(cvtpk(d, 0.f) & 0xffffu); }
}

struct Args { const void* in[27]; float* out; unsigned char* ws; };
static_assert(sizeof(Args) == 29 * 8, "Args has no padding");
typedef const __attribute__((address_space(4))) Args* KArgs;
DI KArgs KA() { KArgs p = (KArgs)__builtin_amdgcn_kernarg_segment_ptr(); asm volatile("" : "+s"(p)); return p; }
#define KIN(T, k) ((const T*)KA()->in[k])
#define PH DI
#define PHN __device__ __noinline__
enum { I_X = 0, I_MEM, I_POS, I_NMIXG, I_WIN, I_CONVW, I_CONVB, I_CLNG, I_CLNB, I_POOLW, I_POOLS, I_WGATE, I_WBR, I_WOUT, I_NXAG, I_NMEMG, I_WQ, I_WKV, I_QG, I_KG, I_WO, I_NFFNG, I_FGU, I_FDN, I_ROUTER, I_MGU, I_MDN };

constexpr unsigned F8MASK = FFN_FP8_MASK;
static_assert((F8MASK & 0xA) == 0xA, "the workspace map places the MoE buffers for fp8 experts");
constexpr bool DENSE_ANY8 = (F8MASK & 0x5) != 0, DENSE_ANYB = (F8MASK & 0x5) != 0x5, MOE_ANY8 = (F8MASK & 0xA) != 0, MOE_ANYB = (F8MASK & 0xA) != 0xA;
struct Ids { int tid, lane, wave, G, wg, gw, NGW; };
DI Ids ids(int wave) { Ids i; i.lane = lane_id(); asm volatile("" : "+v"(i.lane)); asm volatile("" : "+s"(wave)); i.wave = wave; i.tid = wave * 64 + i.lane; i.G = gridDim.x; i.wg = blockIdx.x; asm volatile("" : "+s"(i.G), "+s"(i.wg)); i.gw = i.wg * NWAVES + i.wave; i.NGW = i.G * NWAVES; return i; }

PHN unsigned ph_w_layer(KArgs ka, int wv, LAS unsigned char* lds, int l, unsigned ib) {
    const Ids t = ids(__builtin_amdgcn_readfirstlane(wv));     unsigned char* ws = ka->ws; LAS float* scr = (LAS float*)(lds + t.wave * 16384);
    bf16* wc = (bf16*)(ws + WS_WCAT) + (size_t)l * NCAT * D;
    const float* gmix = ((const float*)ka->in[I_NMIXG]) + l * D;
    if ((U_FP8_MASK >> l) & 1) tr_matrix<true>(ib, ((const float*)ka->in[I_WIN]) + (size_t)l * D * DIN, D, DIN, wc, 0, 0, scr, t.gw, t.NGW, t.lane, gmix);
    else tr_matrix(ib, ((const float*)ka->in[I_WIN]) + (size_t)l * D * DIN, D, DIN, wc, 0, 0, scr, t.gw, t.NGW, t.lane, gmix);
    for (int i = 0; i < 4; ++i) { if (GATE_FP8) tr_matrix<true>(ib, ((const float*)ka->in[I_WGATE]) + (size_t)(l * 4 + i) * D * D, D, D, (unsigned char*)(wc + (size_t)DIN * D), i * D, 0, scr, t.gw, t.NGW, t.lane, gmix);
        else tr_matrix(ib, ((const float*)ka->in[I_WGATE]) + (size_t)(l * 4 + i) * D * D, D, D, wc, DIN + i * D, 0, scr, t.gw, t.NGW, t.lane, gmix); }
    for (int i = 0; i < 4; ++i) if (i != 1) { if ((MERGE_FP8_MASK >> l) & 1) tr_matrix<true>(ib, ((const float*)ka->in[I_WBR]) + (size_t)(l * 4 + i) * 256 * D, 256, D, ws + WS_WB + (size_t)l * D * D * 2 + 256 * i, 0, 0, scr, t.gw, t.NGW, t.lane, nullptr, D);
        else tr_matrix(ib, ((const float*)ka->in[I_WBR]) + (size_t)(l * 4 + i) * 256 * D, 256, D, (bf16*)(ws + WS_WB) + (size_t)l * D * D + 256 * i, 0, 0, scr, t.gw, t.NGW, t.lane, nullptr, D); }
    if ((OUT_FP8_MASK >> l) & 1) tr_matrix<true>(ib, ((const float*)ka->in[I_WOUT]) + (size_t)l * D * D, D, D, (bf16*)(ws + WS_WOUT) + (size_t)l * D * D, 0, 0, scr, t.gw, t.NGW, t.lane);
    else tr_matrix(ib, ((const float*)ka->in[I_WOUT]) + (size_t)l * D * D, D, D, (bf16*)(ws + WS_WOUT) + (size_t)l * D * D, 0, 0, scr, t.gw, t.NGW, t.lane);
    tr_matrix(ib, ((const float*)ka->in[I_WQ]) + (size_t)l * D * 256, D, 256, (bf16*)(ws + WS_WQ) + (size_t)l * 256 * D, 0, 0, scr, t.gw, t.NGW, t.lane, ((const float*)ka->in[I_NXAG]) + l * D);
    tr_matrix(ib, ((const float*)ka->in[I_WKV]) + (size_t)l * D * 512, D, 512, (bf16*)(ws + WS_WKV) + (size_t)l * 512 * D, 0, 0, scr, t.gw, t.NGW, t.lane);
    tr_matrix(ib, ((const float*)ka->in[I_WO]) + (size_t)l * 256 * D, 256, D, (bf16*)(ws + WS_WO) + (size_t)l * D * 256, 0, 0, scr, t.gw, t.NGW, t.lane);
    return ib;
}
PHN unsigned ph_w_ffn(KArgs ka, int wv, LAS unsigned char* lds, int s, unsigned ib) {
    const Ids t = ids(__builtin_amdgcn_readfirstlane(wv));     unsigned char* ws = ka->ws; LAS float* scr = (LAS float*)(lds + t.wave * 16384);
    if (s < 2) { const bool f8 = (F8MASK >> (2 * s)) & 1u;
        const float* gu = ((const float*)ka->in[I_FGU]) + (size_t)s * D * NGU; const float* dn = ((const float*)ka->in[I_FDN]) + (size_t)s * DFF * D;
        unsigned char* wgu = ws + WS_WGUD + (size_t)s * NGU * D * 2; unsigned char* wdn = ws + WS_WDND + (size_t)s * D * DFF * 2;
        const float* gf = ((const float*)ka->in[I_NFFNG]) + (2 * s) * D;
        if (f8) { if constexpr (DENSE_ANY8) { tr_matrix<true>(ib, gu, D, NGU, wgu, 0, 1, scr, t.gw, t.NGW, t.lane, gf); tr_matrix<true>(ib, dn, DFF, D, wdn, 0, 0, scr, t.gw, t.NGW, t.lane); } }
        else { if constexpr (DENSE_ANYB) { tr_matrix<false>(ib, gu, D, NGU, wgu, 0, 1, scr, t.gw, t.NGW, t.lane, gf); tr_matrix<false>(ib, dn, DFF, D, wdn, 0, 0, scr, t.gw, t.NGW, t.lane); } }
    } else { const int k = s - 2; const bool f8 = (F8MASK >> (2 * (k >> 3) + 1)) & 1u;
        const float* gu = ((const float*)ka->in[I_MGU]) + (size_t)k * D * NGU; const float* dn = ((const float*)ka->in[I_MDN]) + (size_t)k * DFF * D;
        unsigned char* wgu = ws + WS_WGUM + (size_t)k * NGU * D * 2; unsigned char* wdn = ws + WS_WDNM + (size_t)k * D * DFF * 2;
        if (f8) { if constexpr (MOE_ANY8) { tr_matrix<true>(ib, gu, D, NGU, wgu, 0, 1, scr, t.gw, t.NGW, t.lane); tr_matrix<true>(ib, dn, DFF, D, wdn, 0, 0, scr, t.gw, t.NGW, t.lane); } }
        else { if constexpr (MOE_ANYB) { tr_matrix<false>(ib, gu, D, NGU, wgu, 0, 1, scr, t.gw, t.NGW, t.lane); tr_matrix<false>(ib, dn, DFF, D, wdn, 0, 0, scr, t.gw, t.NGW, t.lane); } }
    }
    return ib;
}
PHN void ph_misc0(KArgs ka, int wv) {
    const Ids t = ids(__builtin_amdgcn_readfirstlane(wv));     unsigned char* ws = ka->ws;
    { const float* pool_w = ((const float*)ka->in[I_POOLW]); const float* pool_scale = ((const float*)ka->in[I_POOLS]); const float* w_branch = ((const float*)ka->in[I_WBR]); bf16* WB = (bf16*)(ws + WS_WB);
      for (int idx = t.wg * NTHR + t.tid; idx < DEPTH * 1024 * 256; idx += t.G * NTHR) {
          const int l = idx >> 18, n = (idx >> 8) & 1023, gc = idx & 255, g = gc >> 6;
          const float* pw = pool_w + ((size_t)(l * 4) * 64 + gc) * 64; const float* ps = pool_scale + l * 256 + 64 * g; const float* wb = w_branch + ((size_t)(l * 4 + 1) * 256 + 64 * g) * D + n;
          float s = 0.f;
          for (int d = 0; d < 64; ++d) s += pw[d] * ps[d] * wb[(size_t)d * D];
          if ((MERGE_FP8_MASK >> l) & 1) ((unsigned char*)(WB + (size_t)l * D * D))[(size_t)n * D + 256 + gc] = (unsigned char)(cvt4_fp8(s * W8_SCALE, 0.f, 0.f, 0.f) & 0xffu);
          else WB[(size_t)l * D * D + (size_t)n * D + 256 + gc] = (bf16)(cvtpk(s, 0.f) & 0xffffu); } }
    { const float* mem = ((const float*)ka->in[I_MEM]); const float* gm = ((const float*)ka->in[I_NMEMG]); bf16* MEMH = (bf16*)(ws + WS_MEMH);
      for (int it = t.gw; it < DEPTH * MMEM; it += t.NGW) { const int l = it / MMEM, rw = it - l * MMEM; rms_row_bf16(mem + (size_t)rw * D, gm + l * D, MEMH + (size_t)it * D, t.lane); } }
    { const int* positions = ((const int*)ka->in[I_POS]); f32x2* ROT = (f32x2*)(ws + WS_ROT);
      for (int idx = t.wg * NTHR + t.tid; idx < MTOT * 32; idx += t.G * NTHR) { const int tok = idx >> 5, i = idx & 31;
          const float ang = (float)positions[tok] * INV_FREQ[i]; double rev = (double)ang * 0.15915494309189535; rev -= floor(rev); const float rv = (float)rev;
          ROT[idx] = (f32x2){__builtin_amdgcn_cosf(rv), __builtin_amdgcn_sinf(rv)}; } }
}
PH void ph_kv(int wv, LAS unsigned char* lds) {
    const Ids t = ids(wv); unsigned char* ws = KA()->ws;
    pg8::OrdKV S; S.to.init(DEPTH * (MMEM / 256), 2, t.G, t.wg); S.A = (const char*)(ws + WS_MEMH); S.B = (const char*)(ws + WS_WKV);
    pg8::EpiBf16<false> E{(bf16*)(ws + WS_KV), 512, nullptr};
    pg8::gemm_phase<pg8::EpiBf16<false>, pg8::OrdKV>(lds, D, D, S, E, t.wave);
}
PHN void ph_knorm(KArgs ka, int wv) {
    const Ids t = ids(__builtin_amdgcn_readfirstlane(wv));     unsigned char* ws = ka->ws; unsigned* ctl = (unsigned*)(ws + WS_CTL); bf16* KV = (bf16*)(ws + WS_KV); const float* xa_kg = ((const float*)ka->in[I_KG]);
    for (int it = t.gw; it < DEPTH * MMEM; it += t.NGW) { const int l = it / MMEM, rw = it - l * MMEM, b = rw >> 8; const int lane = t.lane;
        if (lane < 32) { bf16* kp = KV + (size_t)it * 512 + 8 * lane; const u32x4 w = *(const u32x4*)kp; float f[8]; unpack8(w, f); float ss = 0.f;
#pragma unroll
            for (int j = 0; j < 8; ++j) ss += f[j] * f[j];
            ss += SHX(ss, 1, lane); ss += SHX(ss, 2, lane); ss += SHX(ss, 4, lane);
            const float rs = 1.f / sqrtf(ss * (1.f / 64.f) + EPS); const float* gk = xa_kg + l * 64 + 8 * (lane & 7); float n2 = 0.f;
#pragma unroll
            for (int j = 0; j < 8; ++j) { f[j] *= rs * gk[j]; n2 += f[j] * f[j]; }
            *(u32x4*)kp = pack8(f);
            n2 += SHX(n2, 1, lane); n2 += SHX(n2, 2, lane); n2 += SHX(n2, 4, lane);
            if ((lane & 7) == 0) atomicMax(ctl + CW_KMAX + (l * NB + b) * 4 + (lane >> 3), __float_as_uint(n2 * 1.02f)); } }
}
PHN void ph_xprep(KArgs ka, int wv, int g, int from_in) {
    const Ids t = ids(__builtin_amdgcn_readfirstlane(wv));
    unsigned char* ws = ka->ws; const size_t grow = (size_t)g * MG;
    const float* src = from_in ? (((const float*)ka->in[I_X]) + grow * D) : (ka->out + grow * D);
    bf16* XB = (bf16*)(ws + WS_XB); float* ssq = (float*)(ws + WS_SSQ); const int lane = t.lane;
    f32x4 nv[4];
    { const f32x4* xr = (const f32x4*)(src + (size_t)(t.gw < MG ? t.gw : 0) * D) + lane;
#pragma unroll
      for (int j = 0; j < 4; ++j) nv[j] = xr[64 * j]; }
    for (int m = t.gw; m < MG; m += t.NGW) {
        f32x4 v[4]; float s = 0.f;
#pragma unroll
        for (int j = 0; j < 4; ++j) { v[j] = nv[j]; s += (v[j].x * v[j].x + v[j].y * v[j].y) + (v[j].z * v[j].z + v[j].w * v[j].w); }
        { const int mn = (m + t.NGW < MG) ? (m + t.NGW) : m; const f32x4* xr = (const f32x4*)(src + (size_t)mn * D) + lane;
#pragma unroll
          for (int j = 0; j < 4; ++j) nv[j] = xr[64 * j]; }
        s = wave_sum(s, lane);
        u32x2* o8 = (u32x2*)(XB + (size_t)m * D) + lane;
#pragma unroll
        for (int j = 0; j < 4; ++j) { u32x2 w; w.x = cvtpk(v[j].x, v[j].y); w.y = cvtpk(v[j].z, v[j].w); o8[64 * j] = w; }
        if (GATE_FP8) { unsigned* o4 = (unsigned*)(ws + WS_XB8 + (size_t)m * D) + lane;
#pragma unroll
            for (int j = 0; j < 4; ++j) o4[64 * j] = cvt4_fp8(v[j].x, v[j].y, v[j].z, v[j].w); }
        if (lane < 16) ssq[(size_t)m * 16 + lane] = lane == 0 ? s : 0.f; }
}
PH void ph_gemm1(int wv, LAS unsigned char* lds, int l, int parts = 3) {
    asm volatile("" : "+s"(l));
    const Ids t = ids(wv); unsigned char* ws = KA()->ws; bf16* wcat = (bf16*)(ws + WS_WCAT) + (size_t)l * NCAT * D;
#pragma nounroll
    for (int s = 0; s < 2; ++s) {
        if (s == 0) { if (parts & 1) {
            if constexpr (U_FP8_MASK != 0 && GATE_FP8 != 0) if ((U_FP8_MASK >> l) & 1) {
                pg8::OrdStd S; S.to.init(MG / 256, DIN / 256, t.G, t.wg); S.A = (const char*)(ws + WS_XB8); S.B = (const char*)wcat; S.atile = 256 * D; S.btile = 256 * D;
                pg8::EpiCat<false, true> E{(bf16*)(ws + WS_U), (bf16*)(ws + WS_GATES), (const float*)(ws + WS_SSQ)};
                pg8::gemm_phase<pg8::EpiCat<false, true>, pg8::OrdStd, true>(lds, D, D, S, E, t.wave); continue; }
            pg8::OrdStd S; S.to.init(MG / 256, (GATE_FP8 ? DIN : NCAT) / 256, t.G, t.wg); S.A = (const char*)(ws + WS_XB); S.B = (const char*)wcat; S.atile = 256 * D * 2; S.btile = 256 * D * 2;
            pg8::EpiCat<false> E{(bf16*)(ws + WS_U), (bf16*)(ws + WS_GATES), (const float*)(ws + WS_SSQ)};
            pg8::gemm_phase<pg8::EpiCat<false>, pg8::OrdStd>(lds, D, D, S, E, t.wave); } }
        else { if constexpr (GATE_FP8 != 0) if (parts & 14) {
            pg8::OrdStd S; S.to.init(MG / 256, 4096 / 256, t.G, t.wg); if (parts & 4) { S.i0 = 0; S.ni = 4; } else if (parts & 8) { S.i0 = 4; S.ni = 1 << 30; } S.A = (const char*)(ws + WS_XB8); S.B = (const char*)(wcat + (size_t)DIN * D); S.atile = 256 * D; S.btile = 256 * D;
            pg8::EpiCat<true> E{(bf16*)(ws + WS_U), (bf16*)(ws + WS_GATES), (const float*)(ws + WS_SSQ)};
            pg8::gemm_phase<pg8::EpiCat<true>, pg8::OrdStd, true>(lds, D, D, S, E, t.wave); } }
    }
}
constexpr int NSB = BG * 4 * 16, NRC = BG * 4 * 16, NCONV = BG * 64, NPOOL = BG * 64;
PH void ph_mix(int wv, LAS unsigned char* lds, int g, int l, int part, int rep = 0, int jlo = 0, int jhi = 1 << 30) {
    asm volatile("" : "+s"(l));
    const Ids t = ids(wv); unsigned char* ws = KA()->ws; unsigned* ctl = (unsigned*)(ws + WS_CTL);
    volatile LAS unsigned* MISC = (volatile LAS unsigned*)(lds + MISC_OFF);
    unsigned* qctr = ctl + CW_QCTR + 64 * ((g * 4 + l) * 2 + part + 16 * rep);
    const bf16* UB = (const bf16*)(ws + WS_U); bf16* YB = (bf16*)(ws + WS_Y); float* KVS = (float*)(ws + WS_KVS); const f32x2* ROT = (const f32x2*)(ws + WS_ROT);
    const int NUQ = part == 0 ? (NSB + NRC + NPOOL) : (NRC + NCONV); const int y8 = (MERGE_FP8_MASK >> l) & 1;
    (void)qctr; (void)MISC;
    const int NV = (t.G & 7) ? 1 : 8, v = t.wg % NV, r = t.wg / NV, per = t.G / NV, NUL = NUQ / BG;
    for (int idx = r; idx < NUL * (BG / NV); idx += per) { const int bl = v + NV * (idx / NUL), j = idx % NUL;
        if (j < jlo || j >= jhi) continue;
        if (part == 0) {
            if (j < 64) { __syncthreads(); if (t.tid == 0) { MISC[2] = 0u; MISC[3] = 0u; } __syncthreads(); sb_unit(UB, YB, y8, bl, j & 3, 15 - (j >> 2), lds, t.tid, t.wave, t.lane); }
            else if (j < 128) { const int k = j - 64; retkv_unit(UB, KVS, ROT, bl, (g * BG + bl) * SEQ, (k >> 4) & 3, k & 15, lds, t.tid, t.wave, t.lane); }
            else { const int k = j - 128; pool_unit(UB, YB, y8, bl, k & 63, lds, t.tid); }
        } else {
            if (j < 64) { reto_unit(UB, YB, y8, KVS, ROT, bl, (g * BG + bl) * SEQ, (j >> 4) & 3, j & 15, lds, t.tid, t.wave, t.lane); }
            else { const int k = j - 64;
                conv_unit(UB, YB, y8, KIN(float, I_CONVW) + (size_t)l * 31 * 256, KIN(float, I_CONVB) + l * 256, KIN(float, I_CLNG) + l * 256, KIN(float, I_CLNB) + l * 256, bl, k & 63, lds, t.tid, t.wave, t.lane); }
        }
    }
}
PH void ph_merge(int wv, LAS unsigned char* lds, int l) {
    asm volatile("" : "+s"(l));
    const Ids t = ids(wv); unsigned char* ws = KA()->ws;
    pg8::OrdMerge S; S.G = t.G; S.c = t.wg; S.ntiles = (MG / 256) * 8; S.A = (const char*)(ws + WS_Y); S.B = (const char*)((bf16*)(ws + WS_WB) + (size_t)l * D * D);
    if constexpr ((MERGE_FP8_MASK != 0) && GATE_FP8) if ((MERGE_FP8_MASK >> l) & 1) { S.esz = 1;
        pg8::EpiMerge E{(const bf16*)(ws + WS_GATES), (bf16*)(ws + WS_MERGED), (int)((OUT_FP8_MASK >> l) & 1), 1.f / (255.f * 8.f * W8_SCALE)};
        pg8::gemm_phase<pg8::EpiMerge, pg8::OrdMerge, true, true>(lds, D, D, S, E, t.wave); return; }
    S.esz = 2;
    pg8::EpiMerge E{(const bf16*)(ws + WS_GATES), (bf16*)(ws + WS_MERGED), (int)((OUT_FP8_MASK >> l) & 1), 1.f / 255.f};
    pg8::gemm_phase<pg8::EpiMerge, pg8::OrdMerge, false, true>(lds, D, D, S, E, t.wave);
}
PH void ph_res(int wv, LAS unsigned char* lds, int g, int l, int which, int xbm) {
    asm volatile("" : "+s"(l));
    const Ids t = ids(wv); unsigned char* ws = KA()->ws; (void)g; (void)l;
    if constexpr (OUT_FP8_MASK != 0) if (which == 0 && ((OUT_FP8_MASK >> l) & 1)) {
        pg8::OrdStd S; S.to.init(MG / 256, 4, t.G, t.wg); S.A = (const char*)(ws + WS_MERGED); S.B = (const char*)((bf16*)(ws + WS_WOUT) + (size_t)l * D * D); S.atile = (size_t)256 * D; S.btile = (size_t)256 * D;
        pg8::EpiRes<true, true, 2> E{(bf16*)(ws + WS_XB), xbm, (float*)(ws + WS_SSQ), ws + WS_HB};
        pg8::gemm_phase<pg8::EpiRes<true, true, 2>, pg8::OrdStd, true>(lds, D, D, S, E, t.wave);
        return; }
    int K; const char* A; const char* B;
    if (which == 0) { K = D; A = (const char*)(ws + WS_MERGED); B = (const char*)((bf16*)(ws + WS_WOUT) + (size_t)l * D * D); }
    else { K = 256; A = (const char*)(ws + WS_OB); B = (const char*)((bf16*)(ws + WS_WO) + (size_t)l * D * 256); }
    pg8::OrdStd S; S.to.init(MG / 256, 4, t.G, t.wg); S.A = A; S.B = B; S.atile = (size_t)256 * K * 2; S.btile = (size_t)256 * K * 2;
    pg8::EpiRes<true, false> E{(bf16*)(ws + WS_XB), xbm, (float*)(ws + WS_SSQ), ws + WS_HB};
    pg8::gemm_phase<pg8::EpiRes<true, false>, pg8::OrdStd>(lds, K, K, S, E, t.wave);
}
template <bool F8> PH void ph_down(int wv, LAS unsigned char* lds, int g, int l, int xbm) {
    asm volatile("" : "+s"(l));
    constexpr int FE = F8 ? 1 : 2;
    const Ids t = ids(wv); unsigned char* ws = KA()->ws; (void)g;
    pg8::OrdStd S; S.to.init(MG / 256, 4, t.G, t.wg); S.A = (const char*)(ws + WS_ACTD); S.B = (const char*)(ws + WS_WDND + (size_t)(l >> 1) * D * DFF * 2); S.atile = (size_t)256 * DFF * FE; S.btile = (size_t)256 * DFF * FE;
    pg8::EpiRes<true, F8> E{(bf16*)(ws + WS_XB), xbm, (float*)(ws + WS_SSQ), ws + WS_XB8};
    pg8::gemm_phase<pg8::EpiRes<true, F8>, pg8::OrdStd, F8>(lds, DFF, DFF, S, E, t.wave);
}
PH void ph_q(int wv, LAS unsigned char* lds, int l) {
    asm volatile("" : "+s"(l));
    const Ids t = ids(wv); unsigned char* ws = KA()->ws;
    pg8::OrdQ S; S.to.init(MG / 256, 2, t.G, t.wg); S.A = (const char*)(ws + WS_XB); S.B = (const char*)((bf16*)(ws + WS_WQ) + (size_t)l * 256 * D);
    pg8::EpiBf16<false> E{(bf16*)(ws + WS_QB), 512, (const float*)(ws + WS_SSQ)};
    pg8::gemm_phase<pg8::EpiBf16<false>, pg8::OrdQ>(lds, D, D, S, E, t.wave, 512);
}
PH void ph_xa(int wv, LAS unsigned char* lds, int g, int l) {
    asm volatile("" : "+s"(l));
    const Ids t = ids(wv); unsigned char* ws = KA()->ws; const unsigned* ctl = (const unsigned*)(ws + WS_CTL);
    const int NV = (t.G & 7) ? 1 : 8, v = t.wg % NV, r = t.wg / NV, per = t.G / NV;
    for (int idx = r; idx < 64 * (BG / NV); idx += per) { const int bl = v + NV * (idx >> 6), j = idx & 63, hd = (j >> 4) & 3, qblk = j & 15, bglob = g * BG + bl;
        const float kmax = sqrtf(__uint_as_float(ctl[CW_KMAX + (l * NB + bglob) * 4 + hd]));
        xa_unit((const bf16*)(ws + WS_QB), (const bf16*)(ws + WS_KV) + (size_t)l * MMEM * 512, KIN(float, I_QG) + l * 64, kmax, (bf16*)(ws + WS_OB), bl, bglob, hd, qblk, lds, t.tid, t.wave, t.lane); }
}
template <bool F8> PH void ph_gu(int wv, LAS unsigned char* lds, int l) {
    asm volatile("" : "+s"(l));
    constexpr int FE = F8 ? 1 : 2;
    const Ids t = ids(wv); unsigned char* ws = KA()->ws;
    pg8::OrdStd S; S.to.init(MG / 256, NGU / 256, t.G, t.wg); S.A = (const char*)(ws + (F8 ? WS_HB : WS_XB)); S.B = (const char*)(ws + WS_WGUD + (size_t)(l >> 1) * NGU * D * 2); S.atile = 256 * D * FE; S.btile = 256 * D * FE;
    pg8::EpiGU<F8> E{(void*)(ws + WS_ACTD), (const float*)(ws + WS_SSQ)};
    pg8::gemm_phase<pg8::EpiGU<F8>, pg8::OrdStd, F8>(lds, D, D, S, E, t.wave);
}
struct MoeCtx { int rpw, r_lo, r_hi; };
DI MoeCtx moe_ctx(const Ids& t) { MoeCtx c; c.rpw = (MG + t.G - 1) / t.G; const int blk = (t.G & 7) ? t.wg : (t.wg & 7) * (t.G >> 3) + (t.wg >> 3);        c.r_lo = blk * c.rpw; c.r_hi = (c.r_lo + c.rpw < MG) ? (c.r_lo + c.rpw) : MG; return c; }
template <bool F8> PH void ph_route(int wv, LAS unsigned char* lds, int g, int l) {
    asm volatile("" : "+s"(l));
    constexpr int FE = F8 ? 1 : 2;
    const Ids t = ids(wv); unsigned char* ws = KA()->ws; unsigned* ctl = (unsigned*)(ws + WS_CTL); const int l2 = l >> 1, inst = g * 2 + l2;
    unsigned* wgcnt = ctl + CW_WGCNT + inst * 8192; const MoeCtx mc = moe_ctx(t);
    volatile LAS unsigned* LC = (volatile LAS unsigned*)(lds + MISC_OFF) + 16;
    const bf16* XBr = (const bf16*)(ws + WS_XB); bf16* HB = (bf16*)(ws + WS_HB); (void)g;
    int* R_E = (int*)(ws + WS_ROUTE); float* R_W1 = (float*)(R_E + MG); float* R_W2 = R_W1 + MG;
    if (t.tid < 16) LC[t.tid] = 0u;
    __syncthreads();
    const float* rt = KIN(float, I_ROUTER) + (size_t)l2 * D * NEXP; const float* gn = KIN(float, I_NFFNG) + l * D; const int lane = t.lane;
    LAS f32x4* RW = (LAS f32x4*)lds;
    for (int f = t.tid; f < D * 2; f += NTHR) { const int k = f >> 1, half = f & 1, ln = (k & 255) >> 2, j = k >> 8, q = k & 3; RW[(2 * (4 * j + q) + half) * 64 + ln] = *((const f32x4*)rt + f); }
    f32x4 gg4[4];
#pragma unroll
    for (int j = 0; j < 4; ++j) gg4[j] = *((const f32x4*)gn + lane + 64 * j);
    __syncthreads();
    u32x2 xw[4];
    { const int m0 = mc.r_lo + t.wave; const u32x2* xr = (const u32x2*)(XBr + (size_t)(m0 < mc.r_hi ? m0 : mc.r_lo) * D) + lane;
#pragma unroll
      for (int j = 0; j < 4; ++j) xw[j] = xr[64 * j]; }
    for (int m = mc.r_lo + t.wave; m < mc.r_hi; m += NWAVES) {
        f32x4 v[4]; float s = 0.f;
#pragma unroll
        for (int j = 0; j < 4; ++j) { const u32x2 w = xw[j]; v[j] = (f32x4){bflo(w.x), bfhi(w.x), bflo(w.y), bfhi(w.y)}; s += (v[j].x * v[j].x + v[j].y * v[j].y) + (v[j].z * v[j].z + v[j].w * v[j].w); }
        { const int mn = (m + NWAVES < mc.r_hi) ? (m + NWAVES) : m; const u32x2* xr = (const u32x2*)(XBr + (size_t)mn * D) + lane;
#pragma unroll
          for (int j = 0; j < 4; ++j) xw[j] = xr[64 * j]; }
        const float rstd = 1.f / sqrtf(wave_sum(s, lane) * (1.f / D) + EPS);
        float lg[8];
#pragma unroll
        for (int e = 0; e < 8; ++e) lg[e] = 0.f;
        u32x2* o8 = (u32x2*)(HB + (size_t)m * D) + lane; unsigned* o4 = (unsigned*)((unsigned char*)HB + (size_t)m * D) + lane;
#pragma unroll
        for (int j = 0; j < 4; ++j) { const f32x4 gg = gg4[j]; const f32x4 hn = v[j] * rstd * gg;
            if (F8) o4[64 * j] = cvt4_fp8(hn.x, hn.y, hn.z, hn.w);
            else { u32x2 w; w.x = cvtpk(hn.x, hn.y); w.y = cvtpk(hn.z, hn.w); o8[64 * j] = w; }
#pragma unroll
            for (int q = 0; q < 4; ++q) { const f32x4 r0 = RW[(2 * (4 * j + q)) * 64 + lane], r1 = RW[(2 * (4 * j + q) + 1) * 64 + lane]; const float hv = hn[q];
                lg[0] += hv * r0.x; lg[1] += hv * r0.y; lg[2] += hv * r0.z; lg[3] += hv * r0.w; lg[4] += hv * r1.x; lg[5] += hv * r1.y; lg[6] += hv * r1.z; lg[7] += hv * r1.w; } }
        {
          const float p0 = fold32(lg[0], lg[4]), p1 = fold32(lg[1], lg[5]), p2 = fold32(lg[2], lg[6]), p3 = fold32(lg[3], lg[7]);
          const float q0 = row_sum16(fold16(p0, p2)), q1 = row_sum16(fold16(p1, p3));
#pragma unroll
          for (int rw = 0; rw < 4; ++rw) { lg[2 * rw] = __builtin_bit_cast(float, __builtin_amdgcn_readlane(__builtin_bit_cast(int, q0), 16 * rw)); lg[2 * rw + 1] = __builtin_bit_cast(float, __builtin_amdgcn_readlane(__builtin_bit_cast(int, q1), 16 * rw)); } }
        float v1 = lg[0]; int i1 = 0;
#pragma unroll
        for (int e = 1; e < 8; ++e) if (lg[e] > v1) { v1 = lg[e]; i1 = e; }
        float v2 = -3.0e38f; int i2 = -1;
#pragma unroll
        for (int e = 0; e < 8; ++e) if (e != i1 && (i2 < 0 || lg[e] > v2)) { v2 = lg[e]; i2 = e; }
        const float w1 = 1.f / (1.f + __expf(v2 - v1));
        if (lane == 0) { R_E[m] = i1 | (i2 << 8); R_W1[m] = w1; R_W2[m] = 1.f - w1;
            __hip_atomic_fetch_add((LAS unsigned*)&LC[i1], 1u, __ATOMIC_RELAXED, __HIP_MEMORY_SCOPE_WORKGROUP); __hip_atomic_fetch_add((LAS unsigned*)&LC[i2], 1u, __ATOMIC_RELAXED, __HIP_MEMORY_SCOPE_WORKGROUP); }
    }
    __syncthreads();
    if (t.tid < 8) wgcnt[t.wg * 8 + t.tid] = LC[t.tid];
}
template <bool F8> PHN void ph_gather(KArgs ka, int wv, LAS unsigned char* lds, int g, int l) {
    constexpr int FE = F8 ? 1 : 2;
    const Ids t = ids(__builtin_amdgcn_readfirstlane(wv));     unsigned char* ws = ka->ws; unsigned* ctl = (unsigned*)(ws + WS_CTL); const int l2 = l >> 1, inst = g * 2 + l2;
    unsigned* wgcnt = ctl + CW_WGCNT + inst * 8192; unsigned* moff = ctl + CW_MOFF + 64 * inst; const MoeCtx mc = moe_ctx(t);
    volatile LAS unsigned* LC = (volatile LAS unsigned*)(lds + MISC_OFF) + 16;
    const bf16* HB = (const bf16*)(ws + WS_HB); bf16* HP = (bf16*)(ws + WS_HP);
    const int* R_E = (const int*)(ws + WS_ROUTE); int* R_S1 = (int*)(ws + WS_ROUTE) + 3 * MG; int* R_S2 = R_S1 + MG;
    if (t.tid < 16) LC[t.tid] = 0u;
    __syncthreads();
    for (int idx = t.tid; idx < t.G * 8; idx += NTHR) { const unsigned v = wgcnt[idx]; const int e = idx & 7;
        __hip_atomic_fetch_add((LAS unsigned*)&LC[8 + e], v, __ATOMIC_RELAXED, __HIP_MEMORY_SCOPE_WORKGROUP);
        if ((idx >> 3) < t.wg) __hip_atomic_fetch_add((LAS unsigned*)&LC[e], v, __ATOMIC_RELAXED, __HIP_MEMORY_SCOPE_WORKGROUP); }
    __syncthreads();
    if (t.tid == 0) { unsigned o = 0;
        for (int e = 0; e < 8; ++e) { const unsigned tot = LC[8 + e]; if (t.wg == 0) moff[e] = o; LC[e] = LC[e] + o; o += (tot + 255u) & ~255u; }
        if (t.wg == 0) moff[8] = o; }
    __syncthreads();
    const int lane = t.lane;
    LAS unsigned char* EX = (LAS unsigned char*)lds; LAS unsigned* SL = (LAS unsigned*)(lds + 8192); const int npairs = 2 * (mc.r_hi - mc.r_lo);
    for (int p = t.tid; p < npairs; p += NTHR) { const int ee = R_E[mc.r_lo + (p >> 1)]; EX[p] = (unsigned char)((p & 1) ? (ee >> 8) : (ee & 255)); }
    __syncthreads();
    for (int p = t.tid; p < npairs; p += NTHR) { const unsigned e = EX[p]; unsigned rank = 0;
        for (int q = 0; q < p; ++q) rank += (EX[q] == e) ? 1u : 0u;
        const unsigned s = LC[e] + rank; SL[p] = s; if (p & 1) R_S2[mc.r_lo + (p >> 1)] = (int)s; else R_S1[mc.r_lo + (p >> 1)] = (int)s; }
    __syncthreads();
    for (int mb = mc.r_lo + t.wave; mb < mc.r_hi; mb += NWAVES * 64) {
        const int mrow = mb + NWAVES * lane; int s1v = 0, s2v = 0;
        if (mrow < mc.r_hi) { s1v = (int)SL[2 * (mrow - mc.r_lo)]; s2v = (int)SL[2 * (mrow - mc.r_lo) + 1]; }
        const int nr = (mc.r_hi - mb + NWAVES - 1) / NWAVES, nrow = nr < 64 ? nr : 64;
        for (int i0 = 0; i0 < nrow; i0 += 4) {
            u32x4 a[4], b[4]; int s1[4], s2[4];
#pragma unroll
            for (int k = 0; k < 4; ++k) { const int i = (i0 + k < nrow) ? (i0 + k) : (nrow - 1); const size_t m = (size_t)(mb + NWAVES * i);
                s1[k] = __builtin_amdgcn_readlane(s1v, i); s2[k] = __builtin_amdgcn_readlane(s2v, i);
                if (F8) a[k] = *((const u32x4*)((const unsigned char*)HB + m * D) + lane);
                else { const u32x4* src = (const u32x4*)(HB + m * D) + lane; a[k] = src[0]; b[k] = src[64]; } }
#pragma unroll
            for (int k = 0; k < 4; ++k) { if (i0 + k < nrow) {
                if (F8) { *((u32x4*)((unsigned char*)HP + (size_t)s1[k] * D) + lane) = a[k]; *((u32x4*)((unsigned char*)HP + (size_t)s2[k] * D) + lane) = a[k]; }
                else { u32x4* d1 = (u32x4*)(HP + (size_t)s1[k] * D) + lane; u32x4* d2 = (u32x4*)(HP + (size_t)s2[k] * D) + lane; d1[0] = a[k]; d1[64] = b[k]; d2[0] = a[k]; d2[64] = b[k]; } } } }
    }
}
template <bool F8> PH void ph_moe_gu(int wv, LAS unsigned char* lds, int g, int l) {
    asm volatile("" : "+s"(l));
    constexpr int FE = F8 ? 1 : 2;
    const Ids t = ids(wv); unsigned char* ws = KA()->ws; const unsigned* ctl = (const unsigned*)(ws + WS_CTL); const int l2 = l >> 1, inst = g * 2 + l2; const unsigned* moff = ctl + CW_MOFF + 64 * inst;
    pg8::OrdMoe S;
#pragma unroll
    for (int e = 0; e < 9; ++e) S.off[e] = __builtin_amdgcn_readfirstlane((int)moff[e]);
    S.to.init(S.off[8] >> 8, NGU / 256, t.G, t.wg); S.A = (const char*)(ws + WS_HP); S.B = (const char*)(ws + WS_WGUM + (size_t)l2 * NEXP * NGU * D * 2); S.atile = 256 * D * FE; S.btile = 256 * D * FE; S.bexp = (size_t)NGU * D * 2;
    pg8::EpiGU<F8, false> E{(void*)(ws + WS_ACT), nullptr};
    pg8::gemm_phase<pg8::EpiGU<F8, false>, pg8::OrdMoe, F8>(lds, D, D, S, E, t.wave);
}
template <bool F8> PH void ph_moe_dn(int wv, LAS unsigned char* lds, int g, int l) {
    asm volatile("" : "+s"(l));
    constexpr int FE = F8 ? 1 : 2;
    const Ids t = ids(wv); unsigned char* ws = KA()->ws; const unsigned* ctl = (const unsigned*)(ws + WS_CTL); const int l2 = l >> 1, inst = g * 2 + l2; const unsigned* moff = ctl + CW_MOFF + 64 * inst;
    pg8::OrdMoe S;
#pragma unroll
    for (int e = 0; e < 9; ++e) S.off[e] = __builtin_amdgcn_readfirstlane((int)moff[e]);
    const int nrt = S.off[8] >> 8, nfull = (F8 && nrt > 256) ? 256 : nrt;
    S.to.init(nfull, 4, t.G, t.wg); S.A = (const char*)(ws + WS_ACT); S.B = (const char*)(ws + WS_WDNM + (size_t)l2 * NEXP * D * DFF * 2); S.atile = (size_t)256 * DFF * FE; S.btile = (size_t)256 * DFF * FE; S.bexp = (size_t)D * DFF * 2;
    pg8::EpiBf16<F8> E{(bf16*)(ws + WS_HP), D, nullptr};
    pg8::gemm_phase<pg8::EpiBf16<F8>, pg8::OrdMoe, F8>(lds, DFF, DFF, S, E, t.wave);
    if constexpr (F8) if (nrt > 256) {
        const int kh = t.wg >> 5;
        if (kh < 4) { S.pm0 = 256; S.koff = (size_t)kh * 768; S.to.init(nrt - 256, 4, t.G, t.wg & 31);
            pg8::EpiBf16<F8> E2{kh == 0 ? (bf16*)(ws + WS_HP) : (bf16*)(ws + WS_HPX + (size_t)(kh - 1) * 4 * MiB) - (size_t)65536 * D, D, nullptr};
            pg8::gemm_phase<pg8::EpiBf16<F8>, pg8::OrdMoe, F8>(lds, DFF, DFF, S, E2, t.wave, kh < 3 ? 768 : 512); } }
}
PHN void ph_combine(KArgs ka, int wv, int g, int xbm) {
    const Ids t = ids(__builtin_amdgcn_readfirstlane(wv));
    unsigned char* ws = ka->ws; float* xo = ka->out + (size_t)g * MG * D; const bf16* HP = (const bf16*)(ws + WS_HP);
    const int* R_E = (const int*)(ws + WS_ROUTE); const float* R_W1 = (const float*)(R_E + MG); const float* R_W2 = R_W1 + MG; const int* R_S1 = (const int*)(R_W2 + MG); const int* R_S2 = R_S1 + MG;
    const int lane = t.lane;
    bf16* XB = (bf16*)(ws + WS_XB); float* ssq = (float*)(ws + WS_SSQ);
    const MoeCtx mc = moe_ctx(t);
    for (int mb = mc.r_lo + t.wave; mb < mc.r_hi; mb += NWAVES * 64) {
        const int mrow = mb + NWAVES * lane; int s1v = 0, s2v = 0; float w1v = 0.f, w2v = 0.f;
        if (mrow < mc.r_hi) { s1v = R_S1[mrow]; s2v = R_S2[mrow]; w1v = R_W1[mrow]; w2v = R_W2[mrow]; }
        const int nr = (mc.r_hi - mb + NWAVES - 1) / NWAVES, nrow = nr < 64 ? nr : 64;
        for (int i0 = 0; i0 < nrow; i0 += 2) {
            u32x4 xa[2][2], pa[2][2], pb[2][2]; float w1[2], w2[2]; size_t mm[2]; int sl1[2], sl2[2];
#pragma unroll
            for (int k = 0; k < 2; ++k) { const int i = (i0 + k < nrow) ? (i0 + k) : (nrow - 1); mm[k] = (size_t)(mb + NWAVES * i);
                const int s1 = __builtin_amdgcn_readlane(s1v, i), s2 = __builtin_amdgcn_readlane(s2v, i); sl1[k] = s1; sl2[k] = s2;
                w1[k] = __builtin_bit_cast(float, __builtin_amdgcn_readlane(__builtin_bit_cast(int, w1v), i)); w2[k] = __builtin_bit_cast(float, __builtin_amdgcn_readlane(__builtin_bit_cast(int, w2v), i));
                const u32x4* px = (const u32x4*)(XB + mm[k] * D) + lane; const u32x4* p1 = (const u32x4*)(HP + (size_t)s1 * D) + lane; const u32x4* p2 = (const u32x4*)(HP + (size_t)s2 * D) + lane;
                xa[k][0] = px[0]; xa[k][1] = px[64]; pa[k][0] = p1[0]; pa[k][1] = p1[64]; pb[k][0] = p2[0]; pb[k][1] = p2[64]; }
#pragma unroll
            for (int k = 0; k < 2; ++k) { if (i0 + k < nrow) { const size_t m = mm[k]; float ssum = 0.f;
#pragma unroll
                for (int j = 0; j < 2; ++j) { float a[8], b[8], x[8]; unpack8(pa[k][j], a); unpack8(pb[k][j], b); unpack8(xa[k][j], x);
                    if (sl1[k] >= 65536) {
#pragma unroll
                        for (int p = 0; p < 3; ++p) { float t8[8]; unpack8(*((const u32x4*)((const bf16*)(ws + WS_HPX + (size_t)p * 4 * MiB) + (size_t)(sl1[k] - 65536) * D) + lane + 64 * j), t8);
#pragma unroll
                            for (int q = 0; q < 8; ++q) a[q] += t8[q]; } }
                    if (sl2[k] >= 65536) {
#pragma unroll
                        for (int p = 0; p < 3; ++p) { float t8[8]; unpack8(*((const u32x4*)((const bf16*)(ws + WS_HPX + (size_t)p * 4 * MiB) + (size_t)(sl2[k] - 65536) * D) + lane + 64 * j), t8);
#pragma unroll
                            for (int q = 0; q < 8; ++q) b[q] += t8[q]; } }
#pragma unroll
                    for (int q = 0; q < 8; ++q) x[q] += w1[k] * a[q] + w2[k] * b[q];
                    if (xbm) {
#pragma unroll
                        for (int q = 0; q < 8; ++q) ssum += x[q] * x[q];
                        *((u32x4*)(XB + m * D) + lane + 64 * j) = pack8(x);
                        if (GATE_FP8) { u32x2 w8; w8.x = cvt4_fp8(x[0], x[1], x[2], x[3]); w8.y = cvt4_fp8(x[4], x[5], x[6], x[7]); *((u32x2*)(ws + WS_XB8 + m * D) + lane + 64 * j) = w8; } }
                    else { f32x4* xr = (f32x4*)(xo + m * D) + 2 * lane + 128 * j; xr[0] = (f32x4){x[0], x[1], x[2], x[3]}; xr[1] = (f32x4){x[4], x[5], x[6], x[7]}; } }
                if (xbm) { ssum = wave_sum(ssum, lane); if (lane < 16) ssq[m * 16 + lane] = lane == 0 ? ssum : 0.f; } } } }
    }
}

__global__ void __launch_bounds__(NTHR, 2) trunk_fwd(Args args) {
    extern __shared__ __attribute__((aligned(16))) unsigned char lds_raw[];
    LAS unsigned char* lds = (LAS unsigned char*)lds_raw;
    volatile LAS unsigned* MISC = (volatile LAS unsigned*)(lds + MISC_OFF);
    const int tid = threadIdx.x; int wave = __builtin_amdgcn_readfirstlane(tid >> 6); asm volatile("" : "+s"(wave));
    unsigned* ctl = (unsigned*)(args.ws + WS_CTL);
    for (int u = tid; u < (LDS_BYTES - LDSCTL_OFF) / 4; u += NTHR) ((LAS unsigned*)(lds + LDSCTL_OFF))[u] = 0u;
    __syncthreads();
    XcdBarrier bar; bar.bar = ctl + CW_BAR; bar.x = xb_xcc_id(); bar.st = MISC + 8;
    if (tid == 0) { (void)xb_add(&bar.bar[XB_XCNT(bar.x)], 1u); (void)__hip_atomic_fetch_or(&bar.bar[XB_XMASK(blockIdx.x & 7)], 1u << bar.x, __ATOMIC_RELAXED, __HIP_MEMORY_SCOPE_AGENT); }
#define WV() ({ int _w = wave; asm volatile("" : "+s"(_w)); _w; })
#define GRID_BAR() xcd_barrier_fn((GAS unsigned*)bar.bar, bar.x, bar.st, WV())
#if LOCAL_SYNC
#define LBAR() lbar_fn((GAS unsigned*)bar.bar, bar.x, bar.st, WV(), (int)blockIdx.x, (int)(gridDim.x >> 3))
#else
#define LBAR() GRID_BAR()
#endif
    unsigned ib = 0;
    for (int l = 0; l < DEPTH; ++l) ib = ph_w_layer(KA(), WV(), lds, l, ib);
    for (int s = 0; s < 2 + 2 * NEXP; ++s) ib = ph_w_ffn(KA(), WV(), lds, s, ib);
    ph_misc0(KA(), WV());
#ifdef DUP_PRO
    for (int l = 0; l < DEPTH; ++l) ib = ph_w_layer(KA(), WV(), lds, l, ib);
    for (int s = 0; s < 2 + 2 * NEXP; ++s) ib = ph_w_ffn(KA(), WV(), lds, s, ib);
    ph_misc0(KA(), WV());
#endif
    GRID_BAR();
    if (tid == 0) {
        unsigned ok = (gridDim.x & 7u) ? 0u : 1u;
        for (int j = 0; j < 8; ++j) { const unsigned m = xb_ld(&bar.bar[XB_XMASK(j)]); ok &= (m != 0u && (m & (m - 1u)) == 0u) ? 1u : 0u; }
        MISC[12] = ok; }
    ph_kv(wave, lds);
    GRID_BAR();
    ph_knorm(KA(), WV());
    GRID_BAR();
    for (int g = 0; g < NG; ++g) {
        for (int l = 0; l < DEPTH; ++l) {
            if (l == 0) { ph_xprep(KA(), WV(), g, 1); GRID_BAR(); }
            ph_gemm1(wave, lds, l, GATE_FP8 ? 1 : 3); LBAR();
#ifdef DUP_G1
            ph_gemm1(wave, lds, l, DUP_G1); GRID_BAR();
#endif
#pragma nounroll
            for (int mp = 0; mp < 2; ++mp) { int mpo = mp; asm volatile("" : "+s"(mpo));
                ph_mix(wave, lds, g, l, mpo);
                if (GATE_FP8) ph_gemm1(wave, lds, l, GATE_SPLIT ? (mpo ? 8 : 4) : (mpo ? 2 : 0));
                LBAR(); }
#ifdef DUP_MIX_LO
            ph_mix(wave, lds, g, l, DUP_MIX_PART, 1, DUP_MIX_LO, DUP_MIX_HI); GRID_BAR();
#endif
            ph_merge(wave, lds, l); LBAR();
#ifdef DUP_BAR
            GRID_BAR(); GRID_BAR(); GRID_BAR(); GRID_BAR(); GRID_BAR(); GRID_BAR(); GRID_BAR(); GRID_BAR();
#endif
#ifdef DUP_MERGE
            ph_merge(wave, lds, l); GRID_BAR();
#endif
            ph_res(wave, lds, g, l, 0, 1); LBAR();
            ph_q(wave, lds, l); LBAR();
            ph_xa(wave, lds, g, l); LBAR();
            const bool f8 = (F8MASK >> l) & 1u; const int nxt = (l + 1 < DEPTH) ? 1 : 0;
            if ((l & 1) == 0) {
                ph_res(wave, lds, g, l, 1, f8 ? 2 : 1); LBAR();
                if (f8) { if constexpr (DENSE_ANY8) { ph_gu<true>(wave, lds, l); LBAR();
#ifdef DUP_GU8
                    ph_gu<true>(wave, lds, l); GRID_BAR();
#endif
                    ph_down<true>(wave, lds, g, l, nxt ? (GATE_FP8 ? 3 : 1) : 0); LBAR(); } }
                else { if constexpr (DENSE_ANYB) { ph_gu<false>(wave, lds, l); LBAR();
#ifdef DUP_GUB
                    ph_gu<false>(wave, lds, l); GRID_BAR();
#endif
                    ph_down<false>(wave, lds, g, l, nxt ? (GATE_FP8 ? 3 : 1) : 0); LBAR(); } }
            } else {
                ph_res(wave, lds, g, l, 1, 0); LBAR();
                if (f8) { if constexpr (MOE_ANY8) { ph_route<true>(wave, lds, g, l); GRID_BAR(); ph_gather<true>(KA(), WV(), lds, g, l); GRID_BAR(); ph_moe_gu<true>(wave, lds, g, l); GRID_BAR(); ph_moe_dn<true>(wave, lds, g, l); GRID_BAR(); } }
                else { if constexpr (MOE_ANYB) { ph_route<false>(wave, lds, g, l); GRID_BAR(); ph_gather<false>(KA(), WV(), lds, g, l); GRID_BAR(); ph_moe_gu<false>(wave, lds, g, l); GRID_BAR(); ph_moe_dn<false>(wave, lds, g, l); GRID_BAR(); } }
                ph_combine(KA(), WV(), g, nxt); if (nxt) LBAR(); else GRID_BAR();
            }
        }
    }
}

extern "C" void kernel_launch(void* const* d_in, const int* in_sizes, int n_in, void* d_out, int out_size, void* d_ws, size_t ws_size, hipStream_t stream) {
    static int grid = 0;
    if (grid == 0) {
        if (n_in != 27 || in_sizes[0] != MTOT * D || out_size != MTOT * D || ws_size < WS_END) { fprintf(stderr, "kernel_launch: unexpected problem (n_in %d, in0 %d, out %d, ws %zu < %zu)\n", n_in, n_in > 0 ? in_sizes[0] : -1, out_size, ws_size, (size_t)WS_END); grid = -1; return; }
        int dev = 0, cus = 0, per_cu = 0;
        if (hipGetDevice(&dev) != hipSuccess || hipDeviceGetAttribute(&cus, hipDeviceAttributeMultiprocessorCount, dev) != hipSuccess) { grid = -1; return; }
        if (hipFuncSetAttribute((const void*)trunk_fwd, hipFuncAttributeMaxDynamicSharedMemorySize, LDS_BYTES) != hipSuccess) { fprintf(stderr, "kernel_launch: hipFuncSetAttribute failed\n"); grid = -1; return; }
        if (hipOccupancyMaxActiveBlocksPerMultiprocessor(&per_cu, (const void*)trunk_fwd, NTHR, LDS_BYTES) != hipSuccess || per_cu < 1) fprintf(stderr, "kernel_launch: occupancy query reports %d\n", per_cu);
        (void)hipGetLastError();
        grid = cus;
    }
    if (grid < 0) return;
    if (hipMemsetAsync((char*)d_ws + WS_CTL, 0, CTL_ZERO_BYTES, stream) != hipSuccess) return;
    Args a{};
    for (int i = 0; i < 27; ++i) a.in[i] = d_in[i];
    a.out = (float*)d_out; a.ws = (unsigned char*)d_ws;
    hipLaunchKernelGGL(trunk_fwd, dim3(grid), dim3(NTHR), LDS_BYTES, stream, a);
}
```

```cpp
#include <hip/hip_runtime.h>
#include <cstdio>
#include <cstdint>

#define DI __device__ __forceinline__
#define LAS __attribute__((address_space(3)))
#define GAS __attribute__((address_space(1)))
typedef unsigned short bf16;
typedef short bf16x8 __attribute__((ext_vector_type(8)));
typedef short s16x4 __attribute__((ext_vector_type(4)));
typedef float f32x2 __attribute__((ext_vector_type(2)));
typedef float f32x4 __attribute__((ext_vector_type(4)));
typedef float f32x16 __attribute__((ext_vector_type(16)));
typedef unsigned u32x2 __attribute__((ext_vector_type(2)));
typedef unsigned u32x4 __attribute__((ext_vector_type(4)));
typedef __bf16 bf16x2_t __attribute__((ext_vector_type(2)));
typedef GAS unsigned gu32;
typedef int i32x8 __attribute__((ext_vector_type(8)));
#ifndef GATE_FP8
#define U_FP8_MASK 0xC
#define MERGE_FP8_MASK 0xC
#define OUT_FP8_MASK 0xC
#define WSUM_DPP 1
#define GATE_SPLIT 0
#define LOCAL_SYNC 1
#define GATE_FP8 1
#endif
#ifndef FFN_FP8_MASK
#define FFN_FP8_MASK 0xE
#endif
constexpr float W8_SCALE = 64.f, W8_INV = 1.f / 64.f;

constexpr int NB = 16, SEQ = 4096, D = 1024, DEPTH = 4, NG = 2, BG = NB / NG, MG = BG * SEQ, MTOT = NB * SEQ;
constexpr int DIN = 2560, NCAT = DIN + 4096, DFF = 2816, NGU = 2 * DFF, NEXP = 8, NMEM = 256, MMEM = NB * NMEM;
constexpr int MOE_SLOTS = 2 * MG + NEXP * 256;
constexpr float EPS = 1e-6f;
constexpr int NWAVES = 8, NTHR = 512;
constexpr int UC_CA = 0, UC_CG = 256, UC_POOL = 512, UC_SBQ = 768, UC_SBK = 1024, UC_SBV = 1280, UC_RQ = 1536, UC_RK = 1792, UC_RV = 2048, UC_RG = 2304;
constexpr int YC_CONV = 0, YC_POOL = 256, YC_SB = 512, YC_RET = 768;

constexpr size_t MiB = 1u << 20;
constexpr size_t WS_CTL = 0, CTL_ZERO_BYTES = 256 * 1024;
constexpr size_t WS_WCAT = 1 * MiB;
constexpr size_t WS_WB = 53 * MiB;
constexpr size_t WS_WOUT = 61 * MiB;
constexpr size_t WS_WQ = 69 * MiB;
constexpr size_t WS_WKV = 71 * MiB;
constexpr size_t WS_WO = 75 * MiB;
constexpr size_t WS_WGUD = 77 * MiB;
constexpr size_t WS_WDND = 99 * MiB;
constexpr size_t WS_WGUM = 110 * MiB;
constexpr size_t WS_WDNM = 286 * MiB;
constexpr size_t WS_ROT = 374 * MiB;
constexpr size_t WS_MEMH = 390 * MiB;
constexpr size_t WS_KV = 422 * MiB;
constexpr size_t WS_HB = 438 * MiB;
constexpr size_t WS_U = 502 * MiB;
constexpr size_t WS_GATES = 662 * MiB;
constexpr size_t WS_Y = 922 * MiB;
constexpr size_t WS_MERGED = 986 * MiB;
constexpr size_t WS_QB_OLD = 1050 * MiB;
constexpr size_t WS_OB_OLD = 1066 * MiB;
constexpr size_t WS_ROUTE = 1082 * MiB;
constexpr size_t WS_KVS = 1083 * MiB;
constexpr size_t WS_SSQ = 1091 * MiB;
constexpr size_t WS_XB8 = 1093 * MiB;
constexpr size_t WS_XB = 1125 * MiB;
constexpr size_t WS_END_MAIN = 1189 * MiB;
constexpr size_t WS_HPX = WS_END_MAIN + 176 * MiB;
constexpr size_t WS_QB = WS_QB_OLD;
constexpr size_t WS_OB = WS_HPX + 12 * MiB;
constexpr size_t WS_END = WS_OB + 16 * MiB;
constexpr size_t WS_ACT = WS_U, WS_HP = WS_GATES + 128 * MiB;
constexpr size_t WS_ACTD = WS_END_MAIN;
static_assert((size_t)MOE_SLOTS * DFF * 2 <= WS_Y - WS_U, "act overlay");
static_assert(GATE_FP8 && WS_HP + (size_t)MOE_SLOTS * D * 2 <= WS_Y && WS_ACT + (size_t)MOE_SLOTS * DFF <= WS_HP, "hp / act placement (fp8 experts, 8-bit gates)");
constexpr int CW_TMO = 0, CW_CODE = 1;
constexpr int CW_BAR = 4096;
constexpr int CW_QCTR = 8192;
constexpr int CW_KMAX = 10240;
constexpr int CW_MOFF = 10752;
constexpr int CW_WGCNT = 16384;

constexpr int RING_BYTES = 131072;
constexpr int LDSCTL_OFF = RING_BYTES, MISC_OFF = LDSCTL_OFF + 320;
constexpr int LDS_BYTES = 147456;
constexpr int KS = 72, VS = 96;
constexpr int L_KS = 0, L_VT = 36864, L_ST = 86016;

#define SHX(x, m, lane) __builtin_bit_cast(float, __builtin_amdgcn_ds_bpermute((((lane) ^ (m)) << 2), __builtin_bit_cast(int, (float)(x))))
DI float shx32(float x, int lane) { const auto r = __builtin_amdgcn_permlane32_swap(__builtin_bit_cast(unsigned, x), __builtin_bit_cast(unsigned, x), false, false); return __builtin_bit_cast(float, (lane & 32) ? r[0] : r[1]); }
DI float shx16(float x, int lane) { const auto r = __builtin_amdgcn_permlane16_swap(__builtin_bit_cast(unsigned, x), __builtin_bit_cast(unsigned, x), false, false); return __builtin_bit_cast(float, (lane & 16) ? r[0] : r[1]); }
template <int CTRL> DI float dppx(float v) { return __builtin_bit_cast(float, __builtin_amdgcn_update_dpp(0, __builtin_bit_cast(int, v), CTRL, 0xf, 0xf, true)); }
DI float row_sum16(float v) { v += dppx<0xB1>(v); v += dppx<0x4E>(v); v += dppx<0x141>(v); v += dppx<0x140>(v); return v; }
DI float fold32(float a, float b) { asm volatile("s_nop 1\n\tv_permlane32_swap_b32 %0, %1\n\ts_nop 1" : "+v"(a), "+v"(b)); return a + b; }
DI float fold16(float a, float b) { asm volatile("s_nop 1\n\tv_permlane16_swap_b32 %0, %1\n\ts_nop 1" : "+v"(a), "+v"(b)); return a + b; }
DI float wave_sum(float v, int lane) {
#if WSUM_DPP
    v = row_sum16(v); v += shx16(v, lane); v += shx32(v, lane);
#else
#pragma unroll
    for (int o = 1; o < 64; o <<= 1) v += SHX(v, o, lane);
#endif
    return v;
}
DI unsigned cvtpk(float lo, float hi) { f32x2 v = {lo, hi}; bf16x2_t b = __builtin_convertvector(v, bf16x2_t); return __builtin_bit_cast(unsigned, b); }
DI float bflo(unsigned w) { return __uint_as_float(w << 16); }
DI float bfhi(unsigned w) { return __uint_as_float(w & 0xffff0000u); }
DI void unpack8(const u32x4 w, float (&f)[8]) { f[0] = bflo(w.x); f[1] = bfhi(w.x); f[2] = bflo(w.y); f[3] = bfhi(w.y); f[4] = bflo(w.z); f[5] = bfhi(w.z); f[6] = bflo(w.w); f[7] = bfhi(w.w); }
DI u32x4 pack8(const float (&f)[8]) { u32x4 w; w.x = cvtpk(f[0], f[1]); w.y = cvtpk(f[2], f[3]); w.z = cvtpk(f[4], f[5]); w.w = cvtpk(f[6], f[7]); return w; }
DI float sat8(float x) { return __builtin_amdgcn_fmed3f(x, -448.f, 448.f); }
DI unsigned cvt4_fp8(float a, float b, float c, float d) { int w = __builtin_amdgcn_cvt_pk_fp8_f32(sat8(a), sat8(b), 0, false); w = __builtin_amdgcn_cvt_pk_fp8_f32(sat8(c), sat8(d), w, true); return (unsigned)w; }
DI unsigned pack4_u8(float a, float b, float c, float d) {
    const unsigned q0 = (unsigned)(a * 255.f + 0.5f), q1 = (unsigned)(b * 255.f + 0.5f), q2 = (unsigned)(c * 255.f + 0.5f), q3 = (unsigned)(d * 255.f + 0.5f); return q0 | (q1 << 8) | (q2 << 16) | (q3 << 24); }
DI float fexp2(float x) { return __builtin_amdgcn_exp2f(x); }
DI float frcp(float x) { return __builtin_amdgcn_rcpf(x); }
DI float sigmoid_f(float x) { return frcp(1.f + fexp2(-1.44269504f * x)); }
DI int lane_id() { int l; asm volatile("v_mbcnt_lo_u32_b32 %0, -1, 0\n\tv_mbcnt_hi_u32_b32 %0, -1, %0" : "=v"(l)); return l; }
DI int crow(int reg, int h) { return (reg & 3) + 8 * (reg >> 2) + 4 * h; }
#define MFMA32(a, b, c) __builtin_amdgcn_mfma_f32_32x32x16_bf16((a), (b), (c), 0, 0, 0)

__device__ const float INV_FREQ[32] = {1.0f, 0.7498942017555237f, 0.5623413324356079f, 0.4216965138912201f, 0.3162277638912201f, 0.23713737726211548f, 0.17782793939113617f, 0.1333521455526352f,
    0.10000000149011612f, 0.0749894231557846f, 0.05623413249850273f, 0.04216964915394783f, 0.03162277489900589f, 0.023713737726211548f, 0.017782794311642647f, 0.013335213996469975f,
    0.009999999776482582f, 0.007498942315578461f, 0.005623413249850273f, 0.0042169648222625256f, 0.003162277629598975f, 0.0023713738191872835f, 0.0017782794311642647f, 0.0013335214462131262f,
    0.0010000000474974513f, 0.0007498941849917173f, 0.000562341301701963f, 0.0004216965171508491f, 0.0003162277571391314f, 0.00023713737027719617f, 0.00017782794020604342f, 0.0001333521504420787f};

namespace pg8 {
constexpr int BM = 256, BK = 64, HALF = 128, HTB = HALF * BK * 2, STAGE_BYTES = 8 * HTB, NXCD = 8, WGM = 8;
__host__ __device__ __forceinline__ int lds_byte(int r, int c) { const int st = (r >> 4) * 2 + (c >> 5), rr = r & 15, cc = c & 31, ob = rr * 64 + cc * 2; return st * 1024 + (ob ^ (((ob >> 9) & 1) << 5)); }
__host__ __device__ __forceinline__ void stage_rc(int b, int& R, int& C) { const int st = b / 1024, sb = b % 1024, swz = sb ^ (((sb >> 9) & 1) << 5); R = (st >> 1) * 16 + swz / 64; C = (st & 1) * 32 + (swz % 64) / 2; }
__host__ __device__ __forceinline__ int perm32(int rho) { const int n = rho >> 4, i = rho & 15; return 8 * (i >> 2) + 4 * n + (i & 3); }

struct Unit { int pm, pn, z; const char* a; const char* b; };
DI const char* uni(const char* p) { const unsigned long long v = (unsigned long long)p; const unsigned lo = __builtin_amdgcn_readfirstlane((unsigned)v), hi = __builtin_amdgcn_readfirstlane((unsigned)(v >> 32)); return (const char*)(((unsigned long long)hi << 32) | lo); }

struct TileOrder {
    int nM, nN, nwg, G, c;
    DI void init(int nM_, int nN_, int G_, int c_) { nM = nM_; nN = nN_; nwg = nM * nN; G = G_; c = c_; }
    DI bool tile(int i, int& pm, int& pn) const {
        const long L = (long)i * G + c; if (L >= nwg) return false;
        int wgid = (int)L; { const int q = nwg / NXCD, r = nwg % NXCD, xcd = wgid % NXCD, off = wgid / NXCD; wgid = (xcd < r ? xcd * (q + 1) : r * (q + 1) + (xcd - r) * q) + off; }
        const int nig = WGM * nN, gid = wgid / nig, fm = gid * WGM, gsz = (nM - fm) < WGM ? (nM - fm) : WGM;
        pm = fm + ((wgid % nig) % gsz); pn = (wgid % nig) / gsz; return true;
    }
};

template <class E, class = void> struct epi_ktop_t { static constexpr bool value = false; };
template <class E> struct epi_ktop_t<E, decltype((void)E::KTOP)> { static constexpr bool value = E::KTOP; };
template <class E> constexpr bool epi_ktop() { return epi_ktop_t<E>::value; }
template <class Epi, class Sched, bool F8 = false, bool HN = false>
DI void gemm_phase(LAS unsigned char* lds, const int K, const int lda, const Sched& S, const Epi& E, const int wid_in, const int kext = 0) {
    int wid = wid_in; asm volatile("" : "+s"(wid));
    int lane = lane_id(); asm volatile("" : "+v"(lane));
    const int tid = wid * 64 + lane, wr = wid >> 2, wc = wid & 3, fr = lane & 15, fq = lane >> 4;
    constexpr int ESZ = F8 ? 1 : 2; const int nt = ((kext ? kext : K) * ESZ) / (BK * 2);
    unsigned voffA, voffB;
    { int R, C; stage_rc(tid * 16, R, C); const int Rb = Epi::PERM ? ((R & ~31) + perm32(R & 31)) : R;
      voffA = (unsigned)(R * lda * ESZ + C * 2); voffB = (unsigned)(Rb * K * ESZ + C * 2); }
    unsigned voffA2 = voffA + (unsigned)(64 * lda * ESZ), voffB2 = voffB + (unsigned)(64 * K * ESZ);
    const size_t kstep = (size_t)(BK * 2);
    const size_t hstepA = (size_t)HALF * lda * ESZ, hstepB = (size_t)HALF * K * ESZ;
    const unsigned ldsw = (unsigned)wid * 1024u;
    constexpr int PIECE = F8 ? 16 : 1024;
    const int aoff = lds_byte(wr * 64 + fr, F8 ? fq * 16 : fq * 8) + ((F8 && (fq & 1)) ? 16 : 0), boff = lds_byte(wc * 32 + fr, F8 ? fq * 16 : fq * 8) + ((F8 && (fq & 1)) ? 16 : 0);
    const int aoffx = aoff ^ 16, boffx = boff ^ 16;
#define PG8_SA(b, h) (((b) * 2 + (h)) * HTB)
#define PG8_SB(b, h) ((4 + (b) * 2 + (h)) * HTB)
#define PG8_STAGE(bufoff, gbase, voff) do { asm volatile("" : "+v"(voff), "+v"(voff##2));     \
        __builtin_amdgcn_global_load_lds((const GAS unsigned*)((const GAS char*)(gbase) + voff), (LAS unsigned*)(lds + (bufoff) + ldsw), 16, 0, 0); \
        __builtin_amdgcn_global_load_lds((const GAS unsigned*)((const GAS char*)(gbase) + voff##2), (LAS unsigned*)(lds + (bufoff) + ldsw + 8192), 16, 0, 0); } while (0)
#define PG8_LD16(off) (*(const LAS u32x4*)(lds + (off)))
#define PG8_LD16B(off) (*(const LAS u32x4*)(ldsB + (off)))
#define PG8_LD16BX(off) (*(const LAS u32x4*)(ldsBx + (off)))
#define PG8_SBR(b, h) (((b) * 2 + (h)) * HTB)
#define PG8_LDA(dst, b, h) do { _Pragma("unroll") for (int m = 0; m < 4; ++m) { if constexpr (F8) dst##8[m] = __builtin_bit_cast(i32x8, __builtin_shufflevector(PG8_LD16(PG8_SA(b, h) + aoff + m * 2048), PG8_LD16(PG8_SA(b, h) + aoffx + m * 2048), 0, 1, 2, 3, 4, 5, 6, 7)); \
        else { _Pragma("unroll") for (int k = 0; k < 2; ++k) dst[m][k] = *(const LAS bf16x8*)(lds + PG8_SA(b, h) + aoff + k * PIECE + m * 2048); } } } while (0)
#define PG8_LDB(dst, b, h) do { _Pragma("unroll") for (int n = 0; n < 2; ++n) { if constexpr (F8) dst##8[n] = __builtin_bit_cast(i32x8, __builtin_shufflevector(PG8_LD16B(PG8_SBR(b, h) + n * 2048), PG8_LD16BX(PG8_SBR(b, h) + n * 2048), 0, 1, 2, 3, 4, 5, 6, 7)); \
        else { _Pragma("unroll") for (int k = 0; k < 2; ++k) dst[n][k] = *(const LAS bf16x8*)(ldsB + PG8_SBR(b, h) + k * PIECE + n * 2048); } } } while (0)
#define PG8_MMA(ai, bj, At, Bt) do { if constexpr (HN && (bj) == 1) break; _Pragma("unroll") for (int m = 0; m < 4; ++m) _Pragma("unroll") for (int n = 0; n < 2; ++n) { \
        if constexpr (F8) acc[ai][bj][m][n] = __builtin_amdgcn_mfma_scale_f32_16x16x128_f8f6f4(Bt##8[n], At##8[m], acc[ai][bj][m][n], 0, 0, 0, 0, 0, 0);     \
        else { _Pragma("unroll") for (int k = 0; k < 2; ++k) acc[ai][bj][m][n] = __builtin_amdgcn_mfma_f32_16x16x32_bf16(Bt[n][k], At[m][k], acc[ai][bj][m][n], 0, 0, 0); } } } while (0)
#define PG8_WAIT_V(n) asm volatile("s_waitcnt vmcnt(" #n ")" ::: "memory")
#define PG8_WAIT_L(n) asm volatile("s_waitcnt lgkmcnt(" #n ")" ::: "memory")
#define PG8_BAR __builtin_amdgcn_s_barrier()
#define PG8_SCHED __builtin_amdgcn_sched_barrier(0)
    const LAS unsigned char* ldsB = lds + 4 * HTB + boff; const LAS unsigned char* ldsBx = lds + 4 * HTB + boffx; (void)ldsBx; (void)aoffx;
    Unit cur, nxt; int ui = 0;
    if (!S.next(0, cur)) return;
    typename Epi::State est;
    if constexpr (Epi::PRE) { int le = lane_id(); asm volatile("" : "+v"(le)); E.pre(est, cur, 0, wr, wc, le & 15, le >> 4); }
    f32x4 acc[2][2][4][2];
#pragma unroll
    for (int a = 0; a < 2; ++a)
#pragma unroll
        for (int b = 0; b < 2; ++b)
#pragma unroll
            for (int m = 0; m < 4; ++m)
#pragma unroll
                for (int n = 0; n < 2; ++n) acc[a][b][m][n] = (f32x4){0.f, 0.f, 0.f, 0.f};
    bf16x8 At[4][2], B0[2][2], B1[2][2]; i32x8 At8[4], B08[2], B18[2];
    const char* cA = cur.a; const char* cB = cur.b;
#define PG8_WAIT_K() do { if constexpr (HN) PG8_WAIT_V(6); else PG8_WAIT_V(8); } while (0)
    PG8_STAGE(PG8_SB(0, 0), cB, voffB); if constexpr (!HN) PG8_STAGE(PG8_SB(0, 1), cB + hstepB, voffB); PG8_STAGE(PG8_SA(0, 0), cA, voffA); PG8_STAGE(PG8_SA(0, 1), cA + hstepA, voffA);
    if (wr == 1) PG8_BAR;
    PG8_WAIT_V(2); PG8_BAR;
    PG8_STAGE(PG8_SB(1, 0), cB + kstep, voffB); PG8_STAGE(PG8_SA(1, 0), cA + kstep, voffA); if constexpr (!HN) PG8_STAGE(PG8_SB(1, 1), cB + hstepB + kstep, voffB);
    if constexpr (HN) PG8_WAIT_V(4); else PG8_WAIT_V(6);
    PG8_BAR;
    for (;;) {
        const bool has_next = S.next(ui + 1, nxt);
        const char* nA = has_next ? nxt.a : cA; const char* nB = has_next ? nxt.b : cB;
#pragma nounroll
        for (int t = 0; t < nt; t += 2) {
            const bool last = (t == nt - 2);
            if constexpr (epi_ktop<Epi>()) { if (F8 || (t & 3) == 2) { int le = lane_id(); asm volatile("" : "+v"(le)); E.ktop(est, cur, F8 ? (t >> 1) : (t >> 2), wr, wc, le & 15, le >> 4); } }
            const char* a1 = cA + (size_t)(t + 1) * kstep;
            const char* a2 = last ? nA : cA + (size_t)(t + 2) * kstep; const char* b2 = last ? nB : cB + (size_t)(t + 2) * kstep;
            asm volatile("" : "+s"(a1), "+s"(a2), "+s"(b2));
            const char* a3 = a2 + kstep; const char* b3 = b2 + kstep;
            PG8_LDB(B0, 0, 0); if constexpr (!HN) PG8_LDB(B1, 0, 1); PG8_SCHED; PG8_LDA(At, 0, 0); PG8_STAGE(PG8_SA(1, 1), a1 + hstepA, voffA);
            PG8_WAIT_K(); PG8_WAIT_L(0); PG8_BAR; __builtin_amdgcn_s_setprio(1); PG8_MMA(0, 0, At, B0); PG8_MMA(0, 1, At, B1); __builtin_amdgcn_s_setprio(0); PG8_BAR; PG8_SCHED;
            PG8_LDA(At, 0, 1); PG8_STAGE(PG8_SB(0, 0), b2, voffB); if constexpr (!HN) PG8_STAGE(PG8_SB(0, 1), b2 + hstepB, voffB); PG8_STAGE(PG8_SA(0, 0), a2, voffA);
            PG8_WAIT_K(); PG8_WAIT_L(0); PG8_BAR; __builtin_amdgcn_s_setprio(1); PG8_MMA(1, 0, At, B0); PG8_MMA(1, 1, At, B1); __builtin_amdgcn_s_setprio(0); PG8_BAR; PG8_SCHED;
            PG8_LDB(B0, 1, 0); if constexpr (!HN) PG8_LDB(B1, 1, 1); PG8_SCHED; PG8_LDA(At, 1, 0); PG8_STAGE(PG8_SA(0, 1), a2 + hstepA, voffA);
            PG8_WAIT_K(); PG8_WAIT_L(0); PG8_BAR; __builtin_amdgcn_s_setprio(1); PG8_MMA(0, 0, At, B0); PG8_MMA(0, 1, At, B1); __builtin_amdgcn_s_setprio(0); PG8_BAR; PG8_SCHED;
            PG8_LDA(At, 1, 1); PG8_STAGE(PG8_SB(1, 0), b3, voffB); if constexpr (!HN) PG8_STAGE(PG8_SB(1, 1), b3 + hstepB, voffB); PG8_STAGE(PG8_SA(1, 0), a3, voffA);
            PG8_WAIT_K(); PG8_WAIT_L(0); PG8_BAR; __builtin_amdgcn_s_setprio(1); PG8_MMA(1, 0, At, B0); PG8_MMA(1, 1, At, B1); __builtin_amdgcn_s_setprio(0); PG8_BAR; PG8_SCHED;
            if constexpr (Epi::KHOOK) { if ((F8 || (t & 3) == 2) && !last) { int le = lane_id(); asm volatile("" : "+v"(le)); E.khook(acc, cur, F8 ? (t >> 1) : (t >> 2), wr, wc, le & 15, le >> 4, est); } }
        }
        if (wr == 0) PG8_BAR;
        { int le = lane_id(); asm volatile("" : "+v"(le));
          if constexpr (Epi::PRE) { E(acc, cur, wr, wc, le & 15, le >> 4, est); if (has_next) E.pre(est, nxt, 0, wr, wc, le & 15, le >> 4); }
          else if constexpr (epi_ktop<Epi>()) E(acc, cur, wr, wc, le & 15, le >> 4, est);
          else E(acc, cur, wr, wc, le & 15, le >> 4); }
        if (!has_next) break;
#pragma unroll
        for (int a = 0; a < 2; ++a)
#pragma unroll
            for (int b = 0; b < (HN ? 1 : 2); ++b)
#pragma unroll
                for (int m = 0; m < 4; ++m)
#pragma unroll
                    for (int n = 0; n < 2; ++n) acc[a][b][m][n] = (f32x4){0.f, 0.f, 0.f, 0.f};
        cur = nxt; cA = nA; cB = nB; ++ui;
        if (wr == 1) PG8_BAR;
    }
    PG8_WAIT_V(0);
    PG8_BAR;
#undef PG8_SA
#undef PG8_SB
#undef PG8_STAGE
#undef PG8_LDA
#undef PG8_LDB
#undef PG8_MMA
#undef PG8_LD16
#undef PG8_LD16B
#undef PG8_LD16BX
#undef PG8_SBR
#undef PG8_WAIT_V
#undef PG8_WAIT_K
#undef PG8_WAIT_L
#undef PG8_BAR
#undef PG8_SCHED
}

struct OrdStd {
    TileOrder to; const char* A; const char* B; size_t atile, btile; int i0 = 0, ni = 1 << 30;
    DI bool next(int i, Unit& u) const { if (i >= ni || !to.tile(i + i0, u.pm, u.pn)) return false; u.z = 0; u.a = A + (size_t)u.pm * atile; u.b = B + (size_t)u.pn * btile; return true; }
};
struct OrdQ {
    TileOrder to; const char* A; const char* B;
    DI bool next(int i, Unit& u) const { if (!to.tile(i, u.pm, u.pn)) return false; u.z = 0; u.a = A + (size_t)u.pm * (256 * D * 2) + (size_t)u.pn * 1024; u.b = B + (size_t)u.pn * 1024; return true; }
};
struct OrdKV {
    TileOrder to; const char* A; const char* B;
    DI bool next(int i, Unit& u) const { if (!to.tile(i, u.pm, u.pn)) return false; const int l = u.pm >> 4; u.z = l; u.a = A + (size_t)u.pm * (256 * 1024 * 2); u.b = B + (size_t)l * (512 * 1024 * 2) + (size_t)u.pn * (256 * 1024 * 2); return true; }
};
struct OrdMerge {
    int G, c, ntiles; const char* A; const char* B; int esz;
    DI bool next(int i, Unit& u) const { const int NV = (G & 7) ? 1 : 8, v = c % NV, r = c / NV, per = G / NV, ntl = ntiles / NV; const int tq = i * per + r; if (tq >= ntl) return false; const int tl = v * ntl + tq; u.z = 0; u.pm = tl >> 3; u.pn = tl & 7;
        u.a = A + (size_t)u.pm * (256 * 1024) * esz; u.b = B + (size_t)u.pn * (128 * 1024) * esz; return true; }
};
struct OrdMoe {
    TileOrder to; const char* A; const char* B; size_t atile, btile, bexp; int off[9]; int pm0 = 0; size_t koff = 0;
    DI bool next(int i, Unit& u) const { if (!to.tile(i, u.pm, u.pn)) return false; u.pm += pm0; const int r0 = u.pm * 256; int e = 0;
#pragma unroll
        for (int k = 1; k < 8; ++k) e += (r0 >= off[k]) ? 1 : 0;
        u.z = e; u.a = uni(A + (size_t)u.pm * atile + koff); u.b = uni(B + (size_t)e * bexp + (size_t)u.pn * btile + koff); return true; }
};

DI float row_rstd(const float* ssq, size_t row, int fq, int lane) {
    const f32x4 a = *(const f32x4*)(ssq + row * 16 + 4 * fq); float s = (a.x + a.y) + (a.z + a.w); s += shx16(s, lane); s += shx32(s, lane); return __builtin_amdgcn_rsqf(s * (1.f / D) + EPS); }
DI u32x4 pair16(u32x2 a, u32x2 b) {
    asm volatile("s_nop 1\n\tv_permlane16_swap_b32 %0, %1\n\ts_nop 1" : "+v"(a.x), "+v"(b.x));
    asm volatile("s_nop 1\n\tv_permlane16_swap_b32 %0, %1\n\ts_nop 1" : "+v"(a.y), "+v"(b.y));
    return (u32x4){a.x, a.y, b.x, b.y};
}
DI void rows_rstd(float (&rs)[2][4], const float* ssq, int row0, int fq, int lane, float mul) {
    f32x4 a[2][4];
#pragma unroll
    for (int ai = 0; ai < 2; ++ai)
#pragma unroll
        for (int m = 0; m < 4; ++m) a[ai][m] = *(const f32x4*)(ssq + (size_t)(row0 + ai * HALF + m * 16) * 16 + 4 * fq);
#pragma unroll
    for (int ai = 0; ai < 2; ++ai)
#pragma unroll
        for (int m = 0; m < 4; ++m) { float s = (a[ai][m].x + a[ai][m].y) + (a[ai][m].z + a[ai][m].w); s += shx16(s, lane); s += shx32(s, lane); rs[ai][m] = __builtin_amdgcn_rsqf(s * (1.f / D) + EPS) * mul; }
}
DI unsigned pack4_lowbytes(float a, float b, float c, float d) {
    const unsigned ab = __builtin_amdgcn_perm(__float_as_uint(b), __float_as_uint(a), 0x0c0c0400u), cd = __builtin_amdgcn_perm(__float_as_uint(d), __float_as_uint(c), 0x04000c0cu); return ab | cd; }
template <bool G8, bool S8 = false> struct EpiCat {
    static constexpr bool PERM = true; static constexpr bool PRE = false; static constexpr bool KHOOK = false; struct State {};
    bf16* U; bf16* Gt; const float* ssq;
    DI void operator()(const f32x4 (&acc)[2][2][4][2], const Unit& u, int wr, int wc, int fr, int fq) const {
        const bool isg = G8 || u.pn >= 10; bf16* base = isg ? Gt : U; const int ldc = isg ? 4096 : DIN; const int colt = G8 ? u.pn * 256 : (isg ? (u.pn - 10) * 256 : u.pn * 256);
        const int row0 = u.pm * BM + wr * 64 + fr, col0 = colt + wc * 32 + 8 * fq;
        if constexpr (G8) {
            unsigned char* g8 = (unsigned char*)Gt; float rsv[2][4]; rows_rstd(rsv, ssq, row0, fq, fr + 16 * fq, -1.44269504f * W8_INV);
#define G8Q(x) (frcp(__builtin_fmaf(fexp2((x) * rs), 1.f / 255.f, 1.f / 255.f)) + 12582912.f)
            const int colp = colt + wc * 32 + 16 * (fq >> 1);
#pragma unroll
            for (int ai = 0; ai < 2; ++ai)
#pragma unroll
                for (int mp = 0; mp < 2; ++mp) { const size_t row = (size_t)(row0 + ai * HALF + (2 * mp + (fq & 1)) * 16);
#pragma unroll
                    for (int bj = 0; bj < 2; ++bj) { u32x2 w[2];
#pragma unroll
                        for (int k = 0; k < 2; ++k) { const int m = 2 * mp + k; const float rs = rsv[ai][m]; const f32x4 v0 = acc[ai][bj][m][0], v1 = acc[ai][bj][m][1];
                            w[k].x = pack4_lowbytes(G8Q(v0[0]), G8Q(v0[1]), G8Q(v0[2]), G8Q(v0[3])); w[k].y = pack4_lowbytes(G8Q(v1[0]), G8Q(v1[1]), G8Q(v1[2]), G8Q(v1[3])); }
                        *(u32x4*)(g8 + row * 4096 + colp + bj * HALF) = pair16(w[0], w[1]); } }
#undef G8Q
            return; }
        float rsv[2][4]; rows_rstd(rsv, ssq, row0, fq, fr + 16 * fq, (G8 || S8) ? W8_INV : 1.f);
#pragma unroll
        for (int ai = 0; ai < 2; ++ai)
#pragma unroll
            for (int m = 0; m < 4; ++m) { const size_t row = (size_t)(row0 + ai * HALF + m * 16); bf16* rowp = base + row * ldc + col0; const float rs = rsv[ai][m];
#pragma unroll
                for (int bj = 0; bj < 2; ++bj) { f32x4 v0 = acc[ai][bj][m][0] * rs, v1 = acc[ai][bj][m][1] * rs;
                    if (isg) {
#pragma unroll
                        for (int j = 0; j < 4; ++j) { v0[j] = sigmoid_f(v0[j]); v1[j] = sigmoid_f(v1[j]); } }
                    u32x4 w; w.x = cvtpk(v0[0], v0[1]); w.y = cvtpk(v0[2], v0[3]); w.z = cvtpk(v1[0], v1[1]); w.w = cvtpk(v1[2], v1[3]);
                    *(u32x4*)(rowp + bj * HALF) = w; } }
    }
};
template <bool S8> struct EpiBf16 {
    static constexpr bool PERM = true; static constexpr bool PRE = false; static constexpr bool KHOOK = false; struct State {}; static constexpr float sc = S8 ? W8_INV : 1.f;
    bf16* O; int ldc; const float* ssq;
    DI void operator()(const f32x4 (&acc)[2][2][4][2], const Unit& u, int wr, int wc, int fr, int fq) const {
        const int row0 = u.pm * BM + wr * 64 + fr, col0 = u.pn * BM + wc * 32 + 8 * fq;
        float rsv[2][4];
        if (ssq) rows_rstd(rsv, ssq, row0, fq, fr + 16 * fq, sc);
#pragma unroll
        for (int ai = 0; ai < 2; ++ai)
#pragma unroll
            for (int m = 0; m < 4; ++m) { const size_t row = (size_t)(row0 + ai * HALF + m * 16); bf16* rowp = O + row * ldc + col0; const float s2 = ssq ? rsv[ai][m] : sc;
#pragma unroll
                for (int bj = 0; bj < 2; ++bj) { const f32x4 v0 = acc[ai][bj][m][0] * s2, v1 = acc[ai][bj][m][1] * s2;
                    u32x4 w; w.x = cvtpk(v0[0], v0[1]); w.y = cvtpk(v0[2], v0[3]); w.z = cvtpk(v1[0], v1[1]); w.w = cvtpk(v1[2], v1[3]);
                    *(u32x4*)(rowp + bj * HALF) = w; } }
    }
};
struct EpiMerge {
    static constexpr bool PERM = true; static constexpr bool PRE = false; static constexpr bool KHOOK = true; static constexpr bool KTOP = GATE_FP8 != 0; struct State { u32x2 gw[2][4]; u32x4 gb[2][4]; };
    const bf16* Gt; bf16* Mg; int m8; float ksc;
    DI void ktop(State& st, const Unit& u, int z, int wr, int wc, int fr, int fq) const {
        const int row0 = u.pm * BM + wr * 64 + fr, col0 = u.pn * HALF + wc * 32 + 8 * fq;
#pragma unroll
        for (int ai = 0; ai < 2; ++ai)
#pragma unroll
            for (int m = 0; m < 4; ++m) { const unsigned char* p = (const unsigned char*)Gt + (size_t)(row0 + ai * HALF + m * 16) * 4096 + z * 1024 + col0;
                asm volatile("global_load_dwordx2 %0, %1, off" : "=v"(st.gw[ai][m]) : "v"(p) : "memory"); }
    }
    DI void pre(State& st, const Unit& u, int z, int wr, int wc, int fr, int fq) const {
        const int row0 = u.pm * BM + wr * 64 + fr, col0 = u.pn * HALF + wc * 32 + 8 * fq;
#pragma unroll
        for (int ai = 0; ai < 2; ++ai)
#pragma unroll
            for (int m = 0; m < 4; ++m) { if (GATE_FP8) st.gw[ai][m] = *(const u32x2*)((const unsigned char*)Gt + (size_t)(row0 + ai * HALF + m * 16) * 4096 + z * 1024 + col0);
                else st.gb[ai][m] = *(const u32x4*)(Gt + (size_t)(row0 + ai * HALF + m * 16) * 4096 + z * 1024 + col0); }
    }
    template <bool FIRST, bool LAST> DI void gate(f32x4 (&acc)[2][2][4][2], const Unit& u, int wr, int wc, int fr, int fq, State& st) const {
        const int row0 = u.pm * BM + wr * 64 + fr, col0 = u.pn * HALF + wc * 32 + 8 * fq;
        u32x2 mw[2][4];
#pragma unroll
        for (int ai = 0; ai < 2; ++ai)
#pragma unroll
            for (int m = 0; m < 4; ++m) { float g[8];
                if (GATE_FP8) { const unsigned a = st.gw[ai][m].x, b = st.gw[ai][m].y;
                    g[0] = (float)(a & 0xffu); g[1] = (float)((a >> 8) & 0xffu); g[2] = (float)((a >> 16) & 0xffu); g[3] = (float)(a >> 24);
                    g[4] = (float)(b & 0xffu); g[5] = (float)((b >> 8) & 0xffu); g[6] = (float)((b >> 16) & 0xffu); g[7] = (float)(b >> 24); }
                else unpack8(st.gb[ai][m], g);
                const f32x4 v0 = acc[ai][0][m][0], v1 = acc[ai][0][m][1];
                f32x4 t0, t1;
                if (FIRST) { t0 = (f32x4){g[0] * v0[0], g[1] * v0[1], g[2] * v0[2], g[3] * v0[3]}; t1 = (f32x4){g[4] * v1[0], g[5] * v1[1], g[6] * v1[2], g[7] * v1[3]}; }
                else { const f32x4 r0 = acc[ai][1][m][0], r1 = acc[ai][1][m][1];
                    t0 = (f32x4){__builtin_fmaf(g[0], v0[0], r0[0]), __builtin_fmaf(g[1], v0[1], r0[1]), __builtin_fmaf(g[2], v0[2], r0[2]), __builtin_fmaf(g[3], v0[3], r0[3])};
                    t1 = (f32x4){__builtin_fmaf(g[4], v1[0], r1[0]), __builtin_fmaf(g[5], v1[1], r1[1]), __builtin_fmaf(g[6], v1[2], r1[2]), __builtin_fmaf(g[7], v1[3], r1[3])}; }
                acc[ai][1][m][0] = t0; acc[ai][1][m][1] = t1; acc[ai][0][m][0] = (f32x4){0.f, 0.f, 0.f, 0.f}; acc[ai][0][m][1] = (f32x4){0.f, 0.f, 0.f, 0.f};
                if (LAST && GATE_FP8) { t0 *= ksc; t1 *= ksc; }
                if (LAST) { if (m8) { mw[ai][m].x = cvt4_fp8(t0[0] * 4.f, t0[1] * 4.f, t0[2] * 4.f, t0[3] * 4.f); mw[ai][m].y = cvt4_fp8(t1[0] * 4.f, t1[1] * 4.f, t1[2] * 4.f, t1[3] * 4.f); }
                    else { u32x4 w; w.x = cvtpk(t0[0], t0[1]); w.y = cvtpk(t0[2], t0[3]); w.z = cvtpk(t1[0], t1[1]); w.w = cvtpk(t1[2], t1[3]);
                        *(u32x4*)(Mg + (size_t)(row0 + ai * HALF + m * 16) * 1024 + col0) = w; } } }
        if (LAST) { if (m8) {
#pragma unroll
            for (int ai = 0; ai < 2; ++ai)
#pragma unroll
                for (int mp = 0; mp < 2; ++mp) *(u32x4*)((unsigned char*)Mg + (size_t)(row0 + ai * HALF + (2 * mp + (fq & 1)) * 16) * 1024 + u.pn * HALF + wc * 32 + 16 * (fq >> 1)) = pair16(mw[ai][2 * mp], mw[ai][2 * mp + 1]); } }
    }
    DI void khook(f32x4 (&acc)[2][2][4][2], const Unit& u, int z, int wr, int wc, int fr, int fq, State& st) const {
        if (z == 0) gate<true, false>(acc, u, wr, wc, fr, fq, st); else gate<false, false>(acc, u, wr, wc, fr, fq, st);
        if (!KTOP) pre(st, u, z + 1, wr, wc, fr, fq);
    }
    DI void operator()(f32x4 (&acc)[2][2][4][2], const Unit& u, int wr, int wc, int fr, int fq, State& st) const { gate<false, true>(acc, u, wr, wc, fr, fq, st); }
};
template <bool XB, bool S8, int ASH = 0> struct EpiRes {
    static constexpr bool PERM = true; static constexpr bool PRE = false; static constexpr bool KHOOK = false; struct State {};
    static constexpr float sc = (S8 ? W8_INV : 1.f) / (float)(1 << ASH);
    bf16* xres; int xbm; float* ssq; unsigned char* xb8;
    DI void operator()(const f32x4 (&acc)[2][2][4][2], const Unit& u, int wr, int wc, int fr, int fq) const {
        const int row0 = u.pm * BM + wr * 64 + fr, col0 = u.pn * BM + wc * 32 + 8 * fq, lane = fr + 16 * fq;
#pragma unroll
        for (int ai = 0; ai < 2; ++ai) {
            u32x4 bsv[4][2];
#pragma unroll
            for (int m = 0; m < 4; ++m)
#pragma unroll
                for (int bj = 0; bj < 2; ++bj) bsv[m][bj] = *(const u32x4*)(xres + (size_t)(row0 + ai * HALF + m * 16) * D + col0 + bj * HALF);
            u32x2 c8[4][2];
#pragma unroll
            for (int m = 0; m < 4; ++m) { const size_t row = (size_t)(row0 + ai * HALF + m * 16), off = row * D + col0; float s = 0.f;
#pragma unroll
                for (int bj = 0; bj < 2; ++bj) { float b[8]; unpack8(bsv[m][bj], b);
                    const f32x4 v0 = (f32x4){b[0], b[1], b[2], b[3]} + acc[ai][bj][m][0] * sc, v1 = (f32x4){b[4], b[5], b[6], b[7]} + acc[ai][bj][m][1] * sc;
                    u32x4 w; w.x = cvtpk(v0.x, v0.y); w.y = cvtpk(v0.z, v0.w); w.z = cvtpk(v1.x, v1.y); w.w = cvtpk(v1.z, v1.w); *(u32x4*)(xres + off + bj * HALF) = w;
                    s += ((v0.x * v0.x + v0.y * v0.y) + (v0.z * v0.z + v0.w * v0.w)) + ((v1.x * v1.x + v1.y * v1.y) + (v1.z * v1.z + v1.w * v1.w));
                    if (xbm & 2) { c8[m][bj].x = cvt4_fp8(v0.x, v0.y, v0.z, v0.w); c8[m][bj].y = cvt4_fp8(v1.x, v1.y, v1.z, v1.w); } }
                s += shx16(s, lane); s += shx32(s, lane); if (fq == 0) ssq[row * 16 + u.pn * 4 + wc] = s; }
            if (xbm & 2) {
#pragma unroll
                for (int mp = 0; mp < 2; ++mp) { const size_t row = (size_t)(row0 + ai * HALF + (2 * mp + (fq & 1)) * 16);
#pragma unroll
                    for (int bj = 0; bj < 2; ++bj) *(u32x4*)(xb8 + row * D + u.pn * BM + wc * 32 + 16 * (fq >> 1) + bj * HALF) = pair16(c8[2 * mp][bj], c8[2 * mp + 1][bj]); } }
            asm volatile("" ::: "memory"); }
    }
};
template <bool F8O, bool RS = true> struct EpiGU {
    static constexpr bool PERM = true; static constexpr bool PRE = false; static constexpr bool KHOOK = false; struct State {};
    static constexpr float sc = F8O ? W8_INV : 1.f;
    void* O; const float* ssq;
    DI void operator()(const f32x4 (&acc)[2][2][4][2], const Unit& u, int wr, int wc, int fr, int fq) const {
        const int row0 = u.pm * BM + wr * 64 + fr, col0 = u.pn * HALF + wc * 32 + 8 * fq;
        float rsv[2][4];
        if (ssq) rows_rstd(rsv, ssq, row0, fq, fr + 16 * fq, sc);
#pragma unroll
        for (int ai = 0; ai < 2; ++ai) { u32x2 w8[4];
#pragma unroll
            for (int m = 0; m < 4; ++m) { const size_t row = (size_t)(row0 + ai * HALF + m * 16), eo = row * DFF + col0; const float s2 = ssq ? rsv[ai][m] : sc;
                float r[8];
#pragma unroll
                for (int n = 0; n < 2; ++n)
#pragma unroll
                    for (int j = 0; j < 4; ++j) {
                        if constexpr (RS) { const float g = acc[ai][0][m][n][j] * s2, uu = acc[ai][1][m][n][j] * s2; r[4 * n + j] = g * sigmoid_f(g) * uu; }
                        else { const float a = acc[ai][0][m][n][j], b = acc[ai][1][m][n][j]; r[4 * n + j] = (a * b) * frcp(1.f + fexp2(a * (-1.44269504f * sc))) * (sc * sc); } }
                if constexpr (F8O) { w8[m].x = cvt4_fp8(r[0], r[1], r[2], r[3]); w8[m].y = cvt4_fp8(r[4], r[5], r[6], r[7]); }
                else *(u32x4*)((bf16*)O + eo) = pack8(r); }
            if constexpr (F8O) {
#pragma unroll
                for (int mp = 0; mp < 2; ++mp) { const size_t row = (size_t)(row0 + ai * HALF + (2 * mp + (fq & 1)) * 16);
                    *(u32x4*)((unsigned char*)O + row * DFF + u.pn * HALF + wc * 32 + 16 * (fq >> 1)) = pair16(w8[2 * mp], w8[2 * mp + 1]); } } }
    }
};
}

#define XB_TMO      128
#define XB_XCNT(j)  (256  + 64 * (j))
#define XB_XSUB(j)  (1280 + 64 * (j))
#define XB_XGEN(j)  (2304 + 64 * (j))
#define XB_TOP      3328
#define XB_TOPGEN   3392
#define XCD_BAR_WORDS 3456
#define XB_SPIN_CAP (1u << 22)
DI unsigned xb_ld(unsigned* p)              { return __hip_atomic_load(p, __ATOMIC_RELAXED, __HIP_MEMORY_SCOPE_AGENT); }
DI unsigned xb_add(unsigned* p, unsigned v) { return __hip_atomic_fetch_add(p, v, __ATOMIC_RELAXED, __HIP_MEMORY_SCOPE_AGENT); }
DI unsigned xb_xcc_id() { return (unsigned)__builtin_amdgcn_s_getreg((3 << 11) | 20) & 0xFu; }
#define XB_SPIN(cond, bar) do { unsigned _sp = 0; while (cond) { __builtin_amdgcn_s_sleep(1); \
    if ((++_sp & 255u) == 0u) { if (xb_ld(&(bar)[XB_TMO])) break; if (_sp > XB_SPIN_CAP) { atomicAdd(&(bar)[XB_TMO], 1u); break; } } } } while (0)
struct XcdBarrier { unsigned* bar; unsigned x; volatile LAS unsigned* st; };
DI XcdBarrier xcd_barrier_post(unsigned* bar, volatile LAS unsigned* st) {
    XcdBarrier b; b.bar = bar; b.x = xb_xcc_id(); b.st = st;
    if (threadIdx.x == 0) (void)xb_add(&bar[XB_XCNT(b.x)], 1u);
    return b;
}
DI void xcd_barrier_complete(unsigned* bar, unsigned x, unsigned& nloc, unsigned& nx) {
    const unsigned G = gridDim.x * gridDim.y * gridDim.z;
    unsigned sum, cnt, mine, sp = 0u;
    for (;;) {
        sum = 0u; cnt = 0u; mine = 0u;
#pragma unroll
        for (unsigned j = 0; j < 16; ++j) { const unsigned c = xb_ld(&bar[XB_XCNT(j)]); sum += c; cnt += (c > 0u) ? 1u : 0u; mine = (j == x) ? c : mine; }
        if (sum == G) break;
        __builtin_amdgcn_s_sleep(1);
        if ((++sp & 255u) == 0u) { if (xb_ld(&bar[XB_TMO])) break; if (sp > XB_SPIN_CAP) { atomicAdd(&bar[XB_TMO], 1u); break; } }
    }
    nloc = mine > 0u ? mine : 1u; nx = cnt > 0u ? cnt : 1u;
}
__device__ __noinline__ void xcd_barrier_fn(GAS unsigned* gbar, unsigned bx, volatile LAS unsigned* bst, int wave) {
    XcdBarrier b; b.bar = (unsigned*)gbar; b.x = bx; b.st = bst; const bool t0 = (wave == 0) && (lane_id() == 0);
    asm volatile("s_waitcnt vmcnt(0)" ::: "memory");
    __syncthreads();
    if (t0) {
        unsigned* bar = b.bar;
        __builtin_amdgcn_s_waitcnt(0);
        unsigned nloc = b.st[0], nx = b.st[1];
        if (nloc == 0u) { xcd_barrier_complete(bar, b.x, nloc, nx); b.st[0] = nloc; b.st[1] = nx; }
        const unsigned old = xb_add(&bar[XB_XSUB(b.x)], 1u);
        const unsigned gen = old / nloc;
        if (old + 1u == (gen + 1u) * nloc) {
            __builtin_amdgcn_fence(__ATOMIC_RELEASE, "agent");
            asm volatile("s_waitcnt vmcnt(0)" ::: "memory");
            const unsigned og = xb_add(&bar[XB_TOP], 1u);
            const unsigned tg = og / nx;
            if (og + 1u == (tg + 1u) * nx) xb_add(&bar[XB_TOPGEN], 1u);
            else XB_SPIN(xb_ld(&bar[XB_TOPGEN]) == tg, bar);
            __builtin_amdgcn_fence(__ATOMIC_ACQUIRE, "agent");
            xb_add(&bar[XB_XGEN(b.x)], 1u);
            asm volatile("s_waitcnt vmcnt(0)" ::: "memory");
        } else {
            XB_SPIN(xb_ld(&bar[XB_XGEN(b.x)]) == gen, bar);
            __builtin_amdgcn_fence(__ATOMIC_ACQUIRE, "agent");
            asm volatile("s_waitcnt vmcnt(0)" ::: "memory");
        }
    }
    __syncthreads();
}

#define XB_XMASK(v) (3456 + (v))
#define XB_LOC(v)   (3520 + 64 * (v))
__device__ __noinline__ void lbar_fn(GAS unsigned* gbar, unsigned bx, volatile LAS unsigned* bst, int wave, int wgv, int per) {
    const bool t0 = (wave == 0) && (lane_id() == 0);
    asm volatile("s_waitcnt vmcnt(0)" ::: "memory");
    __syncthreads();
    if (bst[4] == 0u) {
        if (t0) { XcdBarrier b; b.bar = (unsigned*)gbar; b.x = bx; b.st = bst; unsigned* bar = b.bar;
            __builtin_amdgcn_s_waitcnt(0);
            unsigned nloc = b.st[0], nx = b.st[1];
            if (nloc == 0u) { xcd_barrier_complete(bar, b.x, nloc, nx); b.st[0] = nloc; b.st[1] = nx; }
            const unsigned old = xb_add(&bar[XB_XSUB(b.x)], 1u);
            const unsigned gen = old / nloc;
            if (old + 1u == (gen + 1u) * nloc) {
                __builtin_amdgcn_fence(__ATOMIC_RELEASE, "agent");
                asm volatile("s_waitcnt vmcnt(0)" ::: "memory");
                const unsigned og = xb_add(&bar[XB_TOP], 1u);
                const unsigned tg = og / nx;
                if (og + 1u == (tg + 1u) * nx) xb_add(&bar[XB_TOPGEN], 1u);
                else XB_SPIN(xb_ld(&bar[XB_TOPGEN]) == tg, bar);
                __builtin_amdgcn_fence(__ATOMIC_ACQUIRE, "agent");
                xb_add(&bar[XB_XGEN(b.x)], 1u);
                asm volatile("s_waitcnt vmcnt(0)" ::: "memory");
            } else {
                XB_SPIN(xb_ld(&bar[XB_XGEN(b.x)]) == gen, bar);
                __builtin_amdgcn_fence(__ATOMIC_ACQUIRE, "agent");
                asm volatile("s_waitcnt vmcnt(0)" ::: "memory");
            } }
    } else if (t0) {
        unsigned* bar = (unsigned*)gbar; unsigned* cnt = bar + XB_LOC(wgv & 7);
        __builtin_amdgcn_s_waitcnt(0);
        const unsigned gen = bst[5] + 1u; bst[5] = gen; const unsigned target = gen * (unsigned)per;
        (void)xb_add(cnt, 1u);
        asm volatile("buffer_inv sc1" ::: "memory");
        XB_SPIN(xb_ld(cnt) < target, bar);
        asm volatile("s_waitcnt vmcnt(0)" ::: "memory");
    }
    __syncthreads();
}

DI void stagger_ticks(int wg, int step_ticks) {
    const unsigned long long t0 = __builtin_amdgcn_s_memrealtime(); const unsigned long long dt = (unsigned long long)(((unsigned)wg >> 3) & 7u) * (unsigned)step_ticks;
    while (__builtin_amdgcn_s_memrealtime() - t0 < dt) __builtin_amdgcn_s_sleep(8);
}
struct TrIn { f32x4 v[8]; f32x4 g0, g1; };
DI void tr_load(TrIn& in, const float* W, int ldw, int k0, int n0, int lane, const float* gain) {
    const int c4 = 4 * (lane & 7), r8 = lane >> 3;
#pragma unroll
    for (int i = 0; i < 8; ++i) in.v[i] = *(const f32x4*)(W + (size_t)(k0 + r8 + 8 * i) * ldw + n0 + c4);
    if (gain) { in.g0 = *(const f32x4*)(gain + k0 + 8 * (lane & 7)); in.g1 = *(const f32x4*)(gain + k0 + 8 * (lane & 7) + 4); }
}
template <bool F8>
DI void tr_store(const TrIn& in, int k0, void* WT, int ldwt, int drow0, LAS float* scr, int lane, bool has_gain) {
    const int c4 = 4 * (lane & 7), r8 = lane >> 3;
#pragma unroll
    for (int i = 0; i < 8; ++i) { const int kk = r8 + 8 * i; const f32x4 v = in.v[i];
        LAS float* d = scr + kk * 33 + c4; d[0] = v.x; d[1] = v.y; d[2] = v.z; d[3] = v.w; }
    asm volatile("s_waitcnt lgkmcnt(0)" ::: "memory");
    const int c = lane & 7;
    float gs[8];
    if (has_gain) { gs[0] = in.g0.x; gs[1] = in.g0.y; gs[2] = in.g0.z; gs[3] = in.g0.w; gs[4] = in.g1.x; gs[5] = in.g1.y; gs[6] = in.g1.z; gs[7] = in.g1.w; }
    else {
#pragma unroll
        for (int i = 0; i < 8; ++i) gs[i] = 1.f; }
    if (F8) {
#pragma unroll
        for (int i = 0; i < 8; ++i) gs[i] *= W8_SCALE; }
#pragma unroll
    for (int j = 0; j < 4; ++j) { const int n = (lane >> 3) + 8 * j; const LAS float* s = scr + (8 * c) * 33 + n;
        if (F8) { u32x2 o; o.x = cvt4_fp8(s[0 * 33] * gs[0], s[1 * 33] * gs[1], s[2 * 33] * gs[2], s[3 * 33] * gs[3]); o.y = cvt4_fp8(s[4 * 33] * gs[4], s[5 * 33] * gs[5], s[6 * 33] * gs[6], s[7 * 33] * gs[7]);
            *(u32x2*)((unsigned char*)WT + (size_t)(drow0 + n) * ldwt + k0 + 8 * c) = o; }
        else { u32x4 o; o.x = cvtpk(s[0 * 33] * gs[0], s[1 * 33] * gs[1]); o.y = cvtpk(s[2 * 33] * gs[2], s[3 * 33] * gs[3]); o.z = cvtpk(s[4 * 33] * gs[4], s[5 * 33] * gs[5]); o.w = cvtpk(s[6 * 33] * gs[6], s[7 * 33] * gs[7]);
            *(u32x4*)((bf16*)WT + (size_t)(drow0 + n) * ldwt + k0 + 8 * c) = o; } }
    asm volatile("s_waitcnt lgkmcnt(0)" ::: "memory");
}
DI int gu_row(int n) { return n < DFF ? (n >> 7) * 256 + (n & 127) : ((n - DFF) >> 7) * 256 + 128 + ((n - DFF) & 127); }
template <bool F8 = false>
DI void tr_matrix(unsigned& ibase, const float* W, int K, int N, void* WT, int row_off, int gu, LAS float* scr, int gw, int NGW, int lane, const float* gain = nullptr, int ldwt = 0) {
    const int nblk = N >> 5, nit = (K >> 6) * nblk; const int first = (int)(((unsigned)gw + (unsigned)NGW - ibase % (unsigned)NGW) % (unsigned)NGW); ibase += (unsigned)nit;
    if (first >= nit) return;
    TrIn cur; int it = first; { const int kb = it / nblk, nb = it - kb * nblk; tr_load(cur, W, N, kb * 64, nb * 32, lane, gain); }
    for (;;) {
        const int itn = it + NGW; const bool hn = itn < nit; TrIn nx;
        if (hn) { const int kb = itn / nblk, nb = itn - kb * nblk; tr_load(nx, W, N, kb * 64, nb * 32, lane, gain); }
        { const int kb = it / nblk, nb = it - kb * nblk, n0 = nb * 32; tr_store<F8>(cur, kb * 64, WT, ldwt ? ldwt : K, gu ? gu_row(n0) : row_off + n0, scr, lane, gain != nullptr); }
        if (!hn) break;
        cur = nx; it = itn; }
}
DI void rms_row_bf16(const float* xrow, const float* gain, bf16* orow, int lane) {
    const f32x4* xr = (const f32x4*)xrow + lane; const f32x4* gr = (const f32x4*)gain + lane;
    f32x4 v[4]; float s = 0.f;
#pragma unroll
    for (int j = 0; j < 4; ++j) { v[j] = xr[64 * j]; s += (v[j].x * v[j].x + v[j].y * v[j].y) + (v[j].z * v[j].z + v[j].w * v[j].w); }
    const float rstd = 1.f / sqrtf(wave_sum(s, lane) * (1.f / D) + EPS);
    u32x2* o8 = (u32x2*)orow + lane;
#pragma unroll
    for (int j = 0; j < 4; ++j) { const f32x4 g = gr[64 * j]; u32x2 w; w.x = cvtpk(v[j].x * rstd * g.x, v[j].y * rstd * g.y); w.y = cvtpk(v[j].z * rstd * g.z, v[j].w * rstd * g.w); o8[64 * j] = w; }
}

DI void rms_row_fp8(const float* xrow, const float* gain, unsigned char* orow, int lane) {
    const f32x4* xr = (const f32x4*)xrow + lane; const f32x4* gr = (const f32x4*)gain + lane;
    f32x4 v[4]; float s = 0.f;
#pragma unroll
    for (int j = 0; j < 4; ++j) { v[j] = xr[64 * j]; s += (v[j].x * v[j].x + v[j].y * v[j].y) + (v[j].z * v[j].z + v[j].w * v[j].w); }
    const float rstd = 1.f / sqrtf(wave_sum(s, lane) * (1.f / D) + EPS);
    unsigned* o4 = (unsigned*)orow + lane;
#pragma unroll
    for (int j = 0; j < 4; ++j) { const f32x4 g = gr[64 * j]; o4[64 * j] = cvt4_fp8(v[j].x * rstd * g.x, v[j].y * rstd * g.y, v[j].z * rstd * g.z, v[j].w * rstd * g.w); }
}

struct KVStage { u32x4 k[4], v[4]; };
DI void kv_load(KVStage& st, const bf16* Kp, int kpitch, const bf16* Vp, int vpitch, int tid) {
#pragma unroll
    for (int i = 0; i < 4; ++i) { const int id = tid + 512 * i, row = id >> 3, c8 = id & 7;
        st.k[i] = *(const u32x4*)(Kp + (size_t)row * kpitch + 8 * c8); st.v[i] = *(const u32x4*)(Vp + (size_t)row * vpitch + 8 * c8); }
}
DI void kv_write(const KVStage& st, LAS bf16* Ksm, LAS bf16* Vsm, int tid) {
#pragma unroll
    for (int i = 0; i < 4; ++i) { const int id = tid + 512 * i, row = id >> 3, c8 = id & 7;
        *(LAS u32x4*)(Ksm + row * KS + 8 * c8) = st.k[i]; *(LAS u32x4*)(Vsm + row * VS + 8 * c8) = st.v[i]; }
}
typedef short v4i16_t __attribute__((ext_vector_type(4)));
DI s16x4 trd(const LAS bf16* p) { return __builtin_bit_cast(s16x4, __builtin_amdgcn_ds_read_tr16_b64_v4i16((LAS v4i16_t*)p)); }
DI int tr_lane_off(int lane, int rs, int hmul) { return (hmul * (lane >> 5) + ((lane & 15) >> 2)) * rs + 16 * ((lane >> 4) & 1) + 4 * (lane & 3); }
DI void qk_subtile(const LAS bf16* Ksm, int ktl, const bf16x8 (&qf)[4], int r, int h, f32x16& z0, f32x16& z1) {
#pragma unroll
    for (int i = 0; i < 16; ++i) { z0[i] = 0.f; z1[i] = 0.f; }
#pragma unroll
    for (int s = 0; s < 4; ++s) {
        const bf16x8 k0 = *(const LAS bf16x8*)(Ksm + (64 * ktl + r) * KS + 16 * s + 8 * h);
        const bf16x8 k1 = *(const LAS bf16x8*)(Ksm + (64 * ktl + 32 + r) * KS + 16 * s + 8 * h);
        z0 = MFMA32(k0, qf[s], z0); z1 = MFMA32(k1, qf[s], z1); }
}
template <int ST> DI bf16x8 pack_step(const f32x16& x) {
    u32x4 p; p.x = cvtpk(x[8 * ST + 0], x[8 * ST + 1]); p.y = cvtpk(x[8 * ST + 2], x[8 * ST + 3]); p.z = cvtpk(x[8 * ST + 4], x[8 * ST + 5]); p.w = cvtpk(x[8 * ST + 6], x[8 * ST + 7]);
    return __builtin_bit_cast(bf16x8, p);
}
DI void pv_subtile(const LAS bf16* Vsm, int ktl, const f32x16& p0, const f32x16& p1, int lane, f32x16 (&o)[2]) {
    const bf16x8 pf[4] = {pack_step<0>(p0), pack_step<1>(p0), pack_step<0>(p1), pack_step<1>(p1)};
    const LAS bf16* vb = Vsm + tr_lane_off(lane, VS, 4) + 64 * ktl * VS;
#pragma unroll
    for (int ts = 0; ts < 4; ++ts) {
#pragma unroll
        for (int dt = 0; dt < 2; ++dt) {
            const s16x4 lo = trd(vb + (16 * ts) * VS + 32 * dt), hi = trd(vb + (16 * ts + 8) * VS + 32 * dt);
            const bf16x8 vf = __builtin_shufflevector(lo, hi, 0, 1, 2, 3, 4, 5, 6, 7);
            o[dt] = MFMA32(vf, pf[ts], o[dt]); } }
}
template <int T, int GI> DI void sb_group(f32x16& z, float& c, int h, int lane) {
    float s[4], m[4];
#pragma unroll
    for (int i = 0; i < 4; ++i) { const float e = fexp2(-z[4 * GI + i]); s[i] = frcp(1.f + e); m[i] = 1.f - s[i]; }
    const float w2 = m[3], w1 = m[3] * m[2], w0 = w1 * m[1], Gm = w0 * m[0];
    const float Gp = shx32(Gm, lane);
    const float mc = h ? c : c * Gp;
    z[4 * GI + 3] = s[3] * mc; z[4 * GI + 2] = s[2] * w2 * mc; z[4 * GI + 1] = s[1] * w1 * mc; z[4 * GI + 0] = s[0] * w0 * mc;
    c *= Gm * Gp;
}
DI void sb_transform(f32x16& z0, f32x16& z1, float& c, int h, bool need_mask, int krel, int lane) {
    if (need_mask) {
        const float ninf = -__builtin_inff();
#pragma unroll
        for (int i = 0; i < 16; ++i) { const int kk = krel + crow(i, h); z0[i] = (kk < 0) ? z0[i] : ninf; z1[i] = (kk + 32 < 0) ? z1[i] : ninf; } }
    sb_group<1, 3>(z1, c, h, lane); sb_group<1, 2>(z1, c, h, lane); sb_group<1, 1>(z1, c, h, lane); sb_group<1, 0>(z1, c, h, lane);
    sb_group<0, 3>(z0, c, h, lane); sb_group<0, 2>(z0, c, h, lane); sb_group<0, 1>(z0, c, h, lane); sb_group<0, 0>(z0, c, h, lane);
}
DI void store_ot(const f32x16 (&o)[2], bf16* orow, int h, float sc) {
#pragma unroll
    for (int dt = 0; dt < 2; ++dt)
#pragma unroll
        for (int g = 0; g < 4; ++g) { u32x2 w; w.x = cvtpk(o[dt][4 * g] * sc, o[dt][4 * g + 1] * sc); w.y = cvtpk(o[dt][4 * g + 2] * sc, o[dt][4 * g + 3] * sc);
            *(u32x2*)(orow + 32 * dt + 8 * g + 4 * h) = w; }
}

DI void store_ot8(const f32x16 (&o)[2], unsigned char* orow, int h, float sc) {
#pragma unroll
    for (int dt = 0; dt < 2; ++dt)
#pragma unroll
        for (int g = 0; g < 4; ++g) *(unsigned*)(orow + 32 * dt + 8 * g + 4 * h) = cvt4_fp8(o[dt][4 * g] * sc, o[dt][4 * g + 1] * sc, o[dt][4 * g + 2] * sc, o[dt][4 * g + 3] * sc);
}
constexpr float Y8_SCALE = 8.f;
DI void store_ot_rows(const f32x16 (&o)[2], LAS bf16* wt, bf16* g0, size_t pitch, int lane, float sc) {
    const int r = lane & 31, h = lane >> 5;
#pragma unroll
    for (int dt = 0; dt < 2; ++dt)
#pragma unroll
        for (int g = 0; g < 4; ++g) { u32x2 w; w.x = cvtpk(o[dt][4 * g] * sc, o[dt][4 * g + 1] * sc); w.y = cvtpk(o[dt][4 * g + 2] * sc, o[dt][4 * g + 3] * sc);
            *(LAS u32x2*)(wt + r * KS + 32 * dt + 8 * g + 4 * h) = w; }
    asm volatile("s_waitcnt lgkmcnt(0)" ::: "memory");
#pragma unroll
    for (int i = 0; i < 4; ++i) { const int p = lane + 64 * i, row = p >> 3, c = p & 7; *(u32x4*)(g0 + (size_t)row * pitch + 8 * c) = *(const LAS u32x4*)(wt + row * KS + 8 * c); }
}
DI void store_ot_rows8(const f32x16 (&o)[2], LAS bf16* wt, unsigned char* g0, size_t pitch, int lane, float sc) {
    const int r = lane & 31, h = lane >> 5; LAS unsigned char* wb = (LAS unsigned char*)wt;
#pragma unroll
    for (int dt = 0; dt < 2; ++dt)
#pragma unroll
        for (int g = 0; g < 4; ++g) *(LAS unsigned*)(wb + r * (2 * KS) + 32 * dt + 8 * g + 4 * h) = cvt4_fp8(o[dt][4 * g] * sc, o[dt][4 * g + 1] * sc, o[dt][4 * g + 2] * sc, o[dt][4 * g + 3] * sc);
    asm volatile("s_waitcnt lgkmcnt(0)" ::: "memory");
#pragma unroll
    for (int i = 0; i < 2; ++i) { const int p = lane + 64 * i, row = p >> 2, c = p & 3; *(u32x4*)(g0 + (size_t)row * pitch + 16 * c) = *(const LAS u32x4*)(wb + row * (2 * KS) + 16 * c); }
}
DI void sb_unit(const bf16* U, bf16* Y, int y8, int bl, int hd, int qb, LAS unsigned char* lds, int tid, int wave, int lane) {
    LAS bf16* Ksm = (LAS bf16*)(lds + L_KS); LAS bf16* Vtm = (LAS bf16*)(lds + L_VT);
    const int r = lane & 31, h = lane >> 5;
    const size_t tok0 = (size_t)bl * SEQ; const int tq = qb * 256 + 32 * wave + r;
    const bf16* Kb = U + tok0 * DIN + UC_SBK + 64 * hd; const bf16* Vb = U + tok0 * DIN + UC_SBV + 64 * hd;
    KVStage st; kv_load(st, Kb + (size_t)(256 * qb) * DIN, DIN, Vb + (size_t)(256 * qb) * DIN, DIN, tid);
    bf16x8 qf[4];
    { const bf16* qrow = U + (tok0 + tq) * DIN + UC_SBQ + 64 * hd; u32x4 qw[4];
#pragma unroll
      for (int s = 0; s < 4; ++s) qw[s] = *(const u32x4*)(qrow + 16 * s + 8 * h);
#pragma unroll
      for (int s = 0; s < 4; ++s) { float f[8]; unpack8(qw[s], f);
#pragma unroll
          for (int j = 0; j < 8; ++j) f[j] *= (0.125f * 1.44269504f);
          qf[s] = __builtin_bit_cast(bf16x8, pack8(f)); } }
    f32x16 o[2];
#pragma unroll
    for (int i = 0; i < 16; ++i) { o[0][i] = 0.f; o[1][i] = 0.f; }
    float c = 1.f;
    for (int kb = qb; kb >= 0; --kb) {
        { volatile LAS unsigned* fl = (volatile LAS unsigned*)(lds + MISC_OFF) + 2;
          if (lane == 0 && __builtin_amdgcn_ballot_w64(c != 0.f) != 0ull) fl[kb & 1] = 1u;
          __syncthreads();
          const unsigned live = fl[kb & 1];
          if (tid == 0) fl[(kb + 1) & 1] = 0u;
          if (live == 0u) break; }
        kv_write(st, Ksm, Vtm, tid);
        __syncthreads();
        if (kb > 0) kv_load(st, Kb + (size_t)(256 * (kb - 1)) * DIN, DIN, Vb + (size_t)(256 * (kb - 1)) * DIN, DIN, tid);
        const bool diag = (kb == qb);
        const int khi = diag ? ((32 * wave + 31) >> 6) : 3;
        for (int ktl = khi; ktl >= 0; --ktl) {
            if (__builtin_amdgcn_ballot_w64(c != 0.f) == 0ull) break;
            f32x16 z0, z1; qk_subtile(Ksm, ktl, qf, r, h, z0, z1);
            const bool need_mask = diag && (64 * ktl + 63 >= 32 * wave);
            sb_transform(z0, z1, c, h, need_mask, 256 * kb + 64 * ktl - tq, lane);
            pv_subtile(Vtm, ktl, z0, z1, lane, o);
        }
    }
    __syncthreads();
    { const size_t q0 = tok0 + (size_t)qb * 256 + 32 * wave;
      int y8s = y8; asm volatile("" : "+s"(y8s));
      if (y8s) store_ot_rows8(o, Ksm + 32 * wave * KS, (unsigned char*)Y + q0 * D + YC_SB + 64 * hd, D, lane, Y8_SCALE); else store_ot_rows(o, Ksm + 32 * wave * KS, Y + q0 * D + YC_SB + 64 * hd, D, lane, 1.f); }
}

DI void xa_unit(const bf16* QB, const bf16* kvl, const float* gq, float kmax, bf16* OB, int bl, int bglob, int hd, int qblk, LAS unsigned char* lds, int tid, int wave, int lane) {
    LAS bf16* Ksm = (LAS bf16*)(lds + L_KS); LAS bf16* Vtm = (LAS bf16*)(lds + L_VT);
    const int r = lane & 31, h = lane >> 5;
    const size_t row = (size_t)bl * SEQ + qblk * 256 + 32 * wave + r;
    __syncthreads();
    u32x4 qw[4], qw2[4];
    { KVStage st; const bf16* Kp = kvl + (size_t)bglob * NMEM * 512 + 64 * hd; kv_load(st, Kp, 512, Kp + 256, 512, tid);
      const bf16* qrow = QB + row * 512 + 64 * hd;
#pragma unroll
      for (int s = 0; s < 4; ++s) { qw[s] = *(const u32x4*)(qrow + 16 * s + 8 * h); qw2[s] = *(const u32x4*)(qrow + 256 + 16 * s + 8 * h); }
      kv_write(st, Ksm, Vtm, tid); }
    float qv[4][8]; float ss = 0.f;
    {
#pragma unroll
      for (int s = 0; s < 4; ++s) { float p2[8]; unpack8(qw[s], qv[s]); unpack8(qw2[s], p2);
#pragma unroll
          for (int j = 0; j < 8; ++j) { qv[s][j] += p2[j]; ss += qv[s][j] * qv[s][j]; } } }
    ss += shx32(ss, lane);
    const float rq = 1.f / sqrtf(ss * (1.f / 64.f) + EPS) * (0.125f * 1.44269504f);
    bf16x8 qf[4]; float qn2 = 0.f;
#pragma unroll
    for (int s = 0; s < 4; ++s) {
#pragma unroll
        for (int j = 0; j < 8; ++j) { qv[s][j] *= rq * gq[16 * s + 8 * h + j]; qn2 += qv[s][j] * qv[s][j]; }
        qf[s] = __builtin_bit_cast(bf16x8, pack8(qv[s])); }
    qn2 += shx32(qn2, lane);
    const float bnd = sqrtf(qn2) * kmax * 1.02f + 0.5f;
    f32x16 o[2];
#pragma unroll
    for (int i = 0; i < 16; ++i) { o[0][i] = 0.f; o[1][i] = 0.f; }
    float l = 0.f;
    __syncthreads();
    for (int ktl = 0; ktl < 4; ++ktl) {
        f32x16 z0, z1; qk_subtile(Ksm, ktl, qf, r, h, z0, z1);
#pragma unroll
        for (int i = 0; i < 16; ++i) { z0[i] = fexp2(z0[i] - bnd); z1[i] = fexp2(z1[i] - bnd); l += z0[i] + z1[i]; }
        pv_subtile(Vtm, ktl, z0, z1, lane, o);
    }
    l += shx32(l, lane);
    __syncthreads();
    store_ot_rows(o, Ksm + 32 * wave * KS, OB + ((size_t)bl * SEQ + qblk * 256 + 32 * wave) * 256 + 64 * hd, 256, lane, 1.f / l);
}

DI void ret_stage(const bf16* U, const f32x2* rot, size_t trow0, int gtok, int hd, float lg, LAS bf16* Ksm, LAS bf16* Vtm, int tid) {
    const int m = tid >> 1, hf = tid & 1; const size_t trow = trow0 + m;
    const bf16* kp = U + trow * DIN + UC_RK + 64 * hd + 16 * hf; const f32x2* rp = rot + (size_t)(gtok + m) * 32 + 16 * hf;
    const float sk = fexp2(-(float)m * lg) * 0.125f;
    const u32x4 a0 = *(const u32x4*)kp, a1 = *(const u32x4*)(kp + 8), b0 = *(const u32x4*)(kp + 32), b1 = *(const u32x4*)(kp + 40);
    f32x4 cs4[8];
#pragma unroll
    for (int j = 0; j < 8; ++j) cs4[j] = *((const f32x4*)rp + j);
    const bf16* vp = U + trow * DIN + UC_RV + 64 * hd + 32 * hf; u32x4 vv[4];
#pragma unroll
    for (int q = 0; q < 4; ++q) vv[q] = *(const u32x4*)(vp + 8 * q);
    float x1[16], x2[16];
    { float t[8]; unpack8(a0, t);
#pragma unroll
      for (int j = 0; j < 8; ++j) x1[j] = t[j];
      unpack8(a1, t);
#pragma unroll
      for (int j = 0; j < 8; ++j) x1[8 + j] = t[j];
      unpack8(b0, t);
#pragma unroll
      for (int j = 0; j < 8; ++j) x2[j] = t[j];
      unpack8(b1, t);
#pragma unroll
      for (int j = 0; j < 8; ++j) x2[8 + j] = t[j]; }
    float o1[16], o2[16];
#pragma unroll
    for (int j = 0; j < 16; ++j) { const f32x2 cs = (j & 1) ? (f32x2){cs4[j >> 1].z, cs4[j >> 1].w} : (f32x2){cs4[j >> 1].x, cs4[j >> 1].y}; o1[j] = (x1[j] * cs.x - x2[j] * cs.y) * sk; o2[j] = (x1[j] * cs.y + x2[j] * cs.x) * sk; }
    { LAS bf16* kr = Ksm + m * KS + 16 * hf; float t[8];
#pragma unroll
        for (int j = 0; j < 8; ++j) t[j] = o1[j];
        *(LAS u32x4*)kr = pack8(t);
#pragma unroll
        for (int j = 0; j < 8; ++j) t[j] = o1[8 + j];
        *(LAS u32x4*)(kr + 8) = pack8(t);
#pragma unroll
        for (int j = 0; j < 8; ++j) t[j] = o2[j];
        *(LAS u32x4*)(kr + 32) = pack8(t);
#pragma unroll
        for (int j = 0; j < 8; ++j) t[j] = o2[8 + j];
        *(LAS u32x4*)(kr + 40) = pack8(t); }
#pragma unroll
    for (int q = 0; q < 4; ++q) *(LAS u32x4*)(Vtm + m * VS + 32 * hf + 8 * q) = vv[q];
}
DI float ret_lg(int hd) { const float gam = 1.f - fexp2(-5.f - (float)hd); return __log2f(gam); }
DI void retkv_unit(const bf16* U, float* KVS, const f32x2* rot, int bl, int gtok0, int hd, int ch, LAS unsigned char* lds, int tid, int wave, int lane) {
    LAS bf16* Ksm = (LAS bf16*)(lds + L_KS); LAS bf16* Vtm = (LAS bf16*)(lds + L_VT);
    const int r = lane & 31, h = lane >> 5; const float lg = ret_lg(hd);
    __syncthreads();
    ret_stage(U, rot, (size_t)bl * SEQ + ch * 256, gtok0 + ch * 256, hd, lg, Ksm, Vtm, tid);
    __syncthreads();
    if (wave < 4) { const int dti = wave >> 1, eti = wave & 1;
        f32x16 kv;
#pragma unroll
        for (int i = 0; i < 16; ++i) kv[i] = 0.f;
        const LAS bf16* ka = Ksm + tr_lane_off(lane, KS, 8) + 32 * dti; const LAS bf16* vb = Vtm + tr_lane_off(lane, VS, 8) + 32 * eti;
#pragma unroll 4
        for (int s = 0; s < 16; ++s) {
            const s16x4 a0 = trd(ka + (16 * s) * KS), a1 = trd(ka + (16 * s + 4) * KS), b0 = trd(vb + (16 * s) * VS), b1 = trd(vb + (16 * s + 4) * VS);
            kv = MFMA32(__builtin_shufflevector(a0, a1, 0, 1, 2, 3, 4, 5, 6, 7), __builtin_shufflevector(b0, b1, 0, 1, 2, 3, 4, 5, 6, 7), kv); }
        float* dst = KVS + (size_t)((bl * 4 + hd) * 16 + ch) * 4096 + 32 * eti + r;
#pragma unroll
        for (int i = 0; i < 16; ++i) dst[(32 * dti + crow(i, h)) * 64] = kv[i]; }
}
DI void reto_unit(const bf16* U, bf16* Y, int y8, const float* KVS, const f32x2* rot, int bl, int gtok0, int hd, int ch, LAS unsigned char* lds, int tid, int wave, int lane) {
    LAS bf16* Ksm = (LAS bf16*)(lds + L_KS); LAS bf16* Vtm = (LAS bf16*)(lds + L_VT); LAS bf16* Stm = (LAS bf16*)(lds + L_ST);
    const int r = lane & 31, h = lane >> 5; const float lg = ret_lg(hd);
    const size_t tok0 = (size_t)bl * SEQ; const int n0 = ch * 256;
    __syncthreads();
    { const int d = tid >> 3, e0 = 8 * (tid & 7); float acc[8];
#pragma unroll
      for (int j = 0; j < 8; ++j) acc[j] = 0.f;
      const float* src = KVS + (size_t)((bl * 4 + hd) * 16) * 4096 + d * 64 + e0;
      for (int cp0 = 0; cp0 < ch; cp0 += 8) {
          f32x4 a[8], b[8];
#pragma unroll
          for (int k = 0; k < 8; ++k) { const int cp = (cp0 + k < ch) ? (cp0 + k) : (ch - 1); a[k] = *(const f32x4*)(src + (size_t)cp * 4096); b[k] = *(const f32x4*)(src + (size_t)cp * 4096 + 4); }
#pragma unroll
          for (int k = 0; k < 8; ++k) { const int cp = cp0 + k; const float w = (cp < ch) ? fexp2((256.f * (float)(ch - 1 - cp) + 256.f) * lg) : 0.f;
              acc[0] += w * a[k].x; acc[1] += w * a[k].y; acc[2] += w * a[k].z; acc[3] += w * a[k].w; acc[4] += w * b[k].x; acc[5] += w * b[k].y; acc[6] += w * b[k].z; acc[7] += w * b[k].w; } }
#pragma unroll
      for (int j = 0; j < 8; ++j) Stm[(e0 + j) * KS + d] = (bf16)(cvtpk(acc[j], 0.f) & 0xffffu); }
    ret_stage(U, rot, tok0 + n0, gtok0 + n0, hd, lg, Ksm, Vtm, tid);
    bf16x8 qf[4];
    { const int nl = 32 * wave + r; const size_t trow = tok0 + n0 + nl;
      const bf16* qp = U + trow * DIN + UC_RQ + 64 * hd + 8 * h; const f32x2* rp = rot + (size_t)(gtok0 + n0 + nl) * 32 + 8 * h;
      const float sq = fexp2((float)nl * lg);
      float a[4][8];
#pragma unroll
      for (int s = 0; s < 4; ++s) { const u32x4 w = *(const u32x4*)(qp + 16 * s); unpack8(w, a[s]); }
      float b[4][8];
#pragma unroll
      for (int j = 0; j < 8; ++j) { const f32x2 c0 = rp[j], c1 = rp[16 + j];
          b[0][j] = (a[0][j] * c0.x - a[2][j] * c0.y) * sq; b[2][j] = (a[0][j] * c0.y + a[2][j] * c0.x) * sq;
          b[1][j] = (a[1][j] * c1.x - a[3][j] * c1.y) * sq; b[3][j] = (a[1][j] * c1.y + a[3][j] * c1.x) * sq; }
#pragma unroll
      for (int s = 0; s < 4; ++s) qf[s] = __builtin_bit_cast(bf16x8, pack8(b[s])); }
    __syncthreads();
    f32x16 o[2];
#pragma unroll
    for (int i = 0; i < 16; ++i) { o[0][i] = 0.f; o[1][i] = 0.f; }
    const int khi = (32 * wave + 31) >> 6;
    for (int ktl = 0; ktl <= khi; ++ktl) {
        f32x16 z0, z1; qk_subtile(Ksm, ktl, qf, r, h, z0, z1);
        if (64 * ktl + 63 > 32 * wave) {
            const int krel = 64 * ktl - (32 * wave + r);
#pragma unroll
            for (int i = 0; i < 16; ++i) { const int kk = krel + crow(i, h); z0[i] = (kk <= 0) ? z0[i] : 0.f; z1[i] = (kk + 32 <= 0) ? z1[i] : 0.f; } }
        pv_subtile(Vtm, ktl, z0, z1, lane, o);
    }
#pragma unroll
    for (int s = 0; s < 4; ++s)
#pragma unroll
        for (int dt = 0; dt < 2; ++dt) { const bf16x8 af = *(const LAS bf16x8*)(Stm + (32 * dt + r) * KS + 16 * s + 8 * h); o[dt] = MFMA32(af, qf[s], o[dt]); }
    { float sm = 0.f;
#pragma unroll
      for (int i = 0; i < 16; ++i) sm += o[0][i] + o[1][i];
      sm += shx32(sm, lane); const float mean = sm * (1.f / 64.f); float vq = 0.f;
#pragma unroll
      for (int i = 0; i < 16; ++i) { const float d0 = o[0][i] - mean, d1 = o[1][i] - mean; vq += d0 * d0 + d1 * d1; }
      vq += shx32(vq, lane); const float rstd = 1.f / sqrtf(vq * (1.f / 64.f) + EPS);
      const size_t trow = tok0 + n0 + 32 * wave + r;
      const bf16* gp = U + trow * DIN + UC_RG + 64 * hd; bf16* yp = Y + trow * D + YC_RET + 64 * hd;
#pragma unroll
      for (int dt = 0; dt < 2; ++dt)
#pragma unroll
          for (int g = 0; g < 4; ++g) { const int e0 = 32 * dt + 8 * g + 4 * h; const u32x2 gw = *(const u32x2*)(gp + e0);
              const float g0 = bflo(gw.x), g1 = bfhi(gw.x), g2 = bflo(gw.y), g3 = bfhi(gw.y);
              const float r0 = g0 * sigmoid_f(g0) * (o[dt][4 * g] - mean) * rstd, r1 = g1 * sigmoid_f(g1) * (o[dt][4 * g + 1] - mean) * rstd, r2 = g2 * sigmoid_f(g2) * (o[dt][4 * g + 2] - mean) * rstd, r3 = g3 * sigmoid_f(g3) * (o[dt][4 * g + 3] - mean) * rstd;
              int y8s = y8; asm volatile("" : "+s"(y8s));
              if (y8s) *(unsigned*)((unsigned char*)Y + trow * D + YC_RET + 64 * hd + e0) = cvt4_fp8(r0 * Y8_SCALE, r1 * Y8_SCALE, r2 * Y8_SCALE, r3 * Y8_SCALE);
              else { u32x2 w; w.x = cvtpk(r0, r1); w.y = cvtpk(r2, r3); *(u32x2*)(yp + e0) = w; } } }
}

DI void conv_unit(const bf16* U, bf16* Y, int y8, const float* cw, const float* cb, const float* lng, const float* lnb, int bl, int tile, LAS unsigned char* lds, int tid, int wave, int lane) {
    LAS float* vs = (LAS float*)lds;
    const int t0 = tile * 64; const size_t tok0 = (size_t)bl * SEQ;
    __syncthreads();
#pragma unroll
    for (int it = 0; it < 6; ++it) { const int id = tid + it * NTHR; if (id >= 94 * 32) break; const int rr = id >> 5, c8 = id & 31, t = t0 - 30 + rr; float v[8];
        if (t >= 0) { const bf16* p = U + (tok0 + t) * DIN + 8 * c8; const u32x4 aw = *(const u32x4*)(p + UC_CA), gw = *(const u32x4*)(p + UC_CG); float a[8], g[8]; unpack8(aw, a); unpack8(gw, g);
#pragma unroll
            for (int j = 0; j < 8; ++j) v[j] = a[j] * sigmoid_f(g[j]); }
        else {
#pragma unroll
            for (int j = 0; j < 8; ++j) v[j] = 0.f; }
        LAS f32x4* d = (LAS f32x4*)(vs + rr * 256 + 8 * c8); d[0] = (f32x4){v[0], v[1], v[2], v[3]}; d[1] = (f32x4){v[4], v[5], v[6], v[7]}; }
    __syncthreads();
    const int c = tid & 255, half = tid >> 8;
    float acc[32];
    { float wj[31], win[62];
#pragma unroll
      for (int j = 0; j < 31; ++j) wj[j] = cw[j * 256 + c];
      const LAS float* vp = vs + (32 * half) * 256 + c;
#pragma unroll
      for (int i = 0; i < 62; ++i) win[i] = vp[i * 256];
      const float bias = cb[c];
#pragma unroll
      for (int i = 0; i < 32; ++i) { float a = bias;
#pragma unroll
          for (int j = 0; j < 31; ++j) a += wj[j] * win[i + j];
          acc[i] = a; } }
    __syncthreads();
#pragma unroll
    for (int i = 0; i < 32; ++i) vs[(32 * half + i) * 256 + c] = acc[i];
    __syncthreads();
    const f32x4 g4 = *(const f32x4*)(lng + 4 * lane), b4 = *(const f32x4*)(lnb + 4 * lane);
#pragma unroll
    for (int i = 0; i < 8; ++i) { const int tt = 8 * wave + i; const f32x4 v = *(const LAS f32x4*)(vs + tt * 256 + 4 * lane);
        const float mean = wave_sum((v.x + v.y) + (v.z + v.w), lane) * (1.f / 256.f);
        const f32x4 dv = v - mean; const float var = wave_sum((dv.x * dv.x + dv.y * dv.y) + (dv.z * dv.z + dv.w * dv.w), lane) * (1.f / 256.f);
        const float rstd = 1.f / sqrtf(var + EPS); const f32x4 xn = dv * rstd * g4 + b4;
        const float c0 = xn.x * sigmoid_f(xn.x), c1 = xn.y * sigmoid_f(xn.y), c2 = xn.z * sigmoid_f(xn.z), c3 = xn.w * sigmoid_f(xn.w);
        int y8s = y8; asm volatile("" : "+s"(y8s));
        if (y8s) *(unsigned*)((unsigned char*)Y + (tok0 + t0 + tt) * D + YC_CONV + 4 * lane) = cvt4_fp8(c0 * Y8_SCALE, c1 * Y8_SCALE, c2 * Y8_SCALE, c3 * Y8_SCALE);
        else { u32x2 w; w.x = cvtpk(c0, c1); w.y = cvtpk(c2, c3); *(u32x2*)(Y + (tok0 + t0 + tt) * D + YC_CONV + 4 * lane) = w; } }
}

DI void pool_unit(const bf16* U, bf16* Y, int y8, int bl, int tile, LAS unsigned char* lds, int tid) {
    LAS float* us = (LAS float*)lds;
    const int t0 = tile * 64; const size_t tok0 = (size_t)bl * SEQ;
    __syncthreads();
#pragma unroll
    for (int it = 0; it < 5; ++it) { const int id = tid + it * NTHR; if (id >= 79 * 32) break; const int rr = id >> 5, c8 = id & 31, t = t0 - 15 + rr; float v[8];
        if (t >= 0) { const u32x4 w = *(const u32x4*)(U + (tok0 + t) * DIN + UC_POOL + 8 * c8); unpack8(w, v); }
        else {
#pragma unroll
            for (int j = 0; j < 8; ++j) v[j] = 0.f; }
        LAS f32x4* d = (LAS f32x4*)(us + rr * 256 + 8 * c8); d[0] = (f32x4){v[0], v[1], v[2], v[3]}; d[1] = (f32x4){v[4], v[5], v[6], v[7]}; }
    __syncthreads();
    const int c = tid & 255, half = tid >> 8; const int gi = c >> 6, w = 2 << gi;
    float v[47];
    { const LAS float* p = us + (32 * half) * 256 + c;
#pragma unroll
      for (int i = 0; i < 47; ++i) v[i] = p[i * 256]; }
    float s[47];
#pragma unroll
    for (int i = 0; i < 47; ++i) s[i] = v[i] + (i >= 1 ? v[i - 1] : 0.f);
    if (gi >= 1) {
#pragma unroll
        for (int i = 46; i >= 0; --i) s[i] = s[i] + (i >= 2 ? s[i - 2] : 0.f); }
    if (gi >= 2) {
#pragma unroll
        for (int i = 46; i >= 0; --i) s[i] = s[i] + (i >= 4 ? s[i - 4] : 0.f); }
    if (gi >= 3) {
#pragma unroll
        for (int i = 46; i >= 0; --i) s[i] = s[i] + (i >= 8 ? s[i - 8] : 0.f); }
#pragma unroll
    for (int i = 0; i < 32; ++i) { const int t = t0 + 32 * half + i;
        const int n = (t + 1 < w) ? (t + 1) : w; const float d = s[15 + i] * __builtin_amdgcn_rcpf((float)n) - v[15 + i];
        int y8s = y8; asm volatile("" : "+s"(y8s));
        if (y8s) ((unsigned char*)Y)[(tok0 + t) * D + YC_POOL + c] = (unsigned char)(cvt4_fp8(d * Y8_SCALE, 0.f, 0.f, 0.f) & 0xffu);
        else Y[(tok0 + t) * D + YC_POOL + c] = (bf16)(cvtpk(d, 0.f) & 0xffffu); }
}

struct Args { const void* in[27]; float* out; unsigned char* ws; };
static_assert(sizeof(Args) == 29 * 8, "Args has no padding");
typedef const __attribute__((address_space(4))) Args* KArgs;
DI KArgs KA() { KArgs p = (KArgs)__builtin_amdgcn_kernarg_segment_ptr(); asm volatile("" : "+s"(p)); return p; }
#define KIN(T, k) ((const T*)KA()->in[k])
#define PH DI
#define PHN __device__ __noinline__
enum { I_X = 0, I_MEM, I_POS, I_NMIXG, I_WIN, I_CONVW, I_CONVB, I_CLNG, I_CLNB, I_POOLW, I_POOLS, I_WGATE, I_WBR, I_WOUT, I_NXAG, I_NMEMG, I_WQ, I_WKV, I_QG, I_KG, I_WO, I_NFFNG, I_FGU, I_FDN, I_ROUTER, I_MGU, I_MDN };

constexpr unsigned F8MASK = FFN_FP8_MASK;
static_assert((F8MASK & 0xA) == 0xA, "the workspace map places the MoE buffers for fp8 experts");
constexpr bool DENSE_ANY8 = (F8MASK & 0x5) != 0, DENSE_ANYB = (F8MASK & 0x5) != 0x5, MOE_ANY8 = (F8MASK & 0xA) != 0, MOE_ANYB = (F8MASK & 0xA) != 0xA;
struct Ids { int tid, lane, wave, G, wg, gw, NGW; };
DI Ids ids(int wave) { Ids i; i.lane = lane_id(); asm volatile("" : "+v"(i.lane)); asm volatile("" : "+s"(wave)); i.wave = wave; i.tid = wave * 64 + i.lane; i.G = gridDim.x; i.wg = blockIdx.x; asm volatile("" : "+s"(i.G), "+s"(i.wg)); i.gw = i.wg * NWAVES + i.wave; i.NGW = i.G * NWAVES; return i; }

PHN unsigned ph_w_layer(KArgs ka, int wv, LAS unsigned char* lds, int l, unsigned ib) {
    const Ids t = ids(__builtin_amdgcn_readfirstlane(wv));     unsigned char* ws = ka->ws; LAS float* scr = (LAS float*)(lds + t.wave * 16384);
    bf16* wc = (bf16*)(ws + WS_WCAT) + (size_t)l * NCAT * D;
    const float* gmix = ((const float*)ka->in[I_NMIXG]) + l * D;
    if ((U_FP8_MASK >> l) & 1) tr_matrix<true>(ib, ((const float*)ka->in[I_WIN]) + (size_t)l * D * DIN, D, DIN, wc, 0, 0, scr, t.gw, t.NGW, t.lane, gmix);
    else tr_matrix(ib, ((const float*)ka->in[I_WIN]) + (size_t)l * D * DIN, D, DIN, wc, 0, 0, scr, t.gw, t.NGW, t.lane, gmix);
    for (int i = 0; i < 4; ++i) { if (GATE_FP8) tr_matrix<true>(ib, ((const float*)ka->in[I_WGATE]) + (size_t)(l * 4 + i) * D * D, D, D, (unsigned char*)(wc + (size_t)DIN * D), i * D, 0, scr, t.gw, t.NGW, t.lane, gmix);
        else tr_matrix(ib, ((const float*)ka->in[I_WGATE]) + (size_t)(l * 4 + i) * D * D, D, D, wc, DIN + i * D, 0, scr, t.gw, t.NGW, t.lane, gmix); }
    for (int i = 0; i < 4; ++i) if (i != 1) { if ((MERGE_FP8_MASK >> l) & 1) tr_matrix<true>(ib, ((const float*)ka->in[I_WBR]) + (size_t)(l * 4 + i) * 256 * D, 256, D, ws + WS_WB + (size_t)l * D * D * 2 + 256 * i, 0, 0, scr, t.gw, t.NGW, t.lane, nullptr, D);
        else tr_matrix(ib, ((const float*)ka->in[I_WBR]) + (size_t)(l * 4 + i) * 256 * D, 256, D, (bf16*)(ws + WS_WB) + (size_t)l * D * D + 256 * i, 0, 0, scr, t.gw, t.NGW, t.lane, nullptr, D); }
    if ((OUT_FP8_MASK >> l) & 1) tr_matrix<true>(ib, ((const float*)ka->in[I_WOUT]) + (size_t)l * D * D, D, D, (bf16*)(ws + WS_WOUT) + (size_t)l * D * D, 0, 0, scr, t.gw, t.NGW, t.lane);
    else tr_matrix(ib, ((const float*)ka->in[I_WOUT]) + (size_t)l * D * D, D, D, (bf16*)(ws + WS_WOUT) + (size_t)l * D * D, 0, 0, scr, t.gw, t.NGW, t.lane);
    tr_matrix(ib, ((const float*)ka->in[I_WQ]) + (size_t)l * D * 256, D, 256, (bf16*)(ws + WS_WQ) + (size_t)l * 256 * D, 0, 0, scr, t.gw, t.NGW, t.lane, ((const float*)ka->in[I_NXAG]) + l * D);
    tr_matrix(ib, ((const float*)ka->in[I_WKV]) + (size_t)l * D * 512, D, 512, (bf16*)(ws + WS_WKV) + (size_t)l * 512 * D, 0, 0, scr, t.gw, t.NGW, t.lane);
    tr_matrix(ib, ((const float*)ka->in[I_WO]) + (size_t)l * 256 * D, 256, D, (bf16*)(ws + WS_WO) + (size_t)l * D * 256, 0, 0, scr, t.gw, t.NGW, t.lane);
    return ib;
}
PHN unsigned ph_w_ffn(KArgs ka, int wv, LAS unsigned char* lds, int s, unsigned ib) {
    const Ids t = ids(__builtin_amdgcn_readfirstlane(wv));     unsigned char* ws = ka->ws; LAS float* scr = (LAS float*)(lds + t.wave * 16384);
    if (s < 2) { const bool f8 = (F8MASK >> (2 * s)) & 1u;
        const float* gu = ((const float*)ka->in[I_FGU]) + (size_t)s * D * NGU; const float* dn = ((const float*)ka->in[I_FDN]) + (size_t)s * DFF * D;
        unsigned char* wgu = ws + WS_WGUD + (size_t)s * NGU * D * 2; unsigned char* wdn = ws + WS_WDND + (size_t)s * D * DFF * 2;
        const float* gf = ((const float*)ka->in[I_NFFNG]) + (2 * s) * D;
        if (f8) { if constexpr (DENSE_ANY8) { tr_matrix<true>(ib, gu, D, NGU, wgu, 0, 1, scr, t.gw, t.NGW, t.lane, gf); tr_matrix<true>(ib, dn, DFF, D, wdn, 0, 0, scr, t.gw, t.NGW, t.lane); } }
        else { if constexpr (DENSE_ANYB) { tr_matrix<false>(ib, gu, D, NGU, wgu, 0, 1, scr, t.gw, t.NGW, t.lane, gf); tr_matrix<false>(ib, dn, DFF, D, wdn, 0, 0, scr, t.gw, t.NGW, t.lane); } }
    } else { const int k = s - 2; const bool f8 = (F8MASK >> (2 * (k >> 3) + 1)) & 1u;
        const float* gu = ((const float*)ka->in[I_MGU]) + (size_t)k * D * NGU; const float* dn = ((const float*)ka->in[I_MDN]) + (size_t)k * DFF * D;
        unsigned char* wgu = ws + WS_WGUM + (size_t)k * NGU * D * 2; unsigned char* wdn = ws + WS_WDNM + (size_t)k * D * DFF * 2;
        if (f8) { if constexpr (MOE_ANY8) { tr_matrix<true>(ib, gu, D, NGU, wgu, 0, 1, scr, t.gw, t.NGW, t.lane); tr_matrix<true>(ib, dn, DFF, D, wdn, 0, 0, scr, t.gw, t.NGW, t.lane); } }
        else { if constexpr (MOE_ANYB) { tr_matrix<false>(ib, gu, D, NGU, wgu, 0, 1, scr, t.gw, t.NGW, t.lane); tr_matrix<false>(ib, dn, DFF, D, wdn, 0, 0, scr, t.gw, t.NGW, t.lane); } }
    }
    return ib;
}
PHN void ph_misc0(KArgs ka, int wv) {
    const Ids t = ids(__builtin_amdgcn_readfirstlane(wv));     unsigned char* ws = ka->ws;
    { const float* pool_w = ((const float*)ka->in[I_POOLW]); const float* pool_scale = ((const float*)ka->in[I_POOLS]); const float* w_branch = ((const float*)ka->in[I_WBR]); bf16* WB = (bf16*)(ws + WS_WB);
      for (int idx = t.wg * NTHR + t.tid; idx < DEPTH * 1024 * 256; idx += t.G * NTHR) {
          const int l = idx >> 18, n = (idx >> 8) & 1023, gc = idx & 255, g = gc >> 6;
          const float* pw = pool_w + ((size_t)(l * 4) * 64 + gc) * 64; const float* ps = pool_scale + l * 256 + 64 * g; const float* wb = w_branch + ((size_t)(l * 4 + 1) * 256 + 64 * g) * D + n;
          float s = 0.f;
          for (int d = 0; d < 64; ++d) s += pw[d] * ps[d] * wb[(size_t)d * D];
          if ((MERGE_FP8_MASK >> l) & 1) ((unsigned char*)(WB + (size_t)l * D * D))[(size_t)n * D + 256 + gc] = (unsigned char)(cvt4_fp8(s * W8_SCALE, 0.f, 0.f, 0.f) & 0xffu);
          else WB[(size_t)l * D * D + (size_t)n * D + 256 + gc] = (bf16)(cvtpk(s, 0.f) & 0xffffu); } }
    { const float* mem = ((const float*)ka->in[I_MEM]); const float* gm = ((const float*)ka->in[I_NMEMG]); bf16* MEMH = (bf16*)(ws + WS_MEMH);
      for (int it = t.gw; it < DEPTH * MMEM; it += t.NGW) { const int l = it / MMEM, rw = it - l * MMEM; rms_row_bf16(mem + (size_t)rw * D, gm + l * D, MEMH + (size_t)it * D, t.lane); } }
    { const int* positions = ((const int*)ka->in[I_POS]); f32x2* ROT = (f32x2*)(ws + WS_ROT);
      for (int idx = t.wg * NTHR + t.tid; idx < MTOT * 32; idx += t.G * NTHR) { const int tok = idx >> 5, i = idx & 31;
          const float ang = (float)positions[tok] * INV_FREQ[i]; double rev = (double)ang * 0.15915494309189535; rev -= floor(rev); const float rv = (float)rev;
          ROT[idx] = (f32x2){__builtin_amdgcn_cosf(rv), __builtin_amdgcn_sinf(rv)}; } }
}
PH void ph_kv(int wv, LAS unsigned char* lds) {
    const Ids t = ids(wv); unsigned char* ws = KA()->ws;
    pg8::OrdKV S; S.to.init(DEPTH * (MMEM / 256), 2, t.G, t.wg); S.A = (const char*)(ws + WS_MEMH); S.B = (const char*)(ws + WS_WKV);
    pg8::EpiBf16<false> E{(bf16*)(ws + WS_KV), 512, nullptr};
    pg8::gemm_phase<pg8::EpiBf16<false>, pg8::OrdKV>(lds, D, D, S, E, t.wave);
}
PHN void ph_knorm(KArgs ka, int wv) {
    const Ids t = ids(__builtin_amdgcn_readfirstlane(wv));     unsigned char* ws = ka->ws; unsigned* ctl = (unsigned*)(ws + WS_CTL); bf16* KV = (bf16*)(ws + WS_KV); const float* xa_kg = ((const float*)ka->in[I_KG]);
    for (int it = t.gw; it < DEPTH * MMEM; it += t.NGW) { const int l = it / MMEM, rw = it - l * MMEM, b = rw >> 8; const int lane = t.lane;
        if (lane < 32) { bf16* kp = KV + (size_t)it * 512 + 8 * lane; const u32x4 w = *(const u32x4*)kp; float f[8]; unpack8(w, f); float ss = 0.f;
#pragma unroll
            for (int j = 0; j < 8; ++j) ss += f[j] * f[j];
            ss += SHX(ss, 1, lane); ss += SHX(ss, 2, lane); ss += SHX(ss, 4, lane);
            const float rs = 1.f / sqrtf(ss * (1.f / 64.f) + EPS); const float* gk = xa_kg + l * 64 + 8 * (lane & 7); float n2 = 0.f;
#pragma unroll
            for (int j = 0; j < 8; ++j) { f[j] *= rs * gk[j]; n2 += f[j] * f[j]; }
            *(u32x4*)kp = pack8(f);
            n2 += SHX(n2, 1, lane); n2 += SHX(n2, 2, lane); n2 += SHX(n2, 4, lane);
            if ((lane & 7) == 0) atomicMax(ctl + CW_KMAX + (l * NB + b) * 4 + (lane >> 3), __float_as_uint(n2 * 1.02f)); } }
}
PHN void ph_xprep(KArgs ka, int wv, int g, int from_in) {
    const Ids t = ids(__builtin_amdgcn_readfirstlane(wv));
    unsigned char* ws = ka->ws; const size_t grow = (size_t)g * MG;
    const float* src = from_in ? (((const float*)ka->in[I_X]) + grow * D) : (ka->out + grow * D);
    bf16* XB = (bf16*)(ws + WS_XB); float* ssq = (float*)(ws + WS_SSQ); const int lane = t.lane;
    f32x4 nv[4];
    { const f32x4* xr = (const f32x4*)(src + (size_t)(t.gw < MG ? t.gw : 0) * D) + lane;
#pragma unroll
      for (int j = 0; j < 4; ++j) nv[j] = xr[64 * j]; }
    for (int m = t.gw; m < MG; m += t.NGW) {
        f32x4 v[4]; float s = 0.f;
#pragma unroll
        for (int j = 0; j < 4; ++j) { v[j] = nv[j]; s += (v[j].x * v[j].x + v[j].y * v[j].y) + (v[j].z * v[j].z + v[j].w * v[j].w); }
        { const int mn = (m + t.NGW < MG) ? (m + t.NGW) : m; const f32x4* xr = (const f32x4*)(src + (size_t)mn * D) + lane;
#pragma unroll
          for (int j = 0; j < 4; ++j) nv[j] = xr[64 * j]; }
        s = wave_sum(s, lane);
        u32x2* o8 = (u32x2*)(XB + (size_t)m * D) + lane;
#pragma unroll
        for (int j = 0; j < 4; ++j) { u32x2 w; w.x = cvtpk(v[j].x, v[j].y); w.y = cvtpk(v[j].z, v[j].w); o8[64 * j] = w; }
        if (GATE_FP8) { unsigned* o4 = (unsigned*)(ws + WS_XB8 + (size_t)m * D) + lane;
#pragma unroll
            for (int j = 0; j < 4; ++j) o4[64 * j] = cvt4_fp8(v[j].x, v[j].y, v[j].z, v[j].w); }
        if (lane < 16) ssq[(size_t)m * 16 + lane] = lane == 0 ? s : 0.f; }
}
PH void ph_gemm1(int wv, LAS unsigned char* lds, int l, int parts = 3) {
    asm volatile("" : "+s"(l));
    const Ids t = ids(wv); unsigned char* ws = KA()->ws; bf16* wcat = (bf16*)(ws + WS_WCAT) + (size_t)l * NCAT * D;
#pragma nounroll
    for (int s = 0; s < 2; ++s) {
        if (s == 0) { if (parts & 1) {
            if constexpr (U_FP8_MASK != 0 && GATE_FP8 != 0) if ((U_FP8_MASK >> l) & 1) {
                pg8::OrdStd S; S.to.init(MG / 256, DIN / 256, t.G, t.wg); S.A = (const char*)(ws + WS_XB8); S.B = (const char*)wcat; S.atile = 256 * D; S.btile = 256 * D;
                pg8::EpiCat<false, true> E{(bf16*)(ws + WS_U), (bf16*)(ws + WS_GATES), (const float*)(ws + WS_SSQ)};
                pg8::gemm_phase<pg8::EpiCat<false, true>, pg8::OrdStd, true>(lds, D, D, S, E, t.wave); continue; }
            pg8::OrdStd S; S.to.init(MG / 256, (GATE_FP8 ? DIN : NCAT) / 256, t.G, t.wg); S.A = (const char*)(ws + WS_XB); S.B = (const char*)wcat; S.atile = 256 * D * 2; S.btile = 256 * D * 2;
            pg8::EpiCat<false> E{(bf16*)(ws + WS_U), (bf16*)(ws + WS_GATES), (const float*)(ws + WS_SSQ)};
            pg8::gemm_phase<pg8::EpiCat<false>, pg8::OrdStd>(lds, D, D, S, E, t.wave); } }
        else { if constexpr (GATE_FP8 != 0) if (parts & 14) {
            pg8::OrdStd S; S.to.init(MG / 256, 4096 / 256, t.G, t.wg); if (parts & 4) { S.i0 = 0; S.ni = 4; } else if (parts & 8) { S.i0 = 4; S.ni = 1 << 30; } S.A = (const char*)(ws + WS_XB8); S.B = (const char*)(wcat + (size_t)DIN * D); S.atile = 256 * D; S.btile = 256 * D;
            pg8::EpiCat<true> E{(bf16*)(ws + WS_U), (bf16*)(ws + WS_GATES), (const float*)(ws + WS_SSQ)};
            pg8::gemm_phase<pg8::EpiCat<true>, pg8::OrdStd, true>(lds, D, D, S, E, t.wave); } }
    }
}
constexpr int NSB = BG * 4 * 16, NRC = BG * 4 * 16, NCONV = BG * 64, NPOOL = BG * 64;
PH void ph_mix(int wv, LAS unsigned char* lds, int g, int l, int part, int rep = 0, int jlo = 0, int jhi = 1 << 30) {
    asm volatile("" : "+s"(l));
    const Ids t = ids(wv); unsigned char* ws = KA()->ws; unsigned* ctl = (unsigned*)(ws + WS_CTL);
    volatile LAS unsigned* MISC = (volatile LAS unsigned*)(lds + MISC_OFF);
    unsigned* qctr = ctl + CW_QCTR + 64 * ((g * 4 + l) * 2 + part + 16 * rep);
    const bf16* UB = (const bf16*)(ws + WS_U); bf16* YB = (bf16*)(ws + WS_Y); float* KVS = (float*)(ws + WS_KVS); const f32x2* ROT = (const f32x2*)(ws + WS_ROT);
    const int NUQ = part == 0 ? (NSB + NRC + NPOOL) : (NRC + NCONV); const int y8 = (MERGE_FP8_MASK >> l) & 1;
    (void)qctr; (void)MISC;
    const int NV = (t.G & 7) ? 1 : 8, v = t.wg % NV, r = t.wg / NV, per = t.G / NV, NUL = NUQ / BG;
    for (int idx = r; idx < NUL * (BG / NV); idx += per) { const int bl = v + NV * (idx / NUL), j = idx % NUL;
        if (j < jlo || j >= jhi) continue;
        if (part == 0) {
            if (j < 64) { __syncthreads(); if (t.tid == 0) { MISC[2] = 0u; MISC[3] = 0u; } __syncthreads(); sb_unit(UB, YB, y8, bl, j & 3, 15 - (j >> 2), lds, t.tid, t.wave, t.lane); }
            else if (j < 128) { const int k = j - 64; retkv_unit(UB, KVS, ROT, bl, (g * BG + bl) * SEQ, (k >> 4) & 3, k & 15, lds, t.tid, t.wave, t.lane); }
            else { const int k = j - 128; pool_unit(UB, YB, y8, bl, k & 63, lds, t.tid); }
        } else {
            if (j < 64) { reto_unit(UB, YB, y8, KVS, ROT, bl, (g * BG + bl) * SEQ, (j >> 4) & 3, j & 15, lds, t.tid, t.wave, t.lane); }
            else { const int k = j - 64;
                conv_unit(UB, YB, y8, KIN(float, I_CONVW) + (size_t)l * 31 * 256, KIN(float, I_CONVB) + l * 256, KIN(float, I_CLNG) + l * 256, KIN(float, I_CLNB) + l * 256, bl, k & 63, lds, t.tid, t.wave, t.lane); }
        }
    }
}
PH void ph_merge(int wv, LAS unsigned char* lds, int l) {
    asm volatile("" : "+s"(l));
    const Ids t = ids(wv); unsigned char* ws = KA()->ws;
    pg8::OrdMerge S; S.G = t.G; S.c = t.wg; S.ntiles = (MG / 256) * 8; S.A = (const char*)(ws + WS_Y); S.B = (const char*)((bf16*)(ws + WS_WB) + (size_t)l * D * D);
    if constexpr ((MERGE_FP8_MASK != 0) && GATE_FP8) if ((MERGE_FP8_MASK >> l) & 1) { S.esz = 1;
        pg8::EpiMerge E{(const bf16*)(ws + WS_GATES), (bf16*)(ws + WS_MERGED), (int)((OUT_FP8_MASK >> l) & 1), 1.f / (255.f * 8.f * W8_SCALE)};
        pg8::gemm_phase<pg8::EpiMerge, pg8::OrdMerge, true, true>(lds, D, D, S, E, t.wave); return; }
    S.esz = 2;
    pg8::EpiMerge E{(const bf16*)(ws + WS_GATES), (bf16*)(ws + WS_MERGED), (int)((OUT_FP8_MASK >> l) & 1), 1.f / 255.f};
    pg8::gemm_phase<pg8::EpiMerge, pg8::OrdMerge, false, true>(lds, D, D, S, E, t.wave);
}
PH void ph_res(int wv, LAS unsigned char* lds, int g, int l, int which, int xbm) {
    asm volatile("" : "+s"(l));
    const Ids t = ids(wv); unsigned char* ws = KA()->ws; (void)g; (void)l;
    if constexpr (OUT_FP8_MASK != 0) if (which == 0 && ((OUT_FP8_MASK >> l) & 1)) {
        pg8::OrdStd S; S.to.init(MG / 256, 4, t.G, t.wg); S.A = (const char*)(ws + WS_MERGED); S.B = (const char*)((bf16*)(ws + WS_WOUT) + (size_t)l * D * D); S.atile = (size_t)256 * D; S.btile = (size_t)256 * D;
        pg8::EpiRes<true, true, 2> E{(bf16*)(ws + WS_XB), xbm, (float*)(ws + WS_SSQ), ws + WS_HB};
        pg8::gemm_phase<pg8::EpiRes<true, true, 2>, pg8::OrdStd, true>(lds, D, D, S, E, t.wave);
        return; }
    int K; const char* A; const char* B;
    if (which == 0) { K = D; A = (const char*)(ws + WS_MERGED); B = (const char*)((bf16*)(ws + WS_WOUT) + (size_t)l * D * D); }
    else { K = 256; A = (const char*)(ws + WS_OB); B = (const char*)((bf16*)(ws + WS_WO) + (size_t)l * D * 256); }
    pg8::OrdStd S; S.to.init(MG / 256, 4, t.G, t.wg); S.A = A; S.B = B; S.atile = (size_t)256 * K * 2; S.btile = (size_t)256 * K * 2;
    pg8::EpiRes<true, false> E{(bf16*)(ws + WS_XB), xbm, (float*)(ws + WS_SSQ), ws + WS_HB};
    pg8::gemm_phase<pg8::EpiRes<true, false>, pg8::OrdStd>(lds, K, K, S, E, t.wave);
}
template <bool F8> PH void ph_down(int wv, LAS unsigned char* lds, int g, int l, int xbm) {
    asm volatile("" : "+s"(l));
    constexpr int FE = F8 ? 1 : 2;
    const Ids t = ids(wv); unsigned char* ws = KA()->ws; (void)g;
    pg8::OrdStd S; S.to.init(MG / 256, 4, t.G, t.wg); S.A = (const char*)(ws + WS_ACTD); S.B = (const char*)(ws + WS_WDND + (size_t)(l >> 1) * D * DFF * 2); S.atile = (size_t)256 * DFF * FE; S.btile = (size_t)256 * DFF * FE;
    pg8::EpiRes<true, F8> E{(bf16*)(ws + WS_XB), xbm, (float*)(ws + WS_SSQ), ws + WS_XB8};
    pg8::gemm_phase<pg8::EpiRes<true, F8>, pg8::OrdStd, F8>(lds, DFF, DFF, S, E, t.wave);
}
PH void ph_q(int wv, LAS unsigned char* lds, int l) {
    asm volatile("" : "+s"(l));
    const Ids t = ids(wv); unsigned char* ws = KA()->ws;
    pg8::OrdQ S; S.to.init(MG / 256, 2, t.G, t.wg); S.A = (const char*)(ws + WS_XB); S.B = (const char*)((bf16*)(ws + WS_WQ) + (size_t)l * 256 * D);
    pg8::EpiBf16<false> E{(bf16*)(ws + WS_QB), 512, (const float*)(ws + WS_SSQ)};
    pg8::gemm_phase<pg8::EpiBf16<false>, pg8::OrdQ>(lds, D, D, S, E, t.wave, 512);
}
PH void ph_xa(int wv, LAS unsigned char* lds, int g, int l) {
    asm volatile("" : "+s"(l));
    const Ids t = ids(wv); unsigned char* ws = KA()->ws; const unsigned* ctl = (const unsigned*)(ws + WS_CTL);
    const int NV = (t.G & 7) ? 1 : 8, v = t.wg % NV, r = t.wg / NV, per = t.G / NV;
    for (int idx = r; idx < 64 * (BG / NV); idx += per) { const int bl = v + NV * (idx >> 6), j = idx & 63, hd = (j >> 4) & 3, qblk = j & 15, bglob = g * BG + bl;
        const float kmax = sqrtf(__uint_as_float(ctl[CW_KMAX + (l * NB + bglob) * 4 + hd]));
        xa_unit((const bf16*)(ws + WS_QB), (const bf16*)(ws + WS_KV) + (size_t)l * MMEM * 512, KIN(float, I_QG) + l * 64, kmax, (bf16*)(ws + WS_OB), bl, bglob, hd, qblk, lds, t.tid, t.wave, t.lane); }
}
template <bool F8> PH void ph_gu(int wv, LAS unsigned char* lds, int l) {
    asm volatile("" : "+s"(l));
    constexpr int FE = F8 ? 1 : 2;
    const Ids t = ids(wv); unsigned char* ws = KA()->ws;
    pg8::OrdStd S; S.to.init(MG / 256, NGU / 256, t.G, t.wg); S.A = (const char*)(ws + (F8 ? WS_HB : WS_XB)); S.B = (const char*)(ws + WS_WGUD + (size_t)(l >> 1) * NGU * D * 2); S.atile = 256 * D * FE; S.btile = 256 * D * FE;
    pg8::EpiGU<F8> E{(void*)(ws + WS_ACTD), (const float*)(ws + WS_SSQ)};
    pg8::gemm_phase<pg8::EpiGU<F8>, pg8::OrdStd, F8>(lds, D, D, S, E, t.wave);
}
struct MoeCtx { int rpw, r_lo, r_hi; };
DI MoeCtx moe_ctx(const Ids& t) { MoeCtx c; c.rpw = (MG + t.G - 1) / t.G; const int blk = (t.G & 7) ? t.wg : (t.wg & 7) * (t.G >> 3) + (t.wg >> 3);        c.r_lo = blk * c.rpw; c.r_hi = (c.r_lo + c.rpw < MG) ? (c.r_lo + c.rpw) : MG; return c; }
template <bool F8> PH void ph_route(int wv, LAS unsigned char* lds, int g, int l) {
    asm volatile("" : "+s"(l));
    constexpr int FE = F8 ? 1 : 2;
    const Ids t = ids(wv); unsigned char* ws = KA()->ws; unsigned* ctl = (unsigned*)(ws + WS_CTL); const int l2 = l >> 1, inst = g * 2 + l2;
    unsigned* wgcnt = ctl + CW_WGCNT + inst * 8192; const MoeCtx mc = moe_ctx(t);
    volatile LAS unsigned* LC = (volatile LAS unsigned*)(lds + MISC_OFF) + 16;
    const bf16* XBr = (const bf16*)(ws + WS_XB); bf16* HB = (bf16*)(ws + WS_HB); (void)g;
    int* R_E = (int*)(ws + WS_ROUTE); float* R_W1 = (float*)(R_E + MG); float* R_W2 = R_W1 + MG;
    if (t.tid < 16) LC[t.tid] = 0u;
    __syncthreads();
    const float* rt = KIN(float, I_ROUTER) + (size_t)l2 * D * NEXP; const float* gn = KIN(float, I_NFFNG) + l * D; const int lane = t.lane;
    LAS f32x4* RW = (LAS f32x4*)lds;
    for (int f = t.tid; f < D * 2; f += NTHR) { const int k = f >> 1, half = f & 1, ln = (k & 255) >> 2, j = k >> 8, q = k & 3; RW[(2 * (4 * j + q) + half) * 64 + ln] = *((const f32x4*)rt + f); }
    f32x4 gg4[4];
#pragma unroll
    for (int j = 0; j < 4; ++j) gg4[j] = *((const f32x4*)gn + lane + 64 * j);
    __syncthreads();
    u32x2 xw[4];
    { const int m0 = mc.r_lo + t.wave; const u32x2* xr = (const u32x2*)(XBr + (size_t)(m0 < mc.r_hi ? m0 : mc.r_lo) * D) + lane;
#pragma unroll
      for (int j = 0; j < 4; ++j) xw[j] = xr[64 * j]; }
    for (int m = mc.r_lo + t.wave; m < mc.r_hi; m += NWAVES) {
        f32x4 v[4]; float s = 0.f;
#pragma unroll
        for (int j = 0; j < 4; ++j) { const u32x2 w = xw[j]; v[j] = (f32x4){bflo(w.x), bfhi(w.x), bflo(w.y), bfhi(w.y)}; s += (v[j].x * v[j].x + v[j].y * v[j].y) + (v[j].z * v[j].z + v[j].w * v[j].w); }
        { const int mn = (m + NWAVES < mc.r_hi) ? (m + NWAVES) : m; const u32x2* xr = (const u32x2*)(XBr + (size_t)mn * D) + lane;
#pragma unroll
          for (int j = 0; j < 4; ++j) xw[j] = xr[64 * j]; }
        const float rstd = 1.f / sqrtf(wave_sum(s, lane) * (1.f / D) + EPS);
        float lg[8];
#pragma unroll
        for (int e = 0; e < 8; ++e) lg[e] = 0.f;
        u32x2* o8 = (u32x2*)(HB + (size_t)m * D) + lane; unsigned* o4 = (unsigned*)((unsigned char*)HB + (size_t)m * D) + lane;
#pragma unroll
        for (int j = 0; j < 4; ++j) { const f32x4 gg = gg4[j]; const f32x4 hn = v[j] * rstd * gg;
            if (F8) o4[64 * j] = cvt4_fp8(hn.x, hn.y, hn.z, hn.w);
            else { u32x2 w; w.x = cvtpk(hn.x, hn.y); w.y = cvtpk(hn.z, hn.w); o8[64 * j] = w; }
#pragma unroll
            for (int q = 0; q < 4; ++q) { const f32x4 r0 = RW[(2 * (4 * j + q)) * 64 + lane], r1 = RW[(2 * (4 * j + q) + 1) * 64 + lane]; const float hv = hn[q];
                lg[0] += hv * r0.x; lg[1] += hv * r0.y; lg[2] += hv * r0.z; lg[3] += hv * r0.w; lg[4] += hv * r1.x; lg[5] += hv * r1.y; lg[6] += hv * r1.z; lg[7] += hv * r1.w; } }
        {
          const float p0 = fold32(lg[0], lg[4]), p1 = fold32(lg[1], lg[5]), p2 = fold32(lg[2], lg[6]), p3 = fold32(lg[3], lg[7]);
          const float q0 = row_sum16(fold16(p0, p2)), q1 = row_sum16(fold16(p1, p3));
#pragma unroll
          for (int rw = 0; rw < 4; ++rw) { lg[2 * rw] = __builtin_bit_cast(float, __builtin_amdgcn_readlane(__builtin_bit_cast(int, q0), 16 * rw)); lg[2 * rw + 1] = __builtin_bit_cast(float, __builtin_amdgcn_readlane(__builtin_bit_cast(int, q1), 16 * rw)); } }
        float v1 = lg[0]; int i1 = 0;
#pragma unroll
        for (int e = 1; e < 8; ++e) if (lg[e] > v1) { v1 = lg[e]; i1 = e; }
        float v2 = -3.0e38f; int i2 = -1;
#pragma unroll
        for (int e = 0; e < 8; ++e) if (e != i1 && (i2 < 0 || lg[e] > v2)) { v2 = lg[e]; i2 = e; }
        const float w1 = 1.f / (1.f + __expf(v2 - v1));
        if (lane == 0) { R_E[m] = i1 | (i2 << 8); R_W1[m] = w1; R_W2[m] = 1.f - w1;
            __hip_atomic_fetch_add((LAS unsigned*)&LC[i1], 1u, __ATOMIC_RELAXED, __HIP_MEMORY_SCOPE_WORKGROUP); __hip_atomic_fetch_add((LAS unsigned*)&LC[i2], 1u, __ATOMIC_RELAXED, __HIP_MEMORY_SCOPE_WORKGROUP); }
    }
    __syncthreads();
    if (t.tid < 8) wgcnt[t.wg * 8 + t.tid] = LC[t.tid];
}
template <bool F8> PHN void ph_gather(KArgs ka, int wv, LAS unsigned char* lds, int g, int l) {
    constexpr int FE = F8 ? 1 : 2;
    const Ids t = ids(__builtin_amdgcn_readfirstlane(wv));     unsigned char* ws = ka->ws; unsigned* ctl = (unsigned*)(ws + WS_CTL); const int l2 = l >> 1, inst = g * 2 + l2;
    unsigned* wgcnt = ctl + CW_WGCNT + inst * 8192; unsigned* moff = ctl + CW_MOFF + 64 * inst; const MoeCtx mc = moe_ctx(t);
    volatile LAS unsigned* LC = (volatile LAS unsigned*)(lds + MISC_OFF) + 16;
    const bf16* HB = (const bf16*)(ws + WS_HB); bf16* HP = (bf16*)(ws + WS_HP);
    const int* R_E = (const int*)(ws + WS_ROUTE); int* R_S1 = (int*)(ws + WS_ROUTE) + 3 * MG; int* R_S2 = R_S1 + MG;
    if (t.tid < 16) LC[t.tid] = 0u;
    __syncthreads();
    for (int idx = t.tid; idx < t.G * 8; idx += NTHR) { const unsigned v = wgcnt[idx]; const int e = idx & 7;
        __hip_atomic_fetch_add((LAS unsigned*)&LC[8 + e], v, __ATOMIC_RELAXED, __HIP_MEMORY_SCOPE_WORKGROUP);
        if ((idx >> 3) < t.wg) __hip_atomic_fetch_add((LAS unsigned*)&LC[e], v, __ATOMIC_RELAXED, __HIP_MEMORY_SCOPE_WORKGROUP); }
    __syncthreads();
    if (t.tid == 0) { unsigned o = 0;
        for (int e = 0; e < 8; ++e) { const unsigned tot = LC[8 + e]; if (t.wg == 0) moff[e] = o; LC[e] = LC[e] + o; o += (tot + 255u) & ~255u; }
        if (t.wg == 0) moff[8] = o; }
    __syncthreads();
    const int lane = t.lane;
    LAS unsigned char* EX = (LAS unsigned char*)lds; LAS unsigned* SL = (LAS unsigned*)(lds + 8192); const int npairs = 2 * (mc.r_hi - mc.r_lo);
    for (int p = t.tid; p < npairs; p += NTHR) { const int ee = R_E[mc.r_lo + (p >> 1)]; EX[p] = (unsigned char)((p & 1) ? (ee >> 8) : (ee & 255)); }
    __syncthreads();
    for (int p = t.tid; p < npairs; p += NTHR) { const unsigned e = EX[p]; unsigned rank = 0;
        for (int q = 0; q < p; ++q) rank += (EX[q] == e) ? 1u : 0u;
        const unsigned s = LC[e] + rank; SL[p] = s; if (p & 1) R_S2[mc.r_lo + (p >> 1)] = (int)s; else R_S1[mc.r_lo + (p >> 1)] = (int)s; }
    __syncthreads();
    for (int mb = mc.r_lo + t.wave; mb < mc.r_hi; mb += NWAVES * 64) {
        const int mrow = mb + NWAVES * lane; int s1v = 0, s2v = 0;
        if (mrow < mc.r_hi) { s1v = (int)SL[2 * (mrow - mc.r_lo)]; s2v = (int)SL[2 * (mrow - mc.r_lo) + 1]; }
        const int nr = (mc.r_hi - mb + NWAVES - 1) / NWAVES, nrow = nr < 64 ? nr : 64;
        for (int i0 = 0; i0 < nrow; i0 += 4) {
            u32x4 a[4], b[4]; int s1[4], s2[4];
#pragma unroll
            for (int k = 0; k < 4; ++k) { const int i = (i0 + k < nrow) ? (i0 + k) : (nrow - 1); const size_t m = (size_t)(mb + NWAVES * i);
                s1[k] = __builtin_amdgcn_readlane(s1v, i); s2[k] = __builtin_amdgcn_readlane(s2v, i);
                if (F8) a[k] = *((const u32x4*)((const unsigned char*)HB + m * D) + lane);
                else { const u32x4* src = (const u32x4*)(HB + m * D) + lane; a[k] = src[0]; b[k] = src[64]; } }
#pragma unroll
            for (int k = 0; k < 4; ++k) { if (i0 + k < nrow) {
                if (F8) { *((u32x4*)((unsigned char*)HP + (size_t)s1[k] * D) + lane) = a[k]; *((u32x4*)((unsigned char*)HP + (size_t)s2[k] * D) + lane) = a[k]; }
                else { u32x4* d1 = (u32x4*)(HP + (size_t)s1[k] * D) + lane; u32x4* d2 = (u32x4*)(HP + (size_t)s2[k] * D) + lane; d1[0] = a[k]; d1[64] = b[k]; d2[0] = a[k]; d2[64] = b[k]; } } } }
    }
}
template <bool F8> PH void ph_moe_gu(int wv, LAS unsigned char* lds, int g, int l) {
    asm volatile("" : "+s"(l));
    constexpr int FE = F8 ? 1 : 2;
    const Ids t = ids(wv); unsigned char* ws = KA()->ws; const unsigned* ctl = (const unsigned*)(ws + WS_CTL); const int l2 = l >> 1, inst = g * 2 + l2; const unsigned* moff = ctl + CW_MOFF + 64 * inst;
    pg8::OrdMoe S;
#pragma unroll
    for (int e = 0; e < 9; ++e) S.off[e] = __builtin_amdgcn_readfirstlane((int)moff[e]);
    S.to.init(S.off[8] >> 8, NGU / 256, t.G, t.wg); S.A = (const char*)(ws + WS_HP); S.B = (const char*)(ws + WS_WGUM + (size_t)l2 * NEXP * NGU * D * 2); S.atile = 256 * D * FE; S.btile = 256 * D * FE; S.bexp = (size_t)NGU * D * 2;
    pg8::EpiGU<F8, false> E{(void*)(ws + WS_ACT), nullptr};
    pg8::gemm_phase<pg8::EpiGU<F8, false>, pg8::OrdMoe, F8>(lds, D, D, S, E, t.wave);
}
template <bool F8> PH void ph_moe_dn(int wv, LAS unsigned char* lds, int g, int l) {
    asm volatile("" : "+s"(l));
    constexpr int FE = F8 ? 1 : 2;
    const Ids t = ids(wv); unsigned char* ws = KA()->ws; const unsigned* ctl = (const unsigned*)(ws + WS_CTL); const int l2 = l >> 1, inst = g * 2 + l2; const unsigned* moff = ctl + CW_MOFF + 64 * inst;
    pg8::OrdMoe S;
#pragma unroll
    for (int e = 0; e < 9; ++e) S.off[e] = __builtin_amdgcn_readfirstlane((int)moff[e]);
    const int nrt = S.off[8] >> 8, nfull = (F8 && nrt > 256) ? 256 : nrt;
    S.to.init(nfull, 4, t.G, t.wg); S.A = (const char*)(ws + WS_ACT); S.B = (const char*)(ws + WS_WDNM + (size_t)l2 * NEXP * D * DFF * 2); S.atile = (size_t)256 * DFF * FE; S.btile = (size_t)256 * DFF * FE; S.bexp = (size_t)D * DFF * 2;
    pg8::EpiBf16<F8> E{(bf16*)(ws + WS_HP), D, nullptr};
    pg8::gemm_phase<pg8::EpiBf16<F8>, pg8::OrdMoe, F8>(lds, DFF, DFF, S, E, t.wave);
    if constexpr (F8) if (nrt > 256) {
        const int kh = t.wg >> 5;
        if (kh < 4) { S.pm0 = 256; S.koff = (size_t)kh * 768; S.to.init(nrt - 256, 4, t.G, t.wg & 31);
            pg8::EpiBf16<F8> E2{kh == 0 ? (bf16*)(ws + WS_HP) : (bf16*)(ws + WS_HPX + (size_t)(kh - 1) * 4 * MiB) - (size_t)65536 * D, D, nullptr};
            pg8::gemm_phase<pg8::EpiBf16<F8>, pg8::OrdMoe, F8>(lds, DFF, DFF, S, E2, t.wave, kh < 3 ? 768 : 512); } }
}
PHN void ph_combine(KArgs ka, int wv, int g, int xbm) {
    const Ids t = ids(__builtin_amdgcn_readfirstlane(wv));
    unsigned char* ws = ka->ws; float* xo = ka->out + (size_t)g * MG * D; const bf16* HP = (const bf16*)(ws + WS_HP);
    const int* R_E = (const int*)(ws + WS_ROUTE); const float* R_W1 = (const float*)(R_E + MG); const float* R_W2 = R_W1 + MG; const int* R_S1 = (const int*)(R_W2 + MG); const int* R_S2 = R_S1 + MG;
    const int lane = t.lane;
    bf16* XB = (bf16*)(ws + WS_XB); float* ssq = (float*)(ws + WS_SSQ);
    const MoeCtx mc = moe_ctx(t);
    for (int mb = mc.r_lo + t.wave; mb < mc.r_hi; mb += NWAVES * 64) {
        const int mrow = mb + NWAVES * lane; int s1v = 0, s2v = 0; float w1v = 0.f, w2v = 0.f;
        if (mrow < mc.r_hi) { s1v = R_S1[mrow]; s2v = R_S2[mrow]; w1v = R_W1[mrow]; w2v = R_W2[mrow]; }
        const int nr = (mc.r_hi - mb + NWAVES - 1) / NWAVES, nrow = nr < 64 ? nr : 64;
        for (int i0 = 0; i0 < nrow; i0 += 2) {
            u32x4 xa[2][2], pa[2][2], pb[2][2]; float w1[2], w2[2]; size_t mm[2]; int sl1[2], sl2[2];
#pragma unroll
            for (int k = 0; k < 2; ++k) { const int i = (i0 + k < nrow) ? (i0 + k) : (nrow - 1); mm[k] = (size_t)(mb + NWAVES * i);
                const int s1 = __builtin_amdgcn_readlane(s1v, i), s2 = __builtin_amdgcn_readlane(s2v, i); sl1[k] = s1; sl2[k] = s2;
                w1[k] = __builtin_bit_cast(float, __builtin_amdgcn_readlane(__builtin_bit_cast(int, w1v), i)); w2[k] = __builtin_bit_cast(float, __builtin_amdgcn_readlane(__builtin_bit_cast(int, w2v), i));
                const u32x4* px = (const u32x4*)(XB + mm[k] * D) + lane; const u32x4* p1 = (const u32x4*)(HP + (size_t)s1 * D) + lane; const u32x4* p2 = (const u32x4*)(HP + (size_t)s2 * D) + lane;
                xa[k][0] = px[0]; xa[k][1] = px[64]; pa[k][0] = p1[0]; pa[k][1] = p1[64]; pb[k][0] = p2[0]; pb[k][1] = p2[64]; }
#pragma unroll
            for (int k = 0; k < 2; ++k) { if (i0 + k < nrow) { const size_t m = mm[k]; float ssum = 0.f;
#pragma unroll
                for (int j = 0; j < 2; ++j) { float a[8], b[8], x[8]; unpack8(pa[k][j], a); unpack8(pb[k][j], b); unpack8(xa[k][j], x);
                    if (sl1[k] >= 65536) {
#pragma unroll
                        for (int p = 0; p < 3; ++p) { float t8[8]; unpack8(*((const u32x4*)((const bf16*)(ws + WS_HPX + (size_t)p * 4 * MiB) + (size_t)(sl1[k] - 65536) * D) + lane + 64 * j), t8);
#pragma unroll
                            for (int q = 0; q < 8; ++q) a[q] += t8[q]; } }
                    if (sl2[k] >= 65536) {
#pragma unroll
                        for (int p = 0; p < 3; ++p) { float t8[8]; unpack8(*((const u32x4*)((const bf16*)(ws + WS_HPX + (size_t)p * 4 * MiB) + (size_t)(sl2[k] - 65536) * D) + lane + 64 * j), t8);
#pragma unroll
                            for (int q = 0; q < 8; ++q) b[q] += t8[q]; } }
#pragma unroll
                    for (int q = 0; q < 8; ++q) x[q] += w1[k] * a[q] + w2[k] * b[q];
                    if (xbm) {
#pragma unroll
                        for (int q = 0; q < 8; ++q) ssum += x[q] * x[q];
                        *((u32x4*)(XB + m * D) + lane + 64 * j) = pack8(x);
                        if (GATE_FP8) { u32x2 w8; w8.x = cvt4_fp8(x[0], x[1], x[2], x[3]); w8.y = cvt4_fp8(x[4], x[5], x[6], x[7]); *((u32x2*)(ws + WS_XB8 + m * D) + lane + 64 * j) = w8; } }
                    else { f32x4* xr = (f32x4*)(xo + m * D) + 2 * lane + 128 * j; xr[0] = (f32x4){x[0], x[1], x[2], x[3]}; xr[1] = (f32x4){x[4], x[5], x[6], x[7]}; } }
                if (xbm) { ssum = wave_sum(ssum, lane); if (lane < 16) ssq[m * 16 + lane] = lane == 0 ? ssum : 0.f; } } } }
    }
}

__global__ void __launch_bounds__(NTHR, 2) trunk_fwd(Args args) {
    extern __shared__ __attribute__((aligned(16))) unsigned char lds_raw[];
    LAS unsigned char* lds = (LAS unsigned char*)lds_raw;
    volatile LAS unsigned* MISC = (volatile LAS unsigned*)(lds + MISC_OFF);
    const int tid = threadIdx.x; int wave = __builtin_amdgcn_readfirstlane(tid >> 6); asm volatile("" : "+s"(wave));
    unsigned* ctl = (unsigned*)(args.ws + WS_CTL);
    for (int u = tid; u < (LDS_BYTES - LDSCTL_OFF) / 4; u += NTHR) ((LAS unsigned*)(lds + LDSCTL_OFF))[u] = 0u;
    __syncthreads();
    XcdBarrier bar; bar.bar = ctl + CW_BAR; bar.x = xb_xcc_id(); bar.st = MISC + 8;
    if (tid == 0) { (void)xb_add(&bar.bar[XB_XCNT(bar.x)], 1u); (void)__hip_atomic_fetch_or(&bar.bar[XB_XMASK(blockIdx.x & 7)], 1u << bar.x, __ATOMIC_RELAXED, __HIP_MEMORY_SCOPE_AGENT); }
#define WV() ({ int _w = wave; asm volatile("" : "+s"(_w)); _w; })
#define GRID_BAR() xcd_barrier_fn((GAS unsigned*)bar.bar, bar.x, bar.st, WV())
#if LOCAL_SYNC
#define LBAR() lbar_fn((GAS unsigned*)bar.bar, bar.x, bar.st, WV(), (int)blockIdx.x, (int)(gridDim.x >> 3))
#else
#define LBAR() GRID_BAR()
#endif
    unsigned ib = 0;
    for (int l = 0; l < DEPTH; ++l) ib = ph_w_layer(KA(), WV(), lds, l, ib);
    for (int s = 0; s < 2 + 2 * NEXP; ++s) ib = ph_w_ffn(KA(), WV(), lds, s, ib);
    ph_misc0(KA(), WV());
#ifdef DUP_PRO
    for (int l = 0; l < DEPTH; ++l) ib = ph_w_layer(KA(), WV(), lds, l, ib);
    for (int s = 0; s < 2 + 2 * NEXP; ++s) ib = ph_w_ffn(KA(), WV(), lds, s, ib);
    ph_misc0(KA(), WV());
#endif
    GRID_BAR();
    if (tid == 0) {
        unsigned ok = (gridDim.x & 7u) ? 0u : 1u;
        for (int j = 0; j < 8; ++j) { const unsigned m = xb_ld(&bar.bar[XB_XMASK(j)]); ok &= (m != 0u && (m & (m - 1u)) == 0u) ? 1u : 0u; }
        MISC[12] = ok; }
    ph_kv(wave, lds);
    GRID_BAR();
    ph_knorm(KA(), WV());
    GRID_BAR();
    for (int g = 0; g < NG; ++g) {
        for (int l = 0; l < DEPTH; ++l) {
            if (l == 0) { ph_xprep(KA(), WV(), g, 1); GRID_BAR(); }
            ph_gemm1(wave, lds, l, GATE_FP8 ? 1 : 3); LBAR();
#ifdef DUP_G1
            ph_gemm1(wave, lds, l, DUP_G1); GRID_BAR();
#endif
#pragma nounroll
            for (int mp = 0; mp < 2; ++mp) { int mpo = mp; asm volatile("" : "+s"(mpo));
                ph_mix(wave, lds, g, l, mpo);
                if (GATE_FP8) ph_gemm1(wave, lds, l, GATE_SPLIT ? (mpo ? 8 : 4) : (mpo ? 2 : 0));
                LBAR(); }
#ifdef DUP_MIX_LO
            ph_mix(wave, lds, g, l, DUP_MIX_PART, 1, DUP_MIX_LO, DUP_MIX_HI); GRID_BAR();
#endif
            ph_merge(wave, lds, l); LBAR();
#ifdef DUP_BAR
            GRID_BAR(); GRID_BAR(); GRID_BAR(); GRID_BAR(); GRID_BAR(); GRID_BAR(); GRID_BAR(); GRID_BAR();
#endif
#ifdef DUP_MERGE
            ph_merge(wave, lds, l); GRID_BAR();
#endif
            ph_res(wave, lds, g, l, 0, 1); LBAR();
            ph_q(wave, lds, l); LBAR();
            ph_xa(wave, lds, g, l); LBAR();
            const bool f8 = (F8MASK >> l) & 1u; const int nxt = (l + 1 < DEPTH) ? 1 : 0;
            if ((l & 1) == 0) {
                ph_res(wave, lds, g, l, 1, f8 ? 2 : 1); LBAR();
                if (f8) { if constexpr (DENSE_ANY8) { ph_gu<true>(wave, lds, l); LBAR();
#ifdef DUP_GU8
                    ph_gu<true>(wave, lds, l); GRID_BAR();
#endif
                    ph_down<true>(wave, lds, g, l, nxt ? (GATE_FP8 ? 3 : 1) : 0); LBAR(); } }
                else { if constexpr (DENSE_ANYB) { ph_gu<false>(wave, lds, l); LBAR();
#ifdef DUP_GUB
                    ph_gu<false>(wave, lds, l); GRID_BAR();
#endif
                    ph_down<false>(wave, lds, g, l, nxt ? (GATE_FP8 ? 3 : 1) : 0); LBAR(); } }
            } else {
                ph_res(wave, lds, g, l, 1, 0); LBAR();
                if (f8) { if constexpr (MOE_ANY8) { ph_route<true>(wave, lds, g, l); GRID_BAR(); ph_gather<true>(KA(), WV(), lds, g, l); GRID_BAR(); ph_moe_gu<true>(wave, lds, g, l); GRID_BAR(); ph_moe_dn<true>(wave, lds, g, l); GRID_BAR(); } }
                else { if constexpr (MOE_ANYB) { ph_route<false>(wave, lds, g, l); GRID_BAR(); ph_gather<false>(KA(), WV(), lds, g, l); GRID_BAR(); ph_moe_gu<false>(wave, lds, g, l); GRID_BAR(); ph_moe_dn<false>(wave, lds, g, l); GRID_BAR(); } }
                ph_combine(KA(), WV(), g, nxt); if (nxt) LBAR(); else GRID_BAR();
            }
        }
    }
}

extern "C" void kernel_launch(void* const* d_in, const int* in_sizes, int n_in, void* d_out, int out_size, void* d_ws, size_t ws_size, hipStream_t stream) {
    static int grid = 0;
    if (grid == 0) {
        if (n_in != 27 || in_sizes[0] != MTOT * D || out_size != MTOT * D || ws_size < WS_END) { fprintf(stderr, "kernel_launch: unexpected problem (n_in %d, in0 %d, out %d, ws %zu < %zu)\n", n_in, n_in > 0 ? in_sizes[0] : -1, out_size, ws_size, (size_t)WS_END); grid = -1; return; }
        int dev = 0, cus = 0, per_cu = 0;
        if (hipGetDevice(&dev) != hipSuccess || hipDeviceGetAttribute(&cus, hipDeviceAttributeMultiprocessorCount, dev) != hipSuccess) { grid = -1; return; }
        if (hipFuncSetAttribute((const void*)trunk_fwd, hipFuncAttributeMaxDynamicSharedMemorySize, LDS_BYTES) != hipSuccess) { fprintf(stderr, "kernel_launch: hipFuncSetAttribute failed\n"); grid = -1; return; }
        if (hipOccupancyMaxActiveBlocksPerMultiprocessor(&per_cu, (const void*)trunk_fwd, NTHR, LDS_BYTES) != hipSuccess || per_cu < 1) fprintf(stderr, "kernel_launch: occupancy query reports %d\n", per_cu);
        (void)hipGetLastError();
        grid = cus;
    }
    if (grid < 0) return;
    if (hipMemsetAsync((char*)d_ws + WS_CTL, 0, CTL_ZERO_BYTES, stream) != hipSuccess) return;
    Args a{};
    for (int i = 0; i < 27; ++i) a.in[i] = d_in[i];
    a.out = (float*)d_out; a.ws = (unsigned char*)d_ws;
    hipLaunchKernelGGL(trunk_fwd, dim3(grid), dim3(NTHR), LDS_BYTES, stream, a);
}
```
